# Optimizing an MI355X kernel written in HIP

```python
import jax, jax.numpy as jnp
from jax import lax
import numpy as np

D_MODEL = 1024
BATCH = 4
SEQ = 4096
DEPTH = 4

CHUNK = 64
QBLK = 128
EPS = 1e-6
LN_EPS = 1e-5
MAX_POS_OFFSET = 32768

MLA_HEADS = 8
MLA_Q_RANK = 256
MLA_KV_RANK = 128
MLA_NOPE = 64
MLA_ROPE = 32
MLA_VDIM = 64
MLA_WIDTH = MLA_HEADS * MLA_VDIM
ROPE_THETA = 10000.0

GM_GROUPS = 4
GM_GROUP_CH = 128
GM_WIDTH = GM_GROUPS * GM_GROUP_CH
GM_BLOCK = 128

RW_HEADS = 8
RW_HEAD = 64
RW_WIDTH = RW_HEADS * RW_HEAD
RW_DECAY_LORA = 64
RW_A_LORA = 64
RW_V_LORA = 32
RW_LN_EPS = 64e-5

N_BRANCH = 3
BRANCH_WIDTH = 512

GM_IN = 2 * GM_WIDTH
RW_IN = 3 * RW_WIDTH + RW_DECAY_LORA + RW_A_LORA
Z_IN = N_BRANCH * BRANCH_WIDTH
GATE_IN = N_BRANCH * D_MODEL
IN_SPLITS = [MLA_Q_RANK, MLA_KV_RANK, MLA_ROPE, GM_IN, RW_IN, Z_IN, GATE_IN]
D_IN = sum(IN_SPLITS)

kernel_name = "hybrid_mla_gmlp_rwkv7_streaming_trunk"


def rmsnorm(x, g, eps=EPS):
    xf = x.astype(jnp.float32)
    y = xf * lax.rsqrt(jnp.mean(xf * xf, axis=-1, keepdims=True) + eps)
    return (y * g.astype(jnp.float32)).astype(x.dtype)


def layernorm(x, g, b, eps=LN_EPS):
    xf = x.astype(jnp.float32)
    mu = jnp.mean(xf, axis=-1, keepdims=True)
    var = jnp.mean(jnp.square(xf - mu), axis=-1, keepdims=True)
    y = (xf - mu) * lax.rsqrt(var + eps)
    return (y * g.astype(jnp.float32) + b.astype(jnp.float32)).astype(x.dtype)


def split_last(x, sizes):
    cuts = [int(s) for s in np.cumsum(sizes)[:-1]]
    return jnp.split(x, cuts, axis=-1)


def rope_angles(positions):
    inv_freq = ROPE_THETA ** (-jnp.arange(0, MLA_ROPE, 2, dtype=jnp.float32) / MLA_ROPE)
    ang = positions.astype(jnp.float32)[..., None] * inv_freq
    return jnp.cos(ang), jnp.sin(ang)


def apply_rope(x, cos, sin):
    xf = x.astype(jnp.float32)
    x1, x2 = jnp.split(xf, 2, axis=-1)
    return jnp.concatenate([x1 * cos - x2 * sin, x2 * cos + x1 * sin], axis=-1).astype(x.dtype)


def chunk_causal_attention(q, k, v):
    B, S, H, dk = q.shape
    dv = v.shape[-1]
    nb = S // QBLK
    scale = dk ** -0.5
    key_chunk = jnp.arange(S) // CHUNK
    qb = q.reshape(B, nb, QBLK, H, dk).transpose(1, 0, 2, 3, 4)

    def one_block(args):
        q_blk, blk = args
        q_chunk = (blk * QBLK + jnp.arange(QBLK)) // CHUNK
        allowed = key_chunk[None, :] <= q_chunk[:, None]
        s = jnp.einsum('bqhd,bkhd->bhqk', q_blk, k).astype(jnp.float32) * scale
        s = jnp.where(allowed[None, None], s, jnp.finfo(jnp.float32).min)
        p = jax.nn.softmax(s, axis=-1).astype(v.dtype)
        return jnp.einsum('bhqk,bkhd->bqhd', p, v)

    out = lax.map(one_block, (qb, jnp.arange(nb)))
    return out.transpose(1, 0, 2, 3, 4).reshape(B, S, H, dv)


def mla_mixer(q_lat, kv_lat, k_rope, q_norm_g, w_uq, kv_norm_g, w_ukv, cos, sin):
    B, S, _ = q_lat.shape
    q = (rmsnorm(q_lat, q_norm_g) @ w_uq).reshape(B, S, MLA_HEADS, MLA_NOPE + MLA_ROPE)
    q_nope, q_pe = q[..., :MLA_NOPE], q[..., MLA_NOPE:]
    q_pe = apply_rope(q_pe, cos[:, :, None, :], sin[:, :, None, :])
    kv = (rmsnorm(kv_lat, kv_norm_g) @ w_ukv).reshape(B, S, MLA_HEADS, MLA_NOPE + MLA_VDIM)
    k_nope, v = kv[..., :MLA_NOPE], kv[..., MLA_NOPE:]
    k_pe = apply_rope(k_rope, cos, sin)
    k_pe = jnp.broadcast_to(k_pe[:, :, None, :], (B, S, MLA_HEADS, MLA_ROPE))
    q_full = jnp.concatenate([q_nope, q_pe], axis=-1)
    k_full = jnp.concatenate([k_nope, k_pe], axis=-1)
    return chunk_causal_attention(q_full, k_full, v).reshape(B, S, MLA_WIDTH)


def gmlp_mixer(p, ln_g, ln_b, w_s, b_s):
    B, S, _ = p.shape
    u, v = jnp.split(jax.nn.gelu(p, approximate=False), 2, axis=-1)
    v = layernorm(v, ln_g, ln_b)
    pos_chunk = jnp.arange(GM_BLOCK) // CHUNK
    mask = pos_chunk[None, :] <= pos_chunk[:, None]
    w = jnp.where(mask[None], w_s, 0)
    vb = v.reshape(B, S // GM_BLOCK, GM_BLOCK, GM_GROUPS, GM_GROUP_CH)
    s = jnp.einsum('gts,bnsgc->bntgc', w, vb) + b_s.T[None, None, :, :, None]
    return u * s.reshape(B, S, GM_WIDTH)


def wkv7_scan(r, decay, k, v, a, b):
    B, S, H, N = r.shape
    xs = tuple(jnp.moveaxis(t.astype(jnp.float32), 1, 0) for t in (r, decay, k, v, a, b))

    def step(state, inp):
        r_t, w_t, k_t, v_t, a_t, b_t = inp
        sa = jnp.einsum('bhij,bhj->bhi', state, a_t)
        state = (state * w_t[:, :, None, :] + sa[..., None] * b_t[:, :, None, :]
                 + v_t[..., None] * k_t[:, :, None, :])
        return state, jnp.einsum('bhij,bhj->bhi', state, r_t)

    s0 = jnp.zeros((B, H, N, N), jnp.float32)
    _, ys = lax.scan(step, s0, xs)
    return jnp.moveaxis(ys, 0, 1).astype(r.dtype)


def rwkv7_mixer(p, mu, w0, w2, a0, a2, k_k, k_a, r_k, lnx_g, lnx_b, v_first, v_mix):
    B, S, _ = p.shape
    p_prev = jnp.pad(p, ((0, 0), (1, 0), (0, 0)))[:, :-1]
    xs = p + (p_prev - p) * mu
    r, k, v, w_lat, a_lat = split_last(xs, [RW_WIDTH, RW_WIDTH, RW_WIDTH, RW_DECAY_LORA, RW_A_LORA])
    w_log = -jax.nn.softplus(-(w0 + jnp.tanh(w_lat) @ w2).astype(jnp.float32)) - 0.5
    decay = jnp.exp(-jnp.exp(w_log))
    if v_mix is None:
        v_first = v
    else:
        v0, v1, v2 = v_mix
        v = v + (v_first - v) * jax.nn.sigmoid(v0 + (v @ v1) @ v2)
    a = jax.nn.sigmoid(a0 + a_lat @ a2)

    def heads(t):
        return t.reshape(B, S, RW_HEADS, RW_HEAD)

    kk = heads(k * k_k).astype(jnp.float32)
    kk = kk / jnp.maximum(jnp.sqrt(jnp.sum(kk * kk, axis=-1, keepdims=True)), 1e-12)
    k = k * (1 + (a - 1) * k_a)
    rh, kh, vh, ah = heads(r), heads(k), heads(v), heads(a)
    y = wkv7_scan(rh, heads(decay), kh, vh, -kk, kk * ah.astype(jnp.float32))
    y = layernorm(y, lnx_g.reshape(RW_HEADS, RW_HEAD), lnx_b.reshape(RW_HEADS, RW_HEAD), eps=RW_LN_EPS)
    bonus = jnp.sum(rh * kh * r_k, axis=-1, keepdims=True) * vh
    return (y + bonus).reshape(B, S, RW_WIDTH), v_first


def setup_inputs(seed: int = 0) -> dict:
    key = jax.random.key(seed)
    ks = jax.random.split(key, 32)
    L = DEPTH
    Lv = max(DEPTH - 1, 0)
    D = D_MODEL

    def nrm(i, shape, scale):
        return jax.random.normal(ks[i], shape, jnp.float32) * scale

    x = nrm(0, (BATCH, SEQ, D), 1.0)
    c = nrm(1, (BATCH, D), 1.0)
    offset = jax.random.randint(ks[2], (BATCH, 1), 0, MAX_POS_OFFSET, dtype=jnp.int32)
    positions = offset + jnp.arange(SEQ, dtype=jnp.int32)[None, :]
    return {
        "x": x,
        "c": c,
        "positions": positions,
        "pre_g": 1.0 + nrm(3, (L, D), 0.02),
        "post_g": 1.0 + nrm(4, (L, D), 0.02),
        "w_ada": nrm(5, (L, D, 3 * D), 0.5 * D ** -0.5),
        "b_ada": nrm(6, (L, 3 * D), 0.02),
        "w_in": nrm(7, (L, D, D_IN), D ** -0.5),
        "mla_q_norm": 1.0 + nrm(8, (L, MLA_Q_RANK), 0.02),
        "mla_w_uq": nrm(9, (L, MLA_Q_RANK, MLA_HEADS * (MLA_NOPE + MLA_ROPE)), MLA_Q_RANK ** -0.5),
        "mla_kv_norm": 1.0 + nrm(10, (L, MLA_KV_RANK), 0.02),
        "mla_w_ukv": nrm(11, (L, MLA_KV_RANK, MLA_HEADS * (MLA_NOPE + MLA_VDIM)), MLA_KV_RANK ** -0.5),
        "gm_ln_g": 1.0 + nrm(12, (L, GM_WIDTH), 0.02),
        "gm_ln_b": nrm(13, (L, GM_WIDTH), 0.02),
        "gm_w_s": nrm(14, (L, GM_GROUPS, GM_BLOCK, GM_BLOCK), GM_BLOCK ** -0.5),
        "gm_b_s": 1.0 + nrm(15, (L, GM_GROUPS, GM_BLOCK), 0.02),
        "rw_mu": jax.random.uniform(ks[16], (L, RW_IN), jnp.float32),
        "rw_w0": jax.random.uniform(ks[17], (L, RW_WIDTH), jnp.float32, minval=-3.0, maxval=0.5),
        "rw_w2": nrm(18, (L, RW_DECAY_LORA, RW_WIDTH), 0.1),
        "rw_a0": nrm(19, (L, RW_WIDTH), 0.1),
        "rw_a2": nrm(20, (L, RW_A_LORA, RW_WIDTH), RW_A_LORA ** -0.5),
        "rw_k_k": 0.85 + nrm(21, (L, RW_WIDTH), 0.02),
        "rw_k_a": 1.0 + nrm(22, (L, RW_WIDTH), 0.02),
        "rw_r_k": nrm(23, (L, RW_HEADS, RW_HEAD), 0.1),
        "rw_lnx_g": 1.0 + nrm(24, (L, RW_WIDTH), 0.02),
        "rw_lnx_b": nrm(25, (L, RW_WIDTH), 0.02),
        "rw_v0": 1.0 + nrm(26, (Lv, RW_WIDTH), 0.1),
        "rw_v1": nrm(27, (Lv, RW_WIDTH, RW_V_LORA), RW_WIDTH ** -0.5),
        "rw_v2": nrm(28, (Lv, RW_V_LORA, RW_WIDTH), 0.5 * RW_V_LORA ** -0.5),
        "w_br": nrm(29, (L, N_BRANCH, BRANCH_WIDTH, D), BRANCH_WIDTH ** -0.5),
        "w_out": nrm(30, (L, D, D), D ** -0.5),
    }


def reference(x, c, positions, pre_g, post_g, w_ada, b_ada, w_in,
              mla_q_norm, mla_w_uq, mla_kv_norm, mla_w_ukv,
              gm_ln_g, gm_ln_b, gm_w_s, gm_b_s,
              rw_mu, rw_w0, rw_w2, rw_a0, rw_a2, rw_k_k, rw_k_a, rw_r_k,
              rw_lnx_g, rw_lnx_b, rw_v0, rw_v1, rw_v2,
              w_br, w_out):
    B, S, D = x.shape
    cos, sin = rope_angles(positions)
    c_act = jax.nn.silu(c)
    v_first = None
    for l in range(DEPTH):
        shift, scale, gate = jnp.split(c_act @ w_ada[l] + b_ada[l], 3, axis=-1)
        h = rmsnorm(x, pre_g[l]) * (1 + scale[:, None]) + shift[:, None]
        q_lat, kv_lat, k_rope, gm_in, rw_in, z, g_logit = split_last(h @ w_in[l], IN_SPLITS)

        y_mla = mla_mixer(q_lat, kv_lat, k_rope, mla_q_norm[l], mla_w_uq[l],
                          mla_kv_norm[l], mla_w_ukv[l], cos, sin)
        y_gm = gmlp_mixer(gm_in, gm_ln_g[l], gm_ln_b[l], gm_w_s[l], gm_b_s[l])
        v_mix = None if l == 0 else (rw_v0[l - 1], rw_v1[l - 1], rw_v2[l - 1])
        y_rw, v_first = rwkv7_mixer(rw_in, rw_mu[l], rw_w0[l], rw_w2[l], rw_a0[l], rw_a2[l],
                                    rw_k_k[l], rw_k_a[l], rw_r_k[l], rw_lnx_g[l], rw_lnx_b[l],
                                    v_first, v_mix)

        branches = jnp.stack([y_mla, y_gm, y_rw], axis=2)
        branches = branches * jax.nn.silu(z).reshape(B, S, N_BRANCH, BRANCH_WIDTH)
        proj = jnp.einsum('bsnw,nwd->bsnd', branches, w_br[l])
        merged = jnp.sum(proj * jax.nn.sigmoid(g_logit).reshape(B, S, N_BRANCH, D), axis=2)
        y = merged @ w_out[l]
        x = x + gate[:, None] * rmsnorm(y, post_g[l])
    return x
```

```cpp
#include <hip/hip_runtime.h>
#include <hip/hip_cooperative_groups.h>
#include <cstdint>
#include <cstdio>
namespace cg = cooperative_groups;

#ifndef PHEN
#define PHEN 0xfff
#endif
#ifndef ONE_LAUNCH
#define ONE_LAUNCH 0
#endif

#define LAS __attribute__((address_space(3)))
typedef unsigned short bf16_t;
typedef short bf16x8 __attribute__((ext_vector_type(8)));
typedef short bf16x4 __attribute__((ext_vector_type(4)));
typedef float f32x4 __attribute__((ext_vector_type(4)));
typedef float f32x2 __attribute__((ext_vector_type(2)));
typedef unsigned u32x4 __attribute__((ext_vector_type(4)));
typedef unsigned u32x2 __attribute__((ext_vector_type(2)));

constexpr int M_TOK = 16384, DM = 1024, SEQ = 4096, NBATCH = 4, NL = 4;
constexpr int D_IN_SRC = 7712;
constexpr int NP1 = 3328, NZ = 1536, NIN = 4864, NG = 3072;
constexpr int C_QLAT = 0, C_KVLAT = 256, C_KROPE = 384, C_GMU = 512, C_GMV = 1024, C_RW = 1536, C_RWR = 1536, C_RWK = 2048, C_RWV = 2560, C_WLAT = 3072, C_ALAT = 3136;
constexpr int NTHREADS = 512, NWAVES = 8;
constexpr int LDS_BYTES = 150 * 1024;
constexpr float QSCALE = 0.10206207261596575f * 1.4426950408889634f;

constexpr size_t MiB = 1u << 20;
constexpr size_t OFF_WIN = 0;
constexpr size_t SZ_WIN = (size_t)NIN * DM * 2;
constexpr size_t OFF_WG = 38 * MiB;
constexpr size_t SZ_WG = (size_t)NG * DM * 2;
constexpr size_t OFF_WBR = 62 * MiB;
constexpr size_t SZ_WBR = (size_t)3072 * 512 * 2;
constexpr size_t OFF_WOUT = 74 * MiB;
constexpr size_t SZ_WOUT = (size_t)DM * DM * 2;
constexpr size_t OFF_WUQ = 82 * MiB;
constexpr size_t SZ_WUQ = (size_t)768 * 256 * 2;
constexpr size_t OFF_WUKV = OFF_WUQ + 3 * MiB / 2;
constexpr size_t SZ_WUKV = (size_t)1024 * 128 * 2;
constexpr size_t OFF_SMALL = OFF_WUKV + 1 * MiB;
constexpr size_t OFF_W2T = OFF_SMALL;
constexpr size_t OFF_A2T = OFF_W2T + 256 * 1024;
constexpr size_t OFF_V1T = OFF_A2T + 256 * 1024;
constexpr size_t OFF_V2T = OFF_V1T + 128 * 1024;
constexpr size_t OFF_WS = OFF_V2T + 128 * 1024;
constexpr size_t OFF_MODP = OFF_WS + 512 * 1024;
constexpr size_t OFF_ROPE = OFF_MODP + 3 * MiB / 2;
constexpr size_t OFF_H = 90 * MiB;
constexpr size_t OFF_Z = 122 * MiB;
constexpr size_t OFF_VF = 170 * MiB;
constexpr size_t OFF_R1 = 186 * MiB;
constexpr size_t OFF_R2 = 298 * MiB;
constexpr size_t OFF_R3 = 410 * MiB;
constexpr size_t WS_END = 474 * MiB;
static_assert(OFF_ROPE + 2 * MiB <= OFF_H, "small region");
constexpr size_t R2_R = 0, R2_K = 16 * MiB, R2_V = 32 * MiB, R2_KK = 48 * MiB, R2_B = 64 * MiB, R2_LW = 80 * MiB;
constexpr size_t R3_Q = 0, R3_KF = 24 * MiB, R3_VT = 48 * MiB, R3_MERGED = 0, R3_Y = 32 * MiB;

struct Params {
    const float* x; const float* c; const int* pos; const float* pre_g; const float* post_g; const float* w_ada; const float* b_ada; const float* w_in;
    const float* q_norm; const float* w_uq; const float* kv_norm; const float* w_ukv; const float* ln_g; const float* ln_b; const float* w_s; const float* b_s;
    const float* mu; const float* w0; const float* w2; const float* a0; const float* a2; const float* k_k; const float* k_a; const float* r_k;
    const float* lnx_g; const float* lnx_b; const float* v0; const float* v1; const float* v2; const float* w_br; const float* w_out;
    float* out; unsigned char* ws;
    int ph_lo, ph_hi;
};

__device__ __forceinline__ unsigned cvt_pk_bf16(float lo, float hi) { unsigned r; asm volatile("v_cvt_pk_bf16_f32 %0, %1, %2" : "=v"(r) : "v"(lo), "v"(hi)); return r; }
__device__ __forceinline__ float bf_lo(unsigned u) { return __uint_as_float(u << 16); }
__device__ __forceinline__ float bf_hi(unsigned u) { return __uint_as_float(u & 0xffff0000u); }
__device__ __forceinline__ float bf2f(bf16_t h) { return __uint_as_float(((unsigned)h) << 16); }
__device__ __forceinline__ bf16_t f2bf(float f) { return (bf16_t)(cvt_pk_bf16(f, 0.f) & 0xffffu); }
__device__ __forceinline__ float sigmoidf_(float x) { return 1.f / (1.f + __expf(-x)); }
__device__ __forceinline__ float siluf_(float x) { return x / (1.f + __expf(-x)); }
__device__ __forceinline__ float geluf_(float x) { return 0.5f * x * (1.f + erff(x * 0.70710678118654752f)); }
__device__ __forceinline__ f32x4 unpack4(u32x2 u) { return (f32x4){bf_lo(u.x), bf_hi(u.x), bf_lo(u.y), bf_hi(u.y)}; }
__device__ __forceinline__ u32x2 pack4(f32x4 v) { u32x2 r; r.x = cvt_pk_bf16(v[0], v[1]); r.y = cvt_pk_bf16(v[2], v[3]); return r; }
__device__ __forceinline__ float wave_sum(float v) {
#pragma unroll
    for (int o = 1; o < 64; o <<= 1) v += __shfl_xor(v, o);
    return v;
}
__device__ __forceinline__ bf16x8 ld_frag(const bf16_t* p) { return *(const bf16x8*)p; }
__device__ __forceinline__ bf16x8 pack_frag(f32x4 a, f32x4 b) {
    u32x4 u; u.x = cvt_pk_bf16(a[0], a[1]); u.y = cvt_pk_bf16(a[2], a[3]); u.z = cvt_pk_bf16(b[0], b[1]); u.w = cvt_pk_bf16(b[2], b[3]);
    return __builtin_bit_cast(bf16x8, u);
}
__device__ __forceinline__ bf16x8 join_frag(u32x2 a, u32x2 b) { u32x4 u; u.x = a.x; u.y = a.y; u.z = b.x; u.w = b.y; return __builtin_bit_cast(bf16x8, u); }
__device__ __forceinline__ int tid_l() { int t = threadIdx.x; asm volatile("" : "+v"(t)); return t; }
__device__ __forceinline__ unsigned char* ptr_l(unsigned char* q) { asm volatile("" : "+s"(q)); return q; }
#define MFMA(a, b, c) __builtin_amdgcn_mfma_f32_16x16x32_bf16((a), (b), (c), 0, 0, 0)

namespace pg8 {
constexpr int BM = 256, BK = 64, HALF = 128, HTB = HALF * BK * 2, STAGE_BYTES = 8 * HTB, NXCD = 8, WGM = 8;
__host__ __device__ __forceinline__ int lds_byte(int r, int c) { const int st = (r >> 4) * 2 + (c >> 5), rr = r & 15, cc = c & 31, ob = rr * 64 + cc * 2; return st * 1024 + (ob ^ (((ob >> 9) & 1) << 5)); }
__host__ __device__ __forceinline__ void stage_rc(int b, int& R, int& C) { const int st = b / 1024, sb = b % 1024, swz = sb ^ (((sb >> 9) & 1) << 5); R = (st >> 1) * 16 + swz / 64; C = (st & 1) * 32 + (swz % 64) / 2; }
__host__ __device__ __forceinline__ int perm32(int rho) { const int n = rho >> 4, i = rho & 15; return 8 * (i >> 2) + 4 * n + (i & 3); }

struct Unit { int pm, pn, ak, tag; };
struct Gemm { const bf16_t* A; const bf16_t* Bt; int lda, ldb, K; };

__device__ __forceinline__ void tile_of(int wgid, int nM, int nN, int& pm, int& pn) {
    const int nwg = nM * nN;
    { const int q = nwg / NXCD, r = nwg % NXCD, xcd = wgid % NXCD, off = wgid / NXCD; wgid = (xcd < r ? xcd * (q + 1) : r * (q + 1) + (xcd - r) * q) + off; }
    const int nig = WGM * nN, gid = wgid / nig, fm = gid * WGM, gsz = (nM - fm) < WGM ? (nM - fm) : WGM;
    pm = fm + ((wgid % nig) % gsz); pn = (wgid % nig) / gsz;
}
struct PlainOrder {
    int nM, nN, nwg, G, c;
    __device__ void init(int nM_, int nN_, int G_, int c_) { nM = nM_; nN = nN_; nwg = nM * nN; G = G_; c = c_; }
    __device__ bool next(int i, Unit& u) const { const long L = (long)i * G + c; if (L >= nwg) return false; tile_of((int)L, nM, nN, u.pm, u.pn); u.ak = 0; u.tag = 0; return true; }
};
struct MergeOrder {
    int nM, nN, nwg, G, c;
    __device__ void init(int nM_, int nN_, int G_, int c_) { nM = nM_; nN = nN_; nwg = nM * nN; G = G_; c = c_; }
    __device__ bool next(int i, Unit& u) const { const int ti = i / 3, n = i - 3 * ti; const long L = (long)ti * G + c; if (L >= nwg) return false;
        int pm, pc; tile_of((int)L, nM, nN, pm, pc); u.pm = pm; u.pn = n * nN + pc; u.ak = n * 512; u.tag = n; return true; }
};

template <class Epi, class Sched>
__device__ __forceinline__ void gemm_phase(LAS unsigned char* lds, const Gemm g, const Sched& S, const Epi& E) {
    const int tid = tid_l(), wid = __builtin_amdgcn_readfirstlane(tid >> 6), lane = tid & 63, wr = wid >> 2, wc = wid & 3, fr = lane & 15, fq = lane >> 4;
    const int K = g.K, nt = K / BK;
    unsigned voffA[2], voffB[2];
#pragma unroll
    for (int i = 0; i < 2; ++i) { int R, C; stage_rc(tid * 16 + i * 8192, R, C); const int Rb = (R & ~31) + perm32(R & 31);
        voffA[i] = (unsigned)(R * g.lda + C) * 2u; voffB[i] = (unsigned)(Rb * g.ldb + C) * 2u; }
    const size_t kstep = (size_t)(BK * 2);
    const size_t hstepA = (size_t)HALF * g.lda * 2, hstepB = (size_t)HALF * g.ldb * 2;
    const size_t tstepA = 2 * hstepA, tstepB = 2 * hstepB;
    const unsigned ldsw = (unsigned)wid * 1024u;
    const int aoff = lds_byte(wr * 64 + fr, fq * 8), boff = lds_byte(wc * 32 + fr, fq * 8);
#define PG8_SA(b, h) (((b) * 2 + (h)) * HTB)
#define PG8_SB(b, h) ((4 + (b) * 2 + (h)) * HTB)
#define PG8_STAGE(bufoff, gbase, voff) do { _Pragma("unroll") for (int _i = 0; _i < 2; ++_i) \
        __builtin_amdgcn_global_load_lds((const unsigned*)((const char*)(gbase) + (voff)[_i]), (LAS unsigned*)(lds + (bufoff) + ldsw + _i * 8192), 16, 0, 0); } while (0)
#define PG8_LDA(dst, b, h) do { _Pragma("unroll") for (int m = 0; m < 4; ++m) _Pragma("unroll") for (int k = 0; k < 2; ++k) dst[m][k] = *(const LAS bf16x8*)(lds + PG8_SA(b, h) + aoff + m * 2048 + k * 1024); } while (0)
#define PG8_LDB(dst, b, h) do { _Pragma("unroll") for (int n = 0; n < 2; ++n) _Pragma("unroll") for (int k = 0; k < 2; ++k) dst[n][k] = *(const LAS bf16x8*)(lds + PG8_SB(b, h) + boff + n * 2048 + k * 1024); } while (0)
#define PG8_MMA(ai, bj, At, Bt) do { __builtin_amdgcn_s_setprio(1); _Pragma("unroll") for (int m = 0; m < 4; ++m) _Pragma("unroll") for (int n = 0; n < 2; ++n) _Pragma("unroll") for (int k = 0; k < 2; ++k) \
        acc[ai][bj][m][n] = __builtin_amdgcn_mfma_f32_16x16x32_bf16(Bt[n][k], At[m][k], acc[ai][bj][m][n], 0, 0, 0); __builtin_amdgcn_s_setprio(0); } while (0)
#define PG8_WAIT_V(n) asm volatile("s_waitcnt vmcnt(" #n ")" ::: "memory")
#define PG8_WAIT_L(n) asm volatile("s_waitcnt lgkmcnt(" #n ")" ::: "memory")
#define PG8_BAR __builtin_amdgcn_s_barrier()
#define PG8_SCHED __builtin_amdgcn_sched_barrier(0)
    Unit cur, nxt; int ui = 0;
    if (!S.next(0, cur)) return;
    f32x4 acc[2][2][4][2];
#pragma unroll
    for (int a = 0; a < 2; ++a)
#pragma unroll
        for (int b = 0; b < 2; ++b)
#pragma unroll
            for (int m = 0; m < 4; ++m)
#pragma unroll
                for (int n = 0; n < 2; ++n) acc[a][b][m][n] = (f32x4){0.f, 0.f, 0.f, 0.f};
    bf16x8 At[4][2], B0[2][2], B1[2][2];
    const char* cA = (const char*)g.A + (size_t)cur.pm * tstepA + (size_t)cur.ak * 2; const char* cB = (const char*)g.Bt + (size_t)cur.pn * tstepB;
    PG8_STAGE(PG8_SB(0, 0), cB, voffB); PG8_STAGE(PG8_SB(0, 1), cB + hstepB, voffB); PG8_STAGE(PG8_SA(0, 0), cA, voffA); PG8_STAGE(PG8_SA(0, 1), cA + hstepA, voffA);
    if (wr == 1) PG8_BAR;
    PG8_WAIT_V(2); PG8_BAR;
    PG8_STAGE(PG8_SB(1, 0), cB + kstep, voffB); PG8_STAGE(PG8_SA(1, 0), cA + kstep, voffA); PG8_STAGE(PG8_SB(1, 1), cB + hstepB + kstep, voffB);
    PG8_WAIT_V(6); PG8_BAR;
    for (;;) {
        const bool has_next = S.next(ui + 1, nxt);
        const char* nA = has_next ? (const char*)g.A + (size_t)nxt.pm * tstepA + (size_t)nxt.ak * 2 : cA; const char* nB = has_next ? (const char*)g.Bt + (size_t)nxt.pn * tstepB : cB;
        for (int t = 0; t < nt; t += 2) {
            const bool last = (t == nt - 2);
            const char* a1 = cA + (size_t)(t + 1) * kstep;
            const char* a2 = last ? nA : cA + (size_t)(t + 2) * kstep; const char* b2 = last ? nB : cB + (size_t)(t + 2) * kstep;
            const char* a3 = a2 + kstep; const char* b3 = b2 + kstep;
            PG8_LDB(B0, 0, 0); PG8_LDB(B1, 0, 1); PG8_SCHED; PG8_LDA(At, 0, 0); PG8_STAGE(PG8_SA(1, 1), a1 + hstepA, voffA);
            PG8_WAIT_V(8); PG8_WAIT_L(0); PG8_BAR; PG8_MMA(0, 0, At, B0); PG8_MMA(0, 1, At, B1); PG8_BAR; PG8_SCHED;
            PG8_LDA(At, 0, 1); PG8_STAGE(PG8_SB(0, 0), b2, voffB); PG8_STAGE(PG8_SB(0, 1), b2 + hstepB, voffB); PG8_STAGE(PG8_SA(0, 0), a2, voffA);
            PG8_WAIT_V(8); PG8_WAIT_L(0); PG8_BAR; PG8_MMA(1, 0, At, B0); PG8_MMA(1, 1, At, B1); PG8_BAR; PG8_SCHED;
            PG8_LDB(B0, 1, 0); PG8_LDB(B1, 1, 1); PG8_SCHED; PG8_LDA(At, 1, 0); PG8_STAGE(PG8_SA(0, 1), a2 + hstepA, voffA);
            PG8_WAIT_V(8); PG8_WAIT_L(0); PG8_BAR; PG8_MMA(0, 0, At, B0); PG8_MMA(0, 1, At, B1); PG8_BAR; PG8_SCHED;
            PG8_LDA(At, 1, 1); PG8_STAGE(PG8_SB(1, 0), b3, voffB); PG8_STAGE(PG8_SB(1, 1), b3 + hstepB, voffB); PG8_STAGE(PG8_SA(1, 0), a3, voffA);
            PG8_WAIT_V(8); PG8_WAIT_L(0); PG8_BAR; PG8_MMA(1, 0, At, B0); PG8_MMA(1, 1, At, B1); PG8_BAR; PG8_SCHED;
        }
        if (wr == 0) PG8_BAR;
        E(acc, cur, wr, wc, fr, fq);
        if (!has_next) break;
#pragma unroll
        for (int a = 0; a < 2; ++a)
#pragma unroll
            for (int b = 0; b < 2; ++b)
#pragma unroll
                for (int m = 0; m < 4; ++m)
#pragma unroll
                    for (int n = 0; n < 2; ++n) acc[a][b][m][n] = (f32x4){0.f, 0.f, 0.f, 0.f};
        cur = nxt; cA = nA; cB = nB; ++ui;
        if (wr == 1) PG8_BAR;
    }
    PG8_WAIT_V(0);
    PG8_BAR;
#undef PG8_SA
#undef PG8_SB
#undef PG8_STAGE
#undef PG8_LDA
#undef PG8_LDB
#undef PG8_MMA
#undef PG8_WAIT_V
#undef PG8_WAIT_L
#undef PG8_BAR
#undef PG8_SCHED
}

struct EpiIn {
    bf16_t* P1; bf16_t* Z;
    __device__ __forceinline__ void operator()(const f32x4 (&acc)[2][2][4][2], const Unit& u, int wr, int wc, int fr, int fq) const {
        bf16_t* base; int ld, colt;
        if (u.pn < 13) { base = P1; ld = NP1; colt = u.pn * BM; } else { base = Z; ld = NZ; colt = (u.pn - 13) * BM; }
        const int row0 = u.pm * BM + wr * 64 + fr, col0 = colt + wc * 32 + 8 * fq;
#pragma unroll
        for (int ai = 0; ai < 2; ++ai)
#pragma unroll
            for (int m = 0; m < 4; ++m) { bf16_t* rowp = base + (size_t)(row0 + ai * HALF + m * 16) * ld + col0;
#pragma unroll
                for (int bj = 0; bj < 2; ++bj) { const f32x4 v0 = acc[ai][bj][m][0], v1 = acc[ai][bj][m][1];
                    u32x4 w; w.x = cvt_pk_bf16(v0[0], v0[1]); w.y = cvt_pk_bf16(v0[2], v0[3]); w.z = cvt_pk_bf16(v1[0], v1[1]); w.w = cvt_pk_bf16(v1[2], v1[3]);
                    *(u32x4*)(rowp + bj * HALF) = w; } }
    }
};
template <int ACT> struct EpiPlain {
    bf16_t* O; int ld;
    __device__ __forceinline__ void operator()(const f32x4 (&acc)[2][2][4][2], const Unit& u, int wr, int wc, int fr, int fq) const {
        const int row0 = u.pm * BM + wr * 64 + fr, col0 = u.pn * BM + wc * 32 + 8 * fq;
#pragma unroll
        for (int ai = 0; ai < 2; ++ai)
#pragma unroll
            for (int m = 0; m < 4; ++m) { bf16_t* rowp = O + (size_t)(row0 + ai * HALF + m * 16) * ld + col0;
#pragma unroll
                for (int bj = 0; bj < 2; ++bj) { f32x4 v0 = acc[ai][bj][m][0], v1 = acc[ai][bj][m][1];
                    if (ACT == 1) {
#pragma unroll
                        for (int e = 0; e < 4; ++e) { v0[e] = sigmoidf_(v0[e]); v1[e] = sigmoidf_(v1[e]); } }
                    u32x4 w; w.x = cvt_pk_bf16(v0[0], v0[1]); w.y = cvt_pk_bf16(v0[2], v0[3]); w.z = cvt_pk_bf16(v1[0], v1[1]); w.w = cvt_pk_bf16(v1[2], v1[3]);
                    *(u32x4*)(rowp + bj * HALF) = w; } }
    }
};
struct EpiMerge {
    bf16_t* Mg; const bf16_t* G;
    __device__ __forceinline__ void operator()(const f32x4 (&acc)[2][2][4][2], const Unit& u, int wr, int wc, int fr, int fq) const {
        const int n = u.tag, pc = u.pn - 4 * n;
        const int row0 = u.pm * BM + wr * 64 + fr, col0 = pc * BM + wc * 32 + 8 * fq;
#pragma unroll
        for (int ai = 0; ai < 2; ++ai)
#pragma unroll
            for (int m = 0; m < 4; ++m) { const size_t row = (size_t)(row0 + ai * HALF + m * 16);
#pragma unroll
                for (int bj = 0; bj < 2; ++bj) { const f32x4 v0 = acc[ai][bj][m][0], v1 = acc[ai][bj][m][1];
                    const u32x4 gt = *(const u32x4*)(G + row * NG + n * 1024 + col0 + bj * HALF);
                    bf16_t* mp = Mg + row * DM + col0 + bj * HALF;
                    float o[8];
                    o[0] = bf_lo(gt.x) * v0[0]; o[1] = bf_hi(gt.x) * v0[1]; o[2] = bf_lo(gt.y) * v0[2]; o[3] = bf_hi(gt.y) * v0[3];
                    o[4] = bf_lo(gt.z) * v1[0]; o[5] = bf_hi(gt.z) * v1[1]; o[6] = bf_lo(gt.w) * v1[2]; o[7] = bf_hi(gt.w) * v1[3];
                    if (n > 0) { const u32x4 pv = *(const u32x4*)mp;
                        o[0] += bf_lo(pv.x); o[1] += bf_hi(pv.x); o[2] += bf_lo(pv.y); o[3] += bf_hi(pv.y); o[4] += bf_lo(pv.z); o[5] += bf_hi(pv.z); o[6] += bf_lo(pv.w); o[7] += bf_hi(pv.w); }
                    u32x4 w; w.x = cvt_pk_bf16(o[0], o[1]); w.y = cvt_pk_bf16(o[2], o[3]); w.z = cvt_pk_bf16(o[4], o[5]); w.w = cvt_pk_bf16(o[6], o[7]);
                    *(u32x4*)mp = w; } }
    }
};
}

__device__ __forceinline__ void tr_item(const float* W, int lds_, int k0, int n0s, bf16_t* WT, int ldd, int n0d, int kd0, const float* ksc, float* scr, int lane) {
#pragma unroll 8
    for (int i = 0; i < 32; ++i) { const int kk = 2 * i + (lane >> 5);
        float v = 0.f; if (n0s >= 0) { v = W[(size_t)(k0 + kk) * lds_ + n0s + (lane & 31)]; if (ksc) v *= ksc[k0 + kk]; }
        scr[kk * 33 + (lane & 31)] = v; }
    asm volatile("s_waitcnt lgkmcnt(0)" ::: "memory");
    const int c = lane & 7;
#pragma unroll
    for (int j = 0; j < 4; ++j) { const int n = (lane >> 3) + 8 * j; const float* s = scr + (8 * c) * 33 + n;
        u32x4 o; o.x = cvt_pk_bf16(s[0 * 33], s[1 * 33]); o.y = cvt_pk_bf16(s[2 * 33], s[3 * 33]); o.z = cvt_pk_bf16(s[4 * 33], s[5 * 33]); o.w = cvt_pk_bf16(s[6 * 33], s[7 * 33]);
        *(u32x4*)(WT + (size_t)(n0d + n) * ldd + kd0 + 8 * c) = o; }
    asm volatile("s_waitcnt lgkmcnt(0)" ::: "memory");
}

__device__ __forceinline__ void phase0a(const Params& p, unsigned char* lds) {
    const int tid = tid_l(), lane = tid & 63, wave = tid >> 6, G = gridDim.x;
    const int gw = blockIdx.x * NWAVES + wave, NGW = G * NWAVES;
    unsigned char* ws = p.ws;
    float* scr = (float*)(lds + wave * 16384);
    constexpr int I_WIN = 152 * 16, I_WG = 96 * 16, I_WBR = 3 * 32 * 8, I_WOUT = 32 * 16, I_WUQ = 24 * 4, I_WUKV = 32 * 2, I_W2 = 16, I_A2 = 16, I_V1 = 8;
    constexpr int I_L = I_WIN + I_WG + I_WBR + I_WOUT + I_WUQ + I_WUKV + I_W2 + I_A2 + I_V1;
    for (int it = gw; it < NL * I_L; it += NGW) {
        const int l = it / I_L; int r = it - l * I_L;
        if (r < I_WIN) { const int nb = r >> 4, kb = r & 15; const int nd = nb * 32;
            int ns; if (nd < 416) ns = nd; else if (nd < 512) ns = -1; else if (nd < 3200) ns = nd - 96; else if (nd < 3328) ns = -1; else ns = nd - 224;
            tr_item(p.w_in + (size_t)l * DM * D_IN_SRC, D_IN_SRC, kb * 64, ns, (bf16_t*)(ws + OFF_WIN + l * SZ_WIN), DM, nd, kb * 64, nullptr, scr, lane); continue; }
        r -= I_WIN;
        if (r < I_WG) { const int nb = r >> 4, kb = r & 15;
            tr_item(p.w_in + (size_t)l * DM * D_IN_SRC, D_IN_SRC, kb * 64, 4640 + nb * 32, (bf16_t*)(ws + OFF_WG + l * SZ_WG), DM, nb * 32, kb * 64, nullptr, scr, lane); continue; }
        r -= I_WG;
        if (r < I_WBR) { const int n = r / 256, r2 = r - n * 256, nb = r2 >> 3, kb = r2 & 7;
            tr_item(p.w_br + ((size_t)(l * 3 + n) * 512) * DM, DM, kb * 64, nb * 32, (bf16_t*)(ws + OFF_WBR + l * SZ_WBR), 512, n * 1024 + nb * 32, kb * 64, nullptr, scr, lane); continue; }
        r -= I_WBR;
        if (r < I_WOUT) { const int nb = r >> 4, kb = r & 15;
            tr_item(p.w_out + (size_t)l * DM * DM, DM, kb * 64, nb * 32, (bf16_t*)(ws + OFF_WOUT + l * SZ_WOUT), DM, nb * 32, kb * 64, nullptr, scr, lane); continue; }
        r -= I_WOUT;
        if (r < I_WUQ) { const int nb = r >> 2, kb = r & 3;
            tr_item(p.w_uq + (size_t)l * 256 * 768, 768, kb * 64, nb * 32, (bf16_t*)(ws + OFF_WUQ + l * SZ_WUQ), 256, nb * 32, kb * 64, p.q_norm + l * 256, scr, lane); continue; }
        r -= I_WUQ;
        if (r < I_WUKV) { const int nb = r >> 1, kb = r & 1;
            tr_item(p.w_ukv + (size_t)l * 128 * 1024, 1024, kb * 64, nb * 32, (bf16_t*)(ws + OFF_WUKV + l * SZ_WUKV), 128, nb * 32, kb * 64, p.kv_norm + l * 128, scr, lane); continue; }
        r -= I_WUKV;
        if (r < I_W2) { tr_item(p.w2 + (size_t)l * 64 * 512, 512, 0, r * 32, (bf16_t*)(ws + OFF_W2T) + (size_t)l * 512 * 64, 64, r * 32, 0, nullptr, scr, lane); continue; }
        r -= I_W2;
        if (r < I_A2) { tr_item(p.a2 + (size_t)l * 64 * 512, 512, 0, r * 32, (bf16_t*)(ws + OFF_A2T) + (size_t)l * 512 * 64, 64, r * 32, 0, nullptr, scr, lane); continue; }
        r -= I_A2;
        if (l >= 1) tr_item(p.v1 + (size_t)(l - 1) * 512 * 32, 32, r * 64, 0, (bf16_t*)(ws + OFF_V1T) + (size_t)(l - 1) * 32 * 512, 512, 0, r * 64, nullptr, scr, lane);
    }
    for (int it = gw; it < NL * 48 * 8; it += NGW) {
        const int l = it / 384, r = it - l * 384, nb = r >> 3, ks = r & 7, n = nb * 64 + lane;
        float a0 = 0.f, a1 = 0.f, a2 = 0.f, a3 = 0.f;
        const float* w = p.w_ada + (size_t)l * DM * 3072 + n;
#pragma unroll 8
        for (int k = ks * 128; k < ks * 128 + 128; ++k) { const float wv = w[(size_t)k * 3072];
            a0 += siluf_(p.c[k]) * wv; a1 += siluf_(p.c[DM + k]) * wv; a2 += siluf_(p.c[2 * DM + k]) * wv; a3 += siluf_(p.c[3 * DM + k]) * wv; }
        float* mp = (float*)(ws + OFF_MODP) + ((size_t)(l * 8 + ks) * 4) * 3072 + n;
        mp[0] = a0; mp[3072] = a1; mp[2 * 3072] = a2; mp[3 * 3072] = a3;
    }
    const size_t gt = (size_t)blockIdx.x * NTHREADS + tid, GT = (size_t)G * NTHREADS;
    for (size_t i = gt; i < (size_t)3 * 512 * 32; i += GT) { const int l1 = (int)(i / (512 * 32)), r = (int)(i % (512 * 32)), c = r >> 5, k = r & 31;
        ((bf16_t*)(ws + OFF_V2T))[i] = f2bf(p.v2[(size_t)l1 * 32 * 512 + k * 512 + c]); }
    for (size_t i = gt; i < (size_t)NL * 4 * 128 * 128; i += GT) { const int s = (int)(i & 127), t = (int)((i >> 7) & 127);
        ((bf16_t*)(ws + OFF_WS))[i] = f2bf(((s >> 6) <= (t >> 6)) ? p.w_s[i] : 0.f); }
    for (size_t i = gt; i < (size_t)M_TOK * 16; i += GT) { const int t = (int)(i >> 4), k = (int)(i & 15);
        const float inv = powf(10000.f, -(float)(2 * k) / 32.f); const float ang = (float)p.pos[t] * inv;
        ((float*)(ws + OFF_ROPE))[i] = cosf(ang); ((float*)(ws + OFF_ROPE))[(size_t)M_TOK * 16 + i] = sinf(ang); }
    for (size_t i = gt; i < (size_t)M_TOK * DM / 4; i += GT) ((f32x4*)p.out)[i] = ((const f32x4*)p.x)[i];
}

__device__ __forceinline__ f32x4 mod4(const Params& p, int l, int b, int kind, int col) {
    const float* mp = (const float*)(p.ws + OFF_MODP) + ((size_t)(l * 8) * 4 + b) * 3072 + kind * DM + col;
    f32x4 s = *(const f32x4*)(p.b_ada + (size_t)l * 3072 + kind * DM + col);
#pragma unroll
    for (int ks = 0; ks < 8; ++ks) s += *(const f32x4*)(mp + (size_t)ks * 4 * 3072);
    return s;
}
__device__ __forceinline__ void normmod_row(const Params& p, int l, int row, const f32x4 (&v)[4], int lane) {
    float ss = 0.f;
#pragma unroll
    for (int j = 0; j < 4; ++j) ss += v[j][0] * v[j][0] + v[j][1] * v[j][1] + v[j][2] * v[j][2] + v[j][3] * v[j][3];
    const float rstd = rsqrtf(wave_sum(ss) * (1.f / DM) + 1e-6f);
    const int b = row / SEQ;
    bf16_t* hrow = (bf16_t*)(p.ws + OFF_H) + (size_t)row * DM;
#pragma unroll
    for (int j = 0; j < 4; ++j) { const int col = 4 * lane + 256 * j;
        const f32x4 g = *(const f32x4*)(p.pre_g + (size_t)l * DM + col), sh = mod4(p, l, b, 0, col), sc = mod4(p, l, b, 1, col);
        f32x4 o = v[j] * rstd * g * (sc + 1.f) + sh;
        *(u32x2*)(hrow + col) = pack4(o); }
}
__device__ __forceinline__ void phase0b(const Params& p) {
    const int tidq = tid_l(); const int lane = tidq & 63, gw = blockIdx.x * NWAVES + (tidq >> 6), NGW = gridDim.x * NWAVES;
    for (int row = gw; row < M_TOK; row += NGW) { f32x4 v[4];
#pragma unroll
        for (int j = 0; j < 4; ++j) v[j] = *(const f32x4*)(p.out + (size_t)row * DM + 4 * lane + 256 * j);
        normmod_row(p, 0, row, v, lane); }
}
__device__ __forceinline__ void phase_final(const Params& p, int l) {
    const int tidq = tid_l(); const int lane = tidq & 63, gw = blockIdx.x * NWAVES + (tidq >> 6), NGW = gridDim.x * NWAVES;
    const bf16_t* Y = (const bf16_t*)(p.ws + OFF_R3 + R3_Y);
    for (int row = gw; row < M_TOK; row += NGW) {
        f32x4 y[4]; float ss = 0.f;
#pragma unroll
        for (int j = 0; j < 4; ++j) { y[j] = unpack4(*(const u32x2*)(Y + (size_t)row * DM + 4 * lane + 256 * j)); ss += y[j][0] * y[j][0] + y[j][1] * y[j][1] + y[j][2] * y[j][2] + y[j][3] * y[j][3]; }
        const float rstd = rsqrtf(wave_sum(ss) * (1.f / DM) + 1e-6f);
        const int b = row / SEQ; f32x4 v[4];
#pragma unroll
        for (int j = 0; j < 4; ++j) { const int col = 4 * lane + 256 * j;
            const f32x4 xg = *(const f32x4*)(p.out + (size_t)row * DM + col), pg = *(const f32x4*)(p.post_g + (size_t)l * DM + col), gt = mod4(p, l, b, 2, col);
            v[j] = xg + gt * (y[j] * rstd * pg);
            *(f32x4*)(p.out + (size_t)row * DM + col) = v[j]; }
        if (l + 1 < NL) normmod_row(p, l + 1, row, v, lane);
    }
}

__device__ __forceinline__ void mla_prep_item(const Params& p, int l, int item, unsigned char* lds) {
    const int tid = tid_l(), lane = tid & 63, wave = tid >> 6, fr = lane & 15, fq = lane >> 4;
    const int t0 = item * 64;
    const bf16_t* P1 = (const bf16_t*)(p.ws + OFF_R1);
    bf16_t* Q = (bf16_t*)(p.ws + OFF_R3 + R3_Q); bf16_t* Kf = (bf16_t*)(p.ws + OFF_R3 + R3_KF); bf16_t* Vt = (bf16_t*)(p.ws + OFF_R3 + R3_VT);
    const bf16_t* Wuq = (const bf16_t*)(p.ws + OFF_WUQ + l * SZ_WUQ); const bf16_t* Wukv = (const bf16_t*)(p.ws + OFF_WUKV + l * SZ_WUKV);
    const float* COS = (const float*)(p.ws + OFF_ROPE); const float* SIN = COS + (size_t)M_TOK * 16;
    float* rq = (float*)lds; float* rkv = rq + 64;
    __syncthreads();
    { const int row = tid >> 3, part = tid & 7; const bf16_t* pr = P1 + (size_t)(t0 + row) * NP1;
        float sq = 0.f, sk = 0.f;
#pragma unroll
        for (int i = 0; i < 4; ++i) { const u32x4 u = *(const u32x4*)(pr + C_QLAT + part * 32 + i * 8);
            sq += bf_lo(u.x) * bf_lo(u.x) + bf_hi(u.x) * bf_hi(u.x) + bf_lo(u.y) * bf_lo(u.y) + bf_hi(u.y) * bf_hi(u.y) + bf_lo(u.z) * bf_lo(u.z) + bf_hi(u.z) * bf_hi(u.z) + bf_lo(u.w) * bf_lo(u.w) + bf_hi(u.w) * bf_hi(u.w); }
#pragma unroll
        for (int i = 0; i < 2; ++i) { const u32x4 u = *(const u32x4*)(pr + C_KVLAT + part * 16 + i * 8);
            sk += bf_lo(u.x) * bf_lo(u.x) + bf_hi(u.x) * bf_hi(u.x) + bf_lo(u.y) * bf_lo(u.y) + bf_hi(u.y) * bf_hi(u.y) + bf_lo(u.z) * bf_lo(u.z) + bf_hi(u.z) * bf_hi(u.z) + bf_lo(u.w) * bf_lo(u.w) + bf_hi(u.w) * bf_hi(u.w); }
        sq += __shfl_xor(sq, 1); sq += __shfl_xor(sq, 2); sq += __shfl_xor(sq, 4);
        sk += __shfl_xor(sk, 1); sk += __shfl_xor(sk, 2); sk += __shfl_xor(sk, 4);
        if (part == 0) { rq[row] = rsqrtf(sq * (1.f / 256.f) + 1e-6f); rkv[row] = rsqrtf(sk * (1.f / 128.f) + 1e-6f); }
        const int i2 = part * 2; const int t = t0 + row;
        const unsigned u1 = *(const unsigned*)(pr + C_KROPE + i2), u2 = *(const unsigned*)(pr + C_KROPE + 16 + i2);
        const float c0 = COS[(size_t)t * 16 + i2], c1 = COS[(size_t)t * 16 + i2 + 1], s0 = SIN[(size_t)t * 16 + i2], s1 = SIN[(size_t)t * 16 + i2 + 1];
        const float x10 = bf_lo(u1), x11 = bf_hi(u1), x20 = bf_lo(u2), x21 = bf_hi(u2);
        const unsigned o1 = cvt_pk_bf16(x10 * c0 - x20 * s0, x11 * c1 - x21 * s1), o2 = cvt_pk_bf16(x20 * c0 + x10 * s0, x21 * c1 + x11 * s1);
#pragma unroll
        for (int h = 0; h < 8; ++h) { *(unsigned*)(Kf + (size_t)t * 768 + h * 96 + 64 + i2) = o1; *(unsigned*)(Kf + (size_t)t * 768 + h * 96 + 80 + i2) = o2; }
    }
    __syncthreads();
#pragma unroll 1
    for (int cb = 0; cb < 4; ++cb) { const int combo = wave * 4 + cb, rt = combo & 3, head = combo >> 2;
        f32x4 acc[6];
#pragma unroll
        for (int ct = 0; ct < 6; ++ct) acc[ct] = (f32x4){0.f, 0.f, 0.f, 0.f};
        const bf16_t* ap = P1 + (size_t)(t0 + rt * 16 + fr) * NP1 + C_QLAT + fq * 8;
        const bf16_t* wp = Wuq + (size_t)(head * 96 + fr) * 256 + fq * 8;
#pragma unroll
        for (int ks = 0; ks < 8; ++ks) { const bf16x8 af = ld_frag(ap + ks * 32);
#pragma unroll
            for (int ct = 0; ct < 6; ++ct) acc[ct] = MFMA(ld_frag(wp + (size_t)ct * 16 * 256 + ks * 32), af, acc[ct]); }
        const int t = t0 + rt * 16 + fr; const float rs = rq[rt * 16 + fr] * QSCALE;
        bf16_t* qp = Q + (size_t)t * 768 + head * 96 + fq * 4;
#pragma unroll
        for (int ct = 0; ct < 4; ++ct) *(u32x2*)(qp + ct * 16) = pack4(acc[ct] * rs);
        const f32x4 cs = *(const f32x4*)(COS + (size_t)t * 16 + fq * 4), sn = *(const f32x4*)(SIN + (size_t)t * 16 + fq * 4);
        const f32x4 x1 = acc[4] * rs, x2 = acc[5] * rs;
        *(u32x2*)(qp + 64) = pack4(x1 * cs - x2 * sn); *(u32x2*)(qp + 80) = pack4(x2 * cs + x1 * sn);
    }
#pragma unroll 1
    for (int cb = 0; cb < 4; ++cb) { const int combo = wave * 4 + cb, rt = combo & 3, head = combo >> 2;
        f32x4 ak[4], av[4];
#pragma unroll
        for (int ct = 0; ct < 4; ++ct) { ak[ct] = (f32x4){0.f, 0.f, 0.f, 0.f}; av[ct] = (f32x4){0.f, 0.f, 0.f, 0.f}; }
        const bf16_t* ap = P1 + (size_t)(t0 + rt * 16 + fr) * NP1 + C_KVLAT + fq * 8;
        const bf16_t* wp = Wukv + (size_t)(head * 128 + fr) * 128 + fq * 8;
#pragma unroll
        for (int ks = 0; ks < 4; ++ks) { const bf16x8 af = ld_frag(ap + ks * 32);
#pragma unroll
            for (int ct = 0; ct < 4; ++ct) { ak[ct] = MFMA(ld_frag(wp + (size_t)ct * 16 * 128 + ks * 32), af, ak[ct]);
                av[ct] = MFMA(af, ld_frag(wp + (size_t)(64 + ct * 16) * 128 + ks * 32), av[ct]); } }
        const int t = t0 + rt * 16 + fr; const float rs = rkv[rt * 16 + fr];
#pragma unroll
        for (int ct = 0; ct < 4; ++ct) *(u32x2*)(Kf + (size_t)t * 768 + head * 96 + ct * 16 + fq * 4) = pack4(ak[ct] * rs);
        const f32x4 rv = *(const f32x4*)(rkv + rt * 16 + fq * 4);
        const int b = t0 / SEQ, s0 = (t0 % SEQ) + rt * 16 + fq * 4;
#pragma unroll
        for (int ct = 0; ct < 4; ++ct) *(u32x2*)(Vt + ((size_t)(b * 8 + head) * 64 + ct * 16 + fr) * SEQ + s0) = pack4(av[ct] * rv);
    }
}

__device__ __forceinline__ void gmlp_item(const Params& p, int l, int item, unsigned char* lds) {
    const int tid = tid_l(), lane = tid & 63, wave = tid >> 6, fr = lane & 15, fq = lane >> 4;
    const int t0 = item * 128;
    const bf16_t* P1 = (const bf16_t*)(p.ws + OFF_R1); bf16_t* Z = (bf16_t*)(p.ws + OFF_Z);
    const bf16_t* Ws = (const bf16_t*)(p.ws + OFF_WS) + (size_t)l * 4 * 128 * 128;
    bf16_t* vb = (bf16_t*)lds;
    constexpr int VS = 520;
    __syncthreads();
    { const int tok = tid >> 2, qd = tid & 3; const bf16_t* pr = P1 + (size_t)(t0 + tok) * NP1 + C_GMV + qd * 128;
        float s = 0.f, s2 = 0.f;
#pragma unroll 4
        for (int i = 0; i < 16; ++i) { const u32x4 u = *(const u32x4*)(pr + i * 8); const unsigned uu[4] = {u.x, u.y, u.z, u.w};
#pragma unroll
            for (int e = 0; e < 4; ++e) { const float a = geluf_(bf_lo(uu[e])), b = geluf_(bf_hi(uu[e])); s += a + b; s2 += a * a + b * b; } }
        s += __shfl_xor(s, 1); s += __shfl_xor(s, 2); s2 += __shfl_xor(s2, 1); s2 += __shfl_xor(s2, 2);
        const float mean = s * (1.f / 512.f), var = fmaxf(s2 * (1.f / 512.f) - mean * mean, 0.f), rstd = rsqrtf(var + 1e-5f);
        const float* lg = p.ln_g + (size_t)l * 512 + qd * 128; const float* lb = p.ln_b + (size_t)l * 512 + qd * 128;
#pragma unroll 4
        for (int i = 0; i < 16; ++i) { const u32x4 u = *(const u32x4*)(pr + i * 8); const unsigned uu[4] = {u.x, u.y, u.z, u.w}; unsigned oo[4];
#pragma unroll
            for (int e = 0; e < 4; ++e) { const float a = (geluf_(bf_lo(uu[e])) - mean) * rstd * lg[i * 8 + 2 * e] + lb[i * 8 + 2 * e], b = (geluf_(bf_hi(uu[e])) - mean) * rstd * lg[i * 8 + 2 * e + 1] + lb[i * 8 + 2 * e + 1];
                oo[e] = cvt_pk_bf16(a, b); }
            *(u32x4*)(vb + (size_t)tok * VS + qd * 128 + i * 8) = (u32x4){oo[0], oo[1], oo[2], oo[3]}; }
    }
    __syncthreads();
#pragma unroll 1
    for (int g = 0; g < 4; ++g) {
        const int cbase = g * 128 + wave * 16;
        bf16x8 vfr[4];
#pragma unroll
        for (int ks = 0; ks < 4; ++ks) { bf16x8 f;
#pragma unroll
            for (int j = 0; j < 8; ++j) f[j] = (short)vb[(size_t)(ks * 32 + fq * 8 + j) * VS + cbase + fr];
            vfr[ks] = f; }
        const bf16_t* wg = Ws + (size_t)g * 128 * 128;
#pragma unroll 1
        for (int tt = 0; tt < 8; ++tt) {
            f32x4 acc = (f32x4){0.f, 0.f, 0.f, 0.f};
            const bf16_t* wp = wg + (size_t)(tt * 16 + fr) * 128 + fq * 8;
#pragma unroll
            for (int ks = 0; ks < 4; ++ks) acc = MFMA(vfr[ks], ld_frag(wp + ks * 32), acc);
            const int tl = tt * 16 + fr, t = t0 + tl, c = cbase + fq * 4;
            const float bs = p.b_s[(size_t)(l * 4 + g) * 128 + tl];
            const f32x4 u = unpack4(*(const u32x2*)(P1 + (size_t)t * NP1 + C_GMU + c));
            bf16_t* zp = Z + (size_t)t * NZ + 512 + c; const f32x4 z = unpack4(*(const u32x2*)zp);
            f32x4 o;
#pragma unroll
            for (int e = 0; e < 4; ++e) o[e] = geluf_(u[e]) * (acc[e] + bs) * siluf_(z[e]);
            *(u32x2*)zp = pack4(o);
        }
    }
}

__device__ __forceinline__ f32x4 mix4(const bf16_t* pr, const bf16_t* pp, bool has_prev, const float* mu) {
    const f32x4 a = unpack4(*(const u32x2*)pr); f32x4 b = (f32x4){0.f, 0.f, 0.f, 0.f}; if (has_prev) b = unpack4(*(const u32x2*)pp);
    const f32x4 m = *(const f32x4*)mu; return a + (b - a) * m;
}
__device__ __forceinline__ void rwkv_prep_item(const Params& p, int l, int item) {
    const int tid = tid_l(), lane = tid & 63, wave = tid >> 6, fr = lane & 15, fq = lane >> 4;
    const int rt = wave >> 1, hh = wave & 1;
    const int t = item * 64 + rt * 16 + fr; const bool hp = (t % SEQ) != 0;
    const bf16_t* P1 = (const bf16_t*)(p.ws + OFF_R1);
    const bf16_t* pr = P1 + (size_t)t * NP1; const bf16_t* pp = pr - NP1;
    const float* mu = p.mu + (size_t)l * 1664 - C_RW;
    const bf16_t* W2T = (const bf16_t*)(p.ws + OFF_W2T) + (size_t)l * 512 * 64; const bf16_t* A2T = (const bf16_t*)(p.ws + OFF_A2T) + (size_t)l * 512 * 64;
    unsigned char* r2 = p.ws + OFF_R2;
    bf16_t* VF = (bf16_t*)(p.ws + OFF_VF);
    bf16x8 fa[2], fw[2];
#pragma unroll
    for (int ks = 0; ks < 2; ++ks) { const int ca = C_ALAT + ks * 32 + fq * 8, cw = C_WLAT + ks * 32 + fq * 8;
        const f32x4 a0 = mix4(pr + ca, pp + ca, hp, mu + ca), a1 = mix4(pr + ca + 4, pp + ca + 4, hp, mu + ca + 4);
        f32x4 w0 = mix4(pr + cw, pp + cw, hp, mu + cw), w1 = mix4(pr + cw + 4, pp + cw + 4, hp, mu + cw + 4);
#pragma unroll
        for (int e = 0; e < 4; ++e) { w0[e] = tanhf(w0[e]); w1[e] = tanhf(w1[e]); }
        fa[ks] = pack_frag(a0, a1); fw[ks] = pack_frag(w0, w1); }
    bf16x8 t1f = (bf16x8){0, 0, 0, 0, 0, 0, 0, 0};
    if (l >= 1) { const bf16_t* V1T = (const bf16_t*)(p.ws + OFF_V1T) + (size_t)(l - 1) * 32 * 512;
        f32x4 c0 = (f32x4){0.f, 0.f, 0.f, 0.f}, c1 = c0;
#pragma unroll 2
        for (int ks = 0; ks < 16; ++ks) { const int cv = C_RWV + ks * 32 + fq * 8;
            const bf16x8 af = pack_frag(mix4(pr + cv, pp + cv, hp, mu + cv), mix4(pr + cv + 4, pp + cv + 4, hp, mu + cv + 4));
            c0 = MFMA(ld_frag(V1T + (size_t)fr * 512 + ks * 32 + fq * 8), af, c0); c1 = MFMA(ld_frag(V1T + (size_t)(16 + fr) * 512 + ks * 32 + fq * 8), af, c1); }
        t1f = pack_frag(c0, c1);
    }
#pragma unroll 1
    for (int hq = 0; hq < 4; ++hq) { const int h = hh * 4 + hq;
        float ss = 0.f;
#pragma unroll
        for (int ct = 0; ct < 4; ++ct) { const int c = h * 64 + ct * 16 + fq * 4;
            const f32x4 kr = mix4(pr + C_RWK + c, pp + C_RWK + c, hp, mu + C_RWK + c) * *(const f32x4*)(p.k_k + (size_t)l * 512 + c);
            ss += kr[0] * kr[0] + kr[1] * kr[1] + kr[2] * kr[2] + kr[3] * kr[3]; }
        ss += __shfl_xor(ss, 16); ss += __shfl_xor(ss, 32);
        const float inv = 1.f / fmaxf(sqrtf(ss), 1e-12f);
#pragma unroll 1
        for (int ct = 0; ct < 4; ++ct) { const int crow = h * 64 + ct * 16 + fr;
            f32x4 aa = (f32x4){0.f, 0.f, 0.f, 0.f}, aw = aa, avm = aa;
#pragma unroll
            for (int ks = 0; ks < 2; ++ks) { aa = MFMA(ld_frag(A2T + (size_t)crow * 64 + ks * 32 + fq * 8), fa[ks], aa); aw = MFMA(ld_frag(W2T + (size_t)crow * 64 + ks * 32 + fq * 8), fw[ks], aw); }
            if (l >= 1) { const bf16_t* V2T = (const bf16_t*)(p.ws + OFF_V2T) + (size_t)(l - 1) * 512 * 32 + (size_t)crow * 32;
                avm = MFMA(join_frag(*(const u32x2*)(V2T + fq * 4), *(const u32x2*)(V2T + 16 + fq * 4)), t1f, avm); }
            const int c = h * 64 + ct * 16 + fq * 4; const size_t o = (size_t)t * 512 + c;
            const f32x4 rs = mix4(pr + C_RWR + c, pp + C_RWR + c, hp, mu + C_RWR + c);
            const f32x4 ksv = mix4(pr + C_RWK + c, pp + C_RWK + c, hp, mu + C_RWK + c);
            f32x4 vs = mix4(pr + C_RWV + c, pp + C_RWV + c, hp, mu + C_RWV + c);
            const f32x4 a0 = *(const f32x4*)(p.a0 + (size_t)l * 512 + c), w0 = *(const f32x4*)(p.w0 + (size_t)l * 512 + c), kkw = *(const f32x4*)(p.k_k + (size_t)l * 512 + c);
            const f32x4 ka = *(const f32x4*)(p.k_a + (size_t)l * 512 + c);
            f32x4 lw, asg;
#pragma unroll
            for (int e = 0; e < 4; ++e) { asg[e] = sigmoidf_(a0[e] + aa[e]); lw[e] = -0.6065306597126334f * sigmoidf_(w0[e] + aw[e]); }
            *(f32x4*)((float*)(r2 + R2_LW) + o) = lw;
            if (l == 0) { *(u32x2*)(VF + o) = pack4(vs); }
            else { const f32x4 vf = unpack4(*(const u32x2*)(VF + o)), v0 = *(const f32x4*)(p.v0 + (size_t)(l - 1) * 512 + c);
#pragma unroll
                for (int e = 0; e < 4; ++e) vs[e] = vs[e] + (vf[e] - vs[e]) * sigmoidf_(v0[e] + avm[e]); }
            const f32x4 kk = ksv * kkw * inv, km = ksv * ((asg - 1.f) * ka + 1.f), bb = kk * asg;
            *(u32x2*)((bf16_t*)(r2 + R2_R) + o) = pack4(rs); *(u32x2*)((bf16_t*)(r2 + R2_K) + o) = pack4(km); *(u32x2*)((bf16_t*)(r2 + R2_V) + o) = pack4(vs);
            *(u32x2*)((bf16_t*)(r2 + R2_KK) + o) = pack4(kk); *(u32x2*)((bf16_t*)(r2 + R2_B) + o) = pack4(bb); }
    }
}

__device__ __forceinline__ void attn_item(const Params& p, int b, int h, int qb, unsigned char* lds) {
    const int tid = tid_l(), lane = tid & 63, wave = tid >> 6, fr = lane & 15, fq = lane >> 4;
    const bf16_t* Q = (const bf16_t*)(p.ws + OFF_R3 + R3_Q); const bf16_t* Kf = (const bf16_t*)(p.ws + OFF_R3 + R3_KF); const bf16_t* Vt = (const bf16_t*)(p.ws + OFF_R3 + R3_VT);
    bf16_t* Z = (bf16_t*)(p.ws + OFF_Z);
    constexpr int KS = 104, VS = 72, KB = 64 * KS * 2, VB = 64 * VS * 2, BUF = KB + VB;
    const int nkt = 2 * qb + 2, mykt = (wave < 4) ? nkt - 1 : nkt;
    const int trow = b * SEQ + qb * 128 + wave * 16 + fr;
    bf16x8 qf[3];
#pragma unroll
    for (int ks = 0; ks < 3; ++ks) qf[ks] = ld_frag(Q + (size_t)trow * 768 + h * 96 + ks * 32 + fq * 8);
    const bf16_t* kg = Kf + (size_t)(b * SEQ) * 768 + h * 96; const bf16_t* vg = Vt + (size_t)(b * 8 + h) * 64 * SEQ;
    const int kr0 = tid / 12, kc0 = tid % 12, kr1 = (tid + 512) / 12, kc1 = (tid + 512) % 12, vd = tid >> 3, vc = tid & 7;
    u32x4 pk0, pk1 = (u32x4){0, 0, 0, 0}, pv;
    __syncthreads();
    pk0 = *(const u32x4*)(kg + (size_t)kr0 * 768 + kc0 * 8); if (tid < 256) pk1 = *(const u32x4*)(kg + (size_t)kr1 * 768 + kc1 * 8);
    pv = *(const u32x4*)(vg + (size_t)vd * SEQ + vc * 8);
    { bf16_t* ks_ = (bf16_t*)lds; bf16_t* vs_ = (bf16_t*)(lds + KB);
        *(u32x4*)(ks_ + kr0 * KS + kc0 * 8) = pk0; if (tid < 256) *(u32x4*)(ks_ + kr1 * KS + kc1 * 8) = pk1; *(u32x4*)(vs_ + vd * VS + vc * 8) = pv; }
    __syncthreads();
    f32x4 O[4]; float m = -1e30f, lsum = 0.f;
#pragma unroll
    for (int d = 0; d < 4; ++d) O[d] = (f32x4){0.f, 0.f, 0.f, 0.f};
#pragma unroll 1
    for (int kt = 0; kt < nkt; ++kt) {
        const bool pre = (kt + 1 < nkt);
        if (pre) { const size_t ko = (size_t)(kt + 1) * 64;
            pk0 = *(const u32x4*)(kg + (ko + kr0) * 768 + kc0 * 8); if (tid < 256) pk1 = *(const u32x4*)(kg + (ko + kr1) * 768 + kc1 * 8);
            pv = *(const u32x4*)(vg + (size_t)vd * SEQ + ko + vc * 8); }
        if (kt < mykt) {
            const bf16_t* ks_ = (const bf16_t*)(lds + (kt & 1) * BUF); const bf16_t* vs_ = (const bf16_t*)(lds + (kt & 1) * BUF + KB);
            f32x4 s[4];
#pragma unroll
            for (int c4 = 0; c4 < 4; ++c4) { s[c4] = (f32x4){0.f, 0.f, 0.f, 0.f};
#pragma unroll
                for (int ks = 0; ks < 3; ++ks) s[c4] = MFMA(ld_frag(ks_ + (c4 * 16 + fr) * KS + ks * 32 + fq * 8), qf[ks], s[c4]); }
            float mx = -1e30f;
#pragma unroll
            for (int c4 = 0; c4 < 4; ++c4) mx = fmaxf(fmaxf(fmaxf(s[c4][0], s[c4][1]), fmaxf(s[c4][2], s[c4][3])), mx);
            mx = fmaxf(mx, __shfl_xor(mx, 16)); mx = fmaxf(mx, __shfl_xor(mx, 32));
            const float mn = fmaxf(m, mx), alpha = exp2f(m - mn); m = mn;
            float ps = 0.f;
#pragma unroll
            for (int c4 = 0; c4 < 4; ++c4)
#pragma unroll
                for (int e = 0; e < 4; ++e) { s[c4][e] = exp2f(s[c4][e] - mn); ps += s[c4][e]; }
            lsum = lsum * alpha + ps;
#pragma unroll
            for (int d = 0; d < 4; ++d) O[d] = O[d] * alpha;
            const bf16x8 pf0 = pack_frag(s[0], s[1]), pf1 = pack_frag(s[2], s[3]);
#pragma unroll
            for (int d = 0; d < 4; ++d) { const bf16_t* vp = vs_ + (d * 16 + fr) * VS + fq * 4;
                O[d] = MFMA(join_frag(*(const u32x2*)(vp), *(const u32x2*)(vp + 16)), pf0, O[d]);
                O[d] = MFMA(join_frag(*(const u32x2*)(vp + 32), *(const u32x2*)(vp + 48)), pf1, O[d]); }
        }
        if (pre) { bf16_t* ks_ = (bf16_t*)(lds + ((kt + 1) & 1) * BUF); bf16_t* vs_ = (bf16_t*)(lds + ((kt + 1) & 1) * BUF + KB);
            *(u32x4*)(ks_ + kr0 * KS + kc0 * 8) = pk0; if (tid < 256) *(u32x4*)(ks_ + kr1 * KS + kc1 * 8) = pk1; *(u32x4*)(vs_ + vd * VS + vc * 8) = pv; }
        __syncthreads();
    }
    lsum += __shfl_xor(lsum, 16); lsum += __shfl_xor(lsum, 32);
    const float il = 1.f / lsum;
#pragma unroll
    for (int d = 0; d < 4; ++d) { bf16_t* zp = Z + (size_t)trow * NZ + h * 64 + d * 16 + fq * 4; const f32x4 z = unpack4(*(const u32x2*)zp);
        f32x4 o;
#pragma unroll
        for (int e = 0; e < 4; ++e) o[e] = O[d][e] * il * siluf_(z[e]);
        *(u32x2*)zp = pack4(o); }
}

__device__ __forceinline__ void scan_item(const Params& p, int l, int bh, unsigned char* lds) {
    const int tid = tid_l(), b = bh >> 3, h = bh & 7;
    const unsigned char* r2 = p.ws + OFF_R2; bf16_t* Z = (bf16_t*)(p.ws + OFF_Z);
    float* Lw = (float*)lds; float* La = Lw + 4096; float* Lb = La + 4096; float* Lk = Lb + 4096; float* Lr = Lk + 4096; float* Lv = Lr + 4096; float* Ly = Lv + 4096;
    const int i = tid >> 3, jp = tid & 7;
    float st[8];
#pragma unroll
    for (int e = 0; e < 8; ++e) st[e] = 0.f;
    const int et = tid >> 3, ep = tid & 7;
#pragma unroll 1
    for (int ck = 0; ck < SEQ / 64; ++ck) {
        const size_t tg = (size_t)b * SEQ + ck * 64 + et; const size_t o = tg * 512 + h * 64 + ep * 8;
        __syncthreads();
        { const u32x4 ur = *(const u32x4*)((const bf16_t*)(r2 + R2_R) + o), uk = *(const u32x4*)((const bf16_t*)(r2 + R2_K) + o), uv = *(const u32x4*)((const bf16_t*)(r2 + R2_V) + o),
                      ukk = *(const u32x4*)((const bf16_t*)(r2 + R2_KK) + o), ub = *(const u32x4*)((const bf16_t*)(r2 + R2_B) + o);
            const f32x4 l0 = *(const f32x4*)((const float*)(r2 + R2_LW) + o), l1 = *(const f32x4*)((const float*)(r2 + R2_LW) + o + 4);
            const int lo = et * 64 + ep * 8;
            *(f32x4*)(Lw + lo) = (f32x4){__expf(l0[0]), __expf(l0[1]), __expf(l0[2]), __expf(l0[3])}; *(f32x4*)(Lw + lo + 4) = (f32x4){__expf(l1[0]), __expf(l1[1]), __expf(l1[2]), __expf(l1[3])};
            *(f32x4*)(La + lo) = (f32x4){-bf_lo(ukk.x), -bf_hi(ukk.x), -bf_lo(ukk.y), -bf_hi(ukk.y)}; *(f32x4*)(La + lo + 4) = (f32x4){-bf_lo(ukk.z), -bf_hi(ukk.z), -bf_lo(ukk.w), -bf_hi(ukk.w)};
            *(f32x4*)(Lb + lo) = (f32x4){bf_lo(ub.x), bf_hi(ub.x), bf_lo(ub.y), bf_hi(ub.y)}; *(f32x4*)(Lb + lo + 4) = (f32x4){bf_lo(ub.z), bf_hi(ub.z), bf_lo(ub.w), bf_hi(ub.w)};
            *(f32x4*)(Lk + lo) = (f32x4){bf_lo(uk.x), bf_hi(uk.x), bf_lo(uk.y), bf_hi(uk.y)}; *(f32x4*)(Lk + lo + 4) = (f32x4){bf_lo(uk.z), bf_hi(uk.z), bf_lo(uk.w), bf_hi(uk.w)};
            *(f32x4*)(Lr + lo) = (f32x4){bf_lo(ur.x), bf_hi(ur.x), bf_lo(ur.y), bf_hi(ur.y)}; *(f32x4*)(Lr + lo + 4) = (f32x4){bf_lo(ur.z), bf_hi(ur.z), bf_lo(ur.w), bf_hi(ur.w)};
            *(f32x4*)(Lv + lo) = (f32x4){bf_lo(uv.x), bf_hi(uv.x), bf_lo(uv.y), bf_hi(uv.y)}; *(f32x4*)(Lv + lo + 4) = (f32x4){bf_lo(uv.z), bf_hi(uv.z), bf_lo(uv.w), bf_hi(uv.w)};
        }
        __syncthreads();
#pragma unroll 2
        for (int t = 0; t < 64; ++t) { const int lo = t * 64 + jp * 8;
            const f32x4 w0 = *(const f32x4*)(Lw + lo), w1 = *(const f32x4*)(Lw + lo + 4), a0 = *(const f32x4*)(La + lo), a1 = *(const f32x4*)(La + lo + 4), b0 = *(const f32x4*)(Lb + lo), b1 = *(const f32x4*)(Lb + lo + 4),
                        k0 = *(const f32x4*)(Lk + lo), k1 = *(const f32x4*)(Lk + lo + 4), r0 = *(const f32x4*)(Lr + lo), r1 = *(const f32x4*)(Lr + lo + 4);
            const float vi = Lv[t * 64 + i];
            float sa = st[0] * a0[0] + st[1] * a0[1] + st[2] * a0[2] + st[3] * a0[3] + st[4] * a1[0] + st[5] * a1[1] + st[6] * a1[2] + st[7] * a1[3];
            sa += __shfl_xor(sa, 1); sa += __shfl_xor(sa, 2); sa += __shfl_xor(sa, 4);
            st[0] = st[0] * w0[0] + sa * b0[0] + vi * k0[0]; st[1] = st[1] * w0[1] + sa * b0[1] + vi * k0[1]; st[2] = st[2] * w0[2] + sa * b0[2] + vi * k0[2]; st[3] = st[3] * w0[3] + sa * b0[3] + vi * k0[3];
            st[4] = st[4] * w1[0] + sa * b1[0] + vi * k1[0]; st[5] = st[5] * w1[1] + sa * b1[1] + vi * k1[1]; st[6] = st[6] * w1[2] + sa * b1[2] + vi * k1[2]; st[7] = st[7] * w1[3] + sa * b1[3] + vi * k1[3];
            float y = st[0] * r0[0] + st[1] * r0[1] + st[2] * r0[2] + st[3] * r0[3] + st[4] * r1[0] + st[5] * r1[1] + st[6] * r1[2] + st[7] * r1[3];
            y += __shfl_xor(y, 1); y += __shfl_xor(y, 2); y += __shfl_xor(y, 4);
            if (jp == 0) Ly[t * 64 + i] = y;
        }
        __syncthreads();
        { const int lo = et * 64 + ep * 8;
            const f32x4 y0 = *(const f32x4*)(Ly + lo), y1 = *(const f32x4*)(Ly + lo + 4), r0 = *(const f32x4*)(Lr + lo), r1 = *(const f32x4*)(Lr + lo + 4), k0 = *(const f32x4*)(Lk + lo), k1 = *(const f32x4*)(Lk + lo + 4),
                        v0 = *(const f32x4*)(Lv + lo), v1 = *(const f32x4*)(Lv + lo + 4);
            const f32x4 rk0 = *(const f32x4*)(p.r_k + (size_t)l * 512 + h * 64 + ep * 8), rk1 = *(const f32x4*)(p.r_k + (size_t)l * 512 + h * 64 + ep * 8 + 4);
            float s = y0[0] + y0[1] + y0[2] + y0[3] + y1[0] + y1[1] + y1[2] + y1[3];
            float dot = r0[0] * k0[0] * rk0[0] + r0[1] * k0[1] * rk0[1] + r0[2] * k0[2] * rk0[2] + r0[3] * k0[3] * rk0[3] + r1[0] * k1[0] * rk1[0] + r1[1] * k1[1] * rk1[1] + r1[2] * k1[2] * rk1[2] + r1[3] * k1[3] * rk1[3];
            s += __shfl_xor(s, 1); s += __shfl_xor(s, 2); s += __shfl_xor(s, 4);
            dot += __shfl_xor(dot, 1); dot += __shfl_xor(dot, 2); dot += __shfl_xor(dot, 4);
            const float mean = s * (1.f / 64.f);
            const f32x4 d0 = y0 - mean, d1 = y1 - mean;
            float q = d0[0] * d0[0] + d0[1] * d0[1] + d0[2] * d0[2] + d0[3] * d0[3] + d1[0] * d1[0] + d1[1] * d1[1] + d1[2] * d1[2] + d1[3] * d1[3];
            q += __shfl_xor(q, 1); q += __shfl_xor(q, 2); q += __shfl_xor(q, 4);
            const float rstd = rsqrtf(q * (1.f / 64.f) + 64e-5f);
            const f32x4 g0 = *(const f32x4*)(p.lnx_g + (size_t)l * 512 + h * 64 + ep * 8), g1 = *(const f32x4*)(p.lnx_g + (size_t)l * 512 + h * 64 + ep * 8 + 4),
                        e0 = *(const f32x4*)(p.lnx_b + (size_t)l * 512 + h * 64 + ep * 8), e1 = *(const f32x4*)(p.lnx_b + (size_t)l * 512 + h * 64 + ep * 8 + 4);
            bf16_t* zp = Z + tg * NZ + 1024 + h * 64 + ep * 8; const u32x4 zu = *(const u32x4*)zp;
            const f32x4 o0 = d0 * rstd * g0 + e0 + v0 * dot, o1 = d1 * rstd * g1 + e1 + v1 * dot;
            u32x4 w; w.x = cvt_pk_bf16(o0[0] * siluf_(bf_lo(zu.x)), o0[1] * siluf_(bf_hi(zu.x))); w.y = cvt_pk_bf16(o0[2] * siluf_(bf_lo(zu.y)), o0[3] * siluf_(bf_hi(zu.y)));
            w.z = cvt_pk_bf16(o1[0] * siluf_(bf_lo(zu.z)), o1[1] * siluf_(bf_hi(zu.z))); w.w = cvt_pk_bf16(o1[2] * siluf_(bf_lo(zu.w)), o1[3] * siluf_(bf_hi(zu.w)));
            *(u32x4*)zp = w; }
    }
}

constexpr int PH_PER_LAYER = 7, N_PHASES = 2 + NL * PH_PER_LAYER;
__global__ void __launch_bounds__(NTHREADS, 2) trunk_fwd(Params p0) {
    extern __shared__ __attribute__((aligned(16))) unsigned char lds[];
    const int G = gridDim.x, bx = blockIdx.x;
    Params p = p0;
    for (int ph = p0.ph_lo; ph < p0.ph_hi; ++ph) {
        unsigned char* ws = ptr_l(p0.ws); p.ws = ws;
        if (ph == 0) { if (PHEN & 1) phase0a(p, lds); }
        else if (ph == 1) { if (PHEN & 2) phase0b(p); }
        else {
            const int l = (ph - 2) / PH_PER_LAYER, k = (ph - 2) % PH_PER_LAYER;
            if (k == 0 && (PHEN & 4)) {
                pg8::Gemm g{(const bf16_t*)(ws + OFF_H), (const bf16_t*)(ws + OFF_WIN + l * SZ_WIN), DM, DM, DM};
                pg8::PlainOrder S; S.init(M_TOK / 256, NIN / 256, G, bx);
                pg8::EpiIn E{(bf16_t*)(ws + OFF_R1), (bf16_t*)(ws + OFF_Z)};
                pg8::gemm_phase(( LAS unsigned char*)lds, g, S, E);
            } else if (k == 1 && (PHEN & 8)) {
                for (int it = bx; it < 640; it += G) {
                    if (it < 128) { if (PHEN & 512) gmlp_item(p, l, it, lds); }
                    else if (it < 384) { if (PHEN & 1024) mla_prep_item(p, l, it - 128, lds); }
                    else { if (PHEN & 2048) rwkv_prep_item(p, l, it - 384); }
                }
            } else if (k == 2 && (PHEN & 16)) {
                for (int it = bx; it < 32; it += G) scan_item(p, l, it, lds);
                int rank = bx, cnt = G; if (G > 32) { rank = bx - 32; cnt = G - 32; }
                if (rank >= 0) for (int pi = rank; pi < 512; pi += cnt) { const int bh = pi >> 4, j = pi & 15;
                    attn_item(p, bh >> 3, bh & 7, 31 - j, lds); attn_item(p, bh >> 3, bh & 7, j, lds); }
            } else if (k == 3 && (PHEN & 32)) {
                pg8::Gemm g{(const bf16_t*)(ws + OFF_H), (const bf16_t*)(ws + OFF_WG + l * SZ_WG), DM, DM, DM};
                pg8::PlainOrder S; S.init(M_TOK / 256, NG / 256, G, bx);
                pg8::EpiPlain<1> E{(bf16_t*)(ws + OFF_R2), NG};
                pg8::gemm_phase((LAS unsigned char*)lds, g, S, E);
            } else if (k == 4 && (PHEN & 64)) {
                pg8::Gemm g{(const bf16_t*)(ws + OFF_Z), (const bf16_t*)(ws + OFF_WBR + l * SZ_WBR), NZ, 512, 512};
                pg8::MergeOrder S; S.init(M_TOK / 256, DM / 256, G, bx);
                pg8::EpiMerge E{(bf16_t*)(ws + OFF_R3 + R3_MERGED), (const bf16_t*)(ws + OFF_R2)};
                pg8::gemm_phase((LAS unsigned char*)lds, g, S, E);
            } else if (k == 5 && (PHEN & 128)) {
                pg8::Gemm g{(const bf16_t*)(ws + OFF_R3 + R3_MERGED), (const bf16_t*)(ws + OFF_WOUT + l * SZ_WOUT), DM, DM, DM};
                pg8::PlainOrder S; S.init(M_TOK / 256, DM / 256, G, bx);
                pg8::EpiPlain<0> E{(bf16_t*)(ws + OFF_R3 + R3_Y), DM};
                pg8::gemm_phase((LAS unsigned char*)lds, g, S, E);
            } else if (k == 6 && (PHEN & 256)) {
                phase_final(p, l);
            }
        }
        if (ph + 1 < p0.ph_hi) cg::this_grid().sync();
    }
}

extern "C" void kernel_launch(void* const* d_in, const int* in_sizes, int n_in, void* d_out, int out_size, void* d_ws, size_t ws_size, hipStream_t stream) {
    static int grid = 0;
    if (grid == 0) {
        if (n_in != 31 || out_size != M_TOK * DM || ws_size < WS_END) { fprintf(stderr, "kernel_launch: unexpected shapes (n_in %d out %d ws %zu)\n", n_in, out_size, ws_size); grid = -1; return; }
        int dev = 0, cus = 0, per_cu = 0;
        hipGetDevice(&dev); hipDeviceGetAttribute(&cus, hipDeviceAttributeMultiprocessorCount, dev);
        hipFuncSetAttribute((const void*)trunk_fwd, hipFuncAttributeMaxDynamicSharedMemorySize, LDS_BYTES);
        hipOccupancyMaxActiveBlocksPerMultiprocessor(&per_cu, (const void*)trunk_fwd, NTHREADS, LDS_BYTES);
        if (per_cu < 1) { fprintf(stderr, "kernel_launch: occupancy query says %d blocks per CU\n", per_cu); grid = -1; return; }
        grid = cus * 1;
    }
    if (grid < 0) return;
    Params p{};
    p.x = (const float*)d_in[0]; p.c = (const float*)d_in[1]; p.pos = (const int*)d_in[2]; p.pre_g = (const float*)d_in[3]; p.post_g = (const float*)d_in[4];
    p.w_ada = (const float*)d_in[5]; p.b_ada = (const float*)d_in[6]; p.w_in = (const float*)d_in[7]; p.q_norm = (const float*)d_in[8]; p.w_uq = (const float*)d_in[9];
    p.kv_norm = (const float*)d_in[10]; p.w_ukv = (const float*)d_in[11]; p.ln_g = (const float*)d_in[12]; p.ln_b = (const float*)d_in[13]; p.w_s = (const float*)d_in[14]; p.b_s = (const float*)d_in[15];
    p.mu = (const float*)d_in[16]; p.w0 = (const float*)d_in[17]; p.w2 = (const float*)d_in[18]; p.a0 = (const float*)d_in[19]; p.a2 = (const float*)d_in[20]; p.k_k = (const float*)d_in[21];
    p.k_a = (const float*)d_in[22]; p.r_k = (const float*)d_in[23]; p.lnx_g = (const float*)d_in[24]; p.lnx_b = (const float*)d_in[25]; p.v0 = (const float*)d_in[26]; p.v1 = (const float*)d_in[27];
    p.v2 = (const float*)d_in[28]; p.w_br = (const float*)d_in[29]; p.w_out = (const float*)d_in[30];
    p.out = (float*)d_out; p.ws = (unsigned char*)d_ws;
#if ONE_LAUNCH
    p.ph_lo = 0; p.ph_hi = N_PHASES;
    void* args[] = {&p};
    hipError_t e = hipLaunchCooperativeKernel((const void*)trunk_fwd, dim3(grid), dim3(NTHREADS), args, LDS_BYTES, stream);
    if (e != hipSuccess) fprintf(stderr, "cooperative launch failed: %s (grid %d)\n", hipGetErrorString(e), grid);
#else
    for (int ph = 0; ph < N_PHASES; ++ph) { p.ph_lo = ph; p.ph_hi = ph + 1;
        hipLaunchKernelGGL(trunk_fwd, dim3(grid), dim3(NTHREADS), LDS_BYTES, stream, p); }
#endif
}
```

```cpp
#include <hip/hip_runtime.h>
#include <hip/hip_cooperative_groups.h>
#include <cstdint>
#include <cstdio>
namespace cg = cooperative_groups;

#ifndef PHEN
#define PHEN 0xfff
#endif
#ifndef ONE_LAUNCH
#define ONE_LAUNCH 1
#endif

#define LAS __attribute__((address_space(3)))
typedef unsigned short bf16_t;
typedef short bf16x8 __attribute__((ext_vector_type(8)));
typedef short bf16x4 __attribute__((ext_vector_type(4)));
typedef float f32x4 __attribute__((ext_vector_type(4)));
typedef float f32x2 __attribute__((ext_vector_type(2)));
typedef unsigned u32x4 __attribute__((ext_vector_type(4)));
typedef unsigned u32x2 __attribute__((ext_vector_type(2)));

constexpr int M_TOK = 16384, DM = 1024, SEQ = 4096, NBATCH = 4, NL = 4;
constexpr int D_IN_SRC = 7712;
constexpr int NP1 = 3328, NZ = 1536, NIN = 4864, NG = 3072;
constexpr int C_QLAT = 0, C_KVLAT = 256, C_KROPE = 384, C_GMU = 512, C_GMV = 1024, C_RW = 1536, C_RWR = 1536, C_RWK = 2048, C_RWV = 2560, C_WLAT = 3072, C_ALAT = 3136;
constexpr int NTHREADS = 512, NWAVES = 8;
constexpr int LDS_BYTES = 150 * 1024;
constexpr float QSCALE = 0.10206207261596575f * 1.4426950408889634f;

constexpr size_t MiB = 1u << 20;
constexpr size_t OFF_WIN = 0;
constexpr size_t SZ_WIN = (size_t)NIN * DM * 2;
constexpr size_t OFF_WG = 38 * MiB;
constexpr size_t SZ_WG = (size_t)NG * DM * 2;
constexpr size_t OFF_WBR = 62 * MiB;
constexpr size_t SZ_WBR = (size_t)3072 * 512 * 2;
constexpr size_t OFF_WOUT = 74 * MiB;
constexpr size_t SZ_WOUT = (size_t)DM * DM * 2;
constexpr size_t OFF_WUQ = 82 * MiB;
constexpr size_t SZ_WUQ = (size_t)768 * 256 * 2;
constexpr size_t OFF_WUKV = OFF_WUQ + 3 * MiB / 2;
constexpr size_t SZ_WUKV = (size_t)1024 * 128 * 2;
constexpr size_t OFF_SMALL = OFF_WUKV + 1 * MiB;
constexpr size_t OFF_W2T = OFF_SMALL;
constexpr size_t OFF_A2T = OFF_W2T + 256 * 1024;
constexpr size_t OFF_V1T = OFF_A2T + 256 * 1024;
constexpr size_t OFF_V2T = OFF_V1T + 128 * 1024;
constexpr size_t OFF_WS = OFF_V2T + 128 * 1024;
constexpr size_t OFF_MODP = OFF_WS + 512 * 1024;
constexpr size_t OFF_ROPE = OFF_MODP + 3 * MiB / 2;
constexpr size_t OFF_H = 90 * MiB;
constexpr size_t OFF_Z = 122 * MiB;
constexpr size_t OFF_VF = 170 * MiB;
constexpr size_t OFF_R1 = 186 * MiB;
constexpr size_t OFF_R2 = 298 * MiB;
constexpr size_t OFF_R3 = 410 * MiB;
constexpr size_t WS_END = 474 * MiB;
static_assert(OFF_ROPE + 2 * MiB <= OFF_H, "small region");
constexpr size_t R2_R = 0, R2_K = 16 * MiB, R2_V = 32 * MiB, R2_KK = 48 * MiB, R2_B = 64 * MiB, R2_LW = 80 * MiB;
constexpr size_t R3_Q = 0, R3_KF = 24 * MiB, R3_VT = 48 * MiB, R3_MERGED = 0, R3_Y = 32 * MiB;

struct Params {
    const float* x; const float* c; const int* pos; const float* pre_g; const float* post_g; const float* w_ada; const float* b_ada; const float* w_in;
    const float* q_norm; const float* w_uq; const float* kv_norm; const float* w_ukv; const float* ln_g; const float* ln_b; const float* w_s; const float* b_s;
    const float* mu; const float* w0; const float* w2; const float* a0; const float* a2; const float* k_k; const float* k_a; const float* r_k;
    const float* lnx_g; const float* lnx_b; const float* v0; const float* v1; const float* v2; const float* w_br; const float* w_out;
    float* out; unsigned char* ws;
    int ph_lo, ph_hi;
};

__device__ __forceinline__ unsigned cvt_pk_bf16(float lo, float hi) { unsigned r; asm volatile("v_cvt_pk_bf16_f32 %0, %1, %2" : "=v"(r) : "v"(lo), "v"(hi)); return r; }
__device__ __forceinline__ float bf_lo(unsigned u) { return __uint_as_float(u << 16); }
__device__ __forceinline__ float bf_hi(unsigned u) { return __uint_as_float(u & 0xffff0000u); }
__device__ __forceinline__ float bf2f(bf16_t h) { return __uint_as_float(((unsigned)h) << 16); }
__device__ __forceinline__ bf16_t f2bf(float f) { return (bf16_t)(cvt_pk_bf16(f, 0.f) & 0xffffu); }
__device__ __forceinline__ float sigmoidf_(float x) { return 1.f / (1.f + __expf(-x)); }
__device__ __forceinline__ float siluf_(float x) { return x / (1.f + __expf(-x)); }
__device__ __forceinline__ float geluf_(float x) { return 0.5f * x * (1.f + erff(x * 0.70710678118654752f)); }
__device__ __forceinline__ f32x4 unpack4(u32x2 u) { return (f32x4){bf_lo(u.x), bf_hi(u.x), bf_lo(u.y), bf_hi(u.y)}; }
__device__ __forceinline__ u32x2 pack4(f32x4 v) { u32x2 r; r.x = cvt_pk_bf16(v[0], v[1]); r.y = cvt_pk_bf16(v[2], v[3]); return r; }
__device__ __forceinline__ float wave_sum(float v) {
#pragma unroll
    for (int o = 1; o < 64; o <<= 1) v += __shfl_xor(v, o);
    return v;
}
__device__ __forceinline__ bf16x8 ld_frag(const bf16_t* p) { return *(const bf16x8*)p; }
__device__ __forceinline__ bf16x8 pack_frag(f32x4 a, f32x4 b) {
    u32x4 u; u.x = cvt_pk_bf16(a[0], a[1]); u.y = cvt_pk_bf16(a[2], a[3]); u.z = cvt_pk_bf16(b[0], b[1]); u.w = cvt_pk_bf16(b[2], b[3]);
    return __builtin_bit_cast(bf16x8, u);
}
__device__ __forceinline__ bf16x8 join_frag(u32x2 a, u32x2 b) { u32x4 u; u.x = a.x; u.y = a.y; u.z = b.x; u.w = b.y; return __builtin_bit_cast(bf16x8, u); }
__device__ __forceinline__ int tid_l() { int t = threadIdx.x; asm volatile("" : "+v"(t)); return t; }
__device__ __forceinline__ unsigned char* ptr_l(unsigned char* q) { asm volatile("" : "+s"(q)); return q; }
#define MFMA(a, b, c) __builtin_amdgcn_mfma_f32_16x16x32_bf16((a), (b), (c), 0, 0, 0)

namespace pg8 {
constexpr int BM = 256, BK = 64, HALF = 128, HTB = HALF * BK * 2, STAGE_BYTES = 8 * HTB, NXCD = 8, WGM = 8;
__host__ __device__ __forceinline__ int lds_byte(int r, int c) { const int st = (r >> 4) * 2 + (c >> 5), rr = r & 15, cc = c & 31, ob = rr * 64 + cc * 2; return st * 1024 + (ob ^ (((ob >> 9) & 1) << 5)); }
__host__ __device__ __forceinline__ void stage_rc(int b, int& R, int& C) { const int st = b / 1024, sb = b % 1024, swz = sb ^ (((sb >> 9) & 1) << 5); R = (st >> 1) * 16 + swz / 64; C = (st & 1) * 32 + (swz % 64) / 2; }
__host__ __device__ __forceinline__ int perm32(int rho) { const int n = rho >> 4, i = rho & 15; return 8 * (i >> 2) + 4 * n + (i & 3); }

struct Unit { int pm, pn, ak, tag; };
struct Gemm { const bf16_t* A; const bf16_t* Bt; int lda, ldb, K; };

__device__ __forceinline__ void tile_of(int wgid, int nM, int nN, int& pm, int& pn) {
    const int nwg = nM * nN;
    { const int q = nwg / NXCD, r = nwg % NXCD, xcd = wgid % NXCD, off = wgid / NXCD; wgid = (xcd < r ? xcd * (q + 1) : r * (q + 1) + (xcd - r) * q) + off; }
    const int nig = WGM * nN, gid = wgid / nig, fm = gid * WGM, gsz = (nM - fm) < WGM ? (nM - fm) : WGM;
    pm = fm + ((wgid % nig) % gsz); pn = (wgid % nig) / gsz;
}
struct PlainOrder {
    int nM, nN, nwg, G, c;
    __device__ void init(int nM_, int nN_, int G_, int c_) { nM = nM_; nN = nN_; nwg = nM * nN; G = G_; c = c_; }
    __device__ bool next(int i, Unit& u) const { const long L = (long)i * G + c; if (L >= nwg) return false; tile_of((int)L, nM, nN, u.pm, u.pn); u.ak = 0; u.tag = 0; return true; }
};
struct MergeOrder {
    int nM, nN, nwg, G, c;
    __device__ void init(int nM_, int nN_, int G_, int c_) { nM = nM_; nN = nN_; nwg = nM * nN; G = G_; c = c_; }
    __device__ bool next(int i, Unit& u) const { const int ti = i / 3, n = i - 3 * ti; const long L = (long)ti * G + c; if (L >= nwg) return false;
        int pm, pc; tile_of((int)L, nM, nN, pm, pc); u.pm = pm; u.pn = n * nN + pc; u.ak = n * 512; u.tag = n; return true; }
};

template <class Epi, class Sched>
__device__ __forceinline__ void gemm_phase(LAS unsigned char* lds, const Gemm g, const Sched& S, const Epi& E) {
    const int tid = tid_l(), wid = __builtin_amdgcn_readfirstlane(tid >> 6), lane = tid & 63, wr = wid >> 2, wc = wid & 3, fr = lane & 15, fq = lane >> 4;
    const int K = g.K, nt = K / BK;
    unsigned voffA[2], voffB[2];
#pragma unroll
    for (int i = 0; i < 2; ++i) { int R, C; stage_rc(tid * 16 + i * 8192, R, C); const int Rb = (R & ~31) + perm32(R & 31);
        voffA[i] = (unsigned)(R * g.lda + C) * 2u; voffB[i] = (unsigned)(Rb * g.ldb + C) * 2u; }
    const size_t kstep = (size_t)(BK * 2);
    const size_t hstepA = (size_t)HALF * g.lda * 2, hstepB = (size_t)HALF * g.ldb * 2;
    const size_t tstepA = 2 * hstepA, tstepB = 2 * hstepB;
    const unsigned ldsw = (unsigned)wid * 1024u;
    const int aoff = lds_byte(wr * 64 + fr, fq * 8), boff = lds_byte(wc * 32 + fr, fq * 8);
#define PG8_SA(b, h) (((b) * 2 + (h)) * HTB)
#define PG8_SB(b, h) ((4 + (b) * 2 + (h)) * HTB)
#define PG8_STAGE(bufoff, gbase, voff) do { _Pragma("unroll") for (int _i = 0; _i < 2; ++_i) \
        __builtin_amdgcn_global_load_lds((const unsigned*)((const char*)(gbase) + (voff)[_i]), (LAS unsigned*)(lds + (bufoff) + ldsw + _i * 8192), 16, 0, 0); } while (0)
#define PG8_LDA(dst, b, h) do { _Pragma("unroll") for (int m = 0; m < 4; ++m) _Pragma("unroll") for (int k = 0; k < 2; ++k) dst[m][k] = *(const LAS bf16x8*)(lds + PG8_SA(b, h) + aoff + m * 2048 + k * 1024); } while (0)
#define PG8_LDB(dst, b, h) do { _Pragma("unroll") for (int n = 0; n < 2; ++n) _Pragma("unroll") for (int k = 0; k < 2; ++k) dst[n][k] = *(const LAS bf16x8*)(lds + PG8_SB(b, h) + boff + n * 2048 + k * 1024); } while (0)
#define PG8_MMA(ai, bj, At, Bt) do { __builtin_amdgcn_s_setprio(1); _Pragma("unroll") for (int m = 0; m < 4; ++m) _Pragma("unroll") for (int n = 0; n < 2; ++n) _Pragma("unroll") for (int k = 0; k < 2; ++k) \
        acc[ai][bj][m][n] = __builtin_amdgcn_mfma_f32_16x16x32_bf16(Bt[n][k], At[m][k], acc[ai][bj][m][n], 0, 0, 0); __builtin_amdgcn_s_setprio(0); } while (0)
#define PG8_WAIT_V(n) asm volatile("s_waitcnt vmcnt(" #n ")" ::: "memory")
#define PG8_WAIT_L(n) asm volatile("s_waitcnt lgkmcnt(" #n ")" ::: "memory")
#define PG8_BAR __builtin_amdgcn_s_barrier()
#define PG8_SCHED __builtin_amdgcn_sched_barrier(0)
    Unit cur, nxt; int ui = 0;
    if (!S.next(0, cur)) return;
    f32x4 acc[2][2][4][2];
#pragma unroll
    for (int a = 0; a < 2; ++a)
#pragma unroll
        for (int b = 0; b < 2; ++b)
#pragma unroll
            for (int m = 0; m < 4; ++m)
#pragma unroll
                for (int n = 0; n < 2; ++n) acc[a][b][m][n] = (f32x4){0.f, 0.f, 0.f, 0.f};
    bf16x8 At[4][2], B0[2][2], B1[2][2];
    const char* cA = (const char*)g.A + (size_t)cur.pm * tstepA + (size_t)cur.ak * 2; const char* cB = (const char*)g.Bt + (size_t)cur.pn * tstepB;
    PG8_STAGE(PG8_SB(0, 0), cB, voffB); PG8_STAGE(PG8_SB(0, 1), cB + hstepB, voffB); PG8_STAGE(PG8_SA(0, 0), cA, voffA); PG8_STAGE(PG8_SA(0, 1), cA + hstepA, voffA);
    if (wr == 1) PG8_BAR;
    PG8_WAIT_V(2); PG8_BAR;
    PG8_STAGE(PG8_SB(1, 0), cB + kstep, voffB); PG8_STAGE(PG8_SA(1, 0), cA + kstep, voffA); PG8_STAGE(PG8_SB(1, 1), cB + hstepB + kstep, voffB);
    PG8_WAIT_V(6); PG8_BAR;
    for (;;) {
        const bool has_next = S.next(ui + 1, nxt);
        const char* nA = has_next ? (const char*)g.A + (size_t)nxt.pm * tstepA + (size_t)nxt.ak * 2 : cA; const char* nB = has_next ? (const char*)g.Bt + (size_t)nxt.pn * tstepB : cB;
        for (int t = 0; t < nt; t += 2) {
            const bool last = (t == nt - 2);
            const char* a1 = cA + (size_t)(t + 1) * kstep;
            const char* a2 = last ? nA : cA + (size_t)(t + 2) * kstep; const char* b2 = last ? nB : cB + (size_t)(t + 2) * kstep;
            const char* a3 = a2 + kstep; const char* b3 = b2 + kstep;
            PG8_LDB(B0, 0, 0); PG8_LDB(B1, 0, 1); PG8_SCHED; PG8_LDA(At, 0, 0); PG8_STAGE(PG8_SA(1, 1), a1 + hstepA, voffA);
            PG8_WAIT_V(8); PG8_WAIT_L(0); PG8_BAR; PG8_MMA(0, 0, At, B0); PG8_MMA(0, 1, At, B1); PG8_BAR; PG8_SCHED;
            PG8_LDA(At, 0, 1); PG8_STAGE(PG8_SB(0, 0), b2, voffB); PG8_STAGE(PG8_SB(0, 1), b2 + hstepB, voffB); PG8_STAGE(PG8_SA(0, 0), a2, voffA);
            PG8_WAIT_V(8); PG8_WAIT_L(0); PG8_BAR; PG8_MMA(1, 0, At, B0); PG8_MMA(1, 1, At, B1); PG8_BAR; PG8_SCHED;
            PG8_LDB(B0, 1, 0); PG8_LDB(B1, 1, 1); PG8_SCHED; PG8_LDA(At, 1, 0); PG8_STAGE(PG8_SA(0, 1), a2 + hstepA, voffA);
            PG8_WAIT_V(8); PG8_WAIT_L(0); PG8_BAR; PG8_MMA(0, 0, At, B0); PG8_MMA(0, 1, At, B1); PG8_BAR; PG8_SCHED;
            PG8_LDA(At, 1, 1); PG8_STAGE(PG8_SB(1, 0), b3, voffB); PG8_STAGE(PG8_SB(1, 1), b3 + hstepB, voffB); PG8_STAGE(PG8_SA(1, 0), a3, voffA);
            PG8_WAIT_V(8); PG8_WAIT_L(0); PG8_BAR; PG8_MMA(1, 0, At, B0); PG8_MMA(1, 1, At, B1); PG8_BAR; PG8_SCHED;
        }
        if (wr == 0) PG8_BAR;
        E(acc, cur, wr, wc, fr, fq);
        if (!has_next) break;
#pragma unroll
        for (int a = 0; a < 2; ++a)
#pragma unroll
            for (int b = 0; b < 2; ++b)
#pragma unroll
                for (int m = 0; m < 4; ++m)
#pragma unroll
                    for (int n = 0; n < 2; ++n) acc[a][b][m][n] = (f32x4){0.f, 0.f, 0.f, 0.f};
        cur = nxt; cA = nA; cB = nB; ++ui;
        if (wr == 1) PG8_BAR;
    }
    PG8_WAIT_V(0);
    PG8_BAR;
#undef PG8_SA
#undef PG8_SB
#undef PG8_STAGE
#undef PG8_LDA
#undef PG8_LDB
#undef PG8_MMA
#undef PG8_WAIT_V
#undef PG8_WAIT_L
#undef PG8_BAR
#undef PG8_SCHED
}

struct EpiIn {
    bf16_t* P1; bf16_t* Z;
    __device__ __forceinline__ void operator()(const f32x4 (&acc)[2][2][4][2], const Unit& u, int wr, int wc, int fr, int fq) const {
        bf16_t* base; int ld, colt;
        if (u.pn < 13) { base = P1; ld = NP1; colt = u.pn * BM; } else { base = Z; ld = NZ; colt = (u.pn - 13) * BM; }
        const int row0 = u.pm * BM + wr * 64 + fr, col0 = colt + wc * 32 + 8 * fq;
#pragma unroll
        for (int ai = 0; ai < 2; ++ai)
#pragma unroll
            for (int m = 0; m < 4; ++m) { bf16_t* rowp = base + (size_t)(row0 + ai * HALF + m * 16) * ld + col0;
#pragma unroll
                for (int bj = 0; bj < 2; ++bj) { const f32x4 v0 = acc[ai][bj][m][0], v1 = acc[ai][bj][m][1];
                    u32x4 w; w.x = cvt_pk_bf16(v0[0], v0[1]); w.y = cvt_pk_bf16(v0[2], v0[3]); w.z = cvt_pk_bf16(v1[0], v1[1]); w.w = cvt_pk_bf16(v1[2], v1[3]);
                    *(u32x4*)(rowp + bj * HALF) = w; } }
    }
};
template <int ACT> struct EpiPlain {
    bf16_t* O; int ld;
    __device__ __forceinline__ void operator()(const f32x4 (&acc)[2][2][4][2], const Unit& u, int wr, int wc, int fr, int fq) const {
        const int row0 = u.pm * BM + wr * 64 + fr, col0 = u.pn * BM + wc * 32 + 8 * fq;
#pragma unroll
        for (int ai = 0; ai < 2; ++ai)
#pragma unroll
            for (int m = 0; m < 4; ++m) { bf16_t* rowp = O + (size_t)(row0 + ai * HALF + m * 16) * ld + col0;
#pragma unroll
                for (int bj = 0; bj < 2; ++bj) { f32x4 v0 = acc[ai][bj][m][0], v1 = acc[ai][bj][m][1];
                    if (ACT == 1) {
#pragma unroll
                        for (int e = 0; e < 4; ++e) { v0[e] = sigmoidf_(v0[e]); v1[e] = sigmoidf_(v1[e]); } }
                    u32x4 w; w.x = cvt_pk_bf16(v0[0], v0[1]); w.y = cvt_pk_bf16(v0[2], v0[3]); w.z = cvt_pk_bf16(v1[0], v1[1]); w.w = cvt_pk_bf16(v1[2], v1[3]);
                    *(u32x4*)(rowp + bj * HALF) = w; } }
    }
};
struct EpiMerge {
    bf16_t* Mg; const bf16_t* G;
    __device__ __forceinline__ void operator()(const f32x4 (&acc)[2][2][4][2], const Unit& u, int wr, int wc, int fr, int fq) const {
        const int n = u.tag, pc = u.pn - 4 * n;
        const int row0 = u.pm * BM + wr * 64 + fr, col0 = pc * BM + wc * 32 + 8 * fq;
#pragma unroll
        for (int ai = 0; ai < 2; ++ai)
#pragma unroll
            for (int m = 0; m < 4; ++m) { const size_t row = (size_t)(row0 + ai * HALF + m * 16);
#pragma unroll
                for (int bj = 0; bj < 2; ++bj) { const f32x4 v0 = acc[ai][bj][m][0], v1 = acc[ai][bj][m][1];
                    const u32x4 gt = *(const u32x4*)(G + row * NG + n * 1024 + col0 + bj * HALF);
                    bf16_t* mp = Mg + row * DM + col0 + bj * HALF;
                    float o[8];
                    o[0] = bf_lo(gt.x) * v0[0]; o[1] = bf_hi(gt.x) * v0[1]; o[2] = bf_lo(gt.y) * v0[2]; o[3] = bf_hi(gt.y) * v0[3];
                    o[4] = bf_lo(gt.z) * v1[0]; o[5] = bf_hi(gt.z) * v1[1]; o[6] = bf_lo(gt.w) * v1[2]; o[7] = bf_hi(gt.w) * v1[3];
                    if (n > 0) { const u32x4 pv = *(const u32x4*)mp;
                        o[0] += bf_lo(pv.x); o[1] += bf_hi(pv.x); o[2] += bf_lo(pv.y); o[3] += bf_hi(pv.y); o[4] += bf_lo(pv.z); o[5] += bf_hi(pv.z); o[6] += bf_lo(pv.w); o[7] += bf_hi(pv.w); }
                    u32x4 w; w.x = cvt_pk_bf16(o[0], o[1]); w.y = cvt_pk_bf16(o[2], o[3]); w.z = cvt_pk_bf16(o[4], o[5]); w.w = cvt_pk_bf16(o[6], o[7]);
                    *(u32x4*)mp = w; } }
    }
};
}

__device__ __forceinline__ void tr_item(const float* W, int lds_, int k0, int n0s, bf16_t* WT, int ldd, int n0d, int kd0, const float* ksc, float* scr, int lane) {
#pragma unroll 8
    for (int i = 0; i < 32; ++i) { const int kk = 2 * i + (lane >> 5);
        float v = 0.f; if (n0s >= 0) { v = W[(size_t)(k0 + kk) * lds_ + n0s + (lane & 31)]; if (ksc) v *= ksc[k0 + kk]; }
        scr[kk * 33 + (lane & 31)] = v; }
    asm volatile("s_waitcnt lgkmcnt(0)" ::: "memory");
    const int c = lane & 7;
#pragma unroll
    for (int j = 0; j < 4; ++j) { const int n = (lane >> 3) + 8 * j; const float* s = scr + (8 * c) * 33 + n;
        u32x4 o; o.x = cvt_pk_bf16(s[0 * 33], s[1 * 33]); o.y = cvt_pk_bf16(s[2 * 33], s[3 * 33]); o.z = cvt_pk_bf16(s[4 * 33], s[5 * 33]); o.w = cvt_pk_bf16(s[6 * 33], s[7 * 33]);
        *(u32x4*)(WT + (size_t)(n0d + n) * ldd + kd0 + 8 * c) = o; }
    asm volatile("s_waitcnt lgkmcnt(0)" ::: "memory");
}

__device__ __forceinline__ void phase0a(const Params& p, unsigned char* lds) {
    const int tid = tid_l(), lane = tid & 63, wave = tid >> 6, G = gridDim.x;
    const int gw = blockIdx.x * NWAVES + wave, NGW = G * NWAVES;
    unsigned char* ws = p.ws;
    float* scr = (float*)(lds + wave * 16384);
    constexpr int I_WIN = 152 * 16, I_WG = 96 * 16, I_WBR = 3 * 32 * 8, I_WOUT = 32 * 16, I_WUQ = 24 * 4, I_WUKV = 32 * 2, I_W2 = 16, I_A2 = 16, I_V1 = 8;
    constexpr int I_L = I_WIN + I_WG + I_WBR + I_WOUT + I_WUQ + I_WUKV + I_W2 + I_A2 + I_V1;
    for (int it = gw; it < NL * I_L; it += NGW) {
        const int l = it / I_L; int r = it - l * I_L;
        if (r < I_WIN) { const int nb = r >> 4, kb = r & 15; const int nd = nb * 32;
            int ns; if (nd < 416) ns = nd; else if (nd < 512) ns = -1; else if (nd < 3200) ns = nd - 96; else if (nd < 3328) ns = -1; else ns = nd - 224;
            tr_item(p.w_in + (size_t)l * DM * D_IN_SRC, D_IN_SRC, kb * 64, ns, (bf16_t*)(ws + OFF_WIN + l * SZ_WIN), DM, nd, kb * 64, nullptr, scr, lane); continue; }
        r -= I_WIN;
        if (r < I_WG) { const int nb = r >> 4, kb = r & 15;
            tr_item(p.w_in + (size_t)l * DM * D_IN_SRC, D_IN_SRC, kb * 64, 4640 + nb * 32, (bf16_t*)(ws + OFF_WG + l * SZ_WG), DM, nb * 32, kb * 64, nullptr, scr, lane); continue; }
        r -= I_WG;
        if (r < I_WBR) { const int n = r / 256, r2 = r - n * 256, nb = r2 >> 3, kb = r2 & 7;
            tr_item(p.w_br + ((size_t)(l * 3 + n) * 512) * DM, DM, kb * 64, nb * 32, (bf16_t*)(ws + OFF_WBR + l * SZ_WBR), 512, n * 1024 + nb * 32, kb * 64, nullptr, scr, lane); continue; }
        r -= I_WBR;
        if (r < I_WOUT) { const int nb = r >> 4, kb = r & 15;
            tr_item(p.w_out + (size_t)l * DM * DM, DM, kb * 64, nb * 32, (bf16_t*)(ws + OFF_WOUT + l * SZ_WOUT), DM, nb * 32, kb * 64, nullptr, scr, lane); continue; }
        r -= I_WOUT;
        if (r < I_WUQ) { const int nb = r >> 2, kb = r & 3;
            tr_item(p.w_uq + (size_t)l * 256 * 768, 768, kb * 64, nb * 32, (bf16_t*)(ws + OFF_WUQ + l * SZ_WUQ), 256, nb * 32, kb * 64, p.q_norm + l * 256, scr, lane); continue; }
        r -= I_WUQ;
        if (r < I_WUKV) { const int nb = r >> 1, kb = r & 1;
            tr_item(p.w_ukv + (size_t)l * 128 * 1024, 1024, kb * 64, nb * 32, (bf16_t*)(ws + OFF_WUKV + l * SZ_WUKV), 128, nb * 32, kb * 64, p.kv_norm + l * 128, scr, lane); continue; }
        r -= I_WUKV;
        if (r < I_W2) { tr_item(p.w2 + (size_t)l * 64 * 512, 512, 0, r * 32, (bf16_t*)(ws + OFF_W2T) + (size_t)l * 512 * 64, 64, r * 32, 0, nullptr, scr, lane); continue; }
        r -= I_W2;
        if (r < I_A2) { tr_item(p.a2 + (size_t)l * 64 * 512, 512, 0, r * 32, (bf16_t*)(ws + OFF_A2T) + (size_t)l * 512 * 64, 64, r * 32, 0, nullptr, scr, lane); continue; }
        r -= I_A2;
        if (l >= 1) tr_item(p.v1 + (size_t)(l - 1) * 512 * 32, 32, r * 64, 0, (bf16_t*)(ws + OFF_V1T) + (size_t)(l - 1) * 32 * 512, 512, 0, r * 64, nullptr, scr, lane);
    }
    for (int it = gw; it < NL * 48 * 8; it += NGW) {
        const int l = it / 384, r = it - l * 384, nb = r >> 3, ks = r & 7, n = nb * 64 + lane;
        float a0 = 0.f, a1 = 0.f, a2 = 0.f, a3 = 0.f;
        const float* w = p.w_ada + (size_t)l * DM * 3072 + n;
#pragma unroll 8
        for (int k = ks * 128; k < ks * 128 + 128; ++k) { const float wv = w[(size_t)k * 3072];
            a0 += siluf_(p.c[k]) * wv; a1 += siluf_(p.c[DM + k]) * wv; a2 += siluf_(p.c[2 * DM + k]) * wv; a3 += siluf_(p.c[3 * DM + k]) * wv; }
        float* mp = (float*)(ws + OFF_MODP) + ((size_t)(l * 8 + ks) * 4) * 3072 + n;
        mp[0] = a0; mp[3072] = a1; mp[2 * 3072] = a2; mp[3 * 3072] = a3;
    }
    const size_t gt = (size_t)blockIdx.x * NTHREADS + tid, GT = (size_t)G * NTHREADS;
    for (size_t i = gt; i < (size_t)3 * 512 * 32; i += GT) { const int l1 = (int)(i / (512 * 32)), r = (int)(i % (512 * 32)), c = r >> 5, k = r & 31;
        ((bf16_t*)(ws + OFF_V2T))[i] = f2bf(p.v2[(size_t)l1 * 32 * 512 + k * 512 + c]); }
    for (size_t i = gt; i < (size_t)NL * 4 * 128 * 128; i += GT) { const int s = (int)(i & 127), t = (int)((i >> 7) & 127);
        ((bf16_t*)(ws + OFF_WS))[i] = f2bf(((s >> 6) <= (t >> 6)) ? p.w_s[i] : 0.f); }
    for (size_t i = gt; i < (size_t)M_TOK * 16; i += GT) { const int t = (int)(i >> 4), k = (int)(i & 15);
        const float inv = powf(10000.f, -(float)(2 * k) / 32.f); const float ang = (float)p.pos[t] * inv;
        ((float*)(ws + OFF_ROPE))[i] = cosf(ang); ((float*)(ws + OFF_ROPE))[(size_t)M_TOK * 16 + i] = sinf(ang); }
    for (size_t i = gt; i < (size_t)M_TOK * DM / 4; i += GT) ((f32x4*)p.out)[i] = ((const f32x4*)p.x)[i];
}

__device__ __forceinline__ f32x4 mod4(const Params& p, int l, int b, int kind, int col) {
    const float* mp = (const float*)(p.ws + OFF_MODP) + ((size_t)(l * 8) * 4 + b) * 3072 + kind * DM + col;
    f32x4 s = *(const f32x4*)(p.b_ada + (size_t)l * 3072 + kind * DM + col);
#pragma unroll
    for (int ks = 0; ks < 8; ++ks) s += *(const f32x4*)(mp + (size_t)ks * 4 * 3072);
    return s;
}
__device__ __forceinline__ void normmod_row(const Params& p, int l, int row, const f32x4 (&v)[4], int lane) {
    float ss = 0.f;
#pragma unroll
    for (int j = 0; j < 4; ++j) ss += v[j][0] * v[j][0] + v[j][1] * v[j][1] + v[j][2] * v[j][2] + v[j][3] * v[j][3];
    const float rstd = rsqrtf(wave_sum(ss) * (1.f / DM) + 1e-6f);
    const int b = row / SEQ;
    bf16_t* hrow = (bf16_t*)(p.ws + OFF_H) + (size_t)row * DM;
#pragma unroll
    for (int j = 0; j < 4; ++j) { const int col = 4 * lane + 256 * j;
        const f32x4 g = *(const f32x4*)(p.pre_g + (size_t)l * DM + col), sh = mod4(p, l, b, 0, col), sc = mod4(p, l, b, 1, col);
        f32x4 o = v[j] * rstd * g * (sc + 1.f) + sh;
        *(u32x2*)(hrow + col) = pack4(o); }
}
__device__ __forceinline__ void phase0b(const Params& p) {
    const int tidq = tid_l(); const int lane = tidq & 63, gw = blockIdx.x * NWAVES + (tidq >> 6), NGW = gridDim.x * NWAVES;
    for (int row = gw; row < M_TOK; row += NGW) { f32x4 v[4];
#pragma unroll
        for (int j = 0; j < 4; ++j) v[j] = *(const f32x4*)(p.out + (size_t)row * DM + 4 * lane + 256 * j);
        normmod_row(p, 0, row, v, lane); }
}
__device__ __forceinline__ void phase_final(const Params& p, int l) {
    const int tidq = tid_l(); const int lane = tidq & 63, gw = blockIdx.x * NWAVES + (tidq >> 6), NGW = gridDim.x * NWAVES;
    const bf16_t* Y = (const bf16_t*)(p.ws + OFF_R3 + R3_Y);
    for (int row = gw; row < M_TOK; row += NGW) {
        f32x4 y[4]; float ss = 0.f;
#pragma unroll
        for (int j = 0; j < 4; ++j) { y[j] = unpack4(*(const u32x2*)(Y + (size_t)row * DM + 4 * lane + 256 * j)); ss += y[j][0] * y[j][0] + y[j][1] * y[j][1] + y[j][2] * y[j][2] + y[j][3] * y[j][3]; }
        const float rstd = rsqrtf(wave_sum(ss) * (1.f / DM) + 1e-6f);
        const int b = row / SEQ; f32x4 v[4];
#pragma unroll
        for (int j = 0; j < 4; ++j) { const int col = 4 * lane + 256 * j;
            const f32x4 xg = *(const f32x4*)(p.out + (size_t)row * DM + col), pg = *(const f32x4*)(p.post_g + (size_t)l * DM + col), gt = mod4(p, l, b, 2, col);
            v[j] = xg + gt * (y[j] * rstd * pg);
            *(f32x4*)(p.out + (size_t)row * DM + col) = v[j]; }
        if (l + 1 < NL) normmod_row(p, l + 1, row, v, lane);
    }
}

__device__ __forceinline__ void mla_prep_item(const Params& p, int l, int item, unsigned char* lds) {
    const int tid = tid_l(), lane = tid & 63, wave = tid >> 6, fr = lane & 15, fq = lane >> 4;
    const int t0 = item * 64;
    const bf16_t* P1 = (const bf16_t*)(p.ws + OFF_R1);
    bf16_t* Q = (bf16_t*)(p.ws + OFF_R3 + R3_Q); bf16_t* Kf = (bf16_t*)(p.ws + OFF_R3 + R3_KF); bf16_t* Vt = (bf16_t*)(p.ws + OFF_R3 + R3_VT);
    const bf16_t* Wuq = (const bf16_t*)(p.ws + OFF_WUQ + l * SZ_WUQ); const bf16_t* Wukv = (const bf16_t*)(p.ws + OFF_WUKV + l * SZ_WUKV);
    const float* COS = (const float*)(p.ws + OFF_ROPE); const float* SIN = COS + (size_t)M_TOK * 16;
    float* rq = (float*)lds; float* rkv = rq + 64;
    __syncthreads();
    { const int row = tid >> 3, part = tid & 7; const bf16_t* pr = P1 + (size_t)(t0 + row) * NP1;
        float sq = 0.f, sk = 0.f;
#pragma unroll
        for (int i = 0; i < 4; ++i) { const u32x4 u = *(const u32x4*)(pr + C_QLAT + part * 32 + i * 8);
            sq += bf_lo(u.x) * bf_lo(u.x) + bf_hi(u.x) * bf_hi(u.x) + bf_lo(u.y) * bf_lo(u.y) + bf_hi(u.y) * bf_hi(u.y) + bf_lo(u.z) * bf_lo(u.z) + bf_hi(u.z) * bf_hi(u.z) + bf_lo(u.w) * bf_lo(u.w) + bf_hi(u.w) * bf_hi(u.w); }
#pragma unroll
        for (int i = 0; i < 2; ++i) { const u32x4 u = *(const u32x4*)(pr + C_KVLAT + part * 16 + i * 8);
            sk += bf_lo(u.x) * bf_lo(u.x) + bf_hi(u.x) * bf_hi(u.x) + bf_lo(u.y) * bf_lo(u.y) + bf_hi(u.y) * bf_hi(u.y) + bf_lo(u.z) * bf_lo(u.z) + bf_hi(u.z) * bf_hi(u.z) + bf_lo(u.w) * bf_lo(u.w) + bf_hi(u.w) * bf_hi(u.w); }
        sq += __shfl_xor(sq, 1); sq += __shfl_xor(sq, 2); sq += __shfl_xor(sq, 4);
        sk += __shfl_xor(sk, 1); sk += __shfl_xor(sk, 2); sk += __shfl_xor(sk, 4);
        if (part == 0) { rq[row] = rsqrtf(sq * (1.f / 256.f) + 1e-6f); rkv[row] = rsqrtf(sk * (1.f / 128.f) + 1e-6f); }
        const int i2 = part * 2; const int t = t0 + row;
        const unsigned u1 = *(const unsigned*)(pr + C_KROPE + i2), u2 = *(const unsigned*)(pr + C_KROPE + 16 + i2);
        const float c0 = COS[(size_t)t * 16 + i2], c1 = COS[(size_t)t * 16 + i2 + 1], s0 = SIN[(size_t)t * 16 + i2], s1 = SIN[(size_t)t * 16 + i2 + 1];
        const float x10 = bf_lo(u1), x11 = bf_hi(u1), x20 = bf_lo(u2), x21 = bf_hi(u2);
        const unsigned o1 = cvt_pk_bf16(x10 * c0 - x20 * s0, x11 * c1 - x21 * s1), o2 = cvt_pk_bf16(x20 * c0 + x10 * s0, x21 * c1 + x11 * s1);
#pragma unroll
        for (int h = 0; h < 8; ++h) { *(unsigned*)(Kf + (size_t)t * 768 + h * 96 + 64 + i2) = o1; *(unsigned*)(Kf + (size_t)t * 768 + h * 96 + 80 + i2) = o2; }
    }
    __syncthreads();
#pragma unroll 1
    for (int cb = 0; cb < 4; ++cb) { const int combo = wave * 4 + cb, rt = combo & 3, head = combo >> 2;
        f32x4 acc[6];
#pragma unroll
        for (int ct = 0; ct < 6; ++ct) acc[ct] = (f32x4){0.f, 0.f, 0.f, 0.f};
        const bf16_t* ap = P1 + (size_t)(t0 + rt * 16 + fr) * NP1 + C_QLAT + fq * 8;
        const bf16_t* wp = Wuq + (size_t)(head * 96 + fr) * 256 + fq * 8;
#pragma unroll
        for (int ks = 0; ks < 8; ++ks) { const bf16x8 af = ld_frag(ap + ks * 32);
#pragma unroll
            for (int ct = 0; ct < 6; ++ct) acc[ct] = MFMA(ld_frag(wp + (size_t)ct * 16 * 256 + ks * 32), af, acc[ct]); }
        const int t = t0 + rt * 16 + fr; const float rs = rq[rt * 16 + fr] * QSCALE;
        bf16_t* qp = Q + (size_t)t * 768 + head * 96 + fq * 4;
#pragma unroll
        for (int ct = 0; ct < 4; ++ct) *(u32x2*)(qp + ct * 16) = pack4(acc[ct] * rs);
        const f32x4 cs = *(const f32x4*)(COS + (size_t)t * 16 + fq * 4), sn = *(const f32x4*)(SIN + (size_t)t * 16 + fq * 4);
        const f32x4 x1 = acc[4] * rs, x2 = acc[5] * rs;
        *(u32x2*)(qp + 64) = pack4(x1 * cs - x2 * sn); *(u32x2*)(qp + 80) = pack4(x2 * cs + x1 * sn);
    }
#pragma unroll 1
    for (int cb = 0; cb < 4; ++cb) { const int combo = wave * 4 + cb, rt = combo & 3, head = combo >> 2;
        f32x4 ak[4], av[4];
#pragma unroll
        for (int ct = 0; ct < 4; ++ct) { ak[ct] = (f32x4){0.f, 0.f, 0.f, 0.f}; av[ct] = (f32x4){0.f, 0.f, 0.f, 0.f}; }
        const bf16_t* ap = P1 + (size_t)(t0 + rt * 16 + fr) * NP1 + C_KVLAT + fq * 8;
        const bf16_t* wp = Wukv + (size_t)(head * 128 + fr) * 128 + fq * 8;
#pragma unroll
        for (int ks = 0; ks < 4; ++ks) { const bf16x8 af = ld_frag(ap + ks * 32);
#pragma unroll
            for (int ct = 0; ct < 4; ++ct) { ak[ct] = MFMA(ld_frag(wp + (size_t)ct * 16 * 128 + ks * 32), af, ak[ct]);
                av[ct] = MFMA(af, ld_frag(wp + (size_t)(64 + ct * 16) * 128 + ks * 32), av[ct]); } }
        const int t = t0 + rt * 16 + fr; const float rs = rkv[rt * 16 + fr];
#pragma unroll
        for (int ct = 0; ct < 4; ++ct) *(u32x2*)(Kf + (size_t)t * 768 + head * 96 + ct * 16 + fq * 4) = pack4(ak[ct] * rs);
        const f32x4 rv = *(const f32x4*)(rkv + rt * 16 + fq * 4);
        const int b = t0 / SEQ, s0 = (t0 % SEQ) + rt * 16 + fq * 4;
#pragma unroll
        for (int ct = 0; ct < 4; ++ct) *(u32x2*)(Vt + ((size_t)(b * 8 + head) * 64 + ct * 16 + fr) * SEQ + s0) = pack4(av[ct] * rv);
    }
}

__device__ __forceinline__ void gmlp_item(const Params& p, int l, int item, unsigned char* lds) {
    const int tid = tid_l(), lane = tid & 63, wave = tid >> 6, fr = lane & 15, fq = lane >> 4;
    const int t0 = item * 128;
    const bf16_t* P1 = (const bf16_t*)(p.ws + OFF_R1); bf16_t* Z = (bf16_t*)(p.ws + OFF_Z);
    const bf16_t* Ws = (const bf16_t*)(p.ws + OFF_WS) + (size_t)l * 4 * 128 * 128;
    bf16_t* vb = (bf16_t*)lds;
    constexpr int VS = 520;
    __syncthreads();
    { const int tok = tid >> 2, qd = tid & 3; const bf16_t* pr = P1 + (size_t)(t0 + tok) * NP1 + C_GMV + qd * 128;
        float s = 0.f, s2 = 0.f;
#pragma unroll 4
        for (int i = 0; i < 16; ++i) { const u32x4 u = *(const u32x4*)(pr + i * 8); const unsigned uu[4] = {u.x, u.y, u.z, u.w};
#pragma unroll
            for (int e = 0; e < 4; ++e) { const float a = geluf_(bf_lo(uu[e])), b = geluf_(bf_hi(uu[e])); s += a + b; s2 += a * a + b * b; } }
        s += __shfl_xor(s, 1); s += __shfl_xor(s, 2); s2 += __shfl_xor(s2, 1); s2 += __shfl_xor(s2, 2);
        const float mean = s * (1.f / 512.f), var = fmaxf(s2 * (1.f / 512.f) - mean * mean, 0.f), rstd = rsqrtf(var + 1e-5f);
        const float* lg = p.ln_g + (size_t)l * 512 + qd * 128; const float* lb = p.ln_b + (size_t)l * 512 + qd * 128;
#pragma unroll 4
        for (int i = 0; i < 16; ++i) { const u32x4 u = *(const u32x4*)(pr + i * 8); const unsigned uu[4] = {u.x, u.y, u.z, u.w}; unsigned oo[4];
#pragma unroll
            for (int e = 0; e < 4; ++e) { const float a = (geluf_(bf_lo(uu[e])) - mean) * rstd * lg[i * 8 + 2 * e] + lb[i * 8 + 2 * e], b = (geluf_(bf_hi(uu[e])) - mean) * rstd * lg[i * 8 + 2 * e + 1] + lb[i * 8 + 2 * e + 1];
                oo[e] = cvt_pk_bf16(a, b); }
            *(u32x4*)(vb + (size_t)tok * VS + qd * 128 + i * 8) = (u32x4){oo[0], oo[1], oo[2], oo[3]}; }
    }
    __syncthreads();
#pragma unroll 1
    for (int g = 0; g < 4; ++g) {
        const int cbase = g * 128 + wave * 16;
        bf16x8 vfr[4];
#pragma unroll
        for (int ks = 0; ks < 4; ++ks) { bf16x8 f;
#pragma unroll
            for (int j = 0; j < 8; ++j) f[j] = (short)vb[(size_t)(ks * 32 + fq * 8 + j) * VS + cbase + fr];
            vfr[ks] = f; }
        const bf16_t* wg = Ws + (size_t)g * 128 * 128;
#pragma unroll 1
        for (int tt = 0; tt < 8; ++tt) {
            f32x4 acc = (f32x4){0.f, 0.f, 0.f, 0.f};
            const bf16_t* wp = wg + (size_t)(tt * 16 + fr) * 128 + fq * 8;
#pragma unroll
            for (int ks = 0; ks < 4; ++ks) acc = MFMA(vfr[ks], ld_frag(wp + ks * 32), acc);
            const int tl = tt * 16 + fr, t = t0 + tl, c = cbase + fq * 4;
            const float bs = p.b_s[(size_t)(l * 4 + g) * 128 + tl];
            const f32x4 u = unpack4(*(const u32x2*)(P1 + (size_t)t * NP1 + C_GMU + c));
            bf16_t* zp = Z + (size_t)t * NZ + 512 + c; const f32x4 z = unpack4(*(const u32x2*)zp);
            f32x4 o;
#pragma unroll
            for (int e = 0; e < 4; ++e) o[e] = geluf_(u[e]) * (acc[e] + bs) * siluf_(z[e]);
            *(u32x2*)zp = pack4(o);
        }
    }
}

__device__ __forceinline__ f32x4 mix4(const bf16_t* pr, const bf16_t* pp, bool has_prev, const float* mu) {
    const f32x4 a = unpack4(*(const u32x2*)pr); f32x4 b = (f32x4){0.f, 0.f, 0.f, 0.f}; if (has_prev) b = unpack4(*(const u32x2*)pp);
    const f32x4 m = *(const f32x4*)mu; return a + (b - a) * m;
}
__device__ __forceinline__ void rwkv_prep_item(const Params& p, int l, int item) {
    const int tid = tid_l(), lane = tid & 63, wave = tid >> 6, fr = lane & 15, fq = lane >> 4;
    const int rt = wave >> 1, hh = wave & 1;
    const int t = item * 64 + rt * 16 + fr; const bool hp = (t % SEQ) != 0;
    const bf16_t* P1 = (const bf16_t*)(p.ws + OFF_R1);
    const bf16_t* pr = P1 + (size_t)t * NP1; const bf16_t* pp = pr - NP1;
    const float* mu = p.mu + (size_t)l * 1664 - C_RW;
    const bf16_t* W2T = (const bf16_t*)(p.ws + OFF_W2T) + (size_t)l * 512 * 64; const bf16_t* A2T = (const bf16_t*)(p.ws + OFF_A2T) + (size_t)l * 512 * 64;
    unsigned char* r2 = p.ws + OFF_R2;
    bf16_t* VF = (bf16_t*)(p.ws + OFF_VF);
    bf16x8 fa[2], fw[2];
#pragma unroll
    for (int ks = 0; ks < 2; ++ks) { const int ca = C_ALAT + ks * 32 + fq * 8, cw = C_WLAT + ks * 32 + fq * 8;
        const f32x4 a0 = mix4(pr + ca, pp + ca, hp, mu + ca), a1 = mix4(pr + ca + 4, pp + ca + 4, hp, mu + ca + 4);
        f32x4 w0 = mix4(pr + cw, pp + cw, hp, mu + cw), w1 = mix4(pr + cw + 4, pp + cw + 4, hp, mu + cw + 4);
#pragma unroll
        for (int e = 0; e < 4; ++e) { w0[e] = tanhf(w0[e]); w1[e] = tanhf(w1[e]); }
        fa[ks] = pack_frag(a0, a1); fw[ks] = pack_frag(w0, w1); }
    bf16x8 t1f = (bf16x8){0, 0, 0, 0, 0, 0, 0, 0};
    if (l >= 1) { const bf16_t* V1T = (const bf16_t*)(p.ws + OFF_V1T) + (size_t)(l - 1) * 32 * 512;
        f32x4 c0 = (f32x4){0.f, 0.f, 0.f, 0.f}, c1 = c0;
#pragma unroll 2
        for (int ks = 0; ks < 16; ++ks) { const int cv = C_RWV + ks * 32 + fq * 8;
            const bf16x8 af = pack_frag(mix4(pr + cv, pp + cv, hp, mu + cv), mix4(pr + cv + 4, pp + cv + 4, hp, mu + cv + 4));
            c0 = MFMA(ld_frag(V1T + (size_t)fr * 512 + ks * 32 + fq * 8), af, c0); c1 = MFMA(ld_frag(V1T + (size_t)(16 + fr) * 512 + ks * 32 + fq * 8), af, c1); }
        t1f = pack_frag(c0, c1);
    }
#pragma unroll 1
    for (int hq = 0; hq < 4; ++hq) { const int h = hh * 4 + hq;
        float ss = 0.f;
#pragma unroll
        for (int ct = 0; ct < 4; ++ct) { const int c = h * 64 + ct * 16 + fq * 4;
            const f32x4 kr = mix4(pr + C_RWK + c, pp + C_RWK + c, hp, mu + C_RWK + c) * *(const f32x4*)(p.k_k + (size_t)l * 512 + c);
            ss += kr[0] * kr[0] + kr[1] * kr[1] + kr[2] * kr[2] + kr[3] * kr[3]; }
        ss += __shfl_xor(ss, 16); ss += __shfl_xor(ss, 32);
        const float inv = 1.f / fmaxf(sqrtf(ss), 1e-12f);
#pragma unroll 1
        for (int ct = 0; ct < 4; ++ct) { const int crow = h * 64 + ct * 16 + fr;
            f32x4 aa = (f32x4){0.f, 0.f, 0.f, 0.f}, aw = aa, avm = aa;
#pragma unroll
            for (int ks = 0; ks < 2; ++ks) { aa = MFMA(ld_frag(A2T + (size_t)crow * 64 + ks * 32 + fq * 8), fa[ks], aa); aw = MFMA(ld_frag(W2T + (size_t)crow * 64 + ks * 32 + fq * 8), fw[ks], aw); }
            if (l >= 1) { const bf16_t* V2T = (const bf16_t*)(p.ws + OFF_V2T) + (size_t)(l - 1) * 512 * 32 + (size_t)crow * 32;
                avm = MFMA(join_frag(*(const u32x2*)(V2T + fq * 4), *(const u32x2*)(V2T + 16 + fq * 4)), t1f, avm); }
            const int c = h * 64 + ct * 16 + fq * 4; const size_t o = (size_t)t * 512 + c;
            const f32x4 rs = mix4(pr + C_RWR + c, pp + C_RWR + c, hp, mu + C_RWR + c);
            const f32x4 ksv = mix4(pr + C_RWK + c, pp + C_RWK + c, hp, mu + C_RWK + c);
            f32x4 vs = mix4(pr + C_RWV + c, pp + C_RWV + c, hp, mu + C_RWV + c);
            const f32x4 a0 = *(const f32x4*)(p.a0 + (size_t)l * 512 + c), w0 = *(const f32x4*)(p.w0 + (size_t)l * 512 + c), kkw = *(const f32x4*)(p.k_k + (size_t)l * 512 + c);
            const f32x4 ka = *(const f32x4*)(p.k_a + (size_t)l * 512 + c);
            f32x4 lw, asg;
#pragma unroll
            for (int e = 0; e < 4; ++e) { asg[e] = sigmoidf_(a0[e] + aa[e]); lw[e] = -0.6065306597126334f * sigmoidf_(w0[e] + aw[e]); }
            *(f32x4*)((float*)(r2 + R2_LW) + o) = lw;
            if (l == 0) { *(u32x2*)(VF + o) = pack4(vs); }
            else { const f32x4 vf = unpack4(*(const u32x2*)(VF + o)), v0 = *(const f32x4*)(p.v0 + (size_t)(l - 1) * 512 + c);
#pragma unroll
                for (int e = 0; e < 4; ++e) vs[e] = vs[e] + (vf[e] - vs[e]) * sigmoidf_(v0[e] + avm[e]); }
            const f32x4 kk = ksv * kkw * inv, km = ksv * ((asg - 1.f) * ka + 1.f), bb = kk * asg;
            *(u32x2*)((bf16_t*)(r2 + R2_R) + o) = pack4(rs); *(u32x2*)((bf16_t*)(r2 + R2_K) + o) = pack4(km); *(u32x2*)((bf16_t*)(r2 + R2_V) + o) = pack4(vs);
            *(u32x2*)((bf16_t*)(r2 + R2_KK) + o) = pack4(kk); *(u32x2*)((bf16_t*)(r2 + R2_B) + o) = pack4(bb); }
    }
}

__device__ __forceinline__ void attn_item(const Params& p, int b, int h, int qb, unsigned char* lds) {
    const int tid = tid_l(), lane = tid & 63, wave = tid >> 6, fr = lane & 15, fq = lane >> 4;
    const bf16_t* Q = (const bf16_t*)(p.ws + OFF_R3 + R3_Q); const bf16_t* Kf = (const bf16_t*)(p.ws + OFF_R3 + R3_KF); const bf16_t* Vt = (const bf16_t*)(p.ws + OFF_R3 + R3_VT);
    bf16_t* Z = (bf16_t*)(p.ws + OFF_Z);
    constexpr int KS = 104, VS = 72, KB = 64 * KS * 2, VB = 64 * VS * 2, BUF = KB + VB;
    const int nkt = 2 * qb + 2, mykt = (wave < 4) ? nkt - 1 : nkt;
    const int trow = b * SEQ + qb * 128 + wave * 16 + fr;
    bf16x8 qf[3];
#pragma unroll
    for (int ks = 0; ks < 3; ++ks) qf[ks] = ld_frag(Q + (size_t)trow * 768 + h * 96 + ks * 32 + fq * 8);
    const bf16_t* kg = Kf + (size_t)(b * SEQ) * 768 + h * 96; const bf16_t* vg = Vt + (size_t)(b * 8 + h) * 64 * SEQ;
    const int kr0 = tid / 12, kc0 = tid % 12, kr1 = (tid + 512) / 12, kc1 = (tid + 512) % 12, vd = tid >> 3, vc = tid & 7;
    u32x4 pk0, pk1 = (u32x4){0, 0, 0, 0}, pv;
    __syncthreads();
    pk0 = *(const u32x4*)(kg + (size_t)kr0 * 768 + kc0 * 8); if (tid < 256) pk1 = *(const u32x4*)(kg + (size_t)kr1 * 768 + kc1 * 8);
    pv = *(const u32x4*)(vg + (size_t)vd * SEQ + vc * 8);
    { bf16_t* ks_ = (bf16_t*)lds; bf16_t* vs_ = (bf16_t*)(lds + KB);
        *(u32x4*)(ks_ + kr0 * KS + kc0 * 8) = pk0; if (tid < 256) *(u32x4*)(ks_ + kr1 * KS + kc1 * 8) = pk1; *(u32x4*)(vs_ + vd * VS + vc * 8) = pv; }
    __syncthreads();
    f32x4 O[4]; float m = -1e30f, lsum = 0.f;
#pragma unroll
    for (int d = 0; d < 4; ++d) O[d] = (f32x4){0.f, 0.f, 0.f, 0.f};
#pragma unroll 1
    for (int kt = 0; kt < nkt; ++kt) {
        const bool pre = (kt + 1 < nkt);
        if (pre) { const size_t ko = (size_t)(kt + 1) * 64;
            pk0 = *(const u32x4*)(kg + (ko + kr0) * 768 + kc0 * 8); if (tid < 256) pk1 = *(const u32x4*)(kg + (ko + kr1) * 768 + kc1 * 8);
            pv = *(const u32x4*)(vg + (size_t)vd * SEQ + ko + vc * 8); }
        if (kt < mykt) {
            const bf16_t* ks_ = (const bf16_t*)(lds + (kt & 1) * BUF); const bf16_t* vs_ = (const bf16_t*)(lds + (kt & 1) * BUF + KB);
            f32x4 s[4];
#pragma unroll
            for (int c4 = 0; c4 < 4; ++c4) { s[c4] = (f32x4){0.f, 0.f, 0.f, 0.f};
#pragma unroll
                for (int ks = 0; ks < 3; ++ks) s[c4] = MFMA(ld_frag(ks_ + (c4 * 16 + fr) * KS + ks * 32 + fq * 8), qf[ks], s[c4]); }
            float mx = -1e30f;
#pragma unroll
            for (int c4 = 0; c4 < 4; ++c4) mx = fmaxf(fmaxf(fmaxf(s[c4][0], s[c4][1]), fmaxf(s[c4][2], s[c4][3])), mx);
            mx = fmaxf(mx, __shfl_xor(mx, 16)); mx = fmaxf(mx, __shfl_xor(mx, 32));
            const float mn = fmaxf(m, mx), alpha = exp2f(m - mn); m = mn;
            float ps = 0.f;
#pragma unroll
            for (int c4 = 0; c4 < 4; ++c4)
#pragma unroll
                for (int e = 0; e < 4; ++e) { s[c4][e] = exp2f(s[c4][e] - mn); ps += s[c4][e]; }
            lsum = lsum * alpha + ps;
#pragma unroll
            for (int d = 0; d < 4; ++d) O[d] = O[d] * alpha;
            const bf16x8 pf0 = pack_frag(s[0], s[1]), pf1 = pack_frag(s[2], s[3]);
#pragma unroll
            for (int d = 0; d < 4; ++d) { const bf16_t* vp = vs_ + (d * 16 + fr) * VS + fq * 4;
                O[d] = MFMA(join_frag(*(const u32x2*)(vp), *(const u32x2*)(vp + 16)), pf0, O[d]);
                O[d] = MFMA(join_frag(*(const u32x2*)(vp + 32), *(const u32x2*)(vp + 48)), pf1, O[d]); }
        }
        if (pre) { bf16_t* ks_ = (bf16_t*)(lds + ((kt + 1) & 1) * BUF); bf16_t* vs_ = (bf16_t*)(lds + ((kt + 1) & 1) * BUF + KB);
            *(u32x4*)(ks_ + kr0 * KS + kc0 * 8) = pk0; if (tid < 256) *(u32x4*)(ks_ + kr1 * KS + kc1 * 8) = pk1; *(u32x4*)(vs_ + vd * VS + vc * 8) = pv; }
        __syncthreads();
    }
    lsum += __shfl_xor(lsum, 16); lsum += __shfl_xor(lsum, 32);
    const float il = 1.f / lsum;
#pragma unroll
    for (int d = 0; d < 4; ++d) { bf16_t* zp = Z + (size_t)trow * NZ + h * 64 + d * 16 + fq * 4; const f32x4 z = unpack4(*(const u32x2*)zp);
        f32x4 o;
#pragma unroll
        for (int e = 0; e < 4; ++e) o[e] = O[d][e] * il * siluf_(z[e]);
        *(u32x2*)zp = pack4(o); }
}

__device__ __forceinline__ void scan_item(const Params& p, int l, int bh, unsigned char* lds) {
    const int tid = tid_l(), b = bh >> 3, h = bh & 7;
    const unsigned char* r2 = p.ws + OFF_R2; bf16_t* Z = (bf16_t*)(p.ws + OFF_Z);
    float* Lw = (float*)lds; float* La = Lw + 4096; float* Lb = La + 4096; float* Lk = Lb + 4096; float* Lr = Lk + 4096; float* Lv = Lr + 4096; float* Ly = Lv + 4096;
    const int i = tid >> 3, jp = tid & 7;
    float st[8];
#pragma unroll
    for (int e = 0; e < 8; ++e) st[e] = 0.f;
    const int et = tid >> 3, ep = tid & 7;
#pragma unroll 1
    for (int ck = 0; ck < SEQ / 64; ++ck) {
        const size_t tg = (size_t)b * SEQ + ck * 64 + et; const size_t o = tg * 512 + h * 64 + ep * 8;
        __syncthreads();
        { const u32x4 ur = *(const u32x4*)((const bf16_t*)(r2 + R2_R) + o), uk = *(const u32x4*)((const bf16_t*)(r2 + R2_K) + o), uv = *(const u32x4*)((const bf16_t*)(r2 + R2_V) + o),
                      ukk = *(const u32x4*)((const bf16_t*)(r2 + R2_KK) + o), ub = *(const u32x4*)((const bf16_t*)(r2 + R2_B) + o);
            const f32x4 l0 = *(const f32x4*)((const float*)(r2 + R2_LW) + o), l1 = *(const f32x4*)((const float*)(r2 + R2_LW) + o + 4);
            const int lo = et * 64 + ep * 8;
            *(f32x4*)(Lw + lo) = (f32x4){__expf(l0[0]), __expf(l0[1]), __expf(l0[2]), __expf(l0[3])}; *(f32x4*)(Lw + lo + 4) = (f32x4){__expf(l1[0]), __expf(l1[1]), __expf(l1[2]), __expf(l1[3])};
            *(f32x4*)(La + lo) = (f32x4){-bf_lo(ukk.x), -bf_hi(ukk.x), -bf_lo(ukk.y), -bf_hi(ukk.y)}; *(f32x4*)(La + lo + 4) = (f32x4){-bf_lo(ukk.z), -bf_hi(ukk.z), -bf_lo(ukk.w), -bf_hi(ukk.w)};
            *(f32x4*)(Lb + lo) = (f32x4){bf_lo(ub.x), bf_hi(ub.x), bf_lo(ub.y), bf_hi(ub.y)}; *(f32x4*)(Lb + lo + 4) = (f32x4){bf_lo(ub.z), bf_hi(ub.z), bf_lo(ub.w), bf_hi(ub.w)};
            *(f32x4*)(Lk + lo) = (f32x4){bf_lo(uk.x), bf_hi(uk.x), bf_lo(uk.y), bf_hi(uk.y)}; *(f32x4*)(Lk + lo + 4) = (f32x4){bf_lo(uk.z), bf_hi(uk.z), bf_lo(uk.w), bf_hi(uk.w)};
            *(f32x4*)(Lr + lo) = (f32x4){bf_lo(ur.x), bf_hi(ur.x), bf_lo(ur.y), bf_hi(ur.y)}; *(f32x4*)(Lr + lo + 4) = (f32x4){bf_lo(ur.z), bf_hi(ur.z), bf_lo(ur.w), bf_hi(ur.w)};
            *(f32x4*)(Lv + lo) = (f32x4){bf_lo(uv.x), bf_hi(uv.x), bf_lo(uv.y), bf_hi(uv.y)}; *(f32x4*)(Lv + lo + 4) = (f32x4){bf_lo(uv.z), bf_hi(uv.z), bf_lo(uv.w), bf_hi(uv.w)};
        }
        __syncthreads();
#pragma unroll 2
        for (int t = 0; t < 64; ++t) { const int lo = t * 64 + jp * 8;
            const f32x4 w0 = *(const f32x4*)(Lw + lo), w1 = *(const f32x4*)(Lw + lo + 4), a0 = *(const f32x4*)(La + lo), a1 = *(const f32x4*)(La + lo + 4), b0 = *(const f32x4*)(Lb + lo), b1 = *(const f32x4*)(Lb + lo + 4),
                        k0 = *(const f32x4*)(Lk + lo), k1 = *(const f32x4*)(Lk + lo + 4), r0 = *(const f32x4*)(Lr + lo), r1 = *(const f32x4*)(Lr + lo + 4);
            const float vi = Lv[t * 64 + i];
            float sa = st[0] * a0[0] + st[1] * a0[1] + st[2] * a0[2] + st[3] * a0[3] + st[4] * a1[0] + st[5] * a1[1] + st[6] * a1[2] + st[7] * a1[3];
            sa += __shfl_xor(sa, 1); sa += __shfl_xor(sa, 2); sa += __shfl_xor(sa, 4);
            st[0] = st[0] * w0[0] + sa * b0[0] + vi * k0[0]; st[1] = st[1] * w0[1] + sa * b0[1] + vi * k0[1]; st[2] = st[2] * w0[2] + sa * b0[2] + vi * k0[2]; st[3] = st[3] * w0[3] + sa * b0[3] + vi * k0[3];
            st[4] = st[4] * w1[0] + sa * b1[0] + vi * k1[0]; st[5] = st[5] * w1[1] + sa * b1[1] + vi * k1[1]; st[6] = st[6] * w1[2] + sa * b1[2] + vi * k1[2]; st[7] = st[7] * w1[3] + sa * b1[3] + vi * k1[3];
            float y = st[0] * r0[0] + st[1] * r0[1] + st[2] * r0[2] + st[3] * r0[3] + st[4] * r1[0] + st[5] * r1[1] + st[6] * r1[2] + st[7] * r1[3];
            y += __shfl_xor(y, 1); y += __shfl_xor(y, 2); y += __shfl_xor(y, 4);
            if (jp == 0) Ly[t * 64 + i] = y;
        }
        __syncthreads();
        { const int lo = et * 64 + ep * 8;
            const f32x4 y0 = *(const f32x4*)(Ly + lo), y1 = *(const f32x4*)(Ly + lo + 4), r0 = *(const f32x4*)(Lr + lo), r1 = *(const f32x4*)(Lr + lo + 4), k0 = *(const f32x4*)(Lk + lo), k1 = *(const f32x4*)(Lk + lo + 4),
                        v0 = *(const f32x4*)(Lv + lo), v1 = *(const f32x4*)(Lv + lo + 4);
            const f32x4 rk0 = *(const f32x4*)(p.r_k + (size_t)l * 512 + h * 64 + ep * 8), rk1 = *(const f32x4*)(p.r_k + (size_t)l * 512 + h * 64 + ep * 8 + 4);
            float s = y0[0] + y0[1] + y0[2] + y0[3] + y1[0] + y1[1] + y1[2] + y1[3];
            float dot = r0[0] * k0[0] * rk0[0] + r0[1] * k0[1] * rk0[1] + r0[2] * k0[2] * rk0[2] + r0[3] * k0[3] * rk0[3] + r1[0] * k1[0] * rk1[0] + r1[1] * k1[1] * rk1[1] + r1[2] * k1[2] * rk1[2] + r1[3] * k1[3] * rk1[3];
            s += __shfl_xor(s, 1); s += __shfl_xor(s, 2); s += __shfl_xor(s, 4);
            dot += __shfl_xor(dot, 1); dot += __shfl_xor(dot, 2); dot += __shfl_xor(dot, 4);
            const float mean = s * (1.f / 64.f);
            const f32x4 d0 = y0 - mean, d1 = y1 - mean;
            float q = d0[0] * d0[0] + d0[1] * d0[1] + d0[2] * d0[2] + d0[3] * d0[3] + d1[0] * d1[0] + d1[1] * d1[1] + d1[2] * d1[2] + d1[3] * d1[3];
            q += __shfl_xor(q, 1); q += __shfl_xor(q, 2); q += __shfl_xor(q, 4);
            const float rstd = rsqrtf(q * (1.f / 64.f) + 64e-5f);
            const f32x4 g0 = *(const f32x4*)(p.lnx_g + (size_t)l * 512 + h * 64 + ep * 8), g1 = *(const f32x4*)(p.lnx_g + (size_t)l * 512 + h * 64 + ep * 8 + 4),
                        e0 = *(const f32x4*)(p.lnx_b + (size_t)l * 512 + h * 64 + ep * 8), e1 = *(const f32x4*)(p.lnx_b + (size_t)l * 512 + h * 64 + ep * 8 + 4);
            bf16_t* zp = Z + tg * NZ + 1024 + h * 64 + ep * 8; const u32x4 zu = *(const u32x4*)zp;
            const f32x4 o0 = d0 * rstd * g0 + e0 + v0 * dot, o1 = d1 * rstd * g1 + e1 + v1 * dot;
            u32x4 w; w.x = cvt_pk_bf16(o0[0] * siluf_(bf_lo(zu.x)), o0[1] * siluf_(bf_hi(zu.x))); w.y = cvt_pk_bf16(o0[2] * siluf_(bf_lo(zu.y)), o0[3] * siluf_(bf_hi(zu.y)));
            w.z = cvt_pk_bf16(o1[0] * siluf_(bf_lo(zu.z)), o1[1] * siluf_(bf_hi(zu.z))); w.w = cvt_pk_bf16(o1[2] * siluf_(bf_lo(zu.w)), o1[3] * siluf_(bf_hi(zu.w)));
            *(u32x4*)zp = w; }
    }
}

constexpr int PH_PER_LAYER = 7, N_PHASES = 2 + NL * PH_PER_LAYER;
__global__ void __launch_bounds__(NTHREADS, 2) trunk_fwd(Params p0) {
    extern __shared__ __attribute__((aligned(16))) unsigned char lds[];
    const int G = gridDim.x, bx = blockIdx.x;
    Params p = p0;
    for (int ph = p0.ph_lo; ph < p0.ph_hi; ++ph) {
        unsigned char* ws = ptr_l(p0.ws); p.ws = ws;
        if (ph == 0) { if (PHEN & 1) phase0a(p, lds); }
        else if (ph == 1) { if (PHEN & 2) phase0b(p); }
        else {
            const int l = (ph - 2) / PH_PER_LAYER, k = (ph - 2) % PH_PER_LAYER;
            if (k == 0 && (PHEN & 4)) {
                pg8::Gemm g{(const bf16_t*)(ws + OFF_H), (const bf16_t*)(ws + OFF_WIN + l * SZ_WIN), DM, DM, DM};
                pg8::PlainOrder S; S.init(M_TOK / 256, NIN / 256, G, bx);
                pg8::EpiIn E{(bf16_t*)(ws + OFF_R1), (bf16_t*)(ws + OFF_Z)};
                pg8::gemm_phase(( LAS unsigned char*)lds, g, S, E);
            } else if (k == 1 && (PHEN & 8)) {
                for (int it = bx; it < 640; it += G) {
                    if (it < 128) { if (PHEN & 512) gmlp_item(p, l, it, lds); }
                    else if (it < 384) { if (PHEN & 1024) mla_prep_item(p, l, it - 128, lds); }
                    else { if (PHEN & 2048) rwkv_prep_item(p, l, it - 384); }
                }
            } else if (k == 2 && (PHEN & 16)) {
                for (int it = bx; it < 32; it += G) scan_item(p, l, it, lds);
                int rank = bx, cnt = G; if (G > 32) { rank = bx - 32; cnt = G - 32; }
                if (rank >= 0) for (int pi = rank; pi < 512; pi += cnt) { const int bh = pi >> 4, j = pi & 15;
                    attn_item(p, bh >> 3, bh & 7, 31 - j, lds); attn_item(p, bh >> 3, bh & 7, j, lds); }
            } else if (k == 3 && (PHEN & 32)) {
                pg8::Gemm g{(const bf16_t*)(ws + OFF_H), (const bf16_t*)(ws + OFF_WG + l * SZ_WG), DM, DM, DM};
                pg8::PlainOrder S; S.init(M_TOK / 256, NG / 256, G, bx);
                pg8::EpiPlain<1> E{(bf16_t*)(ws + OFF_R2), NG};
                pg8::gemm_phase((LAS unsigned char*)lds, g, S, E);
            } else if (k == 4 && (PHEN & 64)) {
                pg8::Gemm g{(const bf16_t*)(ws + OFF_Z), (const bf16_t*)(ws + OFF_WBR + l * SZ_WBR), NZ, 512, 512};
                pg8::MergeOrder S; S.init(M_TOK / 256, DM / 256, G, bx);
                pg8::EpiMerge E{(bf16_t*)(ws + OFF_R3 + R3_MERGED), (const bf16_t*)(ws + OFF_R2)};
                pg8::gemm_phase((LAS unsigned char*)lds, g, S, E);
            } else if (k == 5 && (PHEN & 128)) {
                pg8::Gemm g{(const bf16_t*)(ws + OFF_R3 + R3_MERGED), (const bf16_t*)(ws + OFF_WOUT + l * SZ_WOUT), DM, DM, DM};
                pg8::PlainOrder S; S.init(M_TOK / 256, DM / 256, G, bx);
                pg8::EpiPlain<0> E{(bf16_t*)(ws + OFF_R3 + R3_Y), DM};
                pg8::gemm_phase((LAS unsigned char*)lds, g, S, E);
            } else if (k == 6 && (PHEN & 256)) {
                phase_final(p, l);
            }
        }
        if (ph + 1 < p0.ph_hi) cg::this_grid().sync();
    }
}

extern "C" void kernel_launch(void* const* d_in, const int* in_sizes, int n_in, void* d_out, int out_size, void* d_ws, size_t ws_size, hipStream_t stream) {
    static int grid = 0;
    if (grid == 0) {
        if (n_in != 31 || out_size != M_TOK * DM || ws_size < WS_END) { fprintf(stderr, "kernel_launch: unexpected shapes (n_in %d out %d ws %zu)\n", n_in, out_size, ws_size); grid = -1; return; }
        int dev = 0, cus = 0, per_cu = 0;
        hipGetDevice(&dev); hipDeviceGetAttribute(&cus, hipDeviceAttributeMultiprocessorCount, dev);
        hipFuncSetAttribute((const void*)trunk_fwd, hipFuncAttributeMaxDynamicSharedMemorySize, LDS_BYTES);
        hipOccupancyMaxActiveBlocksPerMultiprocessor(&per_cu, (const void*)trunk_fwd, NTHREADS, LDS_BYTES);
        if (per_cu < 1) { fprintf(stderr, "kernel_launch: occupancy query says %d blocks per CU\n", per_cu); grid = -1; return; }
        grid = cus * 1;
    }
    if (grid < 0) return;
    Params p{};
    p.x = (const float*)d_in[0]; p.c = (const float*)d_in[1]; p.pos = (const int*)d_in[2]; p.pre_g = (const float*)d_in[3]; p.post_g = (const float*)d_in[4];
    p.w_ada = (const float*)d_in[5]; p.b_ada = (const float*)d_in[6]; p.w_in = (const float*)d_in[7]; p.q_norm = (const float*)d_in[8]; p.w_uq = (const float*)d_in[9];
    p.kv_norm = (const float*)d_in[10]; p.w_ukv = (const float*)d_in[11]; p.ln_g = (const float*)d_in[12]; p.ln_b = (const float*)d_in[13]; p.w_s = (const float*)d_in[14]; p.b_s = (const float*)d_in[15];
    p.mu = (const float*)d_in[16]; p.w0 = (const float*)d_in[17]; p.w2 = (const float*)d_in[18]; p.a0 = (const float*)d_in[19]; p.a2 = (const float*)d_in[20]; p.k_k = (const float*)d_in[21];
    p.k_a = (const float*)d_in[22]; p.r_k = (const float*)d_in[23]; p.lnx_g = (const float*)d_in[24]; p.lnx_b = (const float*)d_in[25]; p.v0 = (const float*)d_in[26]; p.v1 = (const float*)d_in[27];
    p.v2 = (const float*)d_in[28]; p.w_br = (const float*)d_in[29]; p.w_out = (const float*)d_in[30];
    p.out = (float*)d_out; p.ws = (unsigned char*)d_ws;
#if ONE_LAUNCH
    p.ph_lo = 0; p.ph_hi = N_PHASES;
    void* args[] = {&p};
    hipError_t e = hipLaunchCooperativeKernel((const void*)trunk_fwd, dim3(grid), dim3(NTHREADS), args, LDS_BYTES, stream);
    if (e != hipSuccess) fprintf(stderr, "cooperative launch failed: %s (grid %d)\n", hipGetErrorString(e), grid);
#else
    for (int ph = 0; ph < N_PHASES; ++ph) { p.ph_lo = ph; p.ph_hi = ph + 1;
        hipLaunchKernelGGL(trunk_fwd, dim3(grid), dim3(NTHREADS), LDS_BYTES, stream, p); }
#endif
}
```

```cpp
#include <hip/hip_runtime.h>
#include <hip/hip_cooperative_groups.h>
#include <cstdint>
#include <cstdio>
namespace cg = cooperative_groups;

#ifndef PHEN
#define PHEN 0x7fff
#endif
#ifndef EXP_NODOT
#define EXP_NODOT 0
#endif
#ifndef EXP_CONSTY
#define EXP_CONSTY 0
#endif
#ifndef EXP_NOW1
#define EXP_NOW1 0
#endif
#ifndef EXP_NOSTATE
#define EXP_NOSTATE 0
#endif
#ifndef EXP_ZERO
#define EXP_ZERO 0
#endif
#ifndef USE_CHUNK
#define USE_CHUNK 1
#endif
#ifndef PROBE_SCAN
#define PROBE_SCAN 0
#endif
#ifndef ONE_LAUNCH
#define ONE_LAUNCH 1
#endif

#define LAS __attribute__((address_space(3)))
typedef unsigned short bf16_t;
typedef short bf16x8 __attribute__((ext_vector_type(8)));
typedef short bf16x4 __attribute__((ext_vector_type(4)));
typedef float f32x4 __attribute__((ext_vector_type(4)));
typedef float f32x2 __attribute__((ext_vector_type(2)));
typedef unsigned u32x4 __attribute__((ext_vector_type(4)));
typedef unsigned u32x2 __attribute__((ext_vector_type(2)));

constexpr int M_TOK = 16384, DM = 1024, SEQ = 4096, NBATCH = 4, NL = 4;
constexpr int D_IN_SRC = 7712;
constexpr int NP1 = 3328, NZ = 1536, NIN = 4864, NG = 3072;
constexpr int C_QLAT = 0, C_KVLAT = 256, C_KROPE = 384, C_GMU = 512, C_GMV = 1024, C_RW = 1536, C_RWR = 1536, C_RWK = 2048, C_RWV = 2560, C_WLAT = 3072, C_ALAT = 3136;
constexpr int NTHREADS = 512, NWAVES = 8;
constexpr int LDS_BYTES = 150 * 1024;
constexpr float QSCALE = 0.10206207261596575f * 1.4426950408889634f;

constexpr size_t MiB = 1u << 20;
constexpr size_t OFF_WIN = 0;
constexpr size_t SZ_WIN = (size_t)NIN * DM * 2;
constexpr size_t OFF_WG = 38 * MiB;
constexpr size_t SZ_WG = (size_t)NG * DM * 2;
constexpr size_t OFF_WBR = 62 * MiB;
constexpr size_t SZ_WBR = (size_t)3072 * 512 * 2;
constexpr size_t OFF_WOUT = 74 * MiB;
constexpr size_t SZ_WOUT = (size_t)DM * DM * 2;
constexpr size_t OFF_WUQ = 82 * MiB;
constexpr size_t SZ_WUQ = (size_t)768 * 256 * 2;
constexpr size_t OFF_WUKV = OFF_WUQ + 3 * MiB / 2;
constexpr size_t SZ_WUKV = (size_t)1024 * 128 * 2;
constexpr size_t OFF_SMALL = OFF_WUKV + 1 * MiB;
constexpr size_t OFF_W2T = OFF_SMALL;
constexpr size_t OFF_A2T = OFF_W2T + 256 * 1024;
constexpr size_t OFF_V1T = OFF_A2T + 256 * 1024;
constexpr size_t OFF_V2T = OFF_V1T + 128 * 1024;
constexpr size_t OFF_WS = OFF_V2T + 128 * 1024;
constexpr size_t OFF_MODP = OFF_WS + 512 * 1024;
constexpr size_t OFF_ROPE = OFF_MODP + 3 * MiB / 2;
constexpr size_t OFF_DOT = OFF_ROPE + 2 * MiB;
constexpr size_t OFF_H = 90 * MiB;
constexpr size_t OFF_Z = 122 * MiB;
constexpr size_t OFF_VF = 170 * MiB;
constexpr size_t OFF_R1 = 186 * MiB;
constexpr size_t OFF_R2 = 298 * MiB;
constexpr size_t OFF_R3 = 410 * MiB;
constexpr size_t WS_END = 474 * MiB;
static_assert(OFF_DOT + MiB / 2 <= OFF_H, "small region");
constexpr size_t R1_GP = 0, R1_RA = 16 * MiB, R1_HT = 32 * MiB, R1_YQ = 48 * MiB, R1_PC = 64 * MiB;
constexpr size_t R2_R = 0, R2_K = 16 * MiB, R2_V = 32 * MiB, R2_KK = 48 * MiB, R2_B = 64 * MiB, R2_LW = 80 * MiB;
constexpr size_t R3_Q = 0, R3_KF = 24 * MiB, R3_VT = 48 * MiB, R3_MERGED = 0, R3_Y = 32 * MiB;

struct Params {
    const float* x; const float* c; const int* pos; const float* pre_g; const float* post_g; const float* w_ada; const float* b_ada; const float* w_in;
    const float* q_norm; const float* w_uq; const float* kv_norm; const float* w_ukv; const float* ln_g; const float* ln_b; const float* w_s; const float* b_s;
    const float* mu; const float* w0; const float* w2; const float* a0; const float* a2; const float* k_k; const float* k_a; const float* r_k;
    const float* lnx_g; const float* lnx_b; const float* v0; const float* v1; const float* v2; const float* w_br; const float* w_out;
    float* out; unsigned char* ws;
    int ph_lo, ph_hi;
};

typedef __bf16 bf16x2_t __attribute__((ext_vector_type(2)));
__device__ __forceinline__ unsigned cvt_pk_bf16(float lo, float hi) { const f32x2 v = {lo, hi}; const bf16x2_t b = __builtin_convertvector(v, bf16x2_t); return __builtin_bit_cast(unsigned, b); }
__device__ __forceinline__ float bf_lo(unsigned u) { return __uint_as_float(u << 16); }
__device__ __forceinline__ float bf_hi(unsigned u) { return __uint_as_float(u & 0xffff0000u); }
__device__ __forceinline__ float bf2f(bf16_t h) { return __uint_as_float(((unsigned)h) << 16); }
__device__ __forceinline__ bf16_t f2bf(float f) { return (bf16_t)(cvt_pk_bf16(f, 0.f) & 0xffffu); }
__device__ __forceinline__ float sigmoidf_(float x) { return 1.f / (1.f + __expf(-x)); }
__device__ __forceinline__ float siluf_(float x) { return x / (1.f + __expf(-x)); }
__device__ __forceinline__ float geluf_(float x) { return 0.5f * x * (1.f + erff(x * 0.70710678118654752f)); }
__device__ __forceinline__ f32x4 unpack4(u32x2 u) { return (f32x4){bf_lo(u.x), bf_hi(u.x), bf_lo(u.y), bf_hi(u.y)}; }
__device__ __forceinline__ u32x2 pack4(f32x4 v) { u32x2 r; r.x = cvt_pk_bf16(v[0], v[1]); r.y = cvt_pk_bf16(v[2], v[3]); return r; }
__device__ __forceinline__ float wave_sum(float v) {
#pragma unroll
    for (int o = 1; o < 64; o <<= 1) v += __shfl_xor(v, o);
    return v;
}
__device__ __forceinline__ bf16x8 ld_frag(const bf16_t* p) { return *(const bf16x8*)p; }
__device__ __forceinline__ bf16x8 pack_frag(f32x4 a, f32x4 b) {
    u32x4 u; u.x = cvt_pk_bf16(a[0], a[1]); u.y = cvt_pk_bf16(a[2], a[3]); u.z = cvt_pk_bf16(b[0], b[1]); u.w = cvt_pk_bf16(b[2], b[3]);
    return __builtin_bit_cast(bf16x8, u);
}
__device__ __forceinline__ bf16x8 join_frag(u32x2 a, u32x2 b) { u32x4 u; u.x = a.x; u.y = a.y; u.z = b.x; u.w = b.y; return __builtin_bit_cast(bf16x8, u); }
__device__ __forceinline__ int tid_l() { int t = threadIdx.x; asm volatile("" : "+v"(t)); return t; }
__device__ __forceinline__ unsigned char* ptr_l(unsigned char* q) { asm volatile("" : "+s"(q)); return q; }
#define MFMA(a, b, c) __builtin_amdgcn_mfma_f32_16x16x32_bf16((a), (b), (c), 0, 0, 0)

namespace pg8 {
constexpr int BM = 256, BK = 64, HALF = 128, HTB = HALF * BK * 2, STAGE_BYTES = 8 * HTB, NXCD = 8, WGM = 8;
__host__ __device__ __forceinline__ int lds_byte(int r, int c) { const int st = (r >> 4) * 2 + (c >> 5), rr = r & 15, cc = c & 31, ob = rr * 64 + cc * 2; return st * 1024 + (ob ^ (((ob >> 9) & 1) << 5)); }
__host__ __device__ __forceinline__ void stage_rc(int b, int& R, int& C) { const int st = b / 1024, sb = b % 1024, swz = sb ^ (((sb >> 9) & 1) << 5); R = (st >> 1) * 16 + swz / 64; C = (st & 1) * 32 + (swz % 64) / 2; }
__host__ __device__ __forceinline__ int perm32(int rho) { const int n = rho >> 4, i = rho & 15; return 8 * (i >> 2) + 4 * n + (i & 3); }

struct Unit { int pm, pn, ak, tag; };
struct Gemm { const bf16_t* A; const bf16_t* Bt; int lda, ldb, K; };

__device__ __forceinline__ void tile_of(int wgid, int nM, int nN, int& pm, int& pn) {
    const int nwg = nM * nN;
    { const int q = nwg / NXCD, r = nwg % NXCD, xcd = wgid % NXCD, off = wgid / NXCD; wgid = (xcd < r ? xcd * (q + 1) : r * (q + 1) + (xcd - r) * q) + off; }
    const int nig = WGM * nN, gid = wgid / nig, fm = gid * WGM, gsz = (nM - fm) < WGM ? (nM - fm) : WGM;
    pm = fm + ((wgid % nig) % gsz); pn = (wgid % nig) / gsz;
}
struct PlainOrder {
    int nM, nN, nwg, G, c;
    __device__ void init(int nM_, int nN_, int G_, int c_) { nM = nM_; nN = nN_; nwg = nM * nN; G = G_; c = c_; }
    __device__ bool next(int i, Unit& u) const { const long L = (long)i * G + c; if (L >= nwg) return false; tile_of((int)L, nM, nN, u.pm, u.pn); u.ak = 0; u.tag = 0; return true; }
};
struct MergeOrder {
    int nM, nN, nwg, G, c;
    __device__ void init(int nM_, int nN_, int G_, int c_) { nM = nM_; nN = nN_; nwg = nM * nN; G = G_; c = c_; }
    __device__ bool next(int i, Unit& u) const { const int ti = i / 3, n = i - 3 * ti; const long L = (long)ti * G + c; if (L >= nwg) return false;
        int pm, pc; tile_of((int)L, nM, nN, pm, pc); u.pm = pm; u.pn = n * nN + pc; u.ak = n * 512; u.tag = n; return true; }
};

template <class Epi, class Sched>
__device__ __forceinline__ void gemm_phase(LAS unsigned char* lds, const Gemm g, const Sched& S, const Epi& E) {
    const int tid = tid_l(), wid = __builtin_amdgcn_readfirstlane(tid >> 6), lane = tid & 63, wr = wid >> 2, wc = wid & 3, fr = lane & 15, fq = lane >> 4;
    const int K = g.K, nt = K / BK;
    unsigned voffA[2], voffB[2];
#pragma unroll
    for (int i = 0; i < 2; ++i) { int R, C; stage_rc(tid * 16 + i * 8192, R, C); const int Rb = (R & ~31) + perm32(R & 31);
        voffA[i] = (unsigned)(R * g.lda + C) * 2u; voffB[i] = (unsigned)(Rb * g.ldb + C) * 2u; }
    const size_t kstep = (size_t)(BK * 2);
    const size_t hstepA = (size_t)HALF * g.lda * 2, hstepB = (size_t)HALF * g.ldb * 2;
    const size_t tstepA = 2 * hstepA, tstepB = 2 * hstepB;
    const unsigned ldsw = (unsigned)wid * 1024u;
    const int aoff = lds_byte(wr * 64 + fr, fq * 8), boff = lds_byte(wc * 32 + fr, fq * 8);
#define PG8_SA(b, h) (((b) * 2 + (h)) * HTB)
#define PG8_SB(b, h) ((4 + (b) * 2 + (h)) * HTB)
#define PG8_STAGE(bufoff, gbase, voff) do { _Pragma("unroll") for (int _i = 0; _i < 2; ++_i) \
        __builtin_amdgcn_global_load_lds((const unsigned*)((const char*)(gbase) + (voff)[_i]), (LAS unsigned*)(lds + (bufoff) + ldsw + _i * 8192), 16, 0, 0); } while (0)
#define PG8_LDA(dst, b, h) do { _Pragma("unroll") for (int m = 0; m < 4; ++m) _Pragma("unroll") for (int k = 0; k < 2; ++k) dst[m][k] = *(const LAS bf16x8*)(lds + PG8_SA(b, h) + aoff + m * 2048 + k * 1024); } while (0)
#define PG8_LDB(dst, b, h) do { _Pragma("unroll") for (int n = 0; n < 2; ++n) _Pragma("unroll") for (int k = 0; k < 2; ++k) dst[n][k] = *(const LAS bf16x8*)(lds + PG8_SB(b, h) + boff + n * 2048 + k * 1024); } while (0)
#define PG8_MMA(ai, bj, At, Bt) do { __builtin_amdgcn_s_setprio(1); _Pragma("unroll") for (int m = 0; m < 4; ++m) _Pragma("unroll") for (int n = 0; n < 2; ++n) _Pragma("unroll") for (int k = 0; k < 2; ++k) \
        acc[ai][bj][m][n] = __builtin_amdgcn_mfma_f32_16x16x32_bf16(Bt[n][k], At[m][k], acc[ai][bj][m][n], 0, 0, 0); __builtin_amdgcn_s_setprio(0); } while (0)
#define PG8_WAIT_V(n) asm volatile("s_waitcnt vmcnt(" #n ")" ::: "memory")
#define PG8_WAIT_L(n) asm volatile("s_waitcnt lgkmcnt(" #n ")" ::: "memory")
#define PG8_BAR __builtin_amdgcn_s_barrier()
#define PG8_SCHED __builtin_amdgcn_sched_barrier(0)
    Unit cur, nxt; int ui = 0;
    if (!S.next(0, cur)) return;
    f32x4 acc[2][2][4][2];
#pragma unroll
    for (int a = 0; a < 2; ++a)
#pragma unroll
        for (int b = 0; b < 2; ++b)
#pragma unroll
            for (int m = 0; m < 4; ++m)
#pragma unroll
                for (int n = 0; n < 2; ++n) acc[a][b][m][n] = (f32x4){0.f, 0.f, 0.f, 0.f};
    bf16x8 At[4][2], B0[2][2], B1[2][2];
    const char* cA = (const char*)g.A + (size_t)cur.pm * tstepA + (size_t)cur.ak * 2; const char* cB = (const char*)g.Bt + (size_t)cur.pn * tstepB;
    PG8_STAGE(PG8_SB(0, 0), cB, voffB); PG8_STAGE(PG8_SB(0, 1), cB + hstepB, voffB); PG8_STAGE(PG8_SA(0, 0), cA, voffA); PG8_STAGE(PG8_SA(0, 1), cA + hstepA, voffA);
    if (wr == 1) PG8_BAR;
    PG8_WAIT_V(2); PG8_BAR;
    PG8_STAGE(PG8_SB(1, 0), cB + kstep, voffB); PG8_STAGE(PG8_SA(1, 0), cA + kstep, voffA); PG8_STAGE(PG8_SB(1, 1), cB + hstepB + kstep, voffB);
    PG8_WAIT_V(6); PG8_BAR;
    for (;;) {
        const bool has_next = S.next(ui + 1, nxt);
        const char* nA = has_next ? (const char*)g.A + (size_t)nxt.pm * tstepA + (size_t)nxt.ak * 2 : cA; const char* nB = has_next ? (const char*)g.Bt + (size_t)nxt.pn * tstepB : cB;
        for (int t = 0; t < nt; t += 2) {
            const bool last = (t == nt - 2);
            const char* a1 = cA + (size_t)(t + 1) * kstep;
            const char* a2 = last ? nA : cA + (size_t)(t + 2) * kstep; const char* b2 = last ? nB : cB + (size_t)(t + 2) * kstep;
            const char* a3 = a2 + kstep; const char* b3 = b2 + kstep;
            PG8_LDB(B0, 0, 0); PG8_LDB(B1, 0, 1); PG8_SCHED; PG8_LDA(At, 0, 0); PG8_STAGE(PG8_SA(1, 1), a1 + hstepA, voffA);
            PG8_WAIT_V(8); PG8_WAIT_L(0); PG8_BAR; PG8_MMA(0, 0, At, B0); PG8_MMA(0, 1, At, B1); PG8_BAR; PG8_SCHED;
            PG8_LDA(At, 0, 1); PG8_STAGE(PG8_SB(0, 0), b2, voffB); PG8_STAGE(PG8_SB(0, 1), b2 + hstepB, voffB); PG8_STAGE(PG8_SA(0, 0), a2, voffA);
            PG8_WAIT_V(8); PG8_WAIT_L(0); PG8_BAR; PG8_MMA(1, 0, At, B0); PG8_MMA(1, 1, At, B1); PG8_BAR; PG8_SCHED;
            PG8_LDB(B0, 1, 0); PG8_LDB(B1, 1, 1); PG8_SCHED; PG8_LDA(At, 1, 0); PG8_STAGE(PG8_SA(0, 1), a2 + hstepA, voffA);
            PG8_WAIT_V(8); PG8_WAIT_L(0); PG8_BAR; PG8_MMA(0, 0, At, B0); PG8_MMA(0, 1, At, B1); PG8_BAR; PG8_SCHED;
            PG8_LDA(At, 1, 1); PG8_STAGE(PG8_SB(1, 0), b3, voffB); PG8_STAGE(PG8_SB(1, 1), b3 + hstepB, voffB); PG8_STAGE(PG8_SA(1, 0), a3, voffA);
            PG8_WAIT_V(8); PG8_WAIT_L(0); PG8_BAR; PG8_MMA(1, 0, At, B0); PG8_MMA(1, 1, At, B1); PG8_BAR; PG8_SCHED;
        }
        if (wr == 0) PG8_BAR;
        E(acc, cur, wr, wc, fr, fq);
        if (!has_next) break;
#pragma unroll
        for (int a = 0; a < 2; ++a)
#pragma unroll
            for (int b = 0; b < 2; ++b)
#pragma unroll
                for (int m = 0; m < 4; ++m)
#pragma unroll
                    for (int n = 0; n < 2; ++n) acc[a][b][m][n] = (f32x4){0.f, 0.f, 0.f, 0.f};
        cur = nxt; cA = nA; cB = nB; ++ui;
        if (wr == 1) PG8_BAR;
    }
    PG8_WAIT_V(0);
    PG8_BAR;
#undef PG8_SA
#undef PG8_SB
#undef PG8_STAGE
#undef PG8_LDA
#undef PG8_LDB
#undef PG8_MMA
#undef PG8_WAIT_V
#undef PG8_WAIT_L
#undef PG8_BAR
#undef PG8_SCHED
}

struct EpiIn {
    bf16_t* P1; bf16_t* Z;
    __device__ __forceinline__ void operator()(const f32x4 (&acc)[2][2][4][2], const Unit& u, int wr, int wc, int fr, int fq) const {
        bf16_t* base; int ld, colt;
        if (u.pn < 13) { base = P1; ld = NP1; colt = u.pn * BM; } else { base = Z; ld = NZ; colt = (u.pn - 13) * BM; }
        const int row0 = u.pm * BM + wr * 64 + fr, col0 = colt + wc * 32 + 8 * fq;
#pragma unroll
        for (int ai = 0; ai < 2; ++ai)
#pragma unroll
            for (int m = 0; m < 4; ++m) { bf16_t* rowp = base + (size_t)(row0 + ai * HALF + m * 16) * ld + col0;
#pragma unroll
                for (int bj = 0; bj < 2; ++bj) { const f32x4 v0 = acc[ai][bj][m][0], v1 = acc[ai][bj][m][1];
                    u32x4 w; w.x = cvt_pk_bf16(v0[0], v0[1]); w.y = cvt_pk_bf16(v0[2], v0[3]); w.z = cvt_pk_bf16(v1[0], v1[1]); w.w = cvt_pk_bf16(v1[2], v1[3]);
                    *(u32x4*)(rowp + bj * HALF) = w; } }
    }
};
template <int ACT> struct EpiPlain {
    bf16_t* O; int ld;
    __device__ __forceinline__ void operator()(const f32x4 (&acc)[2][2][4][2], const Unit& u, int wr, int wc, int fr, int fq) const {
        const int row0 = u.pm * BM + wr * 64 + fr, col0 = u.pn * BM + wc * 32 + 8 * fq;
#pragma unroll
        for (int ai = 0; ai < 2; ++ai)
#pragma unroll
            for (int m = 0; m < 4; ++m) { bf16_t* rowp = O + (size_t)(row0 + ai * HALF + m * 16) * ld + col0;
#pragma unroll
                for (int bj = 0; bj < 2; ++bj) { f32x4 v0 = acc[ai][bj][m][0], v1 = acc[ai][bj][m][1];
                    if (ACT == 1) {
#pragma unroll
                        for (int e = 0; e < 4; ++e) { v0[e] = sigmoidf_(v0[e]); v1[e] = sigmoidf_(v1[e]); } }
                    u32x4 w; w.x = cvt_pk_bf16(v0[0], v0[1]); w.y = cvt_pk_bf16(v0[2], v0[3]); w.z = cvt_pk_bf16(v1[0], v1[1]); w.w = cvt_pk_bf16(v1[2], v1[3]);
                    *(u32x4*)(rowp + bj * HALF) = w; } }
    }
};
struct EpiMerge {
    bf16_t* Mg; const bf16_t* G;
    __device__ __forceinline__ void operator()(const f32x4 (&acc)[2][2][4][2], const Unit& u, int wr, int wc, int fr, int fq) const {
        const int n = u.tag, pc = u.pn - 4 * n;
        const int row0 = u.pm * BM + wr * 64 + fr, col0 = pc * BM + wc * 32 + 8 * fq;
#pragma unroll
        for (int ai = 0; ai < 2; ++ai)
#pragma unroll
            for (int m = 0; m < 4; ++m) { const size_t row = (size_t)(row0 + ai * HALF + m * 16);
#pragma unroll
                for (int bj = 0; bj < 2; ++bj) { const f32x4 v0 = acc[ai][bj][m][0], v1 = acc[ai][bj][m][1];
                    const u32x4 gt = *(const u32x4*)(G + row * NG + n * 1024 + col0 + bj * HALF);
                    bf16_t* mp = Mg + row * DM + col0 + bj * HALF;
                    float o[8];
                    o[0] = bf_lo(gt.x) * v0[0]; o[1] = bf_hi(gt.x) * v0[1]; o[2] = bf_lo(gt.y) * v0[2]; o[3] = bf_hi(gt.y) * v0[3];
                    o[4] = bf_lo(gt.z) * v1[0]; o[5] = bf_hi(gt.z) * v1[1]; o[6] = bf_lo(gt.w) * v1[2]; o[7] = bf_hi(gt.w) * v1[3];
                    if (n > 0) { const u32x4 pv = *(const u32x4*)mp;
                        o[0] += bf_lo(pv.x); o[1] += bf_hi(pv.x); o[2] += bf_lo(pv.y); o[3] += bf_hi(pv.y); o[4] += bf_lo(pv.z); o[5] += bf_hi(pv.z); o[6] += bf_lo(pv.w); o[7] += bf_hi(pv.w); }
                    u32x4 w; w.x = cvt_pk_bf16(o[0], o[1]); w.y = cvt_pk_bf16(o[2], o[3]); w.z = cvt_pk_bf16(o[4], o[5]); w.w = cvt_pk_bf16(o[6], o[7]);
                    *(u32x4*)mp = w; } }
    }
};
}

__device__ __forceinline__ void tr_item(const float* W, int lds_, int k0, int n0s, bf16_t* WT, int ldd, int n0d, int kd0, const float* ksc, float* scr, int lane) {
#pragma unroll 8
    for (int i = 0; i < 32; ++i) { const int kk = 2 * i + (lane >> 5);
        float v = 0.f; if (n0s >= 0) { v = W[(size_t)(k0 + kk) * lds_ + n0s + (lane & 31)]; if (ksc) v *= ksc[k0 + kk]; }
        scr[kk * 33 + (lane & 31)] = v; }
    asm volatile("s_waitcnt lgkmcnt(0)" ::: "memory");
    const int c = lane & 7;
#pragma unroll
    for (int j = 0; j < 4; ++j) { const int n = (lane >> 3) + 8 * j; const float* s = scr + (8 * c) * 33 + n;
        u32x4 o; o.x = cvt_pk_bf16(s[0 * 33], s[1 * 33]); o.y = cvt_pk_bf16(s[2 * 33], s[3 * 33]); o.z = cvt_pk_bf16(s[4 * 33], s[5 * 33]); o.w = cvt_pk_bf16(s[6 * 33], s[7 * 33]);
        *(u32x4*)(WT + (size_t)(n0d + n) * ldd + kd0 + 8 * c) = o; }
    asm volatile("s_waitcnt lgkmcnt(0)" ::: "memory");
}

__device__ __forceinline__ void phase0a(const Params& p, unsigned char* lds) {
    const int tid = tid_l(), lane = tid & 63, wave = tid >> 6, G = gridDim.x;
    const int gw = blockIdx.x * NWAVES + wave, NGW = G * NWAVES;
    unsigned char* ws = p.ws;
    float* scr = (float*)(lds + wave * 16384);
    constexpr int I_WIN = 152 * 16, I_WG = 96 * 16, I_WBR = 3 * 32 * 8, I_WOUT = 32 * 16, I_WUQ = 24 * 4, I_WUKV = 32 * 2, I_W2 = 16, I_A2 = 16, I_V1 = 8;
    constexpr int I_L = I_WIN + I_WG + I_WBR + I_WOUT + I_WUQ + I_WUKV + I_W2 + I_A2 + I_V1;
    for (int it = gw; it < NL * I_L; it += NGW) {
        const int l = it / I_L; int r = it - l * I_L;
        if (r < I_WIN) { const int nb = r >> 4, kb = r & 15; const int nd = nb * 32;
            int ns; if (nd < 416) ns = nd; else if (nd < 512) ns = -1; else if (nd < 3200) ns = nd - 96; else if (nd < 3328) ns = -1; else ns = nd - 224;
            tr_item(p.w_in + (size_t)l * DM * D_IN_SRC, D_IN_SRC, kb * 64, ns, (bf16_t*)(ws + OFF_WIN + l * SZ_WIN), DM, nd, kb * 64, nullptr, scr, lane); continue; }
        r -= I_WIN;
        if (r < I_WG) { const int nb = r >> 4, kb = r & 15;
            tr_item(p.w_in + (size_t)l * DM * D_IN_SRC, D_IN_SRC, kb * 64, 4640 + nb * 32, (bf16_t*)(ws + OFF_WG + l * SZ_WG), DM, nb * 32, kb * 64, nullptr, scr, lane); continue; }
        r -= I_WG;
        if (r < I_WBR) { const int n = r / 256, r2 = r - n * 256, nb = r2 >> 3, kb = r2 & 7;
            tr_item(p.w_br + ((size_t)(l * 3 + n) * 512) * DM, DM, kb * 64, nb * 32, (bf16_t*)(ws + OFF_WBR + l * SZ_WBR), 512, n * 1024 + nb * 32, kb * 64, nullptr, scr, lane); continue; }
        r -= I_WBR;
        if (r < I_WOUT) { const int nb = r >> 4, kb = r & 15;
            tr_item(p.w_out + (size_t)l * DM * DM, DM, kb * 64, nb * 32, (bf16_t*)(ws + OFF_WOUT + l * SZ_WOUT), DM, nb * 32, kb * 64, nullptr, scr, lane); continue; }
        r -= I_WOUT;
        if (r < I_WUQ) { const int nb = r >> 2, kb = r & 3;
            tr_item(p.w_uq + (size_t)l * 256 * 768, 768, kb * 64, nb * 32, (bf16_t*)(ws + OFF_WUQ + l * SZ_WUQ), 256, nb * 32, kb * 64, p.q_norm + l * 256, scr, lane); continue; }
        r -= I_WUQ;
        if (r < I_WUKV) { const int nb = r >> 1, kb = r & 1;
            tr_item(p.w_ukv + (size_t)l * 128 * 1024, 1024, kb * 64, nb * 32, (bf16_t*)(ws + OFF_WUKV + l * SZ_WUKV), 128, nb * 32, kb * 64, p.kv_norm + l * 128, scr, lane); continue; }
        r -= I_WUKV;
        if (r < I_W2) { tr_item(p.w2 + (size_t)l * 64 * 512, 512, 0, r * 32, (bf16_t*)(ws + OFF_W2T) + (size_t)l * 512 * 64, 64, r * 32, 0, nullptr, scr, lane); continue; }
        r -= I_W2;
        if (r < I_A2) { tr_item(p.a2 + (size_t)l * 64 * 512, 512, 0, r * 32, (bf16_t*)(ws + OFF_A2T) + (size_t)l * 512 * 64, 64, r * 32, 0, nullptr, scr, lane); continue; }
        r -= I_A2;
        if (l >= 1) tr_item(p.v1 + (size_t)(l - 1) * 512 * 32, 32, r * 64, 0, (bf16_t*)(ws + OFF_V1T) + (size_t)(l - 1) * 32 * 512, 512, 0, r * 64, nullptr, scr, lane);
    }
    for (int it = gw; it < NL * 48 * 8; it += NGW) {
        const int l = it / 384, r = it - l * 384, nb = r >> 3, ks = r & 7, n = nb * 64 + lane;
        float a0 = 0.f, a1 = 0.f, a2 = 0.f, a3 = 0.f;
        const float* w = p.w_ada + (size_t)l * DM * 3072 + n;
#pragma unroll 8
        for (int k = ks * 128; k < ks * 128 + 128; ++k) { const float wv = w[(size_t)k * 3072];
            a0 += siluf_(p.c[k]) * wv; a1 += siluf_(p.c[DM + k]) * wv; a2 += siluf_(p.c[2 * DM + k]) * wv; a3 += siluf_(p.c[3 * DM + k]) * wv; }
        float* mp = (float*)(ws + OFF_MODP) + ((size_t)(l * 8 + ks) * 4) * 3072 + n;
        mp[0] = a0; mp[3072] = a1; mp[2 * 3072] = a2; mp[3 * 3072] = a3;
    }
    const size_t gt = (size_t)blockIdx.x * NTHREADS + tid, GT = (size_t)G * NTHREADS;
    for (size_t i = gt; i < (size_t)3 * 512 * 32; i += GT) { const int l1 = (int)(i / (512 * 32)), r = (int)(i % (512 * 32)), c = r >> 5, k = r & 31;
        ((bf16_t*)(ws + OFF_V2T))[i] = f2bf(p.v2[(size_t)l1 * 32 * 512 + k * 512 + c]); }
    for (size_t i = gt; i < (size_t)NL * 4 * 128 * 128; i += GT) { const int s = (int)(i & 127), t = (int)((i >> 7) & 127);
        ((bf16_t*)(ws + OFF_WS))[i] = f2bf(((s >> 6) <= (t >> 6)) ? p.w_s[i] : 0.f); }
    for (size_t i = gt; i < (size_t)M_TOK * 16; i += GT) { const int t = (int)(i >> 4), k = (int)(i & 15);
        const float inv = powf(10000.f, -(float)(2 * k) / 32.f); const float ang = (float)p.pos[t] * inv;
        ((float*)(ws + OFF_ROPE))[i] = cosf(ang); ((float*)(ws + OFF_ROPE))[(size_t)M_TOK * 16 + i] = sinf(ang); }
    for (size_t i = gt; i < (size_t)M_TOK * DM / 4; i += GT) ((f32x4*)p.out)[i] = ((const f32x4*)p.x)[i];
}

__device__ __forceinline__ f32x4 mod4(const Params& p, int l, int b, int kind, int col) {
    const float* mp = (const float*)(p.ws + OFF_MODP) + ((size_t)(l * 8) * 4 + b) * 3072 + kind * DM + col;
    f32x4 s = *(const f32x4*)(p.b_ada + (size_t)l * 3072 + kind * DM + col);
#pragma unroll
    for (int ks = 0; ks < 8; ++ks) s += *(const f32x4*)(mp + (size_t)ks * 4 * 3072);
    return s;
}
__device__ __forceinline__ void normmod_row(const Params& p, int l, int row, const f32x4 (&v)[4], int lane) {
    float ss = 0.f;
#pragma unroll
    for (int j = 0; j < 4; ++j) ss += v[j][0] * v[j][0] + v[j][1] * v[j][1] + v[j][2] * v[j][2] + v[j][3] * v[j][3];
    const float rstd = rsqrtf(wave_sum(ss) * (1.f / DM) + 1e-6f);
    const int b = row / SEQ;
    bf16_t* hrow = (bf16_t*)(p.ws + OFF_H) + (size_t)row * DM;
#pragma unroll
    for (int j = 0; j < 4; ++j) { const int col = 4 * lane + 256 * j;
        const f32x4 g = *(const f32x4*)(p.pre_g + (size_t)l * DM + col), sh = mod4(p, l, b, 0, col), sc = mod4(p, l, b, 1, col);
        f32x4 o = v[j] * rstd * g * (sc + 1.f) + sh;
        *(u32x2*)(hrow + col) = pack4(o); }
}
__device__ __forceinline__ void phase0b(const Params& p) {
    const int tidq = tid_l(); const int lane = tidq & 63, gw = blockIdx.x * NWAVES + (tidq >> 6), NGW = gridDim.x * NWAVES;
    for (int row = gw; row < M_TOK; row += NGW) { f32x4 v[4];
#pragma unroll
        for (int j = 0; j < 4; ++j) v[j] = *(const f32x4*)(p.out + (size_t)row * DM + 4 * lane + 256 * j);
        normmod_row(p, 0, row, v, lane); }
}
__device__ __forceinline__ void phase_final(const Params& p, int l) {
    const int tidq = tid_l(); const int lane = tidq & 63, gw = blockIdx.x * NWAVES + (tidq >> 6), NGW = gridDim.x * NWAVES;
    const bf16_t* Y = (const bf16_t*)(p.ws + OFF_R3 + R3_Y);
    for (int row = gw; row < M_TOK; row += NGW) {
        f32x4 y[4]; float ss = 0.f;
#pragma unroll
        for (int j = 0; j < 4; ++j) { y[j] = unpack4(*(const u32x2*)(Y + (size_t)row * DM + 4 * lane + 256 * j)); ss += y[j][0] * y[j][0] + y[j][1] * y[j][1] + y[j][2] * y[j][2] + y[j][3] * y[j][3]; }
        const float rstd = rsqrtf(wave_sum(ss) * (1.f / DM) + 1e-6f);
        const int b = row / SEQ; f32x4 v[4];
#pragma unroll
        for (int j = 0; j < 4; ++j) { const int col = 4 * lane + 256 * j;
            const f32x4 xg = *(const f32x4*)(p.out + (size_t)row * DM + col), pg = *(const f32x4*)(p.post_g + (size_t)l * DM + col), gt = mod4(p, l, b, 2, col);
            v[j] = xg + gt * (y[j] * rstd * pg);
            *(f32x4*)(p.out + (size_t)row * DM + col) = v[j]; }
        if (l + 1 < NL) normmod_row(p, l + 1, row, v, lane);
    }
}

__device__ __forceinline__ void mla_prep_item(const Params& p, int l, int item, unsigned char* lds) {
    const int tid = tid_l(), lane = tid & 63, wave = tid >> 6, fr = lane & 15, fq = lane >> 4;
    const int t0 = item * 64;
    const bf16_t* P1 = (const bf16_t*)(p.ws + OFF_R1);
    bf16_t* Q = (bf16_t*)(p.ws + OFF_R3 + R3_Q); bf16_t* Kf = (bf16_t*)(p.ws + OFF_R3 + R3_KF); bf16_t* Vt = (bf16_t*)(p.ws + OFF_R3 + R3_VT);
    const bf16_t* Wuq = (const bf16_t*)(p.ws + OFF_WUQ + l * SZ_WUQ); const bf16_t* Wukv = (const bf16_t*)(p.ws + OFF_WUKV + l * SZ_WUKV);
    const float* COS = (const float*)(p.ws + OFF_ROPE); const float* SIN = COS + (size_t)M_TOK * 16;
    float* rq = (float*)lds; float* rkv = rq + 64;
    __syncthreads();
    { const int row = tid >> 3, part = tid & 7; const bf16_t* pr = P1 + (size_t)(t0 + row) * NP1;
        float sq = 0.f, sk = 0.f;
#pragma unroll
        for (int i = 0; i < 4; ++i) { const u32x4 u = *(const u32x4*)(pr + C_QLAT + part * 32 + i * 8);
            sq += bf_lo(u.x) * bf_lo(u.x) + bf_hi(u.x) * bf_hi(u.x) + bf_lo(u.y) * bf_lo(u.y) + bf_hi(u.y) * bf_hi(u.y) + bf_lo(u.z) * bf_lo(u.z) + bf_hi(u.z) * bf_hi(u.z) + bf_lo(u.w) * bf_lo(u.w) + bf_hi(u.w) * bf_hi(u.w); }
#pragma unroll
        for (int i = 0; i < 2; ++i) { const u32x4 u = *(const u32x4*)(pr + C_KVLAT + part * 16 + i * 8);
            sk += bf_lo(u.x) * bf_lo(u.x) + bf_hi(u.x) * bf_hi(u.x) + bf_lo(u.y) * bf_lo(u.y) + bf_hi(u.y) * bf_hi(u.y) + bf_lo(u.z) * bf_lo(u.z) + bf_hi(u.z) * bf_hi(u.z) + bf_lo(u.w) * bf_lo(u.w) + bf_hi(u.w) * bf_hi(u.w); }
        sq += __shfl_xor(sq, 1); sq += __shfl_xor(sq, 2); sq += __shfl_xor(sq, 4);
        sk += __shfl_xor(sk, 1); sk += __shfl_xor(sk, 2); sk += __shfl_xor(sk, 4);
        if (part == 0) { rq[row] = rsqrtf(sq * (1.f / 256.f) + 1e-6f); rkv[row] = rsqrtf(sk * (1.f / 128.f) + 1e-6f); }
        const int i2 = part * 2; const int t = t0 + row;
        const unsigned u1 = *(const unsigned*)(pr + C_KROPE + i2), u2 = *(const unsigned*)(pr + C_KROPE + 16 + i2);
        const float c0 = COS[(size_t)t * 16 + i2], c1 = COS[(size_t)t * 16 + i2 + 1], s0 = SIN[(size_t)t * 16 + i2], s1 = SIN[(size_t)t * 16 + i2 + 1];
        const float x10 = bf_lo(u1), x11 = bf_hi(u1), x20 = bf_lo(u2), x21 = bf_hi(u2);
        const unsigned o1 = cvt_pk_bf16(x10 * c0 - x20 * s0, x11 * c1 - x21 * s1), o2 = cvt_pk_bf16(x20 * c0 + x10 * s0, x21 * c1 + x11 * s1);
#pragma unroll
        for (int h = 0; h < 8; ++h) { *(unsigned*)(Kf + (size_t)t * 768 + h * 96 + 64 + i2) = o1; *(unsigned*)(Kf + (size_t)t * 768 + h * 96 + 80 + i2) = o2; }
    }
    __syncthreads();
#pragma unroll 1
    for (int cb = 0; cb < 4; ++cb) { const int combo = wave * 4 + cb, rt = combo & 3, head = combo >> 2;
        f32x4 acc[6];
#pragma unroll
        for (int ct = 0; ct < 6; ++ct) acc[ct] = (f32x4){0.f, 0.f, 0.f, 0.f};
        const bf16_t* ap = P1 + (size_t)(t0 + rt * 16 + fr) * NP1 + C_QLAT + fq * 8;
        const bf16_t* wp = Wuq + (size_t)(head * 96 + fr) * 256 + fq * 8;
#pragma unroll
        for (int ks = 0; ks < 8; ++ks) { const bf16x8 af = ld_frag(ap + ks * 32);
#pragma unroll
            for (int ct = 0; ct < 6; ++ct) acc[ct] = MFMA(ld_frag(wp + (size_t)ct * 16 * 256 + ks * 32), af, acc[ct]); }
        const int t = t0 + rt * 16 + fr; const float rs = rq[rt * 16 + fr] * QSCALE;
        bf16_t* qp = Q + (size_t)t * 768 + head * 96 + fq * 4;
#pragma unroll
        for (int ct = 0; ct < 4; ++ct) *(u32x2*)(qp + ct * 16) = pack4(acc[ct] * rs);
        const f32x4 cs = *(const f32x4*)(COS + (size_t)t * 16 + fq * 4), sn = *(const f32x4*)(SIN + (size_t)t * 16 + fq * 4);
        const f32x4 x1 = acc[4] * rs, x2 = acc[5] * rs;
        *(u32x2*)(qp + 64) = pack4(x1 * cs - x2 * sn); *(u32x2*)(qp + 80) = pack4(x2 * cs + x1 * sn);
    }
#pragma unroll 1
    for (int cb = 0; cb < 4; ++cb) { const int combo = wave * 4 + cb, rt = combo & 3, head = combo >> 2;
        f32x4 ak[4], av[4];
#pragma unroll
        for (int ct = 0; ct < 4; ++ct) { ak[ct] = (f32x4){0.f, 0.f, 0.f, 0.f}; av[ct] = (f32x4){0.f, 0.f, 0.f, 0.f}; }
        const bf16_t* ap = P1 + (size_t)(t0 + rt * 16 + fr) * NP1 + C_KVLAT + fq * 8;
        const bf16_t* wp = Wukv + (size_t)(head * 128 + fr) * 128 + fq * 8;
#pragma unroll
        for (int ks = 0; ks < 4; ++ks) { const bf16x8 af = ld_frag(ap + ks * 32);
#pragma unroll
            for (int ct = 0; ct < 4; ++ct) { ak[ct] = MFMA(ld_frag(wp + (size_t)ct * 16 * 128 + ks * 32), af, ak[ct]);
                av[ct] = MFMA(af, ld_frag(wp + (size_t)(64 + ct * 16) * 128 + ks * 32), av[ct]); } }
        const int t = t0 + rt * 16 + fr; const float rs = rkv[rt * 16 + fr];
#pragma unroll
        for (int ct = 0; ct < 4; ++ct) *(u32x2*)(Kf + (size_t)t * 768 + head * 96 + ct * 16 + fq * 4) = pack4(ak[ct] * rs);
        const f32x4 rv = *(const f32x4*)(rkv + rt * 16 + fq * 4);
        const int b = t0 / SEQ, s0 = (t0 % SEQ) + rt * 16 + fq * 4;
#pragma unroll
        for (int ct = 0; ct < 4; ++ct) *(u32x2*)(Vt + ((size_t)(b * 8 + head) * 64 + ct * 16 + fr) * SEQ + s0) = pack4(av[ct] * rv);
    }
}

__device__ __forceinline__ void gmlp_item(const Params& p, int l, int item, unsigned char* lds) {
    const int tid = tid_l(), lane = tid & 63, wave = tid >> 6, fr = lane & 15, fq = lane >> 4;
    const int t0 = item * 128;
    const bf16_t* P1 = (const bf16_t*)(p.ws + OFF_R1); bf16_t* Z = (bf16_t*)(p.ws + OFF_Z);
    const bf16_t* Ws = (const bf16_t*)(p.ws + OFF_WS) + (size_t)l * 4 * 128 * 128;
    bf16_t* vb = (bf16_t*)lds;
    constexpr int VS = 520;
    __syncthreads();
    { const int tok = tid >> 2, qd = tid & 3; const bf16_t* pr = P1 + (size_t)(t0 + tok) * NP1 + C_GMV + qd * 128;
        float s = 0.f, s2 = 0.f;
#pragma unroll 4
        for (int i = 0; i < 16; ++i) { const u32x4 u = *(const u32x4*)(pr + i * 8); const unsigned uu[4] = {u.x, u.y, u.z, u.w};
#pragma unroll
            for (int e = 0; e < 4; ++e) { const float a = geluf_(bf_lo(uu[e])), b = geluf_(bf_hi(uu[e])); s += a + b; s2 += a * a + b * b; } }
        s += __shfl_xor(s, 1); s += __shfl_xor(s, 2); s2 += __shfl_xor(s2, 1); s2 += __shfl_xor(s2, 2);
        const float mean = s * (1.f / 512.f), var = fmaxf(s2 * (1.f / 512.f) - mean * mean, 0.f), rstd = rsqrtf(var + 1e-5f);
        const float* lg = p.ln_g + (size_t)l * 512 + qd * 128; const float* lb = p.ln_b + (size_t)l * 512 + qd * 128;
#pragma unroll 4
        for (int i = 0; i < 16; ++i) { const u32x4 u = *(const u32x4*)(pr + i * 8); const unsigned uu[4] = {u.x, u.y, u.z, u.w}; unsigned oo[4];
#pragma unroll
            for (int e = 0; e < 4; ++e) { const float a = (geluf_(bf_lo(uu[e])) - mean) * rstd * lg[i * 8 + 2 * e] + lb[i * 8 + 2 * e], b = (geluf_(bf_hi(uu[e])) - mean) * rstd * lg[i * 8 + 2 * e + 1] + lb[i * 8 + 2 * e + 1];
                oo[e] = cvt_pk_bf16(a, b); }
            *(u32x4*)(vb + (size_t)tok * VS + qd * 128 + i * 8) = (u32x4){oo[0], oo[1], oo[2], oo[3]}; }
    }
    __syncthreads();
#pragma unroll 1
    for (int g = 0; g < 4; ++g) {
        const int cbase = g * 128 + wave * 16;
        bf16x8 vfr[4];
#pragma unroll
        for (int ks = 0; ks < 4; ++ks) { bf16x8 f;
#pragma unroll
            for (int j = 0; j < 8; ++j) f[j] = (short)vb[(size_t)(ks * 32 + fq * 8 + j) * VS + cbase + fr];
            vfr[ks] = f; }
        const bf16_t* wg = Ws + (size_t)g * 128 * 128;
#pragma unroll 1
        for (int tt = 0; tt < 8; ++tt) {
            f32x4 acc = (f32x4){0.f, 0.f, 0.f, 0.f};
            const bf16_t* wp = wg + (size_t)(tt * 16 + fr) * 128 + fq * 8;
#pragma unroll
            for (int ks = 0; ks < 4; ++ks) acc = MFMA(vfr[ks], ld_frag(wp + ks * 32), acc);
            const int tl = tt * 16 + fr, t = t0 + tl, c = cbase + fq * 4;
            const float bs = p.b_s[(size_t)(l * 4 + g) * 128 + tl];
            const f32x4 u = unpack4(*(const u32x2*)(P1 + (size_t)t * NP1 + C_GMU + c));
            bf16_t* zp = Z + (size_t)t * NZ + 512 + c; const f32x4 z = unpack4(*(const u32x2*)zp);
            f32x4 o;
#pragma unroll
            for (int e = 0; e < 4; ++e) o[e] = geluf_(u[e]) * (acc[e] + bs) * siluf_(z[e]);
            *(u32x2*)zp = pack4(o);
        }
    }
}

__device__ __forceinline__ f32x4 mix4(const bf16_t* pr, const bf16_t* pp, bool has_prev, const float* mu) {
    const f32x4 a = unpack4(*(const u32x2*)pr); f32x4 b = (f32x4){0.f, 0.f, 0.f, 0.f}; if (has_prev) b = unpack4(*(const u32x2*)pp);
    const f32x4 m = *(const f32x4*)mu; return a + (b - a) * m;
}
__device__ __forceinline__ void rwkv_prep_item(const Params& p, int l, int item) {
    const int tid = tid_l(), lane = tid & 63, wave = tid >> 6, fr = lane & 15, fq = lane >> 4;
    const int rt = wave >> 1, hh = wave & 1;
    const int t = item * 64 + rt * 16 + fr; const bool hp = (t % SEQ) != 0;
    const bf16_t* P1 = (const bf16_t*)(p.ws + OFF_R1);
    const bf16_t* pr = P1 + (size_t)t * NP1; const bf16_t* pp = pr - NP1;
    const float* mu = p.mu + (size_t)l * 1664 - C_RW;
    const bf16_t* W2T = (const bf16_t*)(p.ws + OFF_W2T) + (size_t)l * 512 * 64; const bf16_t* A2T = (const bf16_t*)(p.ws + OFF_A2T) + (size_t)l * 512 * 64;
    unsigned char* r2 = p.ws + OFF_R2;
    bf16_t* VF = (bf16_t*)(p.ws + OFF_VF);
    bf16x8 fa[2], fw[2];
#pragma unroll
    for (int ks = 0; ks < 2; ++ks) { const int ca = C_ALAT + ks * 32 + fq * 8, cw = C_WLAT + ks * 32 + fq * 8;
        const f32x4 a0 = mix4(pr + ca, pp + ca, hp, mu + ca), a1 = mix4(pr + ca + 4, pp + ca + 4, hp, mu + ca + 4);
        f32x4 w0 = mix4(pr + cw, pp + cw, hp, mu + cw), w1 = mix4(pr + cw + 4, pp + cw + 4, hp, mu + cw + 4);
#pragma unroll
        for (int e = 0; e < 4; ++e) { w0[e] = tanhf(w0[e]); w1[e] = tanhf(w1[e]); }
        fa[ks] = pack_frag(a0, a1); fw[ks] = pack_frag(w0, w1); }
    bf16x8 t1f = (bf16x8){0, 0, 0, 0, 0, 0, 0, 0};
    if (l >= 1) { const bf16_t* V1T = (const bf16_t*)(p.ws + OFF_V1T) + (size_t)(l - 1) * 32 * 512;
        f32x4 c0 = (f32x4){0.f, 0.f, 0.f, 0.f}, c1 = c0;
#pragma unroll 2
        for (int ks = 0; ks < 16; ++ks) { const int cv = C_RWV + ks * 32 + fq * 8;
            const bf16x8 af = pack_frag(mix4(pr + cv, pp + cv, hp, mu + cv), mix4(pr + cv + 4, pp + cv + 4, hp, mu + cv + 4));
            c0 = MFMA(ld_frag(V1T + (size_t)fr * 512 + ks * 32 + fq * 8), af, c0); c1 = MFMA(ld_frag(V1T + (size_t)(16 + fr) * 512 + ks * 32 + fq * 8), af, c1); }
        t1f = pack_frag(c0, c1);
    }
#pragma unroll 1
    for (int hq = 0; hq < 4; ++hq) { const int h = hh * 4 + hq;
        float ss = 0.f;
#pragma unroll
        for (int ct = 0; ct < 4; ++ct) { const int c = h * 64 + ct * 16 + fq * 4;
            const f32x4 kr = mix4(pr + C_RWK + c, pp + C_RWK + c, hp, mu + C_RWK + c) * *(const f32x4*)(p.k_k + (size_t)l * 512 + c);
            ss += kr[0] * kr[0] + kr[1] * kr[1] + kr[2] * kr[2] + kr[3] * kr[3]; }
        ss += __shfl_xor(ss, 16); ss += __shfl_xor(ss, 32);
        const float inv = 1.f / fmaxf(sqrtf(ss), 1e-12f);
        float dsum = 0.f;
#pragma unroll 1
        for (int ct = 0; ct < 4; ++ct) { const int crow = h * 64 + ct * 16 + fr;
            f32x4 aa = (f32x4){0.f, 0.f, 0.f, 0.f}, aw = aa, avm = aa;
#pragma unroll
            for (int ks = 0; ks < 2; ++ks) { aa = MFMA(ld_frag(A2T + (size_t)crow * 64 + ks * 32 + fq * 8), fa[ks], aa); aw = MFMA(ld_frag(W2T + (size_t)crow * 64 + ks * 32 + fq * 8), fw[ks], aw); }
            if (l >= 1) { const bf16_t* V2T = (const bf16_t*)(p.ws + OFF_V2T) + (size_t)(l - 1) * 512 * 32 + (size_t)crow * 32;
                avm = MFMA(join_frag(*(const u32x2*)(V2T + fq * 4), *(const u32x2*)(V2T + 16 + fq * 4)), t1f, avm); }
            const int c = h * 64 + ct * 16 + fq * 4; const size_t o = (size_t)t * 512 + c;
            const f32x4 rs = mix4(pr + C_RWR + c, pp + C_RWR + c, hp, mu + C_RWR + c);
            const f32x4 ksv = mix4(pr + C_RWK + c, pp + C_RWK + c, hp, mu + C_RWK + c);
            f32x4 vs = mix4(pr + C_RWV + c, pp + C_RWV + c, hp, mu + C_RWV + c);
            const f32x4 a0 = *(const f32x4*)(p.a0 + (size_t)l * 512 + c), w0 = *(const f32x4*)(p.w0 + (size_t)l * 512 + c), kkw = *(const f32x4*)(p.k_k + (size_t)l * 512 + c);
            const f32x4 ka = *(const f32x4*)(p.k_a + (size_t)l * 512 + c);
            f32x4 lw, asg;
#pragma unroll
            for (int e = 0; e < 4; ++e) { asg[e] = sigmoidf_(a0[e] + aa[e]); lw[e] = -0.6065306597126334f * sigmoidf_(w0[e] + aw[e]); }
            *(f32x4*)((float*)(r2 + R2_LW) + o) = lw;
            if (l == 0) { *(u32x2*)(VF + o) = pack4(vs); }
            else { const f32x4 vf = unpack4(*(const u32x2*)(VF + o)), v0 = *(const f32x4*)(p.v0 + (size_t)(l - 1) * 512 + c);
#pragma unroll
                for (int e = 0; e < 4; ++e) vs[e] = vs[e] + (vf[e] - vs[e]) * sigmoidf_(v0[e] + avm[e]); }
            const f32x4 kk = ksv * kkw * inv, km = ksv * ((asg - 1.f) * ka + 1.f), bb = kk * asg;
            { const f32x4 rk = *(const f32x4*)(p.r_k + (size_t)l * 512 + c); const f32x4 pr3 = rs * km * rk; dsum += pr3[0] + pr3[1] + pr3[2] + pr3[3]; }
            *(u32x2*)((bf16_t*)(r2 + R2_R) + o) = pack4(rs); *(u32x2*)((bf16_t*)(r2 + R2_K) + o) = pack4(km); *(u32x2*)((bf16_t*)(r2 + R2_V) + o) = pack4(vs);
            *(u32x2*)((bf16_t*)(r2 + R2_KK) + o) = pack4(kk); *(u32x2*)((bf16_t*)(r2 + R2_B) + o) = pack4(bb); }
        dsum += __shfl_xor(dsum, 16); dsum += __shfl_xor(dsum, 32);
        if (fq == 0) ((float*)(p.ws + OFF_DOT))[(size_t)t * 8 + h] = dsum;
    }
}

__device__ __forceinline__ void attn_item(const Params& p, int b, int h, int qb, unsigned char* lds) {
    const int tid = tid_l(), lane = tid & 63, wave = tid >> 6, fr = lane & 15, fq = lane >> 4;
    const bf16_t* Q = (const bf16_t*)(p.ws + OFF_R3 + R3_Q); const bf16_t* Kf = (const bf16_t*)(p.ws + OFF_R3 + R3_KF); const bf16_t* Vt = (const bf16_t*)(p.ws + OFF_R3 + R3_VT);
    bf16_t* Z = (bf16_t*)(p.ws + OFF_Z);
    constexpr int KS = 104, VS = 72, KB = 64 * KS * 2, VB = 64 * VS * 2, BUF = KB + VB;
    const int nkt = 2 * qb + 2, mykt = (wave < 4) ? nkt - 1 : nkt;
    const int trow = b * SEQ + qb * 128 + wave * 16 + fr;
    bf16x8 qf[3];
#pragma unroll
    for (int ks = 0; ks < 3; ++ks) qf[ks] = ld_frag(Q + (size_t)trow * 768 + h * 96 + ks * 32 + fq * 8);
    const bf16_t* kg = Kf + (size_t)(b * SEQ) * 768 + h * 96; const bf16_t* vg = Vt + (size_t)(b * 8 + h) * 64 * SEQ;
    const int kr0 = tid / 12, kc0 = tid % 12, kr1 = (tid + 512) / 12, kc1 = (tid + 512) % 12, vd = tid >> 3, vc = tid & 7;
    u32x4 pk0, pk1 = (u32x4){0, 0, 0, 0}, pv;
    __syncthreads();
    pk0 = *(const u32x4*)(kg + (size_t)kr0 * 768 + kc0 * 8); if (tid < 256) pk1 = *(const u32x4*)(kg + (size_t)kr1 * 768 + kc1 * 8);
    pv = *(const u32x4*)(vg + (size_t)vd * SEQ + vc * 8);
    { bf16_t* ks_ = (bf16_t*)lds; bf16_t* vs_ = (bf16_t*)(lds + KB);
        *(u32x4*)(ks_ + kr0 * KS + kc0 * 8) = pk0; if (tid < 256) *(u32x4*)(ks_ + kr1 * KS + kc1 * 8) = pk1; *(u32x4*)(vs_ + vd * VS + vc * 8) = pv; }
    __syncthreads();
    f32x4 O[4]; float m = -1e30f, lsum = 0.f;
#pragma unroll
    for (int d = 0; d < 4; ++d) O[d] = (f32x4){0.f, 0.f, 0.f, 0.f};
#pragma unroll 1
    for (int kt = 0; kt < nkt; ++kt) {
        const bool pre = (kt + 1 < nkt);
        if (pre) { const size_t ko = (size_t)(kt + 1) * 64;
            pk0 = *(const u32x4*)(kg + (ko + kr0) * 768 + kc0 * 8); if (tid < 256) pk1 = *(const u32x4*)(kg + (ko + kr1) * 768 + kc1 * 8);
            pv = *(const u32x4*)(vg + (size_t)vd * SEQ + ko + vc * 8); }
        if (kt < mykt) {
            const bf16_t* ks_ = (const bf16_t*)(lds + (kt & 1) * BUF); const bf16_t* vs_ = (const bf16_t*)(lds + (kt & 1) * BUF + KB);
            f32x4 s[4];
#pragma unroll
            for (int c4 = 0; c4 < 4; ++c4) { s[c4] = (f32x4){0.f, 0.f, 0.f, 0.f};
#pragma unroll
                for (int ks = 0; ks < 3; ++ks) s[c4] = MFMA(ld_frag(ks_ + (c4 * 16 + fr) * KS + ks * 32 + fq * 8), qf[ks], s[c4]); }
            float mx = -1e30f;
#pragma unroll
            for (int c4 = 0; c4 < 4; ++c4) mx = fmaxf(fmaxf(fmaxf(s[c4][0], s[c4][1]), fmaxf(s[c4][2], s[c4][3])), mx);
            mx = fmaxf(mx, __shfl_xor(mx, 16)); mx = fmaxf(mx, __shfl_xor(mx, 32));
            const float mn = fmaxf(m, mx), alpha = exp2f(m - mn); m = mn;
            float ps = 0.f;
#pragma unroll
            for (int c4 = 0; c4 < 4; ++c4)
#pragma unroll
                for (int e = 0; e < 4; ++e) { s[c4][e] = exp2f(s[c4][e] - mn); ps += s[c4][e]; }
            lsum = lsum * alpha + ps;
#pragma unroll
            for (int d = 0; d < 4; ++d) O[d] = O[d] * alpha;
            const bf16x8 pf0 = pack_frag(s[0], s[1]), pf1 = pack_frag(s[2], s[3]);
#pragma unroll
            for (int d = 0; d < 4; ++d) { const bf16_t* vp = vs_ + (d * 16 + fr) * VS + fq * 4;
                O[d] = MFMA(join_frag(*(const u32x2*)(vp), *(const u32x2*)(vp + 16)), pf0, O[d]);
                O[d] = MFMA(join_frag(*(const u32x2*)(vp + 32), *(const u32x2*)(vp + 48)), pf1, O[d]); }
        }
        if (pre) { bf16_t* ks_ = (bf16_t*)(lds + ((kt + 1) & 1) * BUF); bf16_t* vs_ = (bf16_t*)(lds + ((kt + 1) & 1) * BUF + KB);
            *(u32x4*)(ks_ + kr0 * KS + kc0 * 8) = pk0; if (tid < 256) *(u32x4*)(ks_ + kr1 * KS + kc1 * 8) = pk1; *(u32x4*)(vs_ + vd * VS + vc * 8) = pv; }
        __syncthreads();
    }
    lsum += __shfl_xor(lsum, 16); lsum += __shfl_xor(lsum, 32);
    const float il = 1.f / lsum;
#pragma unroll
    for (int d = 0; d < 4; ++d) { bf16_t* zp = Z + (size_t)trow * NZ + h * 64 + d * 16 + fq * 4; const f32x4 z = unpack4(*(const u32x2*)zp);
        f32x4 o;
#pragma unroll
        for (int e = 0; e < 4; ++e) o[e] = O[d][e] * il * siluf_(z[e]);
        *(u32x2*)zp = pack4(o); }
}

__device__ __forceinline__ void scan_item(const Params& p, int l, int bh, unsigned char* lds) {
    const int tid = tid_l(), b = bh >> 3, h = bh & 7;
    const unsigned char* r2 = p.ws + OFF_R2; bf16_t* Z = (bf16_t*)(p.ws + OFF_Z);
    float* Lw = (float*)lds; float* La = Lw + 4096; float* Lb = La + 4096; float* Lk = Lb + 4096; float* Lr = Lk + 4096; float* Lv = Lr + 4096; float* Ly = Lv + 4096;
    const int i = tid >> 3, jp = tid & 7;
    float st[8];
#pragma unroll
    for (int e = 0; e < 8; ++e) st[e] = 0.f;
    const int et = tid >> 3, ep = tid & 7;
#pragma unroll 1
    for (int ck = 0; ck < SEQ / 64; ++ck) {
        const size_t tg = (size_t)b * SEQ + ck * 64 + et; const size_t o = tg * 512 + h * 64 + ep * 8;
        __syncthreads();
        { const u32x4 ur = *(const u32x4*)((const bf16_t*)(r2 + R2_R) + o), uk = *(const u32x4*)((const bf16_t*)(r2 + R2_K) + o), uv = *(const u32x4*)((const bf16_t*)(r2 + R2_V) + o),
                      ukk = *(const u32x4*)((const bf16_t*)(r2 + R2_KK) + o), ub = *(const u32x4*)((const bf16_t*)(r2 + R2_B) + o);
            const f32x4 l0 = *(const f32x4*)((const float*)(r2 + R2_LW) + o), l1 = *(const f32x4*)((const float*)(r2 + R2_LW) + o + 4);
            const int lo = et * 64 + ep * 8;
            *(f32x4*)(Lw + lo) = (f32x4){__expf(l0[0]), __expf(l0[1]), __expf(l0[2]), __expf(l0[3])}; *(f32x4*)(Lw + lo + 4) = (f32x4){__expf(l1[0]), __expf(l1[1]), __expf(l1[2]), __expf(l1[3])};
            *(f32x4*)(La + lo) = (f32x4){-bf_lo(ukk.x), -bf_hi(ukk.x), -bf_lo(ukk.y), -bf_hi(ukk.y)}; *(f32x4*)(La + lo + 4) = (f32x4){-bf_lo(ukk.z), -bf_hi(ukk.z), -bf_lo(ukk.w), -bf_hi(ukk.w)};
            *(f32x4*)(Lb + lo) = (f32x4){bf_lo(ub.x), bf_hi(ub.x), bf_lo(ub.y), bf_hi(ub.y)}; *(f32x4*)(Lb + lo + 4) = (f32x4){bf_lo(ub.z), bf_hi(ub.z), bf_lo(ub.w), bf_hi(ub.w)};
            *(f32x4*)(Lk + lo) = (f32x4){bf_lo(uk.x), bf_hi(uk.x), bf_lo(uk.y), bf_hi(uk.y)}; *(f32x4*)(Lk + lo + 4) = (f32x4){bf_lo(uk.z), bf_hi(uk.z), bf_lo(uk.w), bf_hi(uk.w)};
            *(f32x4*)(Lr + lo) = (f32x4){bf_lo(ur.x), bf_hi(ur.x), bf_lo(ur.y), bf_hi(ur.y)}; *(f32x4*)(Lr + lo + 4) = (f32x4){bf_lo(ur.z), bf_hi(ur.z), bf_lo(ur.w), bf_hi(ur.w)};
            *(f32x4*)(Lv + lo) = (f32x4){bf_lo(uv.x), bf_hi(uv.x), bf_lo(uv.y), bf_hi(uv.y)}; *(f32x4*)(Lv + lo + 4) = (f32x4){bf_lo(uv.z), bf_hi(uv.z), bf_lo(uv.w), bf_hi(uv.w)};
        }
        __syncthreads();
#pragma unroll 1
        for (int t = 0; t < 64; ++t) { const int lo = t * 64 + jp * 8;
            const f32x4 w0 = *(const f32x4*)(Lw + lo), w1 = *(const f32x4*)(Lw + lo + 4), a0 = *(const f32x4*)(La + lo), a1 = *(const f32x4*)(La + lo + 4), b0 = *(const f32x4*)(Lb + lo), b1 = *(const f32x4*)(Lb + lo + 4),
                        k0 = *(const f32x4*)(Lk + lo), k1 = *(const f32x4*)(Lk + lo + 4), r0 = *(const f32x4*)(Lr + lo), r1 = *(const f32x4*)(Lr + lo + 4);
            const float vi = Lv[t * 64 + i];
            float sa = st[0] * a0[0] + st[1] * a0[1] + st[2] * a0[2] + st[3] * a0[3] + st[4] * a1[0] + st[5] * a1[1] + st[6] * a1[2] + st[7] * a1[3];
            sa += __shfl_xor(sa, 1); sa += __shfl_xor(sa, 2); sa += __shfl_xor(sa, 4);
            st[0] = st[0] * w0[0] + sa * b0[0] + vi * k0[0]; st[1] = st[1] * w0[1] + sa * b0[1] + vi * k0[1]; st[2] = st[2] * w0[2] + sa * b0[2] + vi * k0[2]; st[3] = st[3] * w0[3] + sa * b0[3] + vi * k0[3];
            st[4] = st[4] * w1[0] + sa * b1[0] + vi * k1[0]; st[5] = st[5] * w1[1] + sa * b1[1] + vi * k1[1]; st[6] = st[6] * w1[2] + sa * b1[2] + vi * k1[2]; st[7] = st[7] * w1[3] + sa * b1[3] + vi * k1[3];
            float y = st[0] * r0[0] + st[1] * r0[1] + st[2] * r0[2] + st[3] * r0[3] + st[4] * r1[0] + st[5] * r1[1] + st[6] * r1[2] + st[7] * r1[3];
            y += __shfl_xor(y, 1); y += __shfl_xor(y, 2); y += __shfl_xor(y, 4);
            if (jp == 0) Ly[t * 64 + i] = y;
        }
        __syncthreads();
        { const int lo = et * 64 + ep * 8;
            const f32x4 y0 = *(const f32x4*)(Ly + lo), y1 = *(const f32x4*)(Ly + lo + 4), r0 = *(const f32x4*)(Lr + lo), r1 = *(const f32x4*)(Lr + lo + 4), k0 = *(const f32x4*)(Lk + lo), k1 = *(const f32x4*)(Lk + lo + 4),
                        v0 = *(const f32x4*)(Lv + lo), v1 = *(const f32x4*)(Lv + lo + 4);
            const f32x4 rk0 = *(const f32x4*)(p.r_k + (size_t)l * 512 + h * 64 + ep * 8), rk1 = *(const f32x4*)(p.r_k + (size_t)l * 512 + h * 64 + ep * 8 + 4);
            float s = y0[0] + y0[1] + y0[2] + y0[3] + y1[0] + y1[1] + y1[2] + y1[3];
            float dot = r0[0] * k0[0] * rk0[0] + r0[1] * k0[1] * rk0[1] + r0[2] * k0[2] * rk0[2] + r0[3] * k0[3] * rk0[3] + r1[0] * k1[0] * rk1[0] + r1[1] * k1[1] * rk1[1] + r1[2] * k1[2] * rk1[2] + r1[3] * k1[3] * rk1[3];
            s += __shfl_xor(s, 1); s += __shfl_xor(s, 2); s += __shfl_xor(s, 4);
            dot += __shfl_xor(dot, 1); dot += __shfl_xor(dot, 2); dot += __shfl_xor(dot, 4);
            const float mean = s * (1.f / 64.f);
            const f32x4 d0 = y0 - mean, d1 = y1 - mean;
            float q = d0[0] * d0[0] + d0[1] * d0[1] + d0[2] * d0[2] + d0[3] * d0[3] + d1[0] * d1[0] + d1[1] * d1[1] + d1[2] * d1[2] + d1[3] * d1[3];
            q += __shfl_xor(q, 1); q += __shfl_xor(q, 2); q += __shfl_xor(q, 4);
            const float rstd = rsqrtf(q * (1.f / 64.f) + 64e-5f);
            const f32x4 g0 = *(const f32x4*)(p.lnx_g + (size_t)l * 512 + h * 64 + ep * 8), g1 = *(const f32x4*)(p.lnx_g + (size_t)l * 512 + h * 64 + ep * 8 + 4),
                        e0 = *(const f32x4*)(p.lnx_b + (size_t)l * 512 + h * 64 + ep * 8), e1 = *(const f32x4*)(p.lnx_b + (size_t)l * 512 + h * 64 + ep * 8 + 4);
            bf16_t* zp = Z + tg * NZ + 1024 + h * 64 + ep * 8; const u32x4 zu = *(const u32x4*)zp;
            const f32x4 o0 = d0 * rstd * g0 + e0 + v0 * dot, o1 = d1 * rstd * g1 + e1 + v1 * dot;
            u32x4 w; w.x = cvt_pk_bf16(o0[0] * siluf_(bf_lo(zu.x)), o0[1] * siluf_(bf_hi(zu.x))); w.y = cvt_pk_bf16(o0[2] * siluf_(bf_lo(zu.y)), o0[3] * siluf_(bf_hi(zu.y)));
            w.z = cvt_pk_bf16(o1[0] * siluf_(bf_lo(zu.z)), o1[1] * siluf_(bf_hi(zu.z))); w.w = cvt_pk_bf16(o1[2] * siluf_(bf_lo(zu.w)), o1[3] * siluf_(bf_hi(zu.w)));
            *(u32x4*)zp = w; }
    }
}


constexpr int MS = 72;
__device__ __forceinline__ f32x4 nt_tile(const bf16_t* Am, int arow, const bf16_t* Bm, int brow, f32x4 acc, int fq) {
    acc = MFMA(ld_frag(Am + arow * MS + fq * 8), ld_frag(Bm + brow * MS + fq * 8), acc);
    acc = MFMA(ld_frag(Am + arow * MS + 32 + fq * 8), ld_frag(Bm + brow * MS + 32 + fq * 8), acc);
    return acc;
}
#if PROBE_SCAN
#define CHKF_OLD(ptr, n, bit) do { unsigned _c = 0u; for (int _i = tid; _i < (n); _i += NTHREADS) { const float _a = (ptr)[_i]; if (!(fabsf(_a) < 1e30f)) _c = (bit); } if (_c) atomicOr((unsigned*)(p.ws + WS_END + 5 * MiB), _c); } while (0)
#define CHKB_OLD(ptr, bit) do { unsigned _c = 0u; for (int _i = tid; _i < 4096; _i += NTHREADS) { const float _a = bf2f((ptr)[(_i >> 6) * MS + (_i & 63)]); if (!(fabsf(_a) < 1e30f)) _c = (bit); } if (_c) atomicOr((unsigned*)(p.ws + WS_END + 5 * MiB), _c); } while (0)
#endif
#define CHKF(ptr, n, bit)
#define CHKB(ptr, bit)
__device__ __forceinline__ void chunk_item(const Params& p, int item, unsigned char* lds) {
    const int tid = tid_l(), lane = tid & 63, wave = __builtin_amdgcn_readfirstlane(tid >> 6), fr = lane & 15, fq = lane >> 4;
    const int bh = item >> 6, ck = item & 63, b = bh >> 3, h = bh & 7;
    const size_t tok0 = (size_t)b * SEQ + ck * 64;
    const unsigned char* r2 = p.ws + OFF_R2; unsigned char* r1 = p.ws + OFF_R1;
    float* CUM = (float*)lds; float* TF = CUM + 4096; float* XB = TF + 4096; float* TOT = XB + 1024;
    bf16_t* MB = (bf16_t*)(lds + 38912);
    bf16_t *AT_ = MB, *BT_ = MB + 1 * 64 * MS, *KT_ = MB + 2 * 64 * MS, *RT_ = MB + 3 * 64 * MS, *ATT = MB + 4 * 64 * MS, *VT = MB + 5 * 64 * MS, *KHT = MB + 6 * 64 * MS, *BHT = MB + 7 * 64 * MS,
           *MAK = MB + 8 * 64 * MS, *MRB = MB + 9 * 64 * MS, *MRK = MB + 10 * 64 * MS, *TB = MB + 11 * 64 * MS;
    bf16_t *MVT = AT_, *TAT = BT_, *W1T = KT_;
    const float* LWg = (const float*)(r2 + R2_LW);
    __syncthreads();
    { float c[8]; float run = 0.f;
#pragma unroll
        for (int e = 0; e < 8; ++e) { run += LWg[(tok0 + wave * 8 + e) * 512 + h * 64 + lane]; c[e] = run; }
        TOT[wave * 64 + lane] = run;
        __syncthreads();
        float off = 0.f;
#pragma unroll
        for (int w2 = 0; w2 < 7; ++w2) off += (w2 < wave) ? TOT[w2 * 64 + lane] : 0.f;
#pragma unroll
        for (int e = 0; e < 8; ++e) CUM[(wave * 8 + e) * 64 + lane] = off + c[e];
    }
    __syncthreads();
    { const int t = tid & 63, j0 = (tid >> 6) * 8; const size_t o = (tok0 + t) * 512 + h * 64 + j0;
        const u32x4 ur = *(const u32x4*)((const bf16_t*)(r2 + R2_R) + o), uk = *(const u32x4*)((const bf16_t*)(r2 + R2_K) + o), uv = *(const u32x4*)((const bf16_t*)(r2 + R2_V) + o),
                    ukk = *(const u32x4*)((const bf16_t*)(r2 + R2_KK) + o), ub = *(const u32x4*)((const bf16_t*)(r2 + R2_B) + o);
        const unsigned rr[4] = {ur.x, ur.y, ur.z, ur.w}, kr[4] = {uk.x, uk.y, uk.z, uk.w}, vr[4] = {uv.x, uv.y, uv.z, uv.w}, qr[4] = {ukk.x, ukk.y, ukk.z, ukk.w}, br[4] = {ub.x, ub.y, ub.z, ub.w};
        unsigned oa[4], ob[4], ok[4], orr[4];
#pragma unroll
        for (int e2 = 0; e2 < 4; ++e2) { float va[2], vb[2], vk[2], vrr[2];
#pragma unroll
            for (int hh = 0; hh < 2; ++hh) { const int e = 2 * e2 + hh;
                const float cm = CUM[t * 64 + j0 + e], lwv = LWg[o + e], cC = CUM[63 * 64 + j0 + e];
                const float rv = hh ? bf_hi(rr[e2]) : bf_lo(rr[e2]), kv = hh ? bf_hi(kr[e2]) : bf_lo(kr[e2]), vv = hh ? bf_hi(vr[e2]) : bf_lo(vr[e2]), qv = hh ? bf_hi(qr[e2]) : bf_lo(qr[e2]), bv = hh ? bf_hi(br[e2]) : bf_lo(br[e2]);
                const float en = __expf(-cm), eh = __expf(cC - cm);
                va[hh] = -qv * __expf(cm - lwv); vb[hh] = bv * en; vk[hh] = kv * en; vrr[hh] = rv * __expf(cm);
                ATT[(j0 + e) * MS + t] = f2bf(va[hh]); VT[(j0 + e) * MS + t] = f2bf(vv); KHT[(j0 + e) * MS + t] = f2bf(kv * eh); BHT[(j0 + e) * MS + t] = f2bf(bv * eh);
                if (t == 63) ((float*)(r1 + R1_PC))[(size_t)item * 64 + j0 + e] = __expf(cC); }
            oa[e2] = cvt_pk_bf16(va[0], va[1]); ob[e2] = cvt_pk_bf16(vb[0], vb[1]); ok[e2] = cvt_pk_bf16(vk[0], vk[1]); orr[e2] = cvt_pk_bf16(vrr[0], vrr[1]); }
        *(u32x4*)(AT_ + t * MS + j0) = (u32x4){oa[0], oa[1], oa[2], oa[3]}; *(u32x4*)(BT_ + t * MS + j0) = (u32x4){ob[0], ob[1], ob[2], ob[3]};
        *(u32x4*)(KT_ + t * MS + j0) = (u32x4){ok[0], ok[1], ok[2], ok[3]}; *(u32x4*)(RT_ + t * MS + j0) = (u32x4){orr[0], orr[1], orr[2], orr[3]};
    }
    __syncthreads();
#pragma unroll 1
    for (int x = 0; x < 8; ++x) { const int q = wave * 8 + x, mat = q >> 4, tm = (q >> 2) & 3, tn = q & 3;
        const bf16_t* Am = (mat & 1) ? KT_ : BT_; const bf16_t* Bm = (mat & 2) ? RT_ : AT_;
        f32x4 acc = nt_tile(Am, tm * 16 + fr, Bm, tn * 16 + fr, (f32x4){0.f, 0.f, 0.f, 0.f}, fq);
        const int t = tn * 16 + fr, s0 = tm * 16 + fq * 4;
#pragma unroll
        for (int e = 0; e < 4; ++e) { const bool keep = (mat & 2) ? (s0 + e <= t) : (s0 + e < t); acc[e] = keep ? acc[e] : 0.f; }
        if (mat == 0) *(f32x4*)(CUM + t * 64 + s0) = acc;
        else { bf16_t* Om = (mat == 1) ? MAK : (mat == 2) ? MRB : MRK; *(u32x2*)(Om + t * MS + s0) = pack4(acc); }
    }
    __syncthreads();

    if (wave == 0) { const int base = (lane >> 5) * 32, c = lane & 31; float xv[32]; int roff = base * 65; float prev = 0.f;
#pragma unroll
        for (int t = 0; t < 32; ++t) { float a = (t == c) ? 1.f : 0.f;
            asm volatile("" : "+v"(roff), "+v"(prev));
            const float* Lr = CUM + roff + t * 64;
#pragma unroll
            for (int s2 = 0; s2 < t; ++s2) a += Lr[s2] * xv[s2];
            xv[t] = a; prev = a; }
#pragma unroll
        for (int t = 0; t < 32; ++t) { TF[(base + t) * 64 + base + c] = xv[t]; if (base == 0) TF[t * 64 + 32 + c] = 0.f; }
    }
    __syncthreads();
    { const int r = tid >> 4, c0 = (tid & 15) * 2; float x0 = 0.f, x1 = 0.f;
#pragma unroll 8
        for (int k = 0; k < 32; ++k) { const float lv = CUM[(32 + r) * 64 + k]; x0 += lv * TF[k * 64 + c0]; x1 += lv * TF[k * 64 + c0 + 1]; }
        XB[r * 32 + c0] = x0; XB[r * 32 + c0 + 1] = x1;
        __syncthreads();
        float y0 = 0.f, y1 = 0.f;
#pragma unroll 8
        for (int k = 0; k < 32; ++k) { const float tv = TF[(32 + r) * 64 + 32 + k]; y0 += tv * XB[k * 32 + c0]; y1 += tv * XB[k * 32 + c0 + 1]; }
        TF[(32 + r) * 64 + c0] = y0; TF[(32 + r) * 64 + c0 + 1] = y1;
    }
    __syncthreads();
    { const int t = tid >> 3, s0 = (tid & 7) * 8; const f32x4 a = *(const f32x4*)(TF + t * 64 + s0), b2 = *(const f32x4*)(TF + t * 64 + s0 + 4);
        u32x4 w; w.x = cvt_pk_bf16(a[0], a[1]); w.y = cvt_pk_bf16(a[2], a[3]); w.z = cvt_pk_bf16(b2[0], b2[1]); w.w = cvt_pk_bf16(b2[2], b2[3]);
        *(u32x4*)(TB + t * MS + s0) = w; }
    __syncthreads();
#pragma unroll 1
    for (int x = 0; x < 4; ++x) { const int q = wave * 4 + x, mat = q >> 4, tm = (q >> 2) & 3, tn = q & 3;
        const f32x4 acc = nt_tile(mat ? TB : MAK, tm * 16 + fr, mat ? ATT : VT, tn * 16 + fr, (f32x4){0.f, 0.f, 0.f, 0.f}, fq);
        *(u32x2*)((mat ? TAT : MVT) + (tn * 16 + fr) * MS + tm * 16 + fq * 4) = pack4(acc); }
    __syncthreads();
#pragma unroll 1
    for (int x = 0; x < 2; ++x) { const int q = wave * 2 + x, tm = q >> 2, tn = q & 3;
        const f32x4 acc = nt_tile(TB, tm * 16 + fr, MVT, tn * 16 + fr, (f32x4){0.f, 0.f, 0.f, 0.f}, fq);
        *(u32x2*)(W1T + (tn * 16 + fr) * MS + tm * 16 + fq * 4) = pack4(acc); }
    __syncthreads();
#pragma unroll 1
    for (int x = 0; x < 8; ++x) { const int q = wave * 8 + x, o = q >> 4, tm = (q >> 2) & 3, tn = q & 3;
        const int ar = tm * 16 + fr, br_ = tn * 16 + fr; f32x4 acc = (f32x4){0.f, 0.f, 0.f, 0.f};
        if (o == 0) acc = nt_tile(TAT, ar, BHT, br_, acc, fq);
        else if (o == 1) { acc = unpack4(*(const u32x2*)(RT_ + br_ * MS + tm * 16 + fq * 4)); acc = nt_tile(TAT, ar, MRB, br_, acc, fq); }
        else if (o == 2) { acc = nt_tile(KHT, ar, VT, br_, acc, fq); acc = nt_tile(BHT, ar, W1T, br_, acc, fq); }
        else { acc = nt_tile(VT, ar, MRK, br_, acc, fq);
#if EXP_CONSTY
            acc = (f32x4){1.f, 2.f, 3.f, 4.f};
#endif
#if !EXP_NOW1
            acc = nt_tile(W1T, ar, MRB, br_, acc, fq);
#endif
        }
        bf16_t* og = (bf16_t*)(r1 + (size_t)o * 16 * MiB) + (size_t)item * 4096 + br_ * 64 + tm * 16 + fq * 4;
        *(u32x2*)og = pack4(acc); }
}

__device__ __forceinline__ void seq_item(const Params& p, int l, int bh, unsigned char* lds, bf16_t* dstp, int dst_ld, size_t dst_tok0) {
    const int tid = tid_l(), lane = tid & 63, wave = __builtin_amdgcn_readfirstlane(tid >> 6), fr = lane & 15, fq = lane >> 4;
    const int b = bh >> 3, h = bh & 7;
    const unsigned char* r1 = p.ws + OFF_R1;
    constexpr int BUFB = 4 * 64 * MS * 2 + 256;
    bf16_t* SB = (bf16_t*)(lds + 2 * BUFB) + wave * 16 * MS;
    float* YB = (float*)(lds + 2 * BUFB + 4 * 16 * MS * 2);
    const int srow = tid >> 3, sc8 = tid & 7;
    u32x4 pre[4]; float prepc = 0.f;
    __syncthreads();
    { const size_t ci = (size_t)bh * 64;
#pragma unroll
        for (int m = 0; m < 4; ++m) pre[m] = *(const u32x4*)((const bf16_t*)(r1 + (size_t)m * 16 * MiB) + ci * 4096 + srow * 64 + sc8 * 8);
        if (tid < 64) prepc = ((const float*)(r1 + R1_PC))[ci * 64 + tid];
#pragma unroll
        for (int m = 0; m < 4; ++m) *(u32x4*)((bf16_t*)lds + m * 64 * MS + srow * MS + sc8 * 8) = pre[m];
        if (tid < 64) ((float*)(lds + 4 * 64 * MS * 2))[tid] = prepc;
        if (wave < 4) { for (int e = lane; e < 16 * MS / 2; e += 64) ((unsigned*)SB)[e] = 0u; }
    }
    __syncthreads();
    f32x4 Sacc[4];
#pragma unroll
    for (int jt = 0; jt < 4; ++jt) Sacc[jt] = (f32x4){0.f, 0.f, 0.f, 0.f};
#pragma unroll 1
    for (int c = 0; c < 64; ++c) {
        const bool pf = (c + 1 < 64);
        if (pf) { const size_t ci = (size_t)bh * 64 + c + 1;
#pragma unroll
            for (int m = 0; m < 4; ++m) pre[m] = *(const u32x4*)((const bf16_t*)(r1 + (size_t)m * 16 * MiB) + ci * 4096 + srow * 64 + sc8 * 8);
            if (tid < 64) prepc = ((const float*)(r1 + R1_PC))[ci * 64 + tid]; }
        if (wave < 4) {
            if (c < 64) {
                const unsigned char* bufp = lds + (c & 1) * BUFB;
                const bf16_t* GP = (const bf16_t*)bufp; const bf16_t* RA = GP + 64 * MS; const bf16_t* HT = RA + 64 * MS; const bf16_t* YQ = HT + 64 * MS; const float* PC = (const float*)(bufp + 4 * 64 * MS * 2);
#if EXP_NOSTATE
                const bf16x8 sf0 = (bf16x8){0,0,0,0,0,0,0,0}, sf1 = sf0;
#else
                const bf16x8 sf0 = ld_frag(SB + fr * MS + fq * 8), sf1 = ld_frag(SB + fr * MS + 32 + fq * 8);
#endif
                float* yb = YB + (c & 1) * 4096;
#pragma unroll
                for (int tt = 0; tt < 4; ++tt) { f32x4 y = unpack4(*(const u32x2*)(YQ + (tt * 16 + fr) * MS + wave * 16 + fq * 4));
                    y = MFMA(sf0, ld_frag(RA + (tt * 16 + fr) * MS + fq * 8), y); y = MFMA(sf1, ld_frag(RA + (tt * 16 + fr) * MS + 32 + fq * 8), y);
                    *(f32x4*)(yb + (tt * 16 + fr) * 64 + wave * 16 + fq * 4) = y; }
#pragma unroll
                for (int jt = 0; jt < 4; ++jt) { const f32x4 pc = *(const f32x4*)(PC + jt * 16 + fq * 4);
                    f32x4 a = unpack4(*(const u32x2*)(HT + (wave * 16 + fr) * MS + jt * 16 + fq * 4)) + Sacc[jt] * pc;
                    a = MFMA(ld_frag(GP + (jt * 16 + fr) * MS + fq * 8), sf0, a); a = MFMA(ld_frag(GP + (jt * 16 + fr) * MS + 32 + fq * 8), sf1, a);
                    Sacc[jt] = a; }
#pragma unroll
                for (int jt = 0; jt < 4; ++jt) *(u32x2*)(SB + fr * MS + jt * 16 + fq * 4) = pack4(Sacc[jt]);
            }
        }
        if (pf) { unsigned char* bufn = lds + ((c + 1) & 1) * BUFB;
#pragma unroll
            for (int m = 0; m < 4; ++m) *(u32x4*)((bf16_t*)bufn + m * 64 * MS + srow * MS + sc8 * 8) = pre[m];
            if (tid < 64) ((float*)(bufn + 4 * 64 * MS * 2))[tid] = prepc; }
        __syncthreads();
        if (c < 64) {
            const int t = tid >> 3, q = tid & 7; const float* yb = YB + (c & 1) * 4096 + t * 64 + q * 8;
            const f32x4 y0 = *(const f32x4*)yb, y1 = *(const f32x4*)(yb + 4);
            float s1 = y0[0] + y0[1] + y0[2] + y0[3] + y1[0] + y1[1] + y1[2] + y1[3];
            s1 += __shfl_xor(s1, 1); s1 += __shfl_xor(s1, 2); s1 += __shfl_xor(s1, 4);
            const float mean = s1 * (1.f / 64.f); const f32x4 d0 = y0 - mean, d1 = y1 - mean;
            float s2 = d0[0] * d0[0] + d0[1] * d0[1] + d0[2] * d0[2] + d0[3] * d0[3] + d1[0] * d1[0] + d1[1] * d1[1] + d1[2] * d1[2] + d1[3] * d1[3];
            s2 += __shfl_xor(s2, 1); s2 += __shfl_xor(s2, 2); s2 += __shfl_xor(s2, 4);
            const float rstd = rsqrtf(s2 * (1.f / 64.f) + 64e-5f);
            const size_t tg = (size_t)b * SEQ + c * 64 + t; const int ch = h * 64 + q * 8;
            const float dot = ((const float*)(p.ws + OFF_DOT))[tg * 8 + h];
            const u32x4 vu = *(const u32x4*)((const bf16_t*)(p.ws + OFF_R2 + R2_V) + tg * 512 + ch);
            bf16_t* zp = dstp + (tg - dst_tok0) * dst_ld + ch; const u32x4 zu = *(const u32x4*)((const bf16_t*)(p.ws + OFF_Z) + tg * NZ + 1024 + ch);
            const f32x4 g0 = *(const f32x4*)(p.lnx_g + (size_t)l * 512 + ch), g1 = *(const f32x4*)(p.lnx_g + (size_t)l * 512 + ch + 4), e0 = *(const f32x4*)(p.lnx_b + (size_t)l * 512 + ch), e1 = *(const f32x4*)(p.lnx_b + (size_t)l * 512 + ch + 4);
            const f32x4 v0 = (f32x4){bf_lo(vu.x), bf_hi(vu.x), bf_lo(vu.y), bf_hi(vu.y)}, v1 = (f32x4){bf_lo(vu.z), bf_hi(vu.z), bf_lo(vu.w), bf_hi(vu.w)};
            const f32x4 o0 = d0 * rstd * g0 + e0 + v0 * dot, o1 = d1 * rstd * g1 + e1 + v1 * dot;
            u32x4 w; w.x = cvt_pk_bf16(o0[0] * siluf_(bf_lo(zu.x)), o0[1] * siluf_(bf_hi(zu.x))); w.y = cvt_pk_bf16(o0[2] * siluf_(bf_lo(zu.y)), o0[3] * siluf_(bf_hi(zu.y)));
            w.z = cvt_pk_bf16(o1[0] * siluf_(bf_lo(zu.z)), o1[1] * siluf_(bf_hi(zu.z))); w.w = cvt_pk_bf16(o1[2] * siluf_(bf_lo(zu.w)), o1[3] * siluf_(bf_hi(zu.w)));
            *(u32x4*)zp = w;
        }
    }
}

constexpr int PH_PER_LAYER = 8, N_PHASES = 2 + NL * PH_PER_LAYER;
__global__ void __launch_bounds__(NTHREADS, 2) trunk_fwd(Params p0) {
    extern __shared__ __attribute__((aligned(16))) unsigned char lds[];
    const int G = gridDim.x, bx = blockIdx.x;
    Params p = p0;
#if EXP_ZERO
    for (int i = threadIdx.x; i < LDS_BYTES / 4; i += NTHREADS) ((unsigned*)lds)[i] = 0u;
    __syncthreads();
    if (p0.ph_lo == 0) { u32x4* z = (u32x4*)(p0.ws + OFF_DOT); const size_t n = (WS_END - OFF_DOT) / 16;
        for (size_t i = (size_t)bx * NTHREADS + threadIdx.x; i < n; i += (size_t)G * NTHREADS) z[i] = (u32x4){0u, 0u, 0u, 0u}; }
#endif
    for (int ph = p0.ph_lo; ph < p0.ph_hi; ++ph) {
        unsigned char* ws = ptr_l(p0.ws); p.ws = ws;
        if (ph == 0) { if (PHEN & 1) phase0a(p, lds); }
        else if (ph == 1) { if (PHEN & 2) phase0b(p); }
        else {
            const int l = (ph - 2) / PH_PER_LAYER, k = (ph - 2) % PH_PER_LAYER;
            if (k == 0 && (PHEN & 4)) {
                pg8::Gemm g{(const bf16_t*)(ws + OFF_H), (const bf16_t*)(ws + OFF_WIN + l * SZ_WIN), DM, DM, DM};
                pg8::PlainOrder S; S.init(M_TOK / 256, NIN / 256, G, bx);
                pg8::EpiIn E{(bf16_t*)(ws + OFF_R1), (bf16_t*)(ws + OFF_Z)};
                pg8::gemm_phase(( LAS unsigned char*)lds, g, S, E);
            } else if (k == 1 && (PHEN & 8)) {
                for (int it = bx; it < 640; it += G) {
                    if (it < 128) { if (PHEN & 512) gmlp_item(p, l, it, lds); }
                    else if (it < 384) { if (PHEN & 1024) mla_prep_item(p, l, it - 128, lds); }
                    else { if (PHEN & 2048) rwkv_prep_item(p, l, it - 384); }
                }
            } else if (k == 2 && (PHEN & 16)) {
                for (int it = bx; it < 2048; it += G) { if (USE_CHUNK && (PHEN & 4096)) chunk_item(p, it, lds); }
            } else if (k == 3 && (PHEN & 16)) {
#if !USE_CHUNK
                for (int it = bx; it < 32; it += G) scan_item(p, l, it, lds);
#elif PROBE_SCAN
                for (int it = bx; it < 32; it += G) { if (l == 0 && it < 8) seq_item(p, l, it, lds, (bf16_t*)(ws + WS_END), 512, 0); scan_item(p, l, it, lds); }
#else
                for (int it = bx; it < 32; it += G) { if (PHEN & 8192) seq_item(p, l, it, lds, (bf16_t*)(ws + OFF_Z) + 1024, NZ, 0); }
#endif
                int rank = bx, cnt = G; if (G > 32) { rank = bx - 32; cnt = G - 32; }
                if (rank >= 0) for (int pi = rank; pi < 512; pi += cnt) { const int bh = pi >> 4, j = pi & 15;
                    if (PHEN & 16384) { attn_item(p, bh >> 3, bh & 7, 31 - j, lds); attn_item(p, bh >> 3, bh & 7, j, lds); } }
            } else if (k == 4 && (PHEN & 32)) {
#if PROBE_SCAN
#endif: G = sigmoid(h @ Wg)
                pg8::Gemm g{(const bf16_t*)(ws + OFF_H), (const bf16_t*)(ws + OFF_WG + l * SZ_WG), DM, DM, DM};
                pg8::PlainOrder S; S.init(M_TOK / 256, NG / 256, G, bx);
                pg8::EpiPlain<1> E{(bf16_t*)(ws + OFF_R2), NG};
                pg8::gemm_phase((LAS unsigned char*)lds, g, S, E);
            } else if (k == 5 && (PHEN & 64)) {
                pg8::Gemm g{(const bf16_t*)(ws + OFF_Z), (const bf16_t*)(ws + OFF_WBR + l * SZ_WBR), NZ, 512, 512};
                pg8::MergeOrder S; S.init(M_TOK / 256, DM / 256, G, bx);
                pg8::EpiMerge E{(bf16_t*)(ws + OFF_R3 + R3_MERGED), (const bf16_t*)(ws + OFF_R2)};
                pg8::gemm_phase((LAS unsigned char*)lds, g, S, E);
            } else if (k == 6 && (PHEN & 128)) {
                pg8::Gemm g{(const bf16_t*)(ws + OFF_R3 + R3_MERGED), (const bf16_t*)(ws + OFF_WOUT + l * SZ_WOUT), DM, DM, DM};
                pg8::PlainOrder S; S.init(M_TOK / 256, DM / 256, G, bx);
                pg8::EpiPlain<0> E{(bf16_t*)(ws + OFF_R3 + R3_Y), DM};
                pg8::gemm_phase((LAS unsigned char*)lds, g, S, E);
            } else if (k == 7 && (PHEN & 256)) {
                phase_final(p, l);
            }
        }
#if PROBE_SCAN
        if (ph == N_PHASES - 1 && bx == 0 && threadIdx.x == 0) { const unsigned cd = *(volatile unsigned*)(ws + WS_END + 5 * MiB); p.out[5] = 1000.f * (float)cd; }
        if (ph == 0 && bx == 0 && threadIdx.x == 0) *(unsigned*)(ws + WS_END + 5 * MiB) = 0u;
#endif
        if (ph + 1 < p0.ph_hi) cg::this_grid().sync();
    }
}

extern "C" void kernel_launch(void* const* d_in, const int* in_sizes, int n_in, void* d_out, int out_size, void* d_ws, size_t ws_size, hipStream_t stream) {
    static int grid = 0;
    if (grid == 0) {
        if (n_in != 31 || out_size != M_TOK * DM || ws_size < WS_END) { fprintf(stderr, "kernel_launch: unexpected shapes (n_in %d out %d ws %zu)\n", n_in, out_size, ws_size); grid = -1; return; }
        int dev = 0, cus = 0, per_cu = 0;
        hipGetDevice(&dev); hipDeviceGetAttribute(&cus, hipDeviceAttributeMultiprocessorCount, dev);
        hipFuncSetAttribute((const void*)trunk_fwd, hipFuncAttributeMaxDynamicSharedMemorySize, LDS_BYTES);
        hipOccupancyMaxActiveBlocksPerMultiprocessor(&per_cu, (const void*)trunk_fwd, NTHREADS, LDS_BYTES);
        if (per_cu < 1) { fprintf(stderr, "kernel_launch: occupancy query says %d blocks per CU\n", per_cu); grid = -1; return; }
        grid = cus * 1;
    }
    if (grid < 0) return;
    Params p{};
    p.x = (const float*)d_in[0]; p.c = (const float*)d_in[1]; p.pos = (const int*)d_in[2]; p.pre_g = (const float*)d_in[3]; p.post_g = (const float*)d_in[4];
    p.w_ada = (const float*)d_in[5]; p.b_ada = (const float*)d_in[6]; p.w_in = (const float*)d_in[7]; p.q_norm = (const float*)d_in[8]; p.w_uq = (const float*)d_in[9];
    p.kv_norm = (const float*)d_in[10]; p.w_ukv = (const float*)d_in[11]; p.ln_g = (const float*)d_in[12]; p.ln_b = (const float*)d_in[13]; p.w_s = (const float*)d_in[14]; p.b_s = (const float*)d_in[15];
    p.mu = (const float*)d_in[16]; p.w0 = (const float*)d_in[17]; p.w2 = (const float*)d_in[18]; p.a0 = (const float*)d_in[19]; p.a2 = (const float*)d_in[20]; p.k_k = (const float*)d_in[21];
    p.k_a = (const float*)d_in[22]; p.r_k = (const float*)d_in[23]; p.lnx_g = (const float*)d_in[24]; p.lnx_b = (const float*)d_in[25]; p.v0 = (const float*)d_in[26]; p.v1 = (const float*)d_in[27];
    p.v2 = (const float*)d_in[28]; p.w_br = (const float*)d_in[29]; p.w_out = (const float*)d_in[30];
    p.out = (float*)d_out; p.ws = (unsigned char*)d_ws;
#if ONE_LAUNCH
    p.ph_lo = 0; p.ph_hi = N_PHASES;
    void* args[] = {&p};
    hipError_t e = hipLaunchCooperativeKernel((const void*)trunk_fwd, dim3(grid), dim3(NTHREADS), args, LDS_BYTES, stream);
    if (e != hipSuccess) fprintf(stderr, "cooperative launch failed: %s (grid %d)\n", hipGetErrorString(e), grid);
#else
    for (int ph = 0; ph < N_PHASES; ++ph) { p.ph_lo = ph; p.ph_hi = ph + 1;
        hipLaunchKernelGGL(trunk_fwd, dim3(grid), dim3(NTHREADS), LDS_BYTES, stream, p); }
#endif
}
```

```cpp
#include <hip/hip_runtime.h>
#include <hip/hip_cooperative_groups.h>
#include <cstdint>
#include <cstdio>
namespace cg = cooperative_groups;

#ifndef PHEN
#define PHEN 0x7fff
#endif
#ifndef EXP_SYNC2
#define EXP_SYNC2 0
#endif
#ifndef EXP_NODOT
#define EXP_NODOT 0
#endif
#ifndef EXP_CONSTY
#define EXP_CONSTY 0
#endif
#ifndef EXP_NOW1
#define EXP_NOW1 0
#endif
#ifndef EXP_NOSTATE
#define EXP_NOSTATE 0
#endif
#ifndef EXP_ZERO
#define EXP_ZERO 0
#endif
#ifndef USE_CHUNK
#define USE_CHUNK 1
#endif
#ifndef PROBE_SCAN
#define PROBE_SCAN 0
#endif
#ifndef ONE_LAUNCH
#define ONE_LAUNCH 1
#endif

#define LAS __attribute__((address_space(3)))
typedef unsigned short bf16_t;
typedef short bf16x8 __attribute__((ext_vector_type(8)));
typedef short bf16x4 __attribute__((ext_vector_type(4)));
typedef float f32x4 __attribute__((ext_vector_type(4)));
typedef float f32x2 __attribute__((ext_vector_type(2)));
typedef unsigned u32x4 __attribute__((ext_vector_type(4)));
typedef unsigned u32x2 __attribute__((ext_vector_type(2)));

constexpr int M_TOK = 16384, DM = 1024, SEQ = 4096, NBATCH = 4, NL = 4;
constexpr int D_IN_SRC = 7712;
constexpr int NP1 = 3328, NZ = 1536, NIN = 4864, NG = 3072;
constexpr int C_QLAT = 0, C_KVLAT = 256, C_KROPE = 384, C_GMU = 512, C_GMV = 1024, C_RW = 1536, C_RWR = 1536, C_RWK = 2048, C_RWV = 2560, C_WLAT = 3072, C_ALAT = 3136;
constexpr int NTHREADS = 512, NWAVES = 8;
constexpr int LDS_BYTES = 150 * 1024;
constexpr float QSCALE = 0.10206207261596575f * 1.4426950408889634f;

constexpr size_t MiB = 1u << 20;
constexpr size_t OFF_WIN = 0;
constexpr size_t SZ_WIN = (size_t)NIN * DM * 2;
constexpr size_t OFF_WG = 38 * MiB;
constexpr size_t SZ_WG = (size_t)NG * DM * 2;
constexpr size_t OFF_WBR = 62 * MiB;
constexpr size_t SZ_WBR = (size_t)3072 * 512 * 2;
constexpr size_t OFF_WOUT = 74 * MiB;
constexpr size_t SZ_WOUT = (size_t)DM * DM * 2;
constexpr size_t OFF_WUQ = 82 * MiB;
constexpr size_t SZ_WUQ = (size_t)768 * 256 * 2;
constexpr size_t OFF_WUKV = OFF_WUQ + 3 * MiB / 2;
constexpr size_t SZ_WUKV = (size_t)1024 * 128 * 2;
constexpr size_t OFF_SMALL = OFF_WUKV + 1 * MiB;
constexpr size_t OFF_W2T = OFF_SMALL;
constexpr size_t OFF_A2T = OFF_W2T + 256 * 1024;
constexpr size_t OFF_V1T = OFF_A2T + 256 * 1024;
constexpr size_t OFF_V2T = OFF_V1T + 128 * 1024;
constexpr size_t OFF_WS = OFF_V2T + 128 * 1024;
constexpr size_t OFF_MODP = OFF_WS + 512 * 1024;
constexpr size_t OFF_ROPE = OFF_MODP + 3 * MiB / 2;
constexpr size_t OFF_DOT = OFF_ROPE + 2 * MiB;
constexpr size_t OFF_H = 90 * MiB;
constexpr size_t OFF_Z = 122 * MiB;
constexpr size_t OFF_VF = 170 * MiB;
constexpr size_t OFF_R1 = 186 * MiB;
constexpr size_t OFF_R2 = 298 * MiB;
constexpr size_t OFF_R3 = 410 * MiB;
constexpr size_t WS_END = 474 * MiB;
static_assert(OFF_DOT + MiB / 2 <= OFF_H, "small region");
constexpr size_t R1_GP = 0, R1_RA = 16 * MiB, R1_HT = 32 * MiB, R1_YQ = 48 * MiB, R1_PC = 64 * MiB;
constexpr size_t R2_R = 0, R2_K = 16 * MiB, R2_V = 32 * MiB, R2_KK = 48 * MiB, R2_B = 64 * MiB, R2_LW = 80 * MiB;
constexpr size_t R3_Q = 0, R3_KF = 24 * MiB, R3_VT = 48 * MiB, R3_MERGED = 0, R3_Y = 32 * MiB;

struct Params {
    const float* x; const float* c; const int* pos; const float* pre_g; const float* post_g; const float* w_ada; const float* b_ada; const float* w_in;
    const float* q_norm; const float* w_uq; const float* kv_norm; const float* w_ukv; const float* ln_g; const float* ln_b; const float* w_s; const float* b_s;
    const float* mu; const float* w0; const float* w2; const float* a0; const float* a2; const float* k_k; const float* k_a; const float* r_k;
    const float* lnx_g; const float* lnx_b; const float* v0; const float* v1; const float* v2; const float* w_br; const float* w_out;
    float* out; unsigned char* ws;
    int ph_lo, ph_hi;
};

typedef __bf16 bf16x2_t __attribute__((ext_vector_type(2)));
__device__ __forceinline__ unsigned cvt_pk_bf16(float lo, float hi) { const f32x2 v = {lo, hi}; const bf16x2_t b = __builtin_convertvector(v, bf16x2_t); return __builtin_bit_cast(unsigned, b); }
__device__ __forceinline__ float bf_lo(unsigned u) { return __uint_as_float(u << 16); }
__device__ __forceinline__ float bf_hi(unsigned u) { return __uint_as_float(u & 0xffff0000u); }
__device__ __forceinline__ float bf2f(bf16_t h) { return __uint_as_float(((unsigned)h) << 16); }
__device__ __forceinline__ bf16_t f2bf(float f) { return (bf16_t)(cvt_pk_bf16(f, 0.f) & 0xffffu); }
__device__ __forceinline__ float sigmoidf_(float x) { return 1.f / (1.f + __expf(-x)); }
__device__ __forceinline__ float siluf_(float x) { return x / (1.f + __expf(-x)); }
__device__ __forceinline__ float geluf_(float x) { return 0.5f * x * (1.f + erff(x * 0.70710678118654752f)); }
__device__ __forceinline__ f32x4 unpack4(u32x2 u) { return (f32x4){bf_lo(u.x), bf_hi(u.x), bf_lo(u.y), bf_hi(u.y)}; }
__device__ __forceinline__ u32x2 pack4(f32x4 v) { u32x2 r; r.x = cvt_pk_bf16(v[0], v[1]); r.y = cvt_pk_bf16(v[2], v[3]); return r; }
__device__ __forceinline__ float wave_sum(float v) {
#pragma unroll
    for (int o = 1; o < 64; o <<= 1) v += __shfl_xor(v, o);
    return v;
}
__device__ __forceinline__ bf16x8 ld_frag(const bf16_t* p) { return *(const bf16x8*)p; }
__device__ __forceinline__ bf16x8 pack_frag(f32x4 a, f32x4 b) {
    u32x4 u; u.x = cvt_pk_bf16(a[0], a[1]); u.y = cvt_pk_bf16(a[2], a[3]); u.z = cvt_pk_bf16(b[0], b[1]); u.w = cvt_pk_bf16(b[2], b[3]);
    return __builtin_bit_cast(bf16x8, u);
}
__device__ __forceinline__ bf16x8 join_frag(u32x2 a, u32x2 b) { u32x4 u; u.x = a.x; u.y = a.y; u.z = b.x; u.w = b.y; return __builtin_bit_cast(bf16x8, u); }
__device__ __forceinline__ int tid_l() { int t = threadIdx.x; asm volatile("" : "+v"(t)); return t; }
__device__ __forceinline__ unsigned char* ptr_l(unsigned char* q) { asm volatile("" : "+s"(q)); return q; }
#define MFMA(a, b, c) __builtin_amdgcn_mfma_f32_16x16x32_bf16((a), (b), (c), 0, 0, 0)

namespace pg8 {
constexpr int BM = 256, BK = 64, HALF = 128, HTB = HALF * BK * 2, STAGE_BYTES = 8 * HTB, NXCD = 8, WGM = 8;
__host__ __device__ __forceinline__ int lds_byte(int r, int c) { const int st = (r >> 4) * 2 + (c >> 5), rr = r & 15, cc = c & 31, ob = rr * 64 + cc * 2; return st * 1024 + (ob ^ (((ob >> 9) & 1) << 5)); }
__host__ __device__ __forceinline__ void stage_rc(int b, int& R, int& C) { const int st = b / 1024, sb = b % 1024, swz = sb ^ (((sb >> 9) & 1) << 5); R = (st >> 1) * 16 + swz / 64; C = (st & 1) * 32 + (swz % 64) / 2; }
__host__ __device__ __forceinline__ int perm32(int rho) { const int n = rho >> 4, i = rho & 15; return 8 * (i >> 2) + 4 * n + (i & 3); }

struct Unit { int pm, pn, ak, tag; };
struct Gemm { const bf16_t* A; const bf16_t* Bt; int lda, ldb, K; };

__device__ __forceinline__ void tile_of(int wgid, int nM, int nN, int& pm, int& pn) {
    const int nwg = nM * nN;
    { const int q = nwg / NXCD, r = nwg % NXCD, xcd = wgid % NXCD, off = wgid / NXCD; wgid = (xcd < r ? xcd * (q + 1) : r * (q + 1) + (xcd - r) * q) + off; }
    const int nig = WGM * nN, gid = wgid / nig, fm = gid * WGM, gsz = (nM - fm) < WGM ? (nM - fm) : WGM;
    pm = fm + ((wgid % nig) % gsz); pn = (wgid % nig) / gsz;
}
struct PlainOrder {
    int nM, nN, nwg, G, c;
    __device__ void init(int nM_, int nN_, int G_, int c_) { nM = nM_; nN = nN_; nwg = nM * nN; G = G_; c = c_; }
    __device__ bool next(int i, Unit& u) const { const long L = (long)i * G + c; if (L >= nwg) return false; tile_of((int)L, nM, nN, u.pm, u.pn); u.ak = 0; u.tag = 0; return true; }
};
struct MergeOrder {
    int nM, nN, nwg, G, c;
    __device__ void init(int nM_, int nN_, int G_, int c_) { nM = nM_; nN = nN_; nwg = nM * nN; G = G_; c = c_; }
    __device__ bool next(int i, Unit& u) const { const int ti = i / 3, n = i - 3 * ti; const long L = (long)ti * G + c; if (L >= nwg) return false;
        int pm, pc; tile_of((int)L, nM, nN, pm, pc); u.pm = pm; u.pn = n * nN + pc; u.ak = n * 512; u.tag = n; return true; }
};

template <class Epi, class Sched>
__device__ __forceinline__ void gemm_phase(LAS unsigned char* lds, const Gemm g, const Sched& S, const Epi& E) {
    const int tid = tid_l(), wid = __builtin_amdgcn_readfirstlane(tid >> 6), lane = tid & 63, wr = wid >> 2, wc = wid & 3, fr = lane & 15, fq = lane >> 4;
    const int K = g.K, nt = K / BK;
    unsigned voffA[2], voffB[2];
#pragma unroll
    for (int i = 0; i < 2; ++i) { int R, C; stage_rc(tid * 16 + i * 8192, R, C); const int Rb = (R & ~31) + perm32(R & 31);
        voffA[i] = (unsigned)(R * g.lda + C) * 2u; voffB[i] = (unsigned)(Rb * g.ldb + C) * 2u; }
    const size_t kstep = (size_t)(BK * 2);
    const size_t hstepA = (size_t)HALF * g.lda * 2, hstepB = (size_t)HALF * g.ldb * 2;
    const size_t tstepA = 2 * hstepA, tstepB = 2 * hstepB;
    const unsigned ldsw = (unsigned)wid * 1024u;
    const int aoff = lds_byte(wr * 64 + fr, fq * 8), boff = lds_byte(wc * 32 + fr, fq * 8);
#define PG8_SA(b, h) (((b) * 2 + (h)) * HTB)
#define PG8_SB(b, h) ((4 + (b) * 2 + (h)) * HTB)
#define PG8_STAGE(bufoff, gbase, voff) do { _Pragma("unroll") for (int _i = 0; _i < 2; ++_i) \
        __builtin_amdgcn_global_load_lds((const unsigned*)((const char*)(gbase) + (voff)[_i]), (LAS unsigned*)(lds + (bufoff) + ldsw + _i * 8192), 16, 0, 0); } while (0)
#define PG8_LDA(dst, b, h) do { _Pragma("unroll") for (int m = 0; m < 4; ++m) _Pragma("unroll") for (int k = 0; k < 2; ++k) dst[m][k] = *(const LAS bf16x8*)(lds + PG8_SA(b, h) + aoff + m * 2048 + k * 1024); } while (0)
#define PG8_LDB(dst, b, h) do { _Pragma("unroll") for (int n = 0; n < 2; ++n) _Pragma("unroll") for (int k = 0; k < 2; ++k) dst[n][k] = *(const LAS bf16x8*)(lds + PG8_SB(b, h) + boff + n * 2048 + k * 1024); } while (0)
#define PG8_MMA(ai, bj, At, Bt) do { __builtin_amdgcn_s_setprio(1); _Pragma("unroll") for (int m = 0; m < 4; ++m) _Pragma("unroll") for (int n = 0; n < 2; ++n) _Pragma("unroll") for (int k = 0; k < 2; ++k) \
        acc[ai][bj][m][n] = __builtin_amdgcn_mfma_f32_16x16x32_bf16(Bt[n][k], At[m][k], acc[ai][bj][m][n], 0, 0, 0); __builtin_amdgcn_s_setprio(0); } while (0)
#define PG8_WAIT_V(n) asm volatile("s_waitcnt vmcnt(" #n ")" ::: "memory")
#define PG8_WAIT_L(n) asm volatile("s_waitcnt lgkmcnt(" #n ")" ::: "memory")
#define PG8_BAR __builtin_amdgcn_s_barrier()
#define PG8_SCHED __builtin_amdgcn_sched_barrier(0)
    Unit cur, nxt; int ui = 0;
    if (!S.next(0, cur)) return;
    f32x4 acc[2][2][4][2];
#pragma unroll
    for (int a = 0; a < 2; ++a)
#pragma unroll
        for (int b = 0; b < 2; ++b)
#pragma unroll
            for (int m = 0; m < 4; ++m)
#pragma unroll
                for (int n = 0; n < 2; ++n) acc[a][b][m][n] = (f32x4){0.f, 0.f, 0.f, 0.f};
    bf16x8 At[4][2], B0[2][2], B1[2][2];
    const char* cA = (const char*)g.A + (size_t)cur.pm * tstepA + (size_t)cur.ak * 2; const char* cB = (const char*)g.Bt + (size_t)cur.pn * tstepB;
    PG8_STAGE(PG8_SB(0, 0), cB, voffB); PG8_STAGE(PG8_SB(0, 1), cB + hstepB, voffB); PG8_STAGE(PG8_SA(0, 0), cA, voffA); PG8_STAGE(PG8_SA(0, 1), cA + hstepA, voffA);
    if (wr == 1) PG8_BAR;
    PG8_WAIT_V(2); PG8_BAR;
    PG8_STAGE(PG8_SB(1, 0), cB + kstep, voffB); PG8_STAGE(PG8_SA(1, 0), cA + kstep, voffA); PG8_STAGE(PG8_SB(1, 1), cB + hstepB + kstep, voffB);
    PG8_WAIT_V(6); PG8_BAR;
    for (;;) {
        const bool has_next = S.next(ui + 1, nxt);
        const char* nA = has_next ? (const char*)g.A + (size_t)nxt.pm * tstepA + (size_t)nxt.ak * 2 : cA; const char* nB = has_next ? (const char*)g.Bt + (size_t)nxt.pn * tstepB : cB;
        for (int t = 0; t < nt; t += 2) {
            const bool last = (t == nt - 2);
            const char* a1 = cA + (size_t)(t + 1) * kstep;
            const char* a2 = last ? nA : cA + (size_t)(t + 2) * kstep; const char* b2 = last ? nB : cB + (size_t)(t + 2) * kstep;
            const char* a3 = a2 + kstep; const char* b3 = b2 + kstep;
            PG8_LDB(B0, 0, 0); PG8_LDB(B1, 0, 1); PG8_SCHED; PG8_LDA(At, 0, 0); PG8_STAGE(PG8_SA(1, 1), a1 + hstepA, voffA);
            PG8_WAIT_V(8); PG8_WAIT_L(0); PG8_BAR; PG8_MMA(0, 0, At, B0); PG8_MMA(0, 1, At, B1); PG8_BAR; PG8_SCHED;
            PG8_LDA(At, 0, 1); PG8_STAGE(PG8_SB(0, 0), b2, voffB); PG8_STAGE(PG8_SB(0, 1), b2 + hstepB, voffB); PG8_STAGE(PG8_SA(0, 0), a2, voffA);
            PG8_WAIT_V(8); PG8_WAIT_L(0); PG8_BAR; PG8_MMA(1, 0, At, B0); PG8_MMA(1, 1, At, B1); PG8_BAR; PG8_SCHED;
            PG8_LDB(B0, 1, 0); PG8_LDB(B1, 1, 1); PG8_SCHED; PG8_LDA(At, 1, 0); PG8_STAGE(PG8_SA(0, 1), a2 + hstepA, voffA);
            PG8_WAIT_V(8); PG8_WAIT_L(0); PG8_BAR; PG8_MMA(0, 0, At, B0); PG8_MMA(0, 1, At, B1); PG8_BAR; PG8_SCHED;
            PG8_LDA(At, 1, 1); PG8_STAGE(PG8_SB(1, 0), b3, voffB); PG8_STAGE(PG8_SB(1, 1), b3 + hstepB, voffB); PG8_STAGE(PG8_SA(1, 0), a3, voffA);
            PG8_WAIT_V(8); PG8_WAIT_L(0); PG8_BAR; PG8_MMA(1, 0, At, B0); PG8_MMA(1, 1, At, B1); PG8_BAR; PG8_SCHED;
        }
        if (wr == 0) PG8_BAR;
        E(acc, cur, wr, wc, fr, fq);
        if (!has_next) break;
#pragma unroll
        for (int a = 0; a < 2; ++a)
#pragma unroll
            for (int b = 0; b < 2; ++b)
#pragma unroll
                for (int m = 0; m < 4; ++m)
#pragma unroll
                    for (int n = 0; n < 2; ++n) acc[a][b][m][n] = (f32x4){0.f, 0.f, 0.f, 0.f};
        cur = nxt; cA = nA; cB = nB; ++ui;
        if (wr == 1) PG8_BAR;
    }
    PG8_WAIT_V(0);
    PG8_BAR;
#undef PG8_SA
#undef PG8_SB
#undef PG8_STAGE
#undef PG8_LDA
#undef PG8_LDB
#undef PG8_MMA
#undef PG8_WAIT_V
#undef PG8_WAIT_L
#undef PG8_BAR
#undef PG8_SCHED
}

struct EpiIn {
    bf16_t* P1; bf16_t* Z;
    __device__ __forceinline__ void operator()(const f32x4 (&acc)[2][2][4][2], const Unit& u, int wr, int wc, int fr, int fq) const {
        bf16_t* base; int ld, colt;
        if (u.pn < 13) { base = P1; ld = NP1; colt = u.pn * BM; } else { base = Z; ld = NZ; colt = (u.pn - 13) * BM; }
        const int row0 = u.pm * BM + wr * 64 + fr, col0 = colt + wc * 32 + 8 * fq;
#pragma unroll
        for (int ai = 0; ai < 2; ++ai)
#pragma unroll
            for (int m = 0; m < 4; ++m) { bf16_t* rowp = base + (size_t)(row0 + ai * HALF + m * 16) * ld + col0;
#pragma unroll
                for (int bj = 0; bj < 2; ++bj) { const f32x4 v0 = acc[ai][bj][m][0], v1 = acc[ai][bj][m][1];
                    u32x4 w; w.x = cvt_pk_bf16(v0[0], v0[1]); w.y = cvt_pk_bf16(v0[2], v0[3]); w.z = cvt_pk_bf16(v1[0], v1[1]); w.w = cvt_pk_bf16(v1[2], v1[3]);
                    *(u32x4*)(rowp + bj * HALF) = w; } }
    }
};
template <int ACT> struct EpiPlain {
    bf16_t* O; int ld;
    __device__ __forceinline__ void operator()(const f32x4 (&acc)[2][2][4][2], const Unit& u, int wr, int wc, int fr, int fq) const {
        const int row0 = u.pm * BM + wr * 64 + fr, col0 = u.pn * BM + wc * 32 + 8 * fq;
#pragma unroll
        for (int ai = 0; ai < 2; ++ai)
#pragma unroll
            for (int m = 0; m < 4; ++m) { bf16_t* rowp = O + (size_t)(row0 + ai * HALF + m * 16) * ld + col0;
#pragma unroll
                for (int bj = 0; bj < 2; ++bj) { f32x4 v0 = acc[ai][bj][m][0], v1 = acc[ai][bj][m][1];
                    if (ACT == 1) {
#pragma unroll
                        for (int e = 0; e < 4; ++e) { v0[e] = sigmoidf_(v0[e]); v1[e] = sigmoidf_(v1[e]); } }
                    u32x4 w; w.x = cvt_pk_bf16(v0[0], v0[1]); w.y = cvt_pk_bf16(v0[2], v0[3]); w.z = cvt_pk_bf16(v1[0], v1[1]); w.w = cvt_pk_bf16(v1[2], v1[3]);
                    *(u32x4*)(rowp + bj * HALF) = w; } }
    }
};
struct EpiMerge {
    bf16_t* Mg; const bf16_t* G;
    __device__ __forceinline__ void operator()(const f32x4 (&acc)[2][2][4][2], const Unit& u, int wr, int wc, int fr, int fq) const {
        const int n = u.tag, pc = u.pn - 4 * n;
        const int row0 = u.pm * BM + wr * 64 + fr, col0 = pc * BM + wc * 32 + 8 * fq;
#pragma unroll
        for (int ai = 0; ai < 2; ++ai)
#pragma unroll
            for (int m = 0; m < 4; ++m) { const size_t row = (size_t)(row0 + ai * HALF + m * 16);
#pragma unroll
                for (int bj = 0; bj < 2; ++bj) { const f32x4 v0 = acc[ai][bj][m][0], v1 = acc[ai][bj][m][1];
                    const u32x4 gt = *(const u32x4*)(G + row * NG + n * 1024 + col0 + bj * HALF);
                    bf16_t* mp = Mg + row * DM + col0 + bj * HALF;
                    float o[8];
                    o[0] = bf_lo(gt.x) * v0[0]; o[1] = bf_hi(gt.x) * v0[1]; o[2] = bf_lo(gt.y) * v0[2]; o[3] = bf_hi(gt.y) * v0[3];
                    o[4] = bf_lo(gt.z) * v1[0]; o[5] = bf_hi(gt.z) * v1[1]; o[6] = bf_lo(gt.w) * v1[2]; o[7] = bf_hi(gt.w) * v1[3];
                    if (n > 0) { const u32x4 pv = *(const u32x4*)mp;
                        o[0] += bf_lo(pv.x); o[1] += bf_hi(pv.x); o[2] += bf_lo(pv.y); o[3] += bf_hi(pv.y); o[4] += bf_lo(pv.z); o[5] += bf_hi(pv.z); o[6] += bf_lo(pv.w); o[7] += bf_hi(pv.w); }
                    u32x4 w; w.x = cvt_pk_bf16(o[0], o[1]); w.y = cvt_pk_bf16(o[2], o[3]); w.z = cvt_pk_bf16(o[4], o[5]); w.w = cvt_pk_bf16(o[6], o[7]);
                    *(u32x4*)mp = w; } }
    }
};
}

__device__ __forceinline__ void tr_item(const float* W, int lds_, int k0, int n0s, bf16_t* WT, int ldd, int n0d, int kd0, const float* ksc, float* scr, int lane) {
#pragma unroll 8
    for (int i = 0; i < 32; ++i) { const int kk = 2 * i + (lane >> 5);
        float v = 0.f; if (n0s >= 0) { v = W[(size_t)(k0 + kk) * lds_ + n0s + (lane & 31)]; if (ksc) v *= ksc[k0 + kk]; }
        scr[kk * 33 + (lane & 31)] = v; }
    asm volatile("s_waitcnt lgkmcnt(0)" ::: "memory");
    const int c = lane & 7;
#pragma unroll
    for (int j = 0; j < 4; ++j) { const int n = (lane >> 3) + 8 * j; const float* s = scr + (8 * c) * 33 + n;
        u32x4 o; o.x = cvt_pk_bf16(s[0 * 33], s[1 * 33]); o.y = cvt_pk_bf16(s[2 * 33], s[3 * 33]); o.z = cvt_pk_bf16(s[4 * 33], s[5 * 33]); o.w = cvt_pk_bf16(s[6 * 33], s[7 * 33]);
        *(u32x4*)(WT + (size_t)(n0d + n) * ldd + kd0 + 8 * c) = o; }
    asm volatile("s_waitcnt lgkmcnt(0)" ::: "memory");
}

__device__ __forceinline__ void phase0a(const Params& p, unsigned char* lds) {
    const int tid = tid_l(), lane = tid & 63, wave = tid >> 6, G = gridDim.x;
    const int gw = blockIdx.x * NWAVES + wave, NGW = G * NWAVES;
    unsigned char* ws = p.ws;
    float* scr = (float*)(lds + wave * 16384);
    constexpr int I_WIN = 152 * 16, I_WG = 96 * 16, I_WBR = 3 * 32 * 8, I_WOUT = 32 * 16, I_WUQ = 24 * 4, I_WUKV = 32 * 2, I_W2 = 16, I_A2 = 16, I_V1 = 8;
    constexpr int I_L = I_WIN + I_WG + I_WBR + I_WOUT + I_WUQ + I_WUKV + I_W2 + I_A2 + I_V1;
    for (int it = gw; it < NL * I_L; it += NGW) {
        const int l = it / I_L; int r = it - l * I_L;
        if (r < I_WIN) { const int nb = r >> 4, kb = r & 15; const int nd = nb * 32;
            int ns; if (nd < 416) ns = nd; else if (nd < 512) ns = -1; else if (nd < 3200) ns = nd - 96; else if (nd < 3328) ns = -1; else ns = nd - 224;
            tr_item(p.w_in + (size_t)l * DM * D_IN_SRC, D_IN_SRC, kb * 64, ns, (bf16_t*)(ws + OFF_WIN + l * SZ_WIN), DM, nd, kb * 64, nullptr, scr, lane); continue; }
        r -= I_WIN;
        if (r < I_WG) { const int nb = r >> 4, kb = r & 15;
            tr_item(p.w_in + (size_t)l * DM * D_IN_SRC, D_IN_SRC, kb * 64, 4640 + nb * 32, (bf16_t*)(ws + OFF_WG + l * SZ_WG), DM, nb * 32, kb * 64, nullptr, scr, lane); continue; }
        r -= I_WG;
        if (r < I_WBR) { const int n = r / 256, r2 = r - n * 256, nb = r2 >> 3, kb = r2 & 7;
            tr_item(p.w_br + ((size_t)(l * 3 + n) * 512) * DM, DM, kb * 64, nb * 32, (bf16_t*)(ws + OFF_WBR + l * SZ_WBR), 512, n * 1024 + nb * 32, kb * 64, nullptr, scr, lane); continue; }
        r -= I_WBR;
        if (r < I_WOUT) { const int nb = r >> 4, kb = r & 15;
            tr_item(p.w_out + (size_t)l * DM * DM, DM, kb * 64, nb * 32, (bf16_t*)(ws + OFF_WOUT + l * SZ_WOUT), DM, nb * 32, kb * 64, nullptr, scr, lane); continue; }
        r -= I_WOUT;
        if (r < I_WUQ) { const int nb = r >> 2, kb = r & 3;
            tr_item(p.w_uq + (size_t)l * 256 * 768, 768, kb * 64, nb * 32, (bf16_t*)(ws + OFF_WUQ + l * SZ_WUQ), 256, nb * 32, kb * 64, p.q_norm + l * 256, scr, lane); continue; }
        r -= I_WUQ;
        if (r < I_WUKV) { const int nb = r >> 1, kb = r & 1;
            tr_item(p.w_ukv + (size_t)l * 128 * 1024, 1024, kb * 64, nb * 32, (bf16_t*)(ws + OFF_WUKV + l * SZ_WUKV), 128, nb * 32, kb * 64, p.kv_norm + l * 128, scr, lane); continue; }
        r -= I_WUKV;
        if (r < I_W2) { tr_item(p.w2 + (size_t)l * 64 * 512, 512, 0, r * 32, (bf16_t*)(ws + OFF_W2T) + (size_t)l * 512 * 64, 64, r * 32, 0, nullptr, scr, lane); continue; }
        r -= I_W2;
        if (r < I_A2) { tr_item(p.a2 + (size_t)l * 64 * 512, 512, 0, r * 32, (bf16_t*)(ws + OFF_A2T) + (size_t)l * 512 * 64, 64, r * 32, 0, nullptr, scr, lane); continue; }
        r -= I_A2;
        if (l >= 1) tr_item(p.v1 + (size_t)(l - 1) * 512 * 32, 32, r * 64, 0, (bf16_t*)(ws + OFF_V1T) + (size_t)(l - 1) * 32 * 512, 512, 0, r * 64, nullptr, scr, lane);
    }
    for (int it = gw; it < NL * 48 * 8; it += NGW) {
        const int l = it / 384, r = it - l * 384, nb = r >> 3, ks = r & 7, n = nb * 64 + lane;
        float a0 = 0.f, a1 = 0.f, a2 = 0.f, a3 = 0.f;
        const float* w = p.w_ada + (size_t)l * DM * 3072 + n;
#pragma unroll 8
        for (int k = ks * 128; k < ks * 128 + 128; ++k) { const float wv = w[(size_t)k * 3072];
            a0 += siluf_(p.c[k]) * wv; a1 += siluf_(p.c[DM + k]) * wv; a2 += siluf_(p.c[2 * DM + k]) * wv; a3 += siluf_(p.c[3 * DM + k]) * wv; }
        float* mp = (float*)(ws + OFF_MODP) + ((size_t)(l * 8 + ks) * 4) * 3072 + n;
        mp[0] = a0; mp[3072] = a1; mp[2 * 3072] = a2; mp[3 * 3072] = a3;
    }
    const size_t gt = (size_t)blockIdx.x * NTHREADS + tid, GT = (size_t)G * NTHREADS;
    for (size_t i = gt; i < (size_t)3 * 512 * 32; i += GT) { const int l1 = (int)(i / (512 * 32)), r = (int)(i % (512 * 32)), c = r >> 5, k = r & 31;
        ((bf16_t*)(ws + OFF_V2T))[i] = f2bf(p.v2[(size_t)l1 * 32 * 512 + k * 512 + c]); }
    for (size_t i = gt; i < (size_t)NL * 4 * 128 * 128; i += GT) { const int s = (int)(i & 127), t = (int)((i >> 7) & 127);
        ((bf16_t*)(ws + OFF_WS))[i] = f2bf(((s >> 6) <= (t >> 6)) ? p.w_s[i] : 0.f); }
    for (size_t i = gt; i < (size_t)M_TOK * 16; i += GT) { const int t = (int)(i >> 4), k = (int)(i & 15);
        const float inv = powf(10000.f, -(float)(2 * k) / 32.f); const float ang = (float)p.pos[t] * inv;
        ((float*)(ws + OFF_ROPE))[i] = cosf(ang); ((float*)(ws + OFF_ROPE))[(size_t)M_TOK * 16 + i] = sinf(ang); }
    for (size_t i = gt; i < (size_t)M_TOK * DM / 4; i += GT) ((f32x4*)p.out)[i] = ((const f32x4*)p.x)[i];
}

__device__ __forceinline__ f32x4 mod4(const Params& p, int l, int b, int kind, int col) {
    const float* mp = (const float*)(p.ws + OFF_MODP) + ((size_t)(l * 8) * 4 + b) * 3072 + kind * DM + col;
    f32x4 s = *(const f32x4*)(p.b_ada + (size_t)l * 3072 + kind * DM + col);
#pragma unroll
    for (int ks = 0; ks < 8; ++ks) s += *(const f32x4*)(mp + (size_t)ks * 4 * 3072);
    return s;
}
__device__ __forceinline__ void normmod_row(const Params& p, int l, int row, const f32x4 (&v)[4], int lane) {
    float ss = 0.f;
#pragma unroll
    for (int j = 0; j < 4; ++j) ss += v[j][0] * v[j][0] + v[j][1] * v[j][1] + v[j][2] * v[j][2] + v[j][3] * v[j][3];
    const float rstd = rsqrtf(wave_sum(ss) * (1.f / DM) + 1e-6f);
    const int b = row / SEQ;
    bf16_t* hrow = (bf16_t*)(p.ws + OFF_H) + (size_t)row * DM;
#pragma unroll
    for (int j = 0; j < 4; ++j) { const int col = 4 * lane + 256 * j;
        const f32x4 g = *(const f32x4*)(p.pre_g + (size_t)l * DM + col), sh = mod4(p, l, b, 0, col), sc = mod4(p, l, b, 1, col);
        f32x4 o = v[j] * rstd * g * (sc + 1.f) + sh;
        *(u32x2*)(hrow + col) = pack4(o); }
}
__device__ __forceinline__ void phase0b(const Params& p) {
    const int tidq = tid_l(); const int lane = tidq & 63, gw = blockIdx.x * NWAVES + (tidq >> 6), NGW = gridDim.x * NWAVES;
    for (int row = gw; row < M_TOK; row += NGW) { f32x4 v[4];
#pragma unroll
        for (int j = 0; j < 4; ++j) v[j] = *(const f32x4*)(p.out + (size_t)row * DM + 4 * lane + 256 * j);
        normmod_row(p, 0, row, v, lane); }
}
__device__ __forceinline__ void phase_final(const Params& p, int l) {
    const int tidq = tid_l(); const int lane = tidq & 63, gw = blockIdx.x * NWAVES + (tidq >> 6), NGW = gridDim.x * NWAVES;
    const bf16_t* Y = (const bf16_t*)(p.ws + OFF_R3 + R3_Y);
    for (int row = gw; row < M_TOK; row += NGW) {
        f32x4 y[4]; float ss = 0.f;
#pragma unroll
        for (int j = 0; j < 4; ++j) { y[j] = unpack4(*(const u32x2*)(Y + (size_t)row * DM + 4 * lane + 256 * j)); ss += y[j][0] * y[j][0] + y[j][1] * y[j][1] + y[j][2] * y[j][2] + y[j][3] * y[j][3]; }
        const float rstd = rsqrtf(wave_sum(ss) * (1.f / DM) + 1e-6f);
        const int b = row / SEQ; f32x4 v[4];
#pragma unroll
        for (int j = 0; j < 4; ++j) { const int col = 4 * lane + 256 * j;
            const f32x4 xg = *(const f32x4*)(p.out + (size_t)row * DM + col), pg = *(const f32x4*)(p.post_g + (size_t)l * DM + col), gt = mod4(p, l, b, 2, col);
            v[j] = xg + gt * (y[j] * rstd * pg);
            *(f32x4*)(p.out + (size_t)row * DM + col) = v[j]; }
        if (l + 1 < NL) normmod_row(p, l + 1, row, v, lane);
    }
}

__device__ __forceinline__ void mla_prep_item(const Params& p, int l, int item, unsigned char* lds) {
    const int tid = tid_l(), lane = tid & 63, wave = tid >> 6, fr = lane & 15, fq = lane >> 4;
    const int t0 = item * 64;
    const bf16_t* P1 = (const bf16_t*)(p.ws + OFF_R1);
    bf16_t* Q = (bf16_t*)(p.ws + OFF_R3 + R3_Q); bf16_t* Kf = (bf16_t*)(p.ws + OFF_R3 + R3_KF); bf16_t* Vt = (bf16_t*)(p.ws + OFF_R3 + R3_VT);
    const bf16_t* Wuq = (const bf16_t*)(p.ws + OFF_WUQ + l * SZ_WUQ); const bf16_t* Wukv = (const bf16_t*)(p.ws + OFF_WUKV + l * SZ_WUKV);
    const float* COS = (const float*)(p.ws + OFF_ROPE); const float* SIN = COS + (size_t)M_TOK * 16;
    float* rq = (float*)lds; float* rkv = rq + 64;
    __syncthreads();
    { const int row = tid >> 3, part = tid & 7; const bf16_t* pr = P1 + (size_t)(t0 + row) * NP1;
        float sq = 0.f, sk = 0.f;
#pragma unroll
        for (int i = 0; i < 4; ++i) { const u32x4 u = *(const u32x4*)(pr + C_QLAT + part * 32 + i * 8);
            sq += bf_lo(u.x) * bf_lo(u.x) + bf_hi(u.x) * bf_hi(u.x) + bf_lo(u.y) * bf_lo(u.y) + bf_hi(u.y) * bf_hi(u.y) + bf_lo(u.z) * bf_lo(u.z) + bf_hi(u.z) * bf_hi(u.z) + bf_lo(u.w) * bf_lo(u.w) + bf_hi(u.w) * bf_hi(u.w); }
#pragma unroll
        for (int i = 0; i < 2; ++i) { const u32x4 u = *(const u32x4*)(pr + C_KVLAT + part * 16 + i * 8);
            sk += bf_lo(u.x) * bf_lo(u.x) + bf_hi(u.x) * bf_hi(u.x) + bf_lo(u.y) * bf_lo(u.y) + bf_hi(u.y) * bf_hi(u.y) + bf_lo(u.z) * bf_lo(u.z) + bf_hi(u.z) * bf_hi(u.z) + bf_lo(u.w) * bf_lo(u.w) + bf_hi(u.w) * bf_hi(u.w); }
        sq += __shfl_xor(sq, 1); sq += __shfl_xor(sq, 2); sq += __shfl_xor(sq, 4);
        sk += __shfl_xor(sk, 1); sk += __shfl_xor(sk, 2); sk += __shfl_xor(sk, 4);
        if (part == 0) { rq[row] = rsqrtf(sq * (1.f / 256.f) + 1e-6f); rkv[row] = rsqrtf(sk * (1.f / 128.f) + 1e-6f); }
        const int i2 = part * 2; const int t = t0 + row;
        const unsigned u1 = *(const unsigned*)(pr + C_KROPE + i2), u2 = *(const unsigned*)(pr + C_KROPE + 16 + i2);
        const float c0 = COS[(size_t)t * 16 + i2], c1 = COS[(size_t)t * 16 + i2 + 1], s0 = SIN[(size_t)t * 16 + i2], s1 = SIN[(size_t)t * 16 + i2 + 1];
        const float x10 = bf_lo(u1), x11 = bf_hi(u1), x20 = bf_lo(u2), x21 = bf_hi(u2);
        const unsigned o1 = cvt_pk_bf16(x10 * c0 - x20 * s0, x11 * c1 - x21 * s1), o2 = cvt_pk_bf16(x20 * c0 + x10 * s0, x21 * c1 + x11 * s1);
#pragma unroll
        for (int h = 0; h < 8; ++h) { *(unsigned*)(Kf + (size_t)t * 768 + h * 96 + 64 + i2) = o1; *(unsigned*)(Kf + (size_t)t * 768 + h * 96 + 80 + i2) = o2; }
    }
    __syncthreads();
#pragma unroll 1
    for (int cb = 0; cb < 4; ++cb) { const int combo = wave * 4 + cb, rt = combo & 3, head = combo >> 2;
        f32x4 acc[6];
#pragma unroll
        for (int ct = 0; ct < 6; ++ct) acc[ct] = (f32x4){0.f, 0.f, 0.f, 0.f};
        const bf16_t* ap = P1 + (size_t)(t0 + rt * 16 + fr) * NP1 + C_QLAT + fq * 8;
        const bf16_t* wp = Wuq + (size_t)(head * 96 + fr) * 256 + fq * 8;
#pragma unroll
        for (int ks = 0; ks < 8; ++ks) { const bf16x8 af = ld_frag(ap + ks * 32);
#pragma unroll
            for (int ct = 0; ct < 6; ++ct) acc[ct] = MFMA(ld_frag(wp + (size_t)ct * 16 * 256 + ks * 32), af, acc[ct]); }
        const int t = t0 + rt * 16 + fr; const float rs = rq[rt * 16 + fr] * QSCALE;
        bf16_t* qp = Q + (size_t)t * 768 + head * 96 + fq * 4;
#pragma unroll
        for (int ct = 0; ct < 4; ++ct) *(u32x2*)(qp + ct * 16) = pack4(acc[ct] * rs);
        const f32x4 cs = *(const f32x4*)(COS + (size_t)t * 16 + fq * 4), sn = *(const f32x4*)(SIN + (size_t)t * 16 + fq * 4);
        const f32x4 x1 = acc[4] * rs, x2 = acc[5] * rs;
        *(u32x2*)(qp + 64) = pack4(x1 * cs - x2 * sn); *(u32x2*)(qp + 80) = pack4(x2 * cs + x1 * sn);
    }
#pragma unroll 1
    for (int cb = 0; cb < 4; ++cb) { const int combo = wave * 4 + cb, rt = combo & 3, head = combo >> 2;
        f32x4 ak[4], av[4];
#pragma unroll
        for (int ct = 0; ct < 4; ++ct) { ak[ct] = (f32x4){0.f, 0.f, 0.f, 0.f}; av[ct] = (f32x4){0.f, 0.f, 0.f, 0.f}; }
        const bf16_t* ap = P1 + (size_t)(t0 + rt * 16 + fr) * NP1 + C_KVLAT + fq * 8;
        const bf16_t* wp = Wukv + (size_t)(head * 128 + fr) * 128 + fq * 8;
#pragma unroll
        for (int ks = 0; ks < 4; ++ks) { const bf16x8 af = ld_frag(ap + ks * 32);
#pragma unroll
            for (int ct = 0; ct < 4; ++ct) { ak[ct] = MFMA(ld_frag(wp + (size_t)ct * 16 * 128 + ks * 32), af, ak[ct]);
                av[ct] = MFMA(af, ld_frag(wp + (size_t)(64 + ct * 16) * 128 + ks * 32), av[ct]); } }
        const int t = t0 + rt * 16 + fr; const float rs = rkv[rt * 16 + fr];
#pragma unroll
        for (int ct = 0; ct < 4; ++ct) *(u32x2*)(Kf + (size_t)t * 768 + head * 96 + ct * 16 + fq * 4) = pack4(ak[ct] * rs);
        const f32x4 rv = *(const f32x4*)(rkv + rt * 16 + fq * 4);
        const int b = t0 / SEQ, s0 = (t0 % SEQ) + rt * 16 + fq * 4;
#pragma unroll
        for (int ct = 0; ct < 4; ++ct) *(u32x2*)(Vt + ((size_t)(b * 8 + head) * 64 + ct * 16 + fr) * SEQ + s0) = pack4(av[ct] * rv);
    }
}

__device__ __forceinline__ void gmlp_item(const Params& p, int l, int item, unsigned char* lds) {
    const int tid = tid_l(), lane = tid & 63, wave = tid >> 6, fr = lane & 15, fq = lane >> 4;
    const int t0 = item * 128;
    const bf16_t* P1 = (const bf16_t*)(p.ws + OFF_R1); bf16_t* Z = (bf16_t*)(p.ws + OFF_Z);
    const bf16_t* Ws = (const bf16_t*)(p.ws + OFF_WS) + (size_t)l * 4 * 128 * 128;
    bf16_t* vb = (bf16_t*)lds;
    constexpr int VS = 520;
    __syncthreads();
    { const int tok = tid >> 2, qd = tid & 3; const bf16_t* pr = P1 + (size_t)(t0 + tok) * NP1 + C_GMV + qd * 128;
        float s = 0.f, s2 = 0.f;
#pragma unroll 4
        for (int i = 0; i < 16; ++i) { const u32x4 u = *(const u32x4*)(pr + i * 8); const unsigned uu[4] = {u.x, u.y, u.z, u.w};
#pragma unroll
            for (int e = 0; e < 4; ++e) { const float a = geluf_(bf_lo(uu[e])), b = geluf_(bf_hi(uu[e])); s += a + b; s2 += a * a + b * b; } }
        s += __shfl_xor(s, 1); s += __shfl_xor(s, 2); s2 += __shfl_xor(s2, 1); s2 += __shfl_xor(s2, 2);
        const float mean = s * (1.f / 512.f), var = fmaxf(s2 * (1.f / 512.f) - mean * mean, 0.f), rstd = rsqrtf(var + 1e-5f);
        const float* lg = p.ln_g + (size_t)l * 512 + qd * 128; const float* lb = p.ln_b + (size_t)l * 512 + qd * 128;
#pragma unroll 4
        for (int i = 0; i < 16; ++i) { const u32x4 u = *(const u32x4*)(pr + i * 8); const unsigned uu[4] = {u.x, u.y, u.z, u.w}; unsigned oo[4];
#pragma unroll
            for (int e = 0; e < 4; ++e) { const float a = (geluf_(bf_lo(uu[e])) - mean) * rstd * lg[i * 8 + 2 * e] + lb[i * 8 + 2 * e], b = (geluf_(bf_hi(uu[e])) - mean) * rstd * lg[i * 8 + 2 * e + 1] + lb[i * 8 + 2 * e + 1];
                oo[e] = cvt_pk_bf16(a, b); }
            *(u32x4*)(vb + (size_t)tok * VS + qd * 128 + i * 8) = (u32x4){oo[0], oo[1], oo[2], oo[3]}; }
    }
    __syncthreads();
#pragma unroll 1
    for (int g = 0; g < 4; ++g) {
        const int cbase = g * 128 + wave * 16;
        bf16x8 vfr[4];
#pragma unroll
        for (int ks = 0; ks < 4; ++ks) { bf16x8 f;
#pragma unroll
            for (int j = 0; j < 8; ++j) f[j] = (short)vb[(size_t)(ks * 32 + fq * 8 + j) * VS + cbase + fr];
            vfr[ks] = f; }
        const bf16_t* wg = Ws + (size_t)g * 128 * 128;
#pragma unroll 1
        for (int tt = 0; tt < 8; ++tt) {
            f32x4 acc = (f32x4){0.f, 0.f, 0.f, 0.f};
            const bf16_t* wp = wg + (size_t)(tt * 16 + fr) * 128 + fq * 8;
#pragma unroll
            for (int ks = 0; ks < 4; ++ks) acc = MFMA(vfr[ks], ld_frag(wp + ks * 32), acc);
            const int tl = tt * 16 + fr, t = t0 + tl, c = cbase + fq * 4;
            const float bs = p.b_s[(size_t)(l * 4 + g) * 128 + tl];
            const f32x4 u = unpack4(*(const u32x2*)(P1 + (size_t)t * NP1 + C_GMU + c));
            bf16_t* zp = Z + (size_t)t * NZ + 512 + c; const f32x4 z = unpack4(*(const u32x2*)zp);
            f32x4 o;
#pragma unroll
            for (int e = 0; e < 4; ++e) o[e] = geluf_(u[e]) * (acc[e] + bs) * siluf_(z[e]);
            *(u32x2*)zp = pack4(o);
        }
    }
}

__device__ __forceinline__ f32x4 mix4(const bf16_t* pr, const bf16_t* pp, bool has_prev, const float* mu) {
    const f32x4 a = unpack4(*(const u32x2*)pr); f32x4 b = (f32x4){0.f, 0.f, 0.f, 0.f}; if (has_prev) b = unpack4(*(const u32x2*)pp);
    const f32x4 m = *(const f32x4*)mu; return a + (b - a) * m;
}
__device__ __forceinline__ void rwkv_prep_item(const Params& p, int l, int item) {
    const int tid = tid_l(), lane = tid & 63, wave = tid >> 6, fr = lane & 15, fq = lane >> 4;
    const int rt = wave >> 1, hh = wave & 1;
    const int t = item * 64 + rt * 16 + fr; const bool hp = (t % SEQ) != 0;
    const bf16_t* P1 = (const bf16_t*)(p.ws + OFF_R1);
    const bf16_t* pr = P1 + (size_t)t * NP1; const bf16_t* pp = pr - NP1;
    const float* mu = p.mu + (size_t)l * 1664 - C_RW;
    const bf16_t* W2T = (const bf16_t*)(p.ws + OFF_W2T) + (size_t)l * 512 * 64; const bf16_t* A2T = (const bf16_t*)(p.ws + OFF_A2T) + (size_t)l * 512 * 64;
    unsigned char* r2 = p.ws + OFF_R2;
    bf16_t* VF = (bf16_t*)(p.ws + OFF_VF);
    bf16x8 fa[2], fw[2];
#pragma unroll
    for (int ks = 0; ks < 2; ++ks) { const int ca = C_ALAT + ks * 32 + fq * 8, cw = C_WLAT + ks * 32 + fq * 8;
        const f32x4 a0 = mix4(pr + ca, pp + ca, hp, mu + ca), a1 = mix4(pr + ca + 4, pp + ca + 4, hp, mu + ca + 4);
        f32x4 w0 = mix4(pr + cw, pp + cw, hp, mu + cw), w1 = mix4(pr + cw + 4, pp + cw + 4, hp, mu + cw + 4);
#pragma unroll
        for (int e = 0; e < 4; ++e) { w0[e] = tanhf(w0[e]); w1[e] = tanhf(w1[e]); }
        fa[ks] = pack_frag(a0, a1); fw[ks] = pack_frag(w0, w1); }
    bf16x8 t1f = (bf16x8){0, 0, 0, 0, 0, 0, 0, 0};
    if (l >= 1) { const bf16_t* V1T = (const bf16_t*)(p.ws + OFF_V1T) + (size_t)(l - 1) * 32 * 512;
        f32x4 c0 = (f32x4){0.f, 0.f, 0.f, 0.f}, c1 = c0;
#pragma unroll 2
        for (int ks = 0; ks < 16; ++ks) { const int cv = C_RWV + ks * 32 + fq * 8;
            const bf16x8 af = pack_frag(mix4(pr + cv, pp + cv, hp, mu + cv), mix4(pr + cv + 4, pp + cv + 4, hp, mu + cv + 4));
            c0 = MFMA(ld_frag(V1T + (size_t)fr * 512 + ks * 32 + fq * 8), af, c0); c1 = MFMA(ld_frag(V1T + (size_t)(16 + fr) * 512 + ks * 32 + fq * 8), af, c1); }
        t1f = pack_frag(c0, c1);
    }
#pragma unroll 1
    for (int hq = 0; hq < 4; ++hq) { const int h = hh * 4 + hq;
        float ss = 0.f;
#pragma unroll
        for (int ct = 0; ct < 4; ++ct) { const int c = h * 64 + ct * 16 + fq * 4;
            const f32x4 kr = mix4(pr + C_RWK + c, pp + C_RWK + c, hp, mu + C_RWK + c) * *(const f32x4*)(p.k_k + (size_t)l * 512 + c);
            ss += kr[0] * kr[0] + kr[1] * kr[1] + kr[2] * kr[2] + kr[3] * kr[3]; }
        ss += __shfl_xor(ss, 16); ss += __shfl_xor(ss, 32);
        const float inv = 1.f / fmaxf(sqrtf(ss), 1e-12f);
        float dsum = 0.f;
#pragma unroll 1
        for (int ct = 0; ct < 4; ++ct) { const int crow = h * 64 + ct * 16 + fr;
            f32x4 aa = (f32x4){0.f, 0.f, 0.f, 0.f}, aw = aa, avm = aa;
#pragma unroll
            for (int ks = 0; ks < 2; ++ks) { aa = MFMA(ld_frag(A2T + (size_t)crow * 64 + ks * 32 + fq * 8), fa[ks], aa); aw = MFMA(ld_frag(W2T + (size_t)crow * 64 + ks * 32 + fq * 8), fw[ks], aw); }
            if (l >= 1) { const bf16_t* V2T = (const bf16_t*)(p.ws + OFF_V2T) + (size_t)(l - 1) * 512 * 32 + (size_t)crow * 32;
                avm = MFMA(join_frag(*(const u32x2*)(V2T + fq * 4), *(const u32x2*)(V2T + 16 + fq * 4)), t1f, avm); }
            const int c = h * 64 + ct * 16 + fq * 4; const size_t o = (size_t)t * 512 + c;
            const f32x4 rs = mix4(pr + C_RWR + c, pp + C_RWR + c, hp, mu + C_RWR + c);
            const f32x4 ksv = mix4(pr + C_RWK + c, pp + C_RWK + c, hp, mu + C_RWK + c);
            f32x4 vs = mix4(pr + C_RWV + c, pp + C_RWV + c, hp, mu + C_RWV + c);
            const f32x4 a0 = *(const f32x4*)(p.a0 + (size_t)l * 512 + c), w0 = *(const f32x4*)(p.w0 + (size_t)l * 512 + c), kkw = *(const f32x4*)(p.k_k + (size_t)l * 512 + c);
            const f32x4 ka = *(const f32x4*)(p.k_a + (size_t)l * 512 + c);
            f32x4 lw, asg;
#pragma unroll
            for (int e = 0; e < 4; ++e) { asg[e] = sigmoidf_(a0[e] + aa[e]); lw[e] = -0.6065306597126334f * sigmoidf_(w0[e] + aw[e]); }
            *(f32x4*)((float*)(r2 + R2_LW) + o) = lw;
            if (l == 0) { *(u32x2*)(VF + o) = pack4(vs); }
            else { const f32x4 vf = unpack4(*(const u32x2*)(VF + o)), v0 = *(const f32x4*)(p.v0 + (size_t)(l - 1) * 512 + c);
#pragma unroll
                for (int e = 0; e < 4; ++e) vs[e] = vs[e] + (vf[e] - vs[e]) * sigmoidf_(v0[e] + avm[e]); }
            const f32x4 kk = ksv * kkw * inv, km = ksv * ((asg - 1.f) * ka + 1.f), bb = kk * asg;
            { const f32x4 rk = *(const f32x4*)(p.r_k + (size_t)l * 512 + c); const f32x4 pr3 = rs * km * rk; dsum += pr3[0] + pr3[1] + pr3[2] + pr3[3]; }
            *(u32x2*)((bf16_t*)(r2 + R2_R) + o) = pack4(rs); *(u32x2*)((bf16_t*)(r2 + R2_K) + o) = pack4(km); *(u32x2*)((bf16_t*)(r2 + R2_V) + o) = pack4(vs);
            *(u32x2*)((bf16_t*)(r2 + R2_KK) + o) = pack4(kk); *(u32x2*)((bf16_t*)(r2 + R2_B) + o) = pack4(bb); }
        dsum += __shfl_xor(dsum, 16); dsum += __shfl_xor(dsum, 32);
        if (fq == 0) ((float*)(p.ws + OFF_DOT))[(size_t)t * 8 + h] = dsum;
    }
}

__device__ __forceinline__ void attn_item(const Params& p, int b, int h, int qb, unsigned char* lds) {
    const int tid = tid_l(), lane = tid & 63, wave = tid >> 6, fr = lane & 15, fq = lane >> 4;
    const bf16_t* Q = (const bf16_t*)(p.ws + OFF_R3 + R3_Q); const bf16_t* Kf = (const bf16_t*)(p.ws + OFF_R3 + R3_KF); const bf16_t* Vt = (const bf16_t*)(p.ws + OFF_R3 + R3_VT);
    bf16_t* Z = (bf16_t*)(p.ws + OFF_Z);
    constexpr int KS = 104, VS = 72, KB = 64 * KS * 2, VB = 64 * VS * 2, BUF = KB + VB;
    const int nkt = 2 * qb + 2, mykt = (wave < 4) ? nkt - 1 : nkt;
    const int trow = b * SEQ + qb * 128 + wave * 16 + fr;
    bf16x8 qf[3];
#pragma unroll
    for (int ks = 0; ks < 3; ++ks) qf[ks] = ld_frag(Q + (size_t)trow * 768 + h * 96 + ks * 32 + fq * 8);
    const bf16_t* kg = Kf + (size_t)(b * SEQ) * 768 + h * 96; const bf16_t* vg = Vt + (size_t)(b * 8 + h) * 64 * SEQ;
    const int kr0 = tid / 12, kc0 = tid % 12, kr1 = (tid + 512) / 12, kc1 = (tid + 512) % 12, vd = tid >> 3, vc = tid & 7;
    u32x4 pk0, pk1 = (u32x4){0, 0, 0, 0}, pv;
    __syncthreads();
    pk0 = *(const u32x4*)(kg + (size_t)kr0 * 768 + kc0 * 8); if (tid < 256) pk1 = *(const u32x4*)(kg + (size_t)kr1 * 768 + kc1 * 8);
    pv = *(const u32x4*)(vg + (size_t)vd * SEQ + vc * 8);
    { bf16_t* ks_ = (bf16_t*)lds; bf16_t* vs_ = (bf16_t*)(lds + KB);
        *(u32x4*)(ks_ + kr0 * KS + kc0 * 8) = pk0; if (tid < 256) *(u32x4*)(ks_ + kr1 * KS + kc1 * 8) = pk1; *(u32x4*)(vs_ + vd * VS + vc * 8) = pv; }
    __syncthreads();
    f32x4 O[4]; float m = -1e30f, lsum = 0.f;
#pragma unroll
    for (int d = 0; d < 4; ++d) O[d] = (f32x4){0.f, 0.f, 0.f, 0.f};
#pragma unroll 1
    for (int kt = 0; kt < nkt; ++kt) {
        const bool pre = (kt + 1 < nkt);
        if (pre) { const size_t ko = (size_t)(kt + 1) * 64;
            pk0 = *(const u32x4*)(kg + (ko + kr0) * 768 + kc0 * 8); if (tid < 256) pk1 = *(const u32x4*)(kg + (ko + kr1) * 768 + kc1 * 8);
            pv = *(const u32x4*)(vg + (size_t)vd * SEQ + ko + vc * 8); }
        if (kt < mykt) {
            const bf16_t* ks_ = (const bf16_t*)(lds + (kt & 1) * BUF); const bf16_t* vs_ = (const bf16_t*)(lds + (kt & 1) * BUF + KB);
            f32x4 s[4];
#pragma unroll
            for (int c4 = 0; c4 < 4; ++c4) { s[c4] = (f32x4){0.f, 0.f, 0.f, 0.f};
#pragma unroll
                for (int ks = 0; ks < 3; ++ks) s[c4] = MFMA(ld_frag(ks_ + (c4 * 16 + fr) * KS + ks * 32 + fq * 8), qf[ks], s[c4]); }
            float mx = -1e30f;
#pragma unroll
            for (int c4 = 0; c4 < 4; ++c4) mx = fmaxf(fmaxf(fmaxf(s[c4][0], s[c4][1]), fmaxf(s[c4][2], s[c4][3])), mx);
            mx = fmaxf(mx, __shfl_xor(mx, 16)); mx = fmaxf(mx, __shfl_xor(mx, 32));
            const float mn = fmaxf(m, mx), alpha = exp2f(m - mn); m = mn;
            float ps = 0.f;
#pragma unroll
            for (int c4 = 0; c4 < 4; ++c4)
#pragma unroll
                for (int e = 0; e < 4; ++e) { s[c4][e] = exp2f(s[c4][e] - mn); ps += s[c4][e]; }
            lsum = lsum * alpha + ps;
#pragma unroll
            for (int d = 0; d < 4; ++d) O[d] = O[d] * alpha;
            const bf16x8 pf0 = pack_frag(s[0], s[1]), pf1 = pack_frag(s[2], s[3]);
#pragma unroll
            for (int d = 0; d < 4; ++d) { const bf16_t* vp = vs_ + (d * 16 + fr) * VS + fq * 4;
                O[d] = MFMA(join_frag(*(const u32x2*)(vp), *(const u32x2*)(vp + 16)), pf0, O[d]);
                O[d] = MFMA(join_frag(*(const u32x2*)(vp + 32), *(const u32x2*)(vp + 48)), pf1, O[d]); }
        }
        if (pre) { bf16_t* ks_ = (bf16_t*)(lds + ((kt + 1) & 1) * BUF); bf16_t* vs_ = (bf16_t*)(lds + ((kt + 1) & 1) * BUF + KB);
            *(u32x4*)(ks_ + kr0 * KS + kc0 * 8) = pk0; if (tid < 256) *(u32x4*)(ks_ + kr1 * KS + kc1 * 8) = pk1; *(u32x4*)(vs_ + vd * VS + vc * 8) = pv; }
        __syncthreads();
    }
    lsum += __shfl_xor(lsum, 16); lsum += __shfl_xor(lsum, 32);
    const float il = 1.f / lsum;
#pragma unroll
    for (int d = 0; d < 4; ++d) { bf16_t* zp = Z + (size_t)trow * NZ + h * 64 + d * 16 + fq * 4; const f32x4 z = unpack4(*(const u32x2*)zp);
        f32x4 o;
#pragma unroll
        for (int e = 0; e < 4; ++e) o[e] = O[d][e] * il * siluf_(z[e]);
        *(u32x2*)zp = pack4(o); }
}

__device__ __forceinline__ void scan_item(const Params& p, int l, int bh, unsigned char* lds) {
    const int tid = tid_l(), b = bh >> 3, h = bh & 7;
    const unsigned char* r2 = p.ws + OFF_R2; bf16_t* Z = (bf16_t*)(p.ws + OFF_Z);
    float* Lw = (float*)lds; float* La = Lw + 4096; float* Lb = La + 4096; float* Lk = Lb + 4096; float* Lr = Lk + 4096; float* Lv = Lr + 4096; float* Ly = Lv + 4096;
    const int i = tid >> 3, jp = tid & 7;
    float st[8];
#pragma unroll
    for (int e = 0; e < 8; ++e) st[e] = 0.f;
    const int et = tid >> 3, ep = tid & 7;
#pragma unroll 1
    for (int ck = 0; ck < SEQ / 64; ++ck) {
        const size_t tg = (size_t)b * SEQ + ck * 64 + et; const size_t o = tg * 512 + h * 64 + ep * 8;
        __syncthreads();
        { const u32x4 ur = *(const u32x4*)((const bf16_t*)(r2 + R2_R) + o), uk = *(const u32x4*)((const bf16_t*)(r2 + R2_K) + o), uv = *(const u32x4*)((const bf16_t*)(r2 + R2_V) + o),
                      ukk = *(const u32x4*)((const bf16_t*)(r2 + R2_KK) + o), ub = *(const u32x4*)((const bf16_t*)(r2 + R2_B) + o);
            const f32x4 l0 = *(const f32x4*)((const float*)(r2 + R2_LW) + o), l1 = *(const f32x4*)((const float*)(r2 + R2_LW) + o + 4);
            const int lo = et * 64 + ep * 8;
            *(f32x4*)(Lw + lo) = (f32x4){__expf(l0[0]), __expf(l0[1]), __expf(l0[2]), __expf(l0[3])}; *(f32x4*)(Lw + lo + 4) = (f32x4){__expf(l1[0]), __expf(l1[1]), __expf(l1[2]), __expf(l1[3])};
            *(f32x4*)(La + lo) = (f32x4){-bf_lo(ukk.x), -bf_hi(ukk.x), -bf_lo(ukk.y), -bf_hi(ukk.y)}; *(f32x4*)(La + lo + 4) = (f32x4){-bf_lo(ukk.z), -bf_hi(ukk.z), -bf_lo(ukk.w), -bf_hi(ukk.w)};
            *(f32x4*)(Lb + lo) = (f32x4){bf_lo(ub.x), bf_hi(ub.x), bf_lo(ub.y), bf_hi(ub.y)}; *(f32x4*)(Lb + lo + 4) = (f32x4){bf_lo(ub.z), bf_hi(ub.z), bf_lo(ub.w), bf_hi(ub.w)};
            *(f32x4*)(Lk + lo) = (f32x4){bf_lo(uk.x), bf_hi(uk.x), bf_lo(uk.y), bf_hi(uk.y)}; *(f32x4*)(Lk + lo + 4) = (f32x4){bf_lo(uk.z), bf_hi(uk.z), bf_lo(uk.w), bf_hi(uk.w)};
            *(f32x4*)(Lr + lo) = (f32x4){bf_lo(ur.x), bf_hi(ur.x), bf_lo(ur.y), bf_hi(ur.y)}; *(f32x4*)(Lr + lo + 4) = (f32x4){bf_lo(ur.z), bf_hi(ur.z), bf_lo(ur.w), bf_hi(ur.w)};
            *(f32x4*)(Lv + lo) = (f32x4){bf_lo(uv.x), bf_hi(uv.x), bf_lo(uv.y), bf_hi(uv.y)}; *(f32x4*)(Lv + lo + 4) = (f32x4){bf_lo(uv.z), bf_hi(uv.z), bf_lo(uv.w), bf_hi(uv.w)};
        }
        __syncthreads();
#pragma unroll 1
        for (int t = 0; t < 64; ++t) { const int lo = t * 64 + jp * 8;
            const f32x4 w0 = *(const f32x4*)(Lw + lo), w1 = *(const f32x4*)(Lw + lo + 4), a0 = *(const f32x4*)(La + lo), a1 = *(const f32x4*)(La + lo + 4), b0 = *(const f32x4*)(Lb + lo), b1 = *(const f32x4*)(Lb + lo + 4),
                        k0 = *(const f32x4*)(Lk + lo), k1 = *(const f32x4*)(Lk + lo + 4), r0 = *(const f32x4*)(Lr + lo), r1 = *(const f32x4*)(Lr + lo + 4);
            const float vi = Lv[t * 64 + i];
            float sa = st[0] * a0[0] + st[1] * a0[1] + st[2] * a0[2] + st[3] * a0[3] + st[4] * a1[0] + st[5] * a1[1] + st[6] * a1[2] + st[7] * a1[3];
            sa += __shfl_xor(sa, 1); sa += __shfl_xor(sa, 2); sa += __shfl_xor(sa, 4);
            st[0] = st[0] * w0[0] + sa * b0[0] + vi * k0[0]; st[1] = st[1] * w0[1] + sa * b0[1] + vi * k0[1]; st[2] = st[2] * w0[2] + sa * b0[2] + vi * k0[2]; st[3] = st[3] * w0[3] + sa * b0[3] + vi * k0[3];
            st[4] = st[4] * w1[0] + sa * b1[0] + vi * k1[0]; st[5] = st[5] * w1[1] + sa * b1[1] + vi * k1[1]; st[6] = st[6] * w1[2] + sa * b1[2] + vi * k1[2]; st[7] = st[7] * w1[3] + sa * b1[3] + vi * k1[3];
            float y = st[0] * r0[0] + st[1] * r0[1] + st[2] * r0[2] + st[3] * r0[3] + st[4] * r1[0] + st[5] * r1[1] + st[6] * r1[2] + st[7] * r1[3];
            y += __shfl_xor(y, 1); y += __shfl_xor(y, 2); y += __shfl_xor(y, 4);
            if (jp == 0) Ly[t * 64 + i] = y;
        }
        __syncthreads();
        { const int lo = et * 64 + ep * 8;
            const f32x4 y0 = *(const f32x4*)(Ly + lo), y1 = *(const f32x4*)(Ly + lo + 4), r0 = *(const f32x4*)(Lr + lo), r1 = *(const f32x4*)(Lr + lo + 4), k0 = *(const f32x4*)(Lk + lo), k1 = *(const f32x4*)(Lk + lo + 4),
                        v0 = *(const f32x4*)(Lv + lo), v1 = *(const f32x4*)(Lv + lo + 4);
            const f32x4 rk0 = *(const f32x4*)(p.r_k + (size_t)l * 512 + h * 64 + ep * 8), rk1 = *(const f32x4*)(p.r_k + (size_t)l * 512 + h * 64 + ep * 8 + 4);
            float s = y0[0] + y0[1] + y0[2] + y0[3] + y1[0] + y1[1] + y1[2] + y1[3];
            float dot = r0[0] * k0[0] * rk0[0] + r0[1] * k0[1] * rk0[1] + r0[2] * k0[2] * rk0[2] + r0[3] * k0[3] * rk0[3] + r1[0] * k1[0] * rk1[0] + r1[1] * k1[1] * rk1[1] + r1[2] * k1[2] * rk1[2] + r1[3] * k1[3] * rk1[3];
            s += __shfl_xor(s, 1); s += __shfl_xor(s, 2); s += __shfl_xor(s, 4);
            dot += __shfl_xor(dot, 1); dot += __shfl_xor(dot, 2); dot += __shfl_xor(dot, 4);
            const float mean = s * (1.f / 64.f);
            const f32x4 d0 = y0 - mean, d1 = y1 - mean;
            float q = d0[0] * d0[0] + d0[1] * d0[1] + d0[2] * d0[2] + d0[3] * d0[3] + d1[0] * d1[0] + d1[1] * d1[1] + d1[2] * d1[2] + d1[3] * d1[3];
            q += __shfl_xor(q, 1); q += __shfl_xor(q, 2); q += __shfl_xor(q, 4);
            const float rstd = rsqrtf(q * (1.f / 64.f) + 64e-5f);
            const f32x4 g0 = *(const f32x4*)(p.lnx_g + (size_t)l * 512 + h * 64 + ep * 8), g1 = *(const f32x4*)(p.lnx_g + (size_t)l * 512 + h * 64 + ep * 8 + 4),
                        e0 = *(const f32x4*)(p.lnx_b + (size_t)l * 512 + h * 64 + ep * 8), e1 = *(const f32x4*)(p.lnx_b + (size_t)l * 512 + h * 64 + ep * 8 + 4);
            bf16_t* zp = Z + tg * NZ + 1024 + h * 64 + ep * 8; const u32x4 zu = *(const u32x4*)zp;
            const f32x4 o0 = d0 * rstd * g0 + e0 + v0 * dot, o1 = d1 * rstd * g1 + e1 + v1 * dot;
            u32x4 w; w.x = cvt_pk_bf16(o0[0] * siluf_(bf_lo(zu.x)), o0[1] * siluf_(bf_hi(zu.x))); w.y = cvt_pk_bf16(o0[2] * siluf_(bf_lo(zu.y)), o0[3] * siluf_(bf_hi(zu.y)));
            w.z = cvt_pk_bf16(o1[0] * siluf_(bf_lo(zu.z)), o1[1] * siluf_(bf_hi(zu.z))); w.w = cvt_pk_bf16(o1[2] * siluf_(bf_lo(zu.w)), o1[3] * siluf_(bf_hi(zu.w)));
            *(u32x4*)zp = w; }
    }
}


constexpr int MS = 72;
__device__ __forceinline__ f32x4 nt_tile(const bf16_t* Am, int arow, const bf16_t* Bm, int brow, f32x4 acc, int fq) {
    acc = MFMA(ld_frag(Am + arow * MS + fq * 8), ld_frag(Bm + brow * MS + fq * 8), acc);
    acc = MFMA(ld_frag(Am + arow * MS + 32 + fq * 8), ld_frag(Bm + brow * MS + 32 + fq * 8), acc);
    return acc;
}
#if PROBE_SCAN
#define CHKF_OLD(ptr, n, bit) do { unsigned _c = 0u; for (int _i = tid; _i < (n); _i += NTHREADS) { const float _a = (ptr)[_i]; if (!(fabsf(_a) < 1e30f)) _c = (bit); } if (_c) atomicOr((unsigned*)(p.ws + WS_END + 5 * MiB), _c); } while (0)
#define CHKB_OLD(ptr, bit) do { unsigned _c = 0u; for (int _i = tid; _i < 4096; _i += NTHREADS) { const float _a = bf2f((ptr)[(_i >> 6) * MS + (_i & 63)]); if (!(fabsf(_a) < 1e30f)) _c = (bit); } if (_c) atomicOr((unsigned*)(p.ws + WS_END + 5 * MiB), _c); } while (0)
#endif
#define CHKF(ptr, n, bit)
#define CHKB(ptr, bit)
__device__ __forceinline__ void chunk_item(const Params& p, int item, unsigned char* lds) {
    const int tid = tid_l(), lane = tid & 63, wave = __builtin_amdgcn_readfirstlane(tid >> 6), fr = lane & 15, fq = lane >> 4;
    const int bh = item >> 6, ck = item & 63, b = bh >> 3, h = bh & 7;
    const size_t tok0 = (size_t)b * SEQ + ck * 64;
    const unsigned char* r2 = p.ws + OFF_R2; unsigned char* r1 = p.ws + OFF_R1;
    float* CUM = (float*)lds; float* TF = CUM + 4096; float* XB = TF + 4096; float* TOT = XB + 1024;
    bf16_t* MB = (bf16_t*)(lds + 38912);
    bf16_t *AT_ = MB, *BT_ = MB + 1 * 64 * MS, *KT_ = MB + 2 * 64 * MS, *RT_ = MB + 3 * 64 * MS, *ATT = MB + 4 * 64 * MS, *VT = MB + 5 * 64 * MS, *KHT = MB + 6 * 64 * MS, *BHT = MB + 7 * 64 * MS,
           *MAK = MB + 8 * 64 * MS, *MRB = MB + 9 * 64 * MS, *MRK = MB + 10 * 64 * MS, *TB = MB + 11 * 64 * MS;
    bf16_t *MVT = AT_, *TAT = BT_, *W1T = KT_;
    const float* LWg = (const float*)(r2 + R2_LW);
    __syncthreads();
    { float c[8]; float run = 0.f;
#pragma unroll
        for (int e = 0; e < 8; ++e) { run += LWg[(tok0 + wave * 8 + e) * 512 + h * 64 + lane]; c[e] = run; }
        TOT[wave * 64 + lane] = run;
        __syncthreads();
        float off = 0.f;
#pragma unroll
        for (int w2 = 0; w2 < 7; ++w2) off += (w2 < wave) ? TOT[w2 * 64 + lane] : 0.f;
#pragma unroll
        for (int e = 0; e < 8; ++e) CUM[(wave * 8 + e) * 64 + lane] = off + c[e];
    }
    __syncthreads();
    { const int t = tid & 63, j0 = (tid >> 6) * 8; const size_t o = (tok0 + t) * 512 + h * 64 + j0;
        const u32x4 ur = *(const u32x4*)((const bf16_t*)(r2 + R2_R) + o), uk = *(const u32x4*)((const bf16_t*)(r2 + R2_K) + o), uv = *(const u32x4*)((const bf16_t*)(r2 + R2_V) + o),
                    ukk = *(const u32x4*)((const bf16_t*)(r2 + R2_KK) + o), ub = *(const u32x4*)((const bf16_t*)(r2 + R2_B) + o);
        const unsigned rr[4] = {ur.x, ur.y, ur.z, ur.w}, kr[4] = {uk.x, uk.y, uk.z, uk.w}, vr[4] = {uv.x, uv.y, uv.z, uv.w}, qr[4] = {ukk.x, ukk.y, ukk.z, ukk.w}, br[4] = {ub.x, ub.y, ub.z, ub.w};
        unsigned oa[4], ob[4], ok[4], orr[4];
#pragma unroll
        for (int e2 = 0; e2 < 4; ++e2) { float va[2], vb[2], vk[2], vrr[2];
#pragma unroll
            for (int hh = 0; hh < 2; ++hh) { const int e = 2 * e2 + hh;
                const float cm = CUM[t * 64 + j0 + e], lwv = LWg[o + e], cC = CUM[63 * 64 + j0 + e];
                const float rv = hh ? bf_hi(rr[e2]) : bf_lo(rr[e2]), kv = hh ? bf_hi(kr[e2]) : bf_lo(kr[e2]), vv = hh ? bf_hi(vr[e2]) : bf_lo(vr[e2]), qv = hh ? bf_hi(qr[e2]) : bf_lo(qr[e2]), bv = hh ? bf_hi(br[e2]) : bf_lo(br[e2]);
                const float en = __expf(-cm), eh = __expf(cC - cm);
                va[hh] = -qv * __expf(cm - lwv); vb[hh] = bv * en; vk[hh] = kv * en; vrr[hh] = rv * __expf(cm);
                ATT[(j0 + e) * MS + t] = f2bf(va[hh]); VT[(j0 + e) * MS + t] = f2bf(vv); KHT[(j0 + e) * MS + t] = f2bf(kv * eh); BHT[(j0 + e) * MS + t] = f2bf(bv * eh);
                if (t == 63) ((float*)(r1 + R1_PC))[(size_t)item * 64 + j0 + e] = __expf(cC); }
            oa[e2] = cvt_pk_bf16(va[0], va[1]); ob[e2] = cvt_pk_bf16(vb[0], vb[1]); ok[e2] = cvt_pk_bf16(vk[0], vk[1]); orr[e2] = cvt_pk_bf16(vrr[0], vrr[1]); }
        *(u32x4*)(AT_ + t * MS + j0) = (u32x4){oa[0], oa[1], oa[2], oa[3]}; *(u32x4*)(BT_ + t * MS + j0) = (u32x4){ob[0], ob[1], ob[2], ob[3]};
        *(u32x4*)(KT_ + t * MS + j0) = (u32x4){ok[0], ok[1], ok[2], ok[3]}; *(u32x4*)(RT_ + t * MS + j0) = (u32x4){orr[0], orr[1], orr[2], orr[3]};
    }
    __syncthreads();
#pragma unroll 1
    for (int x = 0; x < 8; ++x) { const int q = wave * 8 + x, mat = q >> 4, tm = (q >> 2) & 3, tn = q & 3;
        const bf16_t* Am = (mat & 1) ? KT_ : BT_; const bf16_t* Bm = (mat & 2) ? RT_ : AT_;
        f32x4 acc = nt_tile(Am, tm * 16 + fr, Bm, tn * 16 + fr, (f32x4){0.f, 0.f, 0.f, 0.f}, fq);
        const int t = tn * 16 + fr, s0 = tm * 16 + fq * 4;
#pragma unroll
        for (int e = 0; e < 4; ++e) { const bool keep = (mat & 2) ? (s0 + e <= t) : (s0 + e < t); acc[e] = keep ? acc[e] : 0.f; }
        if (mat == 0) *(f32x4*)(CUM + t * 64 + s0) = acc;
        else { bf16_t* Om = (mat == 1) ? MAK : (mat == 2) ? MRB : MRK; *(u32x2*)(Om + t * MS + s0) = pack4(acc); }
    }
    __syncthreads();

    if (wave == 0) { const int base = (lane >> 5) * 32, c = lane & 31; float xv[32]; int roff = base * 65; float prev = 0.f;
#pragma unroll
        for (int t = 0; t < 32; ++t) { float a = (t == c) ? 1.f : 0.f;
            asm volatile("" : "+v"(roff), "+v"(prev));
            const float* Lr = CUM + roff + t * 64;
#pragma unroll
            for (int s2 = 0; s2 < t; ++s2) a += Lr[s2] * xv[s2];
            xv[t] = a; prev = a; }
#pragma unroll
        for (int t = 0; t < 32; ++t) { TF[(base + t) * 64 + base + c] = xv[t]; if (base == 0) TF[t * 64 + 32 + c] = 0.f; }
    }
    __syncthreads();
    { const int r = tid >> 4, c0 = (tid & 15) * 2; float x0 = 0.f, x1 = 0.f;
#pragma unroll 8
        for (int k = 0; k < 32; ++k) { const float lv = CUM[(32 + r) * 64 + k]; x0 += lv * TF[k * 64 + c0]; x1 += lv * TF[k * 64 + c0 + 1]; }
        XB[r * 32 + c0] = x0; XB[r * 32 + c0 + 1] = x1;
        __syncthreads();
        float y0 = 0.f, y1 = 0.f;
#pragma unroll 8
        for (int k = 0; k < 32; ++k) { const float tv = TF[(32 + r) * 64 + 32 + k]; y0 += tv * XB[k * 32 + c0]; y1 += tv * XB[k * 32 + c0 + 1]; }
        TF[(32 + r) * 64 + c0] = y0; TF[(32 + r) * 64 + c0 + 1] = y1;
    }
    __syncthreads();
    { const int t = tid >> 3, s0 = (tid & 7) * 8; const f32x4 a = *(const f32x4*)(TF + t * 64 + s0), b2 = *(const f32x4*)(TF + t * 64 + s0 + 4);
        u32x4 w; w.x = cvt_pk_bf16(a[0], a[1]); w.y = cvt_pk_bf16(a[2], a[3]); w.z = cvt_pk_bf16(b2[0], b2[1]); w.w = cvt_pk_bf16(b2[2], b2[3]);
        *(u32x4*)(TB + t * MS + s0) = w; }
    __syncthreads();
#pragma unroll 1
    for (int x = 0; x < 4; ++x) { const int q = wave * 4 + x, mat = q >> 4, tm = (q >> 2) & 3, tn = q & 3;
        const f32x4 acc = nt_tile(mat ? TB : MAK, tm * 16 + fr, mat ? ATT : VT, tn * 16 + fr, (f32x4){0.f, 0.f, 0.f, 0.f}, fq);
        *(u32x2*)((mat ? TAT : MVT) + (tn * 16 + fr) * MS + tm * 16 + fq * 4) = pack4(acc); }
    __syncthreads();
#pragma unroll 1
    for (int x = 0; x < 2; ++x) { const int q = wave * 2 + x, tm = q >> 2, tn = q & 3;
        const f32x4 acc = nt_tile(TB, tm * 16 + fr, MVT, tn * 16 + fr, (f32x4){0.f, 0.f, 0.f, 0.f}, fq);
        *(u32x2*)(W1T + (tn * 16 + fr) * MS + tm * 16 + fq * 4) = pack4(acc); }
    __syncthreads();
#pragma unroll 1
    for (int x = 0; x < 8; ++x) { const int q = wave * 8 + x, o = q >> 4, tm = (q >> 2) & 3, tn = q & 3;
        const int ar = tm * 16 + fr, br_ = tn * 16 + fr; f32x4 acc = (f32x4){0.f, 0.f, 0.f, 0.f};
        if (o == 0) acc = nt_tile(TAT, ar, BHT, br_, acc, fq);
        else if (o == 1) { acc = unpack4(*(const u32x2*)(RT_ + br_ * MS + tm * 16 + fq * 4)); acc = nt_tile(TAT, ar, MRB, br_, acc, fq); }
        else if (o == 2) { acc = nt_tile(KHT, ar, VT, br_, acc, fq); acc = nt_tile(BHT, ar, W1T, br_, acc, fq); }
        else { acc = nt_tile(VT, ar, MRK, br_, acc, fq);
#if EXP_CONSTY
            acc = (f32x4){1.f, 2.f, 3.f, 4.f};
#endif
#if !EXP_NOW1
            acc = nt_tile(W1T, ar, MRB, br_, acc, fq);
#endif
        }
        bf16_t* og = (bf16_t*)(r1 + (size_t)o * 16 * MiB) + (size_t)item * 4096 + br_ * 64 + tm * 16 + fq * 4;
        *(u32x2*)og = pack4(acc); }
}

__device__ __forceinline__ void seq_item(const Params& p, int l, int bh, unsigned char* lds, bf16_t* dstp, int dst_ld, size_t dst_tok0) {
    const int tid = tid_l(), lane = tid & 63, wave = __builtin_amdgcn_readfirstlane(tid >> 6), fr = lane & 15, fq = lane >> 4;
    const int b = bh >> 3, h = bh & 7;
    const unsigned char* r1 = p.ws + OFF_R1;
    constexpr int BUFB = 4 * 64 * MS * 2 + 256;
    bf16_t* SB = (bf16_t*)(lds + 2 * BUFB) + wave * 16 * MS;
    float* YB = (float*)(lds + 2 * BUFB + 4 * 16 * MS * 2);
    const int srow = tid >> 3, sc8 = tid & 7;
    u32x4 pre[4]; float prepc = 0.f;
    __syncthreads();
    { const size_t ci = (size_t)bh * 64;
#pragma unroll
        for (int m = 0; m < 4; ++m) pre[m] = *(const u32x4*)((const bf16_t*)(r1 + (size_t)m * 16 * MiB) + ci * 4096 + srow * 64 + sc8 * 8);
        if (tid < 64) prepc = ((const float*)(r1 + R1_PC))[ci * 64 + tid];
#pragma unroll
        for (int m = 0; m < 4; ++m) *(u32x4*)((bf16_t*)lds + m * 64 * MS + srow * MS + sc8 * 8) = pre[m];
        if (tid < 64) ((float*)(lds + 4 * 64 * MS * 2))[tid] = prepc;
        if (wave < 4) { for (int e = lane; e < 16 * MS / 2; e += 64) ((unsigned*)SB)[e] = 0u; }
    }
    __syncthreads();
    f32x4 Sacc[4];
#pragma unroll
    for (int jt = 0; jt < 4; ++jt) Sacc[jt] = (f32x4){0.f, 0.f, 0.f, 0.f};
#pragma unroll 1
    for (int c = 0; c < 64; ++c) {
        const bool pf = (c + 1 < 64);
        if (pf) { const size_t ci = (size_t)bh * 64 + c + 1;
#pragma unroll
            for (int m = 0; m < 4; ++m) pre[m] = *(const u32x4*)((const bf16_t*)(r1 + (size_t)m * 16 * MiB) + ci * 4096 + srow * 64 + sc8 * 8);
            if (tid < 64) prepc = ((const float*)(r1 + R1_PC))[ci * 64 + tid]; }
        if (wave < 4) {
            if (c < 64) {
                const unsigned char* bufp = lds + (c & 1) * BUFB;
                const bf16_t* GP = (const bf16_t*)bufp; const bf16_t* RA = GP + 64 * MS; const bf16_t* HT = RA + 64 * MS; const bf16_t* YQ = HT + 64 * MS; const float* PC = (const float*)(bufp + 4 * 64 * MS * 2);
#if EXP_NOSTATE
                const bf16x8 sf0 = (bf16x8){0,0,0,0,0,0,0,0}, sf1 = sf0;
#else
                const bf16x8 sf0 = ld_frag(SB + fr * MS + fq * 8), sf1 = ld_frag(SB + fr * MS + 32 + fq * 8);
#endif
                float* yb = YB + (c & 1) * 4096;
#pragma unroll
                for (int tt = 0; tt < 4; ++tt) { f32x4 y = unpack4(*(const u32x2*)(YQ + (tt * 16 + fr) * MS + wave * 16 + fq * 4));
                    y = MFMA(sf0, ld_frag(RA + (tt * 16 + fr) * MS + fq * 8), y); y = MFMA(sf1, ld_frag(RA + (tt * 16 + fr) * MS + 32 + fq * 8), y);
                    *(f32x4*)(yb + (tt * 16 + fr) * 64 + wave * 16 + fq * 4) = y; }
#pragma unroll
                for (int jt = 0; jt < 4; ++jt) { const f32x4 pc = *(const f32x4*)(PC + jt * 16 + fq * 4);
                    f32x4 a = unpack4(*(const u32x2*)(HT + (wave * 16 + fr) * MS + jt * 16 + fq * 4)) + Sacc[jt] * pc;
                    a = MFMA(ld_frag(GP + (jt * 16 + fr) * MS + fq * 8), sf0, a); a = MFMA(ld_frag(GP + (jt * 16 + fr) * MS + 32 + fq * 8), sf1, a);
                    Sacc[jt] = a; }
#pragma unroll
                for (int jt = 0; jt < 4; ++jt) *(u32x2*)(SB + fr * MS + jt * 16 + fq * 4) = pack4(Sacc[jt]);
            }
        }
        if (pf) { unsigned char* bufn = lds + ((c + 1) & 1) * BUFB;
#pragma unroll
            for (int m = 0; m < 4; ++m) *(u32x4*)((bf16_t*)bufn + m * 64 * MS + srow * MS + sc8 * 8) = pre[m];
            if (tid < 64) ((float*)(bufn + 4 * 64 * MS * 2))[tid] = prepc; }
        __syncthreads();
        if (c < 64) {
            const int t = tid >> 3, q = tid & 7; const float* yb = YB + (c & 1) * 4096 + t * 64 + q * 8;
            const f32x4 y0 = *(const f32x4*)yb, y1 = *(const f32x4*)(yb + 4);
            float s1 = y0[0] + y0[1] + y0[2] + y0[3] + y1[0] + y1[1] + y1[2] + y1[3];
            s1 += __shfl_xor(s1, 1); s1 += __shfl_xor(s1, 2); s1 += __shfl_xor(s1, 4);
            const float mean = s1 * (1.f / 64.f); const f32x4 d0 = y0 - mean, d1 = y1 - mean;
            float s2 = d0[0] * d0[0] + d0[1] * d0[1] + d0[2] * d0[2] + d0[3] * d0[3] + d1[0] * d1[0] + d1[1] * d1[1] + d1[2] * d1[2] + d1[3] * d1[3];
            s2 += __shfl_xor(s2, 1); s2 += __shfl_xor(s2, 2); s2 += __shfl_xor(s2, 4);
            const float rstd = rsqrtf(s2 * (1.f / 64.f) + 64e-5f);
            const size_t tg = (size_t)b * SEQ + c * 64 + t; const int ch = h * 64 + q * 8;
            const float dot = ((const float*)(p.ws + OFF_DOT))[tg * 8 + h];
            const u32x4 vu = *(const u32x4*)((const bf16_t*)(p.ws + OFF_R2 + R2_V) + tg * 512 + ch);
            bf16_t* zp = dstp + (tg - dst_tok0) * dst_ld + ch; const u32x4 zu = *(const u32x4*)((const bf16_t*)(p.ws + OFF_Z) + tg * NZ + 1024 + ch);
            const f32x4 g0 = *(const f32x4*)(p.lnx_g + (size_t)l * 512 + ch), g1 = *(const f32x4*)(p.lnx_g + (size_t)l * 512 + ch + 4), e0 = *(const f32x4*)(p.lnx_b + (size_t)l * 512 + ch), e1 = *(const f32x4*)(p.lnx_b + (size_t)l * 512 + ch + 4);
            const f32x4 v0 = (f32x4){bf_lo(vu.x), bf_hi(vu.x), bf_lo(vu.y), bf_hi(vu.y)}, v1 = (f32x4){bf_lo(vu.z), bf_hi(vu.z), bf_lo(vu.w), bf_hi(vu.w)};
            const f32x4 o0 = d0 * rstd * g0 + e0 + v0 * dot, o1 = d1 * rstd * g1 + e1 + v1 * dot;
            u32x4 w; w.x = cvt_pk_bf16(o0[0] * siluf_(bf_lo(zu.x)), o0[1] * siluf_(bf_hi(zu.x))); w.y = cvt_pk_bf16(o0[2] * siluf_(bf_lo(zu.y)), o0[3] * siluf_(bf_hi(zu.y)));
            w.z = cvt_pk_bf16(o1[0] * siluf_(bf_lo(zu.z)), o1[1] * siluf_(bf_hi(zu.z))); w.w = cvt_pk_bf16(o1[2] * siluf_(bf_lo(zu.w)), o1[3] * siluf_(bf_hi(zu.w)));
            *(u32x4*)zp = w;
        }
    }
}

#define XB_TMO      128
#define XB_XCNT(j)  (256  + 64 * (j))
#define XB_XSUB(j)  (1280 + 64 * (j))
#define XB_XGEN(j)  (2304 + 64 * (j))
#define XB_TOP      3328
#define XB_TOPGEN   3392
#define XCD_BAR_WORDS 3456
#define XB_SPIN_CAP (1u << 18)

__device__ __forceinline__ unsigned xb_ld(unsigned* p)              { return __hip_atomic_load(p, __ATOMIC_RELAXED, __HIP_MEMORY_SCOPE_AGENT); }
__device__ __forceinline__ unsigned xb_add(unsigned* p, unsigned v) { return __hip_atomic_fetch_add(p, v, __ATOMIC_RELAXED, __HIP_MEMORY_SCOPE_AGENT); }
__device__ __forceinline__ unsigned xb_xcc_id() { return (unsigned)__builtin_amdgcn_s_getreg((3 << 11) | 20) & 0xFu; }
#define XB_SPIN(cond, bar) do { unsigned _sp = 0; while (cond) { __builtin_amdgcn_s_sleep(1); \
    if ((++_sp & 255u) == 0u) { if (xb_ld(&(bar)[XB_TMO])) break; if (_sp > XB_SPIN_CAP) { atomicAdd(&(bar)[XB_TMO], 1u); break; } } } } while (0)

struct XcdBarrier {
    unsigned* bar; unsigned x;
    volatile LAS unsigned* st;
};

__device__ __forceinline__ XcdBarrier xcd_barrier_post(unsigned* bar, volatile LAS unsigned* st) {
    XcdBarrier b; b.bar = bar; b.x = xb_xcc_id(); b.st = st;
    if (threadIdx.x == 0) (void)xb_add(&bar[XB_XCNT(b.x)], 1u);
    return b;
}
__device__ __forceinline__ void xcd_barrier_complete(unsigned* bar, unsigned x, unsigned& nloc, unsigned& nx) {
    const unsigned G = gridDim.x * gridDim.y * gridDim.z;
    unsigned sum, cnt, mine, sp = 0u;
    for (;;) {
        sum = 0u; cnt = 0u; mine = 0u;
#pragma unroll
        for (unsigned j = 0; j < 16; ++j) { const unsigned c = xb_ld(&bar[XB_XCNT(j)]); sum += c; cnt += (c > 0u) ? 1u : 0u; mine = (j == x) ? c : mine; }
        if (sum == G) break;
        __builtin_amdgcn_s_sleep(1);
        if ((++sp & 255u) == 0u) { if (xb_ld(&bar[XB_TMO])) break; if (sp > XB_SPIN_CAP) { atomicAdd(&bar[XB_TMO], 1u); break; } }
    }
    nloc = mine > 0u ? mine : 1u; nx = cnt > 0u ? cnt : 1u;
}

__device__ __forceinline__ void xcd_barrier(const XcdBarrier& b) {
    asm volatile("s_waitcnt vmcnt(0)" ::: "memory");
    __syncthreads();
    if (threadIdx.x == 0) {
        unsigned* bar = b.bar;
        __builtin_amdgcn_s_waitcnt(0);
        unsigned nloc = b.st[0], nx = b.st[1];
        if (nloc == 0u) { xcd_barrier_complete(bar, b.x, nloc, nx); b.st[0] = nloc; b.st[1] = nx; }
        const unsigned old = xb_add(&bar[XB_XSUB(b.x)], 1u);
        const unsigned gen = old / nloc;
        if (old + 1u == (gen + 1u) * nloc) {
            __builtin_amdgcn_fence(__ATOMIC_RELEASE, "agent");
            asm volatile("s_waitcnt vmcnt(0)" ::: "memory");
            const unsigned og = xb_add(&bar[XB_TOP], 1u);
            const unsigned tg = og / nx;
            if (og + 1u == (tg + 1u) * nx) xb_add(&bar[XB_TOPGEN], 1u);
            else XB_SPIN(xb_ld(&bar[XB_TOPGEN]) == tg, bar);
            __builtin_amdgcn_fence(__ATOMIC_ACQUIRE, "agent");
            xb_add(&bar[XB_XGEN(b.x)], 1u);
            asm volatile("s_waitcnt vmcnt(0)" ::: "memory");
        } else {
            XB_SPIN(xb_ld(&bar[XB_XGEN(b.x)]) == gen, bar);
            __builtin_amdgcn_fence(__ATOMIC_ACQUIRE, "agent");
            asm volatile("s_waitcnt vmcnt(0)" ::: "memory");
        }
    }
    __syncthreads();
}


constexpr int PH_PER_LAYER = 8, N_PHASES = 2 + NL * PH_PER_LAYER;
__global__ void __launch_bounds__(NTHREADS, 2) trunk_fwd(Params p0) {
    extern __shared__ __attribute__((aligned(16))) unsigned char lds[];
    const int G = gridDim.x, bx = blockIdx.x;
    Params p = p0;
    volatile LAS unsigned* xb_st = (volatile LAS unsigned*)((LAS unsigned char*)lds + (LDS_BYTES - 16));
    if (threadIdx.x == 0) { xb_st[0] = 0u; xb_st[1] = 0u; }
    XcdBarrier xbar; xbar.bar = nullptr; xbar.x = 0; xbar.st = xb_st;
    __syncthreads();
#if EXP_ZERO
    for (int i = threadIdx.x; i < LDS_BYTES / 4; i += NTHREADS) ((unsigned*)lds)[i] = 0u;
    __syncthreads();
    if (p0.ph_lo == 0) { u32x4* z = (u32x4*)(p0.ws + OFF_DOT); const size_t n = (WS_END - OFF_DOT) / 16;
        for (size_t i = (size_t)bx * NTHREADS + threadIdx.x; i < n; i += (size_t)G * NTHREADS) z[i] = (u32x4){0u, 0u, 0u, 0u}; }
#endif
    for (int ph = p0.ph_lo; ph < p0.ph_hi; ++ph) {
        unsigned char* ws = ptr_l(p0.ws); p.ws = ws;
        if (ph == 0) { if (PHEN & 1) phase0a(p, lds); }
        else if (ph == 1) { if (PHEN & 2) phase0b(p); }
        else {
            const int l = (ph - 2) / PH_PER_LAYER, k = (ph - 2) % PH_PER_LAYER;
            if (k == 0 && (PHEN & 4)) {
                pg8::Gemm g{(const bf16_t*)(ws + OFF_H), (const bf16_t*)(ws + OFF_WIN + l * SZ_WIN), DM, DM, DM};
                pg8::PlainOrder S; S.init(M_TOK / 256, NIN / 256, G, bx);
                pg8::EpiIn E{(bf16_t*)(ws + OFF_R1), (bf16_t*)(ws + OFF_Z)};
                pg8::gemm_phase(( LAS unsigned char*)lds, g, S, E);
            } else if (k == 1 && (PHEN & 8)) {
                for (int it = bx; it < 640; it += G) {
                    if (it < 128) { if (PHEN & 512) gmlp_item(p, l, it, lds); }
                    else if (it < 384) { if (PHEN & 1024) mla_prep_item(p, l, it - 128, lds); }
                    else { if (PHEN & 2048) rwkv_prep_item(p, l, it - 384); }
                }
            } else if (k == 2 && (PHEN & 16)) {
                for (int it = bx; it < 2048; it += G) { if (USE_CHUNK && (PHEN & 4096)) chunk_item(p, it, lds); }
            } else if (k == 3 && (PHEN & 16)) {
#if !USE_CHUNK
                for (int it = bx; it < 32; it += G) scan_item(p, l, it, lds);
#elif PROBE_SCAN
                for (int it = bx; it < 32; it += G) { if (l == 0 && it < 8) seq_item(p, l, it, lds, (bf16_t*)(ws + WS_END), 512, 0); scan_item(p, l, it, lds); }
#else
                for (int it = bx; it < 32; it += G) { if (PHEN & 8192) seq_item(p, l, it, lds, (bf16_t*)(ws + OFF_Z) + 1024, NZ, 0); }
#endif
                int rank = bx, cnt = G; if (G > 32) { rank = bx - 32; cnt = G - 32; }
                if (rank >= 0) for (int pi = rank; pi < 512; pi += cnt) { const int bh = pi >> 4, j = pi & 15;
                    if (PHEN & 16384) { attn_item(p, bh >> 3, bh & 7, 31 - j, lds); attn_item(p, bh >> 3, bh & 7, j, lds); } }
            } else if (k == 4 && (PHEN & 32)) {
#if PROBE_SCAN
#endif: G = sigmoid(h @ Wg)
                pg8::Gemm g{(const bf16_t*)(ws + OFF_H), (const bf16_t*)(ws + OFF_WG + l * SZ_WG), DM, DM, DM};
                pg8::PlainOrder S; S.init(M_TOK / 256, NG / 256, G, bx);
                pg8::EpiPlain<1> E{(bf16_t*)(ws + OFF_R2), NG};
                pg8::gemm_phase((LAS unsigned char*)lds, g, S, E);
            } else if (k == 5 && (PHEN & 64)) {
                pg8::Gemm g{(const bf16_t*)(ws + OFF_Z), (const bf16_t*)(ws + OFF_WBR + l * SZ_WBR), NZ, 512, 512};
                pg8::MergeOrder S; S.init(M_TOK / 256, DM / 256, G, bx);
                pg8::EpiMerge E{(bf16_t*)(ws + OFF_R3 + R3_MERGED), (const bf16_t*)(ws + OFF_R2)};
                pg8::gemm_phase((LAS unsigned char*)lds, g, S, E);
            } else if (k == 6 && (PHEN & 128)) {
                pg8::Gemm g{(const bf16_t*)(ws + OFF_R3 + R3_MERGED), (const bf16_t*)(ws + OFF_WOUT + l * SZ_WOUT), DM, DM, DM};
                pg8::PlainOrder S; S.init(M_TOK / 256, DM / 256, G, bx);
                pg8::EpiPlain<0> E{(bf16_t*)(ws + OFF_R3 + R3_Y), DM};
                pg8::gemm_phase((LAS unsigned char*)lds, g, S, E);
            } else if (k == 7 && (PHEN & 256)) {
                phase_final(p, l);
            }
        }
#if PROBE_SCAN
        if (ph == N_PHASES - 1 && bx == 0 && threadIdx.x == 0) { const unsigned cd = *(volatile unsigned*)(ws + WS_END + 5 * MiB); p.out[5] = 1000.f * (float)cd; }
        if (ph == 0 && bx == 0 && threadIdx.x == 0) *(unsigned*)(ws + WS_END + 5 * MiB) = 0u;
#endif
        if (ph + 1 < p0.ph_hi) {
            if (ph == p0.ph_lo) {
                if (bx == 0) { unsigned* zb = (unsigned*)ptr_l(p0.ws + WS_END); for (int i = tid_l(); i < XCD_BAR_WORDS; i += NTHREADS) __hip_atomic_store(zb + i, 0u, __ATOMIC_RELAXED, __HIP_MEMORY_SCOPE_AGENT); }
                cg::this_grid().sync();
                xbar = xcd_barrier_post((unsigned*)ptr_l(p0.ws + WS_END), xb_st);
            } else { XcdBarrier b2; b2.bar = (unsigned*)ptr_l(p0.ws + WS_END); b2.x = xbar.x; b2.st = xb_st; xcd_barrier(b2); }
        }
    }
}

extern "C" void kernel_launch(void* const* d_in, const int* in_sizes, int n_in, void* d_out, int out_size, void* d_ws, size_t ws_size, hipStream_t stream) {
    static int grid = 0;
    if (grid == 0) {
        if (n_in != 31 || out_size != M_TOK * DM || ws_size < WS_END + 65536) { fprintf(stderr, "kernel_launch: unexpected shapes (n_in %d out %d ws %zu)\n", n_in, out_size, ws_size); grid = -1; return; }
        int dev = 0, cus = 0, per_cu = 0;
        hipGetDevice(&dev); hipDeviceGetAttribute(&cus, hipDeviceAttributeMultiprocessorCount, dev);
        hipFuncSetAttribute((const void*)trunk_fwd, hipFuncAttributeMaxDynamicSharedMemorySize, LDS_BYTES);
        hipOccupancyMaxActiveBlocksPerMultiprocessor(&per_cu, (const void*)trunk_fwd, NTHREADS, LDS_BYTES);
        if (per_cu < 1) { fprintf(stderr, "kernel_launch: occupancy query says %d blocks per CU\n", per_cu); grid = -1; return; }
        grid = cus * 1;
    }
    if (grid < 0) return;
    Params p{};
    p.x = (const float*)d_in[0]; p.c = (const float*)d_in[1]; p.pos = (const int*)d_in[2]; p.pre_g = (const float*)d_in[3]; p.post_g = (const float*)d_in[4];
    p.w_ada = (const float*)d_in[5]; p.b_ada = (const float*)d_in[6]; p.w_in = (const float*)d_in[7]; p.q_norm = (const float*)d_in[8]; p.w_uq = (const float*)d_in[9];
    p.kv_norm = (const float*)d_in[10]; p.w_ukv = (const float*)d_in[11]; p.ln_g = (const float*)d_in[12]; p.ln_b = (const float*)d_in[13]; p.w_s = (const float*)d_in[14]; p.b_s = (const float*)d_in[15];
    p.mu = (const float*)d_in[16]; p.w0 = (const float*)d_in[17]; p.w2 = (const float*)d_in[18]; p.a0 = (const float*)d_in[19]; p.a2 = (const float*)d_in[20]; p.k_k = (const float*)d_in[21];
    p.k_a = (const float*)d_in[22]; p.r_k = (const float*)d_in[23]; p.lnx_g = (const float*)d_in[24]; p.lnx_b = (const float*)d_in[25]; p.v0 = (const float*)d_in[26]; p.v1 = (const float*)d_in[27];
    p.v2 = (const float*)d_in[28]; p.w_br = (const float*)d_in[29]; p.w_out = (const float*)d_in[30];
    p.out = (float*)d_out; p.ws = (unsigned char*)d_ws;
#if ONE_LAUNCH
    p.ph_lo = 0; p.ph_hi = N_PHASES;
    void* args[] = {&p};
    hipError_t e = hipLaunchCooperativeKernel((const void*)trunk_fwd, dim3(grid), dim3(NTHREADS), args, LDS_BYTES, stream);
    if (e != hipSuccess) fprintf(stderr, "cooperative launch failed: %s (grid %d)\n", hipGetErrorString(e), grid);
#else
    for (int ph = 0; ph < N_PHASES; ++ph) { p.ph_lo = ph; p.ph_hi = ph + 1;
        hipLaunchKernelGGL(trunk_fwd, dim3(grid), dim3(NTHREADS), LDS_BYTES, stream, p); }
#endif
}
```

```cpp
#include <hip/hip_runtime.h>
#include <hip/hip_cooperative_groups.h>
#include <cstdint>
#include <cstdio>
namespace cg = cooperative_groups;

#ifndef PHEN
#define PHEN 0x7fff
#endif
#ifndef REP_P0
#define REP_P0 1
#endif
#ifndef REP_GMO
#define REP_GMO 1
#endif
#ifndef REP_GM
#define REP_GM 1
#endif
#ifndef REP_ATT
#define REP_ATT 1
#endif
#ifndef REP_IN
#define REP_IN 1
#endif
#ifndef REP_CHUNK
#define REP_CHUNK 1
#endif
#ifndef REP_MLA
#define REP_MLA 1
#endif
#ifndef REP_RW
#define REP_RW 1
#endif
#ifndef EXP_SYNC2
#define EXP_SYNC2 0
#endif
#ifndef EXP_NODOT
#define EXP_NODOT 0
#endif
#ifndef EXP_CONSTY
#define EXP_CONSTY 0
#endif
#ifndef EXP_NOW1
#define EXP_NOW1 0
#endif
#ifndef EXP_NOSTATE
#define EXP_NOSTATE 0
#endif
#ifndef EXP_ZERO
#define EXP_ZERO 0
#endif
#ifndef USE_CHUNK
#define USE_CHUNK 1
#endif
#ifndef PROBE_SCAN
#define PROBE_SCAN 0
#endif
#ifndef ONE_LAUNCH
#define ONE_LAUNCH 1
#endif

#define LAS __attribute__((address_space(3)))
typedef unsigned short bf16_t;
typedef short bf16x8 __attribute__((ext_vector_type(8)));
typedef short bf16x4 __attribute__((ext_vector_type(4)));
typedef float f32x4 __attribute__((ext_vector_type(4)));
typedef float f32x2 __attribute__((ext_vector_type(2)));
typedef unsigned u32x4 __attribute__((ext_vector_type(4)));
typedef unsigned u32x2 __attribute__((ext_vector_type(2)));

constexpr int M_TOK = 16384, DM = 1024, SEQ = 4096, NBATCH = 4, NL = 4;
constexpr int D_IN_SRC = 7712;
constexpr int NP1 = 3328, NZ = 1536, NIN = 4864, NG = 3072;
constexpr int C_QLAT = 0, C_KVLAT = 256, C_KROPE = 384, C_GMU = 512, C_GMV = 1024, C_RW = 1536, C_RWR = 1536, C_RWK = 2048, C_RWV = 2560, C_WLAT = 3072, C_ALAT = 3136;
constexpr int NTHREADS = 512, NWAVES = 8;
constexpr int LDS_BYTES = 150 * 1024;
constexpr float QSCALE = 0.10206207261596575f * 1.4426950408889634f;

constexpr size_t MiB = 1u << 20;
constexpr size_t OFF_WIN = 0;
constexpr size_t SZ_WIN = (size_t)NIN * DM * 2;
constexpr size_t OFF_WG = 38 * MiB;
constexpr size_t SZ_WG = (size_t)NG * DM * 2;
constexpr size_t OFF_WBR = 62 * MiB;
constexpr size_t SZ_WBR = (size_t)3072 * 512 * 2;
constexpr size_t OFF_WOUT = 74 * MiB;
constexpr size_t SZ_WOUT = (size_t)DM * DM * 2;
constexpr size_t OFF_WUQ = 82 * MiB;
constexpr size_t SZ_WUQ = (size_t)768 * 256 * 2;
constexpr size_t OFF_WUKV = OFF_WUQ + 3 * MiB / 2;
constexpr size_t SZ_WUKV = (size_t)1024 * 128 * 2;
constexpr size_t OFF_SMALL = OFF_WUKV + 1 * MiB;
constexpr size_t OFF_W2T = OFF_SMALL;
constexpr size_t OFF_A2T = OFF_W2T + 256 * 1024;
constexpr size_t OFF_V1T = OFF_A2T + 256 * 1024;
constexpr size_t OFF_V2T = OFF_V1T + 128 * 1024;
constexpr size_t OFF_WS = OFF_V2T + 128 * 1024;
constexpr size_t OFF_MODP = OFF_WS + 512 * 1024;
constexpr size_t OFF_ROPE = OFF_MODP + 3 * MiB / 2;
constexpr size_t OFF_DOT = OFF_ROPE + 2 * MiB;
constexpr size_t OFF_MODT = OFF_DOT + MiB / 2;
constexpr size_t OFF_H = 90 * MiB;
constexpr size_t OFF_Z = 122 * MiB;
constexpr size_t OFF_VF = 170 * MiB;
constexpr size_t OFF_R1 = 186 * MiB;
constexpr size_t OFF_R2 = 298 * MiB;
constexpr size_t OFF_R3 = 410 * MiB;
constexpr size_t WS_END = 474 * MiB;
static_assert(OFF_MODT + 3 * NL * 4 * 1024 * 4 <= OFF_H, "small region");
constexpr size_t R1_GP = 0, R1_RA = 16 * MiB, R1_HT = 32 * MiB, R1_YQ = 48 * MiB, R1_PC = 64 * MiB;
constexpr size_t R2_R = 0, R2_K = 16 * MiB, R2_V = 32 * MiB, R2_KK = 48 * MiB, R2_B = 64 * MiB, R2_LW = 80 * MiB;
constexpr size_t R3_Q = 0, R3_KF = 24 * MiB, R3_VT = 48 * MiB, R3_MERGED = 0, R3_Y = 32 * MiB;

struct Params {
    const float* x; const float* c; const int* pos; const float* pre_g; const float* post_g; const float* w_ada; const float* b_ada; const float* w_in;
    const float* q_norm; const float* w_uq; const float* kv_norm; const float* w_ukv; const float* ln_g; const float* ln_b; const float* w_s; const float* b_s;
    const float* mu; const float* w0; const float* w2; const float* a0; const float* a2; const float* k_k; const float* k_a; const float* r_k;
    const float* lnx_g; const float* lnx_b; const float* v0; const float* v1; const float* v2; const float* w_br; const float* w_out;
    float* out; unsigned char* ws;
    int ph_lo, ph_hi;
};

typedef __bf16 bf16x2_t __attribute__((ext_vector_type(2)));
__device__ __forceinline__ unsigned cvt_pk_bf16(float lo, float hi) { const f32x2 v = {lo, hi}; const bf16x2_t b = __builtin_convertvector(v, bf16x2_t); return __builtin_bit_cast(unsigned, b); }
__device__ __forceinline__ float bf_lo(unsigned u) { return __uint_as_float(u << 16); }
__device__ __forceinline__ float bf_hi(unsigned u) { return __uint_as_float(u & 0xffff0000u); }
__device__ __forceinline__ float bf2f(bf16_t h) { return __uint_as_float(((unsigned)h) << 16); }
__device__ __forceinline__ bf16_t f2bf(float f) { return (bf16_t)(cvt_pk_bf16(f, 0.f) & 0xffffu); }
__device__ __forceinline__ float sigmoidf_(float x) { return 1.f / (1.f + __expf(-x)); }
__device__ __forceinline__ float siluf_(float x) { return x / (1.f + __expf(-x)); }
__device__ __forceinline__ float geluf_(float x) { return 0.5f * x * (1.f + erff(x * 0.70710678118654752f)); }
__device__ __forceinline__ f32x4 unpack4(u32x2 u) { return (f32x4){bf_lo(u.x), bf_hi(u.x), bf_lo(u.y), bf_hi(u.y)}; }
__device__ __forceinline__ u32x2 pack4(f32x4 v) { u32x2 r; r.x = cvt_pk_bf16(v[0], v[1]); r.y = cvt_pk_bf16(v[2], v[3]); return r; }
__device__ __forceinline__ float wave_sum(float v) {
#pragma unroll
    for (int o = 1; o < 64; o <<= 1) v += __shfl_xor(v, o);
    return v;
}
__device__ __forceinline__ bf16x8 ld_frag(const bf16_t* p) { return *(const bf16x8*)p; }
__device__ __forceinline__ bf16x8 pack_frag(f32x4 a, f32x4 b) {
    u32x4 u; u.x = cvt_pk_bf16(a[0], a[1]); u.y = cvt_pk_bf16(a[2], a[3]); u.z = cvt_pk_bf16(b[0], b[1]); u.w = cvt_pk_bf16(b[2], b[3]);
    return __builtin_bit_cast(bf16x8, u);
}
__device__ __forceinline__ bf16x8 join_frag(u32x2 a, u32x2 b) { u32x4 u; u.x = a.x; u.y = a.y; u.z = b.x; u.w = b.y; return __builtin_bit_cast(bf16x8, u); }
__device__ __forceinline__ int tid_l() { int t = threadIdx.x; asm volatile("" : "+v"(t)); return t; }
__device__ __forceinline__ unsigned char* ptr_l(unsigned char* q) { asm volatile("" : "+s"(q)); return q; }
#define MFMA(a, b, c) __builtin_amdgcn_mfma_f32_16x16x32_bf16((a), (b), (c), 0, 0, 0)

namespace pg8 {
constexpr int BM = 256, BK = 64, HALF = 128, HTB = HALF * BK * 2, STAGE_BYTES = 8 * HTB, NXCD = 8, WGM = 8;
__host__ __device__ __forceinline__ int lds_byte(int r, int c) { const int st = (r >> 4) * 2 + (c >> 5), rr = r & 15, cc = c & 31, ob = rr * 64 + cc * 2; return st * 1024 + (ob ^ (((ob >> 9) & 1) << 5)); }
__host__ __device__ __forceinline__ void stage_rc(int b, int& R, int& C) { const int st = b / 1024, sb = b % 1024, swz = sb ^ (((sb >> 9) & 1) << 5); R = (st >> 1) * 16 + swz / 64; C = (st & 1) * 32 + (swz % 64) / 2; }
__host__ __device__ __forceinline__ int perm32(int rho) { const int n = rho >> 4, i = rho & 15; return 8 * (i >> 2) + 4 * n + (i & 3); }

struct Unit { int pm, pn, ak, tag; };
struct Gemm { const bf16_t* A; const bf16_t* Bt; int lda, ldb, K; };

__device__ __forceinline__ void tile_of(int wgid, int nM, int nN, int& pm, int& pn) {
    const int nwg = nM * nN;
    { const int q = nwg / NXCD, r = nwg % NXCD, xcd = wgid % NXCD, off = wgid / NXCD; wgid = (xcd < r ? xcd * (q + 1) : r * (q + 1) + (xcd - r) * q) + off; }
    const int nig = WGM * nN, gid = wgid / nig, fm = gid * WGM, gsz = (nM - fm) < WGM ? (nM - fm) : WGM;
    pm = fm + ((wgid % nig) % gsz); pn = (wgid % nig) / gsz;
}
struct PlainOrder {
    int nM, nN, nwg, G, c;
    __device__ void init(int nM_, int nN_, int G_, int c_) { nM = nM_; nN = nN_; nwg = nM * nN; G = G_; c = c_; }
    __device__ bool next(int i, Unit& u) const { const long L = (long)i * G + c; if (L >= nwg) return false; tile_of((int)L, nM, nN, u.pm, u.pn); u.ak = 0; u.tag = 0; return true; }
};
struct MergeOrder {
    int nM, nN, nwg, G, c;
    __device__ void init(int nM_, int nN_, int G_, int c_) { nM = nM_; nN = nN_; nwg = nM * nN; G = G_; c = c_; }
    __device__ bool next(int i, Unit& u) const { const int ti = i / 3, n = i - 3 * ti; const long L = (long)ti * G + c; if (L >= nwg) return false;
        int pm, pc; tile_of((int)L, nM, nN, pm, pc); u.pm = pm; u.pn = n * nN + pc; u.ak = n * 512; u.tag = n; return true; }
};

template <class Epi, class Sched>
__device__ __forceinline__ void gemm_phase(LAS unsigned char* lds, const Gemm g, const Sched& S, const Epi& E) {
    const int tid = tid_l(), wid = __builtin_amdgcn_readfirstlane(tid >> 6), lane = tid & 63, wr = wid >> 2, wc = wid & 3, fr = lane & 15, fq = lane >> 4;
    const int K = g.K, nt = K / BK;
    unsigned voffA[2], voffB[2];
#pragma unroll
    for (int i = 0; i < 2; ++i) { int R, C; stage_rc(tid * 16 + i * 8192, R, C); const int Rb = (R & ~31) + perm32(R & 31);
        voffA[i] = (unsigned)(R * g.lda + C) * 2u; voffB[i] = (unsigned)(Rb * g.ldb + C) * 2u; }
    const size_t kstep = (size_t)(BK * 2);
    const size_t hstepA = (size_t)HALF * g.lda * 2, hstepB = (size_t)HALF * g.ldb * 2;
    const size_t tstepA = 2 * hstepA, tstepB = 2 * hstepB;
    const unsigned ldsw = (unsigned)wid * 1024u;
    const int aoff = lds_byte(wr * 64 + fr, fq * 8), boff = lds_byte(wc * 32 + fr, fq * 8);
#define PG8_SA(b, h) (((b) * 2 + (h)) * HTB)
#define PG8_SB(b, h) ((4 + (b) * 2 + (h)) * HTB)
#define PG8_STAGE(bufoff, gbase, voff) do { _Pragma("unroll") for (int _i = 0; _i < 2; ++_i) \
        __builtin_amdgcn_global_load_lds((const unsigned*)((const char*)(gbase) + (voff)[_i]), (LAS unsigned*)(lds + (bufoff) + ldsw + _i * 8192), 16, 0, 0); } while (0)
#define PG8_LDA(dst, b, h) do { _Pragma("unroll") for (int m = 0; m < 4; ++m) _Pragma("unroll") for (int k = 0; k < 2; ++k) dst[m][k] = *(const LAS bf16x8*)(lds + PG8_SA(b, h) + aoff + m * 2048 + k * 1024); } while (0)
#define PG8_LDB(dst, b, h) do { _Pragma("unroll") for (int n = 0; n < 2; ++n) _Pragma("unroll") for (int k = 0; k < 2; ++k) dst[n][k] = *(const LAS bf16x8*)(lds + PG8_SB(b, h) + boff + n * 2048 + k * 1024); } while (0)
#define PG8_MMA(ai, bj, At, Bt) do { __builtin_amdgcn_s_setprio(1); _Pragma("unroll") for (int m = 0; m < 4; ++m) _Pragma("unroll") for (int n = 0; n < 2; ++n) _Pragma("unroll") for (int k = 0; k < 2; ++k) \
        acc[ai][bj][m][n] = __builtin_amdgcn_mfma_f32_16x16x32_bf16(Bt[n][k], At[m][k], acc[ai][bj][m][n], 0, 0, 0); __builtin_amdgcn_s_setprio(0); } while (0)
#define PG8_WAIT_V(n) asm volatile("s_waitcnt vmcnt(" #n ")" ::: "memory")
#define PG8_WAIT_L(n) asm volatile("s_waitcnt lgkmcnt(" #n ")" ::: "memory")
#define PG8_BAR __builtin_amdgcn_s_barrier()
#define PG8_SCHED __builtin_amdgcn_sched_barrier(0)
    Unit cur, nxt; int ui = 0;
    if (!S.next(0, cur)) return;
    f32x4 acc[2][2][4][2];
#pragma unroll
    for (int a = 0; a < 2; ++a)
#pragma unroll
        for (int b = 0; b < 2; ++b)
#pragma unroll
            for (int m = 0; m < 4; ++m)
#pragma unroll
                for (int n = 0; n < 2; ++n) acc[a][b][m][n] = (f32x4){0.f, 0.f, 0.f, 0.f};
    bf16x8 At[4][2], B0[2][2], B1[2][2];
    const char* cA = (const char*)g.A + (size_t)cur.pm * tstepA + (size_t)cur.ak * 2; const char* cB = (const char*)g.Bt + (size_t)cur.pn * tstepB;
    PG8_STAGE(PG8_SB(0, 0), cB, voffB); PG8_STAGE(PG8_SB(0, 1), cB + hstepB, voffB); PG8_STAGE(PG8_SA(0, 0), cA, voffA); PG8_STAGE(PG8_SA(0, 1), cA + hstepA, voffA);
    if (wr == 1) PG8_BAR;
    PG8_WAIT_V(2); PG8_BAR;
    PG8_STAGE(PG8_SB(1, 0), cB + kstep, voffB); PG8_STAGE(PG8_SA(1, 0), cA + kstep, voffA); PG8_STAGE(PG8_SB(1, 1), cB + hstepB + kstep, voffB);
    PG8_WAIT_V(6); PG8_BAR;
    for (;;) {
        const bool has_next = S.next(ui + 1, nxt);
        const char* nA = has_next ? (const char*)g.A + (size_t)nxt.pm * tstepA + (size_t)nxt.ak * 2 : cA; const char* nB = has_next ? (const char*)g.Bt + (size_t)nxt.pn * tstepB : cB;
        for (int t = 0; t < nt; t += 2) {
            const bool last = (t == nt - 2);
            const char* a1 = cA + (size_t)(t + 1) * kstep;
            const char* a2 = last ? nA : cA + (size_t)(t + 2) * kstep; const char* b2 = last ? nB : cB + (size_t)(t + 2) * kstep;
            const char* a3 = a2 + kstep; const char* b3 = b2 + kstep;
            PG8_LDB(B0, 0, 0); PG8_LDB(B1, 0, 1); PG8_SCHED; PG8_LDA(At, 0, 0); PG8_STAGE(PG8_SA(1, 1), a1 + hstepA, voffA);
            PG8_WAIT_V(8); PG8_WAIT_L(0); PG8_BAR; PG8_MMA(0, 0, At, B0); PG8_MMA(0, 1, At, B1); PG8_BAR; PG8_SCHED;
            PG8_LDA(At, 0, 1); PG8_STAGE(PG8_SB(0, 0), b2, voffB); PG8_STAGE(PG8_SB(0, 1), b2 + hstepB, voffB); PG8_STAGE(PG8_SA(0, 0), a2, voffA);
            PG8_WAIT_V(8); PG8_WAIT_L(0); PG8_BAR; PG8_MMA(1, 0, At, B0); PG8_MMA(1, 1, At, B1); PG8_BAR; PG8_SCHED;
            PG8_LDB(B0, 1, 0); PG8_LDB(B1, 1, 1); PG8_SCHED; PG8_LDA(At, 1, 0); PG8_STAGE(PG8_SA(0, 1), a2 + hstepA, voffA);
            PG8_WAIT_V(8); PG8_WAIT_L(0); PG8_BAR; PG8_MMA(0, 0, At, B0); PG8_MMA(0, 1, At, B1); PG8_BAR; PG8_SCHED;
            PG8_LDA(At, 1, 1); PG8_STAGE(PG8_SB(1, 0), b3, voffB); PG8_STAGE(PG8_SB(1, 1), b3 + hstepB, voffB); PG8_STAGE(PG8_SA(1, 0), a3, voffA);
            PG8_WAIT_V(8); PG8_WAIT_L(0); PG8_BAR; PG8_MMA(1, 0, At, B0); PG8_MMA(1, 1, At, B1); PG8_BAR; PG8_SCHED;
        }
        if (wr == 0) PG8_BAR;
        E(acc, cur, wr, wc, fr, fq);
        if (!has_next) break;
#pragma unroll
        for (int a = 0; a < 2; ++a)
#pragma unroll
            for (int b = 0; b < 2; ++b)
#pragma unroll
                for (int m = 0; m < 4; ++m)
#pragma unroll
                    for (int n = 0; n < 2; ++n) acc[a][b][m][n] = (f32x4){0.f, 0.f, 0.f, 0.f};
        cur = nxt; cA = nA; cB = nB; ++ui;
        if (wr == 1) PG8_BAR;
    }
    PG8_WAIT_V(0);
    PG8_BAR;
#undef PG8_SA
#undef PG8_SB
#undef PG8_STAGE
#undef PG8_LDA
#undef PG8_LDB
#undef PG8_MMA
#undef PG8_WAIT_V
#undef PG8_WAIT_L
#undef PG8_BAR
#undef PG8_SCHED
}

struct EpiIn {
    bf16_t* P1; bf16_t* Z;
    __device__ __forceinline__ void operator()(const f32x4 (&acc)[2][2][4][2], const Unit& u, int wr, int wc, int fr, int fq) const {
        bf16_t* base; int ld, colt;
        if (u.pn < 13) { base = P1; ld = NP1; colt = u.pn * BM; } else { base = Z; ld = NZ; colt = (u.pn - 13) * BM; }
        const int row0 = u.pm * BM + wr * 64 + fr, col0 = colt + wc * 32 + 8 * fq;
#pragma unroll
        for (int ai = 0; ai < 2; ++ai)
#pragma unroll
            for (int m = 0; m < 4; ++m) { bf16_t* rowp = base + (size_t)(row0 + ai * HALF + m * 16) * ld + col0;
#pragma unroll
                for (int bj = 0; bj < 2; ++bj) { const f32x4 v0 = acc[ai][bj][m][0], v1 = acc[ai][bj][m][1];
                    u32x4 w; w.x = cvt_pk_bf16(v0[0], v0[1]); w.y = cvt_pk_bf16(v0[2], v0[3]); w.z = cvt_pk_bf16(v1[0], v1[1]); w.w = cvt_pk_bf16(v1[2], v1[3]);
                    *(u32x4*)(rowp + bj * HALF) = w; } }
    }
};
template <int ACT> struct EpiPlain {
    bf16_t* O; int ld;
    __device__ __forceinline__ void operator()(const f32x4 (&acc)[2][2][4][2], const Unit& u, int wr, int wc, int fr, int fq) const {
        const int row0 = u.pm * BM + wr * 64 + fr, col0 = u.pn * BM + wc * 32 + 8 * fq;
#pragma unroll
        for (int ai = 0; ai < 2; ++ai)
#pragma unroll
            for (int m = 0; m < 4; ++m) { bf16_t* rowp = O + (size_t)(row0 + ai * HALF + m * 16) * ld + col0;
#pragma unroll
                for (int bj = 0; bj < 2; ++bj) { f32x4 v0 = acc[ai][bj][m][0], v1 = acc[ai][bj][m][1];
                    if (ACT == 1) {
#pragma unroll
                        for (int e = 0; e < 4; ++e) { v0[e] = sigmoidf_(v0[e]); v1[e] = sigmoidf_(v1[e]); } }
                    u32x4 w; w.x = cvt_pk_bf16(v0[0], v0[1]); w.y = cvt_pk_bf16(v0[2], v0[3]); w.z = cvt_pk_bf16(v1[0], v1[1]); w.w = cvt_pk_bf16(v1[2], v1[3]);
                    *(u32x4*)(rowp + bj * HALF) = w; } }
    }
};
struct EpiMerge {
    bf16_t* Mg; const bf16_t* G;
    __device__ __forceinline__ void operator()(const f32x4 (&acc)[2][2][4][2], const Unit& u, int wr, int wc, int fr, int fq) const {
        const int n = u.tag, pc = u.pn - 4 * n;
        const int row0 = u.pm * BM + wr * 64 + fr, col0 = pc * BM + wc * 32 + 8 * fq;
#pragma unroll
        for (int ai = 0; ai < 2; ++ai)
#pragma unroll
            for (int m = 0; m < 4; ++m) { const size_t row = (size_t)(row0 + ai * HALF + m * 16);
#pragma unroll
                for (int bj = 0; bj < 2; ++bj) { const f32x4 v0 = acc[ai][bj][m][0], v1 = acc[ai][bj][m][1];
                    const u32x4 gt = *(const u32x4*)(G + row * NG + n * 1024 + col0 + bj * HALF);
                    bf16_t* mp = Mg + row * DM + col0 + bj * HALF;
                    float o[8];
                    o[0] = bf_lo(gt.x) * v0[0]; o[1] = bf_hi(gt.x) * v0[1]; o[2] = bf_lo(gt.y) * v0[2]; o[3] = bf_hi(gt.y) * v0[3];
                    o[4] = bf_lo(gt.z) * v1[0]; o[5] = bf_hi(gt.z) * v1[1]; o[6] = bf_lo(gt.w) * v1[2]; o[7] = bf_hi(gt.w) * v1[3];
                    if (n > 0) { const u32x4 pv = *(const u32x4*)mp;
                        o[0] += bf_lo(pv.x); o[1] += bf_hi(pv.x); o[2] += bf_lo(pv.y); o[3] += bf_hi(pv.y); o[4] += bf_lo(pv.z); o[5] += bf_hi(pv.z); o[6] += bf_lo(pv.w); o[7] += bf_hi(pv.w); }
                    u32x4 w; w.x = cvt_pk_bf16(o[0], o[1]); w.y = cvt_pk_bf16(o[2], o[3]); w.z = cvt_pk_bf16(o[4], o[5]); w.w = cvt_pk_bf16(o[6], o[7]);
                    *(u32x4*)mp = w; } }
    }
};
}

__device__ __forceinline__ void tr_item(const float* W, int lds_, int k0, int n0s, bf16_t* WT, int ldd, int n0d, int kd0, const float* ksc, float* scr, int lane) {
#pragma unroll 8
    for (int i = 0; i < 32; ++i) { const int kk = 2 * i + (lane >> 5);
        float v = 0.f; if (n0s >= 0) { v = W[(size_t)(k0 + kk) * lds_ + n0s + (lane & 31)]; if (ksc) v *= ksc[k0 + kk]; }
        scr[kk * 33 + (lane & 31)] = v; }
    asm volatile("s_waitcnt lgkmcnt(0)" ::: "memory");
    const int c = lane & 7;
#pragma unroll
    for (int j = 0; j < 4; ++j) { const int n = (lane >> 3) + 8 * j; const float* s = scr + (8 * c) * 33 + n;
        u32x4 o; o.x = cvt_pk_bf16(s[0 * 33], s[1 * 33]); o.y = cvt_pk_bf16(s[2 * 33], s[3 * 33]); o.z = cvt_pk_bf16(s[4 * 33], s[5 * 33]); o.w = cvt_pk_bf16(s[6 * 33], s[7 * 33]);
        *(u32x4*)(WT + (size_t)(n0d + n) * ldd + kd0 + 8 * c) = o; }
    asm volatile("s_waitcnt lgkmcnt(0)" ::: "memory");
}

__device__ __forceinline__ void phase0a(const Params& p, unsigned char* lds) {
    const int tid = tid_l(), lane = tid & 63, wave = tid >> 6, G = gridDim.x;
    const int gw = blockIdx.x * NWAVES + wave, NGW = G * NWAVES;
    unsigned char* ws = p.ws;
    float* scr = (float*)(lds + wave * 16384);
    constexpr int I_WIN = 152 * 16, I_WG = 96 * 16, I_WBR = 3 * 32 * 8, I_WOUT = 32 * 16, I_WUQ = 24 * 4, I_WUKV = 32 * 2, I_W2 = 16, I_A2 = 16, I_V1 = 8;
    constexpr int I_L = I_WIN + I_WG + I_WBR + I_WOUT + I_WUQ + I_WUKV + I_W2 + I_A2 + I_V1;
    for (int it = gw; it < NL * I_L; it += NGW) {
        const int l = it / I_L; int r = it - l * I_L;
        if (r < I_WIN) { const int nb = r >> 4, kb = r & 15; const int nd = nb * 32;
            int ns; if (nd < 416) ns = nd; else if (nd < 512) ns = -1; else if (nd < 3200) ns = nd - 96; else if (nd < 3328) ns = -1; else ns = nd - 224;
            tr_item(p.w_in + (size_t)l * DM * D_IN_SRC, D_IN_SRC, kb * 64, ns, (bf16_t*)(ws + OFF_WIN + l * SZ_WIN), DM, nd, kb * 64, nullptr, scr, lane); continue; }
        r -= I_WIN;
        if (r < I_WG) { const int nb = r >> 4, kb = r & 15;
            tr_item(p.w_in + (size_t)l * DM * D_IN_SRC, D_IN_SRC, kb * 64, 4640 + nb * 32, (bf16_t*)(ws + OFF_WG + l * SZ_WG), DM, nb * 32, kb * 64, nullptr, scr, lane); continue; }
        r -= I_WG;
        if (r < I_WBR) { const int n = r / 256, r2 = r - n * 256, nb = r2 >> 3, kb = r2 & 7;
            tr_item(p.w_br + ((size_t)(l * 3 + n) * 512) * DM, DM, kb * 64, nb * 32, (bf16_t*)(ws + OFF_WBR + l * SZ_WBR), 512, n * 1024 + nb * 32, kb * 64, nullptr, scr, lane); continue; }
        r -= I_WBR;
        if (r < I_WOUT) { const int nb = r >> 4, kb = r & 15;
            tr_item(p.w_out + (size_t)l * DM * DM, DM, kb * 64, nb * 32, (bf16_t*)(ws + OFF_WOUT + l * SZ_WOUT), DM, nb * 32, kb * 64, nullptr, scr, lane); continue; }
        r -= I_WOUT;
        if (r < I_WUQ) { const int nb = r >> 2, kb = r & 3;
            tr_item(p.w_uq + (size_t)l * 256 * 768, 768, kb * 64, nb * 32, (bf16_t*)(ws + OFF_WUQ + l * SZ_WUQ), 256, nb * 32, kb * 64, p.q_norm + l * 256, scr, lane); continue; }
        r -= I_WUQ;
        if (r < I_WUKV) { const int nb = r >> 1, kb = r & 1;
            tr_item(p.w_ukv + (size_t)l * 128 * 1024, 1024, kb * 64, nb * 32, (bf16_t*)(ws + OFF_WUKV + l * SZ_WUKV), 128, nb * 32, kb * 64, p.kv_norm + l * 128, scr, lane); continue; }
        r -= I_WUKV;
        if (r < I_W2) { tr_item(p.w2 + (size_t)l * 64 * 512, 512, 0, r * 32, (bf16_t*)(ws + OFF_W2T) + (size_t)l * 512 * 64, 64, r * 32, 0, nullptr, scr, lane); continue; }
        r -= I_W2;
        if (r < I_A2) { tr_item(p.a2 + (size_t)l * 64 * 512, 512, 0, r * 32, (bf16_t*)(ws + OFF_A2T) + (size_t)l * 512 * 64, 64, r * 32, 0, nullptr, scr, lane); continue; }
        r -= I_A2;
        if (l >= 1) tr_item(p.v1 + (size_t)(l - 1) * 512 * 32, 32, r * 64, 0, (bf16_t*)(ws + OFF_V1T) + (size_t)(l - 1) * 32 * 512, 512, 0, r * 64, nullptr, scr, lane);
    }
    for (int it = gw; it < NL * 48 * 8; it += NGW) {
        const int l = it / 384, r = it - l * 384, nb = r >> 3, ks = r & 7, n = nb * 64 + lane;
        float a0 = 0.f, a1 = 0.f, a2 = 0.f, a3 = 0.f;
        const float* w = p.w_ada + (size_t)l * DM * 3072 + n;
#pragma unroll 8
        for (int k = ks * 128; k < ks * 128 + 128; ++k) { const float wv = w[(size_t)k * 3072];
            a0 += siluf_(p.c[k]) * wv; a1 += siluf_(p.c[DM + k]) * wv; a2 += siluf_(p.c[2 * DM + k]) * wv; a3 += siluf_(p.c[3 * DM + k]) * wv; }
        float* mp = (float*)(ws + OFF_MODP) + ((size_t)(l * 8 + ks) * 4) * 3072 + n;
        mp[0] = a0; mp[3072] = a1; mp[2 * 3072] = a2; mp[3 * 3072] = a3;
    }
    const size_t gt = (size_t)blockIdx.x * NTHREADS + tid, GT = (size_t)G * NTHREADS;
    for (size_t i = gt; i < (size_t)3 * 512 * 32; i += GT) { const int l1 = (int)(i / (512 * 32)), r = (int)(i % (512 * 32)), c = r >> 5, k = r & 31;
        ((bf16_t*)(ws + OFF_V2T))[i] = f2bf(p.v2[(size_t)l1 * 32 * 512 + k * 512 + c]); }
    for (size_t i = gt; i < (size_t)NL * 4 * 128 * 128; i += GT) { const int s = (int)(i & 127), t = (int)((i >> 7) & 127);
        ((bf16_t*)(ws + OFF_WS))[i] = f2bf(((s >> 6) <= (t >> 6)) ? p.w_s[i] : 0.f); }
    for (size_t i = gt; i < (size_t)M_TOK * 16; i += GT) { const int t = (int)(i >> 4), k = (int)(i & 15);
        const float inv = powf(10000.f, -(float)(2 * k) / 32.f); const float ang = (float)p.pos[t] * inv;
        ((float*)(ws + OFF_ROPE))[i] = cosf(ang); ((float*)(ws + OFF_ROPE))[(size_t)M_TOK * 16 + i] = sinf(ang); }
    for (size_t i = gt; i < (size_t)M_TOK * DM / 4; i += GT) ((f32x4*)p.out)[i] = ((const f32x4*)p.x)[i];
}

__device__ __forceinline__ f32x4 mod4(const Params& p, int l, int b, int kind, int col) {
    const float* mp = (const float*)(p.ws + OFF_MODP) + ((size_t)(l * 8) * 4 + b) * 3072 + kind * DM + col;
    f32x4 s = *(const f32x4*)(p.b_ada + (size_t)l * 3072 + kind * DM + col);
#pragma unroll
    for (int ks = 0; ks < 8; ++ks) s += *(const f32x4*)(mp + (size_t)ks * 4 * 3072);
    return s;
}
__device__ __forceinline__ void phase_modt(const Params& p) {
    float* T = (float*)(p.ws + OFF_MODT);
    for (int i = blockIdx.x * NTHREADS + tid_l(); i < NL * 4 * 256; i += gridDim.x * NTHREADS) { const int l = i / 1024, r = i - l * 1024, b = r >> 8, col = (r & 255) * 4;
        const f32x4 sh = mod4(p, l, b, 0, col), sc = mod4(p, l, b, 1, col), gt = mod4(p, l, b, 2, col);
        const f32x4 g = *(const f32x4*)(p.pre_g + (size_t)l * DM + col), pg = *(const f32x4*)(p.post_g + (size_t)l * DM + col);
        const size_t o = ((size_t)(l * 4 + b)) * 1024 + col;
        *(f32x4*)(T + o) = g * (sc + 1.f); *(f32x4*)(T + (size_t)NL * 4096 + o) = sh; *(f32x4*)(T + (size_t)2 * NL * 4096 + o) = gt * pg; }
}
__device__ __forceinline__ void normmod_row(const Params& p, int l, int row, const f32x4 (&v)[4], int lane) {
    float ss = 0.f;
#pragma unroll
    for (int j = 0; j < 4; ++j) ss += v[j][0] * v[j][0] + v[j][1] * v[j][1] + v[j][2] * v[j][2] + v[j][3] * v[j][3];
    const float rstd = rsqrtf(wave_sum(ss) * (1.f / DM) + 1e-6f);
    const int b = row / SEQ;
    const float* T = (const float*)(p.ws + OFF_MODT) + ((size_t)(l * 4 + b)) * 1024;
    bf16_t* hrow = (bf16_t*)(p.ws + OFF_H) + (size_t)row * DM;
#pragma unroll
    for (int j = 0; j < 4; ++j) { const int col = 4 * lane + 256 * j;
        const f32x4 a = *(const f32x4*)(T + col), sh = *(const f32x4*)(T + (size_t)NL * 4096 + col);
        f32x4 o = v[j] * rstd * a + sh;
        *(u32x2*)(hrow + col) = pack4(o); }
}
__device__ __forceinline__ void phase0b(const Params& p) {
    const int tidq = tid_l(); const int lane = tidq & 63, gw = blockIdx.x * NWAVES + (tidq >> 6), NGW = gridDim.x * NWAVES;
    for (int row = gw; row < M_TOK; row += NGW) { f32x4 v[4];
#pragma unroll
        for (int j = 0; j < 4; ++j) v[j] = *(const f32x4*)(p.out + (size_t)row * DM + 4 * lane + 256 * j);
        normmod_row(p, 0, row, v, lane); }
}
__device__ __forceinline__ void phase_final(const Params& p, int l) {
    const int tidq = tid_l(); const int lane = tidq & 63, gw = blockIdx.x * NWAVES + (tidq >> 6), NGW = gridDim.x * NWAVES;
    const bf16_t* Y = (const bf16_t*)(p.ws + OFF_R3 + R3_Y);
    for (int row = gw; row < M_TOK; row += NGW) {
        f32x4 y[4]; float ss = 0.f;
#pragma unroll
        for (int j = 0; j < 4; ++j) { y[j] = unpack4(*(const u32x2*)(Y + (size_t)row * DM + 4 * lane + 256 * j)); ss += y[j][0] * y[j][0] + y[j][1] * y[j][1] + y[j][2] * y[j][2] + y[j][3] * y[j][3]; }
        const float rstd = rsqrtf(wave_sum(ss) * (1.f / DM) + 1e-6f);
        const int b = row / SEQ; f32x4 v[4];
        const float* GG = (const float*)(p.ws + OFF_MODT) + (size_t)2 * NL * 4096 + ((size_t)(l * 4 + b)) * 1024;
#pragma unroll
        for (int j = 0; j < 4; ++j) { const int col = 4 * lane + 256 * j;
            const f32x4 xg = *(const f32x4*)(p.out + (size_t)row * DM + col), gg = *(const f32x4*)(GG + col);
            v[j] = xg + gg * (y[j] * rstd);
            *(f32x4*)(p.out + (size_t)row * DM + col) = v[j]; }
        if (l + 1 < NL) normmod_row(p, l + 1, row, v, lane);
    }
}

__device__ __forceinline__ void mla_prep_item(const Params& p, int l, int item, unsigned char* lds) {
    const int tid = tid_l(), lane = tid & 63, wave = tid >> 6, fr = lane & 15, fq = lane >> 4;
    const int t0 = item * 64;
    const bf16_t* P1 = (const bf16_t*)(p.ws + OFF_R1);
    bf16_t* Q = (bf16_t*)(p.ws + OFF_R3 + R3_Q); bf16_t* Kf = (bf16_t*)(p.ws + OFF_R3 + R3_KF); bf16_t* Vt = (bf16_t*)(p.ws + OFF_R3 + R3_VT);
    const bf16_t* Wuq = (const bf16_t*)(p.ws + OFF_WUQ + l * SZ_WUQ); const bf16_t* Wukv = (const bf16_t*)(p.ws + OFF_WUKV + l * SZ_WUKV);
    const float* COS = (const float*)(p.ws + OFF_ROPE); const float* SIN = COS + (size_t)M_TOK * 16;
    float* rq = (float*)lds; float* rkv = rq + 64;
    __syncthreads();
    { const int row = tid >> 3, part = tid & 7; const bf16_t* pr = P1 + (size_t)(t0 + row) * NP1;
        float sq = 0.f, sk = 0.f;
#pragma unroll
        for (int i = 0; i < 4; ++i) { const u32x4 u = *(const u32x4*)(pr + C_QLAT + part * 32 + i * 8);
            sq += bf_lo(u.x) * bf_lo(u.x) + bf_hi(u.x) * bf_hi(u.x) + bf_lo(u.y) * bf_lo(u.y) + bf_hi(u.y) * bf_hi(u.y) + bf_lo(u.z) * bf_lo(u.z) + bf_hi(u.z) * bf_hi(u.z) + bf_lo(u.w) * bf_lo(u.w) + bf_hi(u.w) * bf_hi(u.w); }
#pragma unroll
        for (int i = 0; i < 2; ++i) { const u32x4 u = *(const u32x4*)(pr + C_KVLAT + part * 16 + i * 8);
            sk += bf_lo(u.x) * bf_lo(u.x) + bf_hi(u.x) * bf_hi(u.x) + bf_lo(u.y) * bf_lo(u.y) + bf_hi(u.y) * bf_hi(u.y) + bf_lo(u.z) * bf_lo(u.z) + bf_hi(u.z) * bf_hi(u.z) + bf_lo(u.w) * bf_lo(u.w) + bf_hi(u.w) * bf_hi(u.w); }
        sq += __shfl_xor(sq, 1); sq += __shfl_xor(sq, 2); sq += __shfl_xor(sq, 4);
        sk += __shfl_xor(sk, 1); sk += __shfl_xor(sk, 2); sk += __shfl_xor(sk, 4);
        if (part == 0) { rq[row] = rsqrtf(sq * (1.f / 256.f) + 1e-6f); rkv[row] = rsqrtf(sk * (1.f / 128.f) + 1e-6f); }
        const int i2 = part * 2; const int t = t0 + row;
        const unsigned u1 = *(const unsigned*)(pr + C_KROPE + i2), u2 = *(const unsigned*)(pr + C_KROPE + 16 + i2);
        const float c0 = COS[(size_t)t * 16 + i2], c1 = COS[(size_t)t * 16 + i2 + 1], s0 = SIN[(size_t)t * 16 + i2], s1 = SIN[(size_t)t * 16 + i2 + 1];
        const float x10 = bf_lo(u1), x11 = bf_hi(u1), x20 = bf_lo(u2), x21 = bf_hi(u2);
        const unsigned o1 = cvt_pk_bf16(x10 * c0 - x20 * s0, x11 * c1 - x21 * s1), o2 = cvt_pk_bf16(x20 * c0 + x10 * s0, x21 * c1 + x11 * s1);
#pragma unroll
        for (int h = 0; h < 8; ++h) { *(unsigned*)(Kf + (size_t)t * 768 + h * 96 + 64 + i2) = o1; *(unsigned*)(Kf + (size_t)t * 768 + h * 96 + 80 + i2) = o2; }
    }
    __syncthreads();
#pragma unroll 1
    for (int cb = 0; cb < 4; ++cb) { const int combo = wave * 4 + cb, rt = combo & 3, head = combo >> 2;
        f32x4 acc[6];
#pragma unroll
        for (int ct = 0; ct < 6; ++ct) acc[ct] = (f32x4){0.f, 0.f, 0.f, 0.f};
        const bf16_t* ap = P1 + (size_t)(t0 + rt * 16 + fr) * NP1 + C_QLAT + fq * 8;
        const bf16_t* wp = Wuq + (size_t)(head * 96 + fr) * 256 + fq * 8;
#pragma unroll
        for (int ks = 0; ks < 8; ++ks) { const bf16x8 af = ld_frag(ap + ks * 32);
#pragma unroll
            for (int ct = 0; ct < 6; ++ct) acc[ct] = MFMA(ld_frag(wp + (size_t)ct * 16 * 256 + ks * 32), af, acc[ct]); }
        const int t = t0 + rt * 16 + fr; const float rs = rq[rt * 16 + fr] * QSCALE;
        bf16_t* qp = Q + (size_t)t * 768 + head * 96 + fq * 4;
#pragma unroll
        for (int ct = 0; ct < 4; ++ct) *(u32x2*)(qp + ct * 16) = pack4(acc[ct] * rs);
        const f32x4 cs = *(const f32x4*)(COS + (size_t)t * 16 + fq * 4), sn = *(const f32x4*)(SIN + (size_t)t * 16 + fq * 4);
        const f32x4 x1 = acc[4] * rs, x2 = acc[5] * rs;
        *(u32x2*)(qp + 64) = pack4(x1 * cs - x2 * sn); *(u32x2*)(qp + 80) = pack4(x2 * cs + x1 * sn);
    }
#pragma unroll 1
    for (int cb = 0; cb < 4; ++cb) { const int combo = wave * 4 + cb, rt = combo & 3, head = combo >> 2;
        f32x4 ak[4], av[4];
#pragma unroll
        for (int ct = 0; ct < 4; ++ct) { ak[ct] = (f32x4){0.f, 0.f, 0.f, 0.f}; av[ct] = (f32x4){0.f, 0.f, 0.f, 0.f}; }
        const bf16_t* ap = P1 + (size_t)(t0 + rt * 16 + fr) * NP1 + C_KVLAT + fq * 8;
        const bf16_t* wp = Wukv + (size_t)(head * 128 + fr) * 128 + fq * 8;
#pragma unroll
        for (int ks = 0; ks < 4; ++ks) { const bf16x8 af = ld_frag(ap + ks * 32);
#pragma unroll
            for (int ct = 0; ct < 4; ++ct) { ak[ct] = MFMA(ld_frag(wp + (size_t)ct * 16 * 128 + ks * 32), af, ak[ct]);
                av[ct] = MFMA(af, ld_frag(wp + (size_t)(64 + ct * 16) * 128 + ks * 32), av[ct]); } }
        const int t = t0 + rt * 16 + fr; const float rs = rkv[rt * 16 + fr];
#pragma unroll
        for (int ct = 0; ct < 4; ++ct) *(u32x2*)(Kf + (size_t)t * 768 + head * 96 + ct * 16 + fq * 4) = pack4(ak[ct] * rs);
        const f32x4 rv = *(const f32x4*)(rkv + rt * 16 + fq * 4);
        const int b = t0 / SEQ, s0 = (t0 % SEQ) + rt * 16 + fq * 4;
#pragma unroll
        for (int ct = 0; ct < 4; ++ct) *(u32x2*)(Vt + ((size_t)(b * 8 + head) * 64 + ct * 16 + fr) * SEQ + s0) = pack4(av[ct] * rv);
    }
}

__device__ __forceinline__ void gmlp_item(const Params& p, int l, int item, unsigned char* lds, bool do_store = true) {
    const int tid = tid_l(), lane = tid & 63, wave = tid >> 6, fr = lane & 15, fq = lane >> 4;
    const int t0 = item * 128;
    const bf16_t* P1 = (const bf16_t*)(p.ws + OFF_R1); bf16_t* Z = (bf16_t*)(p.ws + OFF_Z);
    const bf16_t* Ws = (const bf16_t*)(p.ws + OFF_WS) + (size_t)l * 4 * 128 * 128;
    bf16_t* vb = (bf16_t*)lds;
    constexpr int VS = 520;
    __syncthreads();
    { const int tok = tid >> 2, qd = tid & 3; const bf16_t* pr = P1 + (size_t)(t0 + tok) * NP1 + C_GMV + qd * 128;
        float s = 0.f, s2 = 0.f;
#pragma unroll 4
        for (int i = 0; i < 16; ++i) { const u32x4 u = *(const u32x4*)(pr + i * 8); const unsigned uu[4] = {u.x, u.y, u.z, u.w};
#pragma unroll
            for (int e = 0; e < 4; ++e) { const float a = geluf_(bf_lo(uu[e])), b = geluf_(bf_hi(uu[e])); s += a + b; s2 += a * a + b * b; } }
        s += __shfl_xor(s, 1); s += __shfl_xor(s, 2); s2 += __shfl_xor(s2, 1); s2 += __shfl_xor(s2, 2);
        const float mean = s * (1.f / 512.f), var = fmaxf(s2 * (1.f / 512.f) - mean * mean, 0.f), rstd = rsqrtf(var + 1e-5f);
        const float* lg = p.ln_g + (size_t)l * 512 + qd * 128; const float* lb = p.ln_b + (size_t)l * 512 + qd * 128;
#pragma unroll 4
        for (int i = 0; i < 16; ++i) { const u32x4 u = *(const u32x4*)(pr + i * 8); const unsigned uu[4] = {u.x, u.y, u.z, u.w}; unsigned oo[4];
#pragma unroll
            for (int e = 0; e < 4; ++e) { const float a = (geluf_(bf_lo(uu[e])) - mean) * rstd * lg[i * 8 + 2 * e] + lb[i * 8 + 2 * e], b = (geluf_(bf_hi(uu[e])) - mean) * rstd * lg[i * 8 + 2 * e + 1] + lb[i * 8 + 2 * e + 1];
                oo[e] = cvt_pk_bf16(a, b); }
            *(u32x4*)(vb + (size_t)tok * VS + qd * 128 + i * 8) = (u32x4){oo[0], oo[1], oo[2], oo[3]}; }
    }
    __syncthreads();
#pragma unroll 1
    for (int g = 0; g < 4; ++g) {
        const int cbase = g * 128 + wave * 16;
        bf16x8 vfr[4];
#pragma unroll
        for (int ks = 0; ks < 4; ++ks) { bf16x8 f;
#pragma unroll
            for (int j = 0; j < 8; ++j) f[j] = (short)vb[(size_t)(ks * 32 + fq * 8 + j) * VS + cbase + fr];
            vfr[ks] = f; }
        const bf16_t* wg = Ws + (size_t)g * 128 * 128;
#pragma unroll 1
        for (int tt = 0; tt < 8; ++tt) {
            f32x4 acc = (f32x4){0.f, 0.f, 0.f, 0.f};
            const bf16_t* wp = wg + (size_t)(tt * 16 + fr) * 128 + fq * 8;
#pragma unroll
            for (int ks = 0; ks < 4; ++ks) acc = MFMA(vfr[ks], ld_frag(wp + ks * 32), acc);
            const int tl = tt * 16 + fr, t = t0 + tl, c = cbase + fq * 4;
            const float bs = p.b_s[(size_t)(l * 4 + g) * 128 + tl];
            const f32x4 u = unpack4(*(const u32x2*)(P1 + (size_t)t * NP1 + C_GMU + c));
            bf16_t* zp = Z + (size_t)t * NZ + 512 + c; const f32x4 z = unpack4(*(const u32x2*)zp);
            f32x4 o;
#pragma unroll
            for (int e = 0; e < 4; ++e) o[e] = geluf_(u[e]) * (acc[e] + bs) * siluf_(z[e]);
            if (do_store) *(u32x2*)zp = pack4(o);
        }
    }
}

__device__ __forceinline__ f32x4 mix4(const bf16_t* pr, const bf16_t* pp, bool has_prev, const float* mu) {
    const f32x4 a = unpack4(*(const u32x2*)pr); f32x4 b = (f32x4){0.f, 0.f, 0.f, 0.f}; if (has_prev) b = unpack4(*(const u32x2*)pp);
    const f32x4 m = *(const f32x4*)mu; return a + (b - a) * m;
}
__device__ __forceinline__ void rwkv_prep_item(const Params& p, int l, int item) {
    const int tid = tid_l(), lane = tid & 63, wave = tid >> 6, fr = lane & 15, fq = lane >> 4;
    const int rt = wave >> 1, hh = wave & 1;
    const int t = item * 64 + rt * 16 + fr; const bool hp = (t % SEQ) != 0;
    const bf16_t* P1 = (const bf16_t*)(p.ws + OFF_R1);
    const bf16_t* pr = P1 + (size_t)t * NP1; const bf16_t* pp = pr - NP1;
    const float* mu = p.mu + (size_t)l * 1664 - C_RW;
    const bf16_t* W2T = (const bf16_t*)(p.ws + OFF_W2T) + (size_t)l * 512 * 64; const bf16_t* A2T = (const bf16_t*)(p.ws + OFF_A2T) + (size_t)l * 512 * 64;
    unsigned char* r2 = p.ws + OFF_R2;
    bf16_t* VF = (bf16_t*)(p.ws + OFF_VF);
    bf16x8 fa[2], fw[2];
#pragma unroll
    for (int ks = 0; ks < 2; ++ks) { const int ca = C_ALAT + ks * 32 + fq * 8, cw = C_WLAT + ks * 32 + fq * 8;
        const f32x4 a0 = mix4(pr + ca, pp + ca, hp, mu + ca), a1 = mix4(pr + ca + 4, pp + ca + 4, hp, mu + ca + 4);
        f32x4 w0 = mix4(pr + cw, pp + cw, hp, mu + cw), w1 = mix4(pr + cw + 4, pp + cw + 4, hp, mu + cw + 4);
#pragma unroll
        for (int e = 0; e < 4; ++e) { w0[e] = tanhf(w0[e]); w1[e] = tanhf(w1[e]); }
        fa[ks] = pack_frag(a0, a1); fw[ks] = pack_frag(w0, w1); }
    bf16x8 t1f = (bf16x8){0, 0, 0, 0, 0, 0, 0, 0};
    if (l >= 1) { const bf16_t* V1T = (const bf16_t*)(p.ws + OFF_V1T) + (size_t)(l - 1) * 32 * 512;
        f32x4 c0 = (f32x4){0.f, 0.f, 0.f, 0.f}, c1 = c0;
#pragma unroll 2
        for (int ks = 0; ks < 16; ++ks) { const int cv = C_RWV + ks * 32 + fq * 8;
            const bf16x8 af = pack_frag(mix4(pr + cv, pp + cv, hp, mu + cv), mix4(pr + cv + 4, pp + cv + 4, hp, mu + cv + 4));
            c0 = MFMA(ld_frag(V1T + (size_t)fr * 512 + ks * 32 + fq * 8), af, c0); c1 = MFMA(ld_frag(V1T + (size_t)(16 + fr) * 512 + ks * 32 + fq * 8), af, c1); }
        t1f = pack_frag(c0, c1);
    }
#pragma unroll 1
    for (int hq = 0; hq < 4; ++hq) { const int h = hh * 4 + hq;
        float ss = 0.f;
#pragma unroll
        for (int ct = 0; ct < 4; ++ct) { const int c = h * 64 + ct * 16 + fq * 4;
            const f32x4 kr = mix4(pr + C_RWK + c, pp + C_RWK + c, hp, mu + C_RWK + c) * *(const f32x4*)(p.k_k + (size_t)l * 512 + c);
            ss += kr[0] * kr[0] + kr[1] * kr[1] + kr[2] * kr[2] + kr[3] * kr[3]; }
        ss += __shfl_xor(ss, 16); ss += __shfl_xor(ss, 32);
        const float inv = 1.f / fmaxf(sqrtf(ss), 1e-12f);
        float dsum = 0.f;
#pragma unroll 1
        for (int ct = 0; ct < 4; ++ct) { const int crow = h * 64 + ct * 16 + fr;
            f32x4 aa = (f32x4){0.f, 0.f, 0.f, 0.f}, aw = aa, avm = aa;
#pragma unroll
            for (int ks = 0; ks < 2; ++ks) { aa = MFMA(ld_frag(A2T + (size_t)crow * 64 + ks * 32 + fq * 8), fa[ks], aa); aw = MFMA(ld_frag(W2T + (size_t)crow * 64 + ks * 32 + fq * 8), fw[ks], aw); }
            if (l >= 1) { const bf16_t* V2T = (const bf16_t*)(p.ws + OFF_V2T) + (size_t)(l - 1) * 512 * 32 + (size_t)crow * 32;
                avm = MFMA(join_frag(*(const u32x2*)(V2T + fq * 4), *(const u32x2*)(V2T + 16 + fq * 4)), t1f, avm); }
            const int c = h * 64 + ct * 16 + fq * 4; const size_t o = (size_t)t * 512 + c;
            const f32x4 rs = mix4(pr + C_RWR + c, pp + C_RWR + c, hp, mu + C_RWR + c);
            const f32x4 ksv = mix4(pr + C_RWK + c, pp + C_RWK + c, hp, mu + C_RWK + c);
            f32x4 vs = mix4(pr + C_RWV + c, pp + C_RWV + c, hp, mu + C_RWV + c);
            const f32x4 a0 = *(const f32x4*)(p.a0 + (size_t)l * 512 + c), w0 = *(const f32x4*)(p.w0 + (size_t)l * 512 + c), kkw = *(const f32x4*)(p.k_k + (size_t)l * 512 + c);
            const f32x4 ka = *(const f32x4*)(p.k_a + (size_t)l * 512 + c);
            f32x4 lw, asg;
#pragma unroll
            for (int e = 0; e < 4; ++e) { asg[e] = sigmoidf_(a0[e] + aa[e]); lw[e] = -0.6065306597126334f * sigmoidf_(w0[e] + aw[e]); }
            *(f32x4*)((float*)(r2 + R2_LW) + o) = lw;
            if (l == 0) { *(u32x2*)(VF + o) = pack4(vs); }
            else { const f32x4 vf = unpack4(*(const u32x2*)(VF + o)), v0 = *(const f32x4*)(p.v0 + (size_t)(l - 1) * 512 + c);
#pragma unroll
                for (int e = 0; e < 4; ++e) vs[e] = vs[e] + (vf[e] - vs[e]) * sigmoidf_(v0[e] + avm[e]); }
            const f32x4 kk = ksv * kkw * inv, km = ksv * ((asg - 1.f) * ka + 1.f), bb = kk * asg;
            { const f32x4 rk = *(const f32x4*)(p.r_k + (size_t)l * 512 + c); const f32x4 pr3 = rs * km * rk; dsum += pr3[0] + pr3[1] + pr3[2] + pr3[3]; }
            *(u32x2*)((bf16_t*)(r2 + R2_R) + o) = pack4(rs); *(u32x2*)((bf16_t*)(r2 + R2_K) + o) = pack4(km); *(u32x2*)((bf16_t*)(r2 + R2_V) + o) = pack4(vs);
            *(u32x2*)((bf16_t*)(r2 + R2_KK) + o) = pack4(kk); *(u32x2*)((bf16_t*)(r2 + R2_B) + o) = pack4(bb); }
        dsum += __shfl_xor(dsum, 16); dsum += __shfl_xor(dsum, 32);
        if (fq == 0) ((float*)(p.ws + OFF_DOT))[(size_t)t * 8 + h] = dsum;
    }
}

__device__ __forceinline__ void attn_item(const Params& p, int b, int h, int qb, unsigned char* lds, bool do_store = true) {
    const int tid = tid_l(), lane = tid & 63, wave = tid >> 6, fr = lane & 15, fq = lane >> 4;
    const bf16_t* Q = (const bf16_t*)(p.ws + OFF_R3 + R3_Q); const bf16_t* Kf = (const bf16_t*)(p.ws + OFF_R3 + R3_KF); const bf16_t* Vt = (const bf16_t*)(p.ws + OFF_R3 + R3_VT);
    bf16_t* Z = (bf16_t*)(p.ws + OFF_Z);
    constexpr int KS = 104, VS = 72, KB = 64 * KS * 2, VB = 64 * VS * 2, BUF = KB + VB;
    const int nkt = 2 * qb + 2, mykt = (wave < 4) ? nkt - 1 : nkt;
    const int trow = b * SEQ + qb * 128 + wave * 16 + fr;
    bf16x8 qf[3];
#pragma unroll
    for (int ks = 0; ks < 3; ++ks) qf[ks] = ld_frag(Q + (size_t)trow * 768 + h * 96 + ks * 32 + fq * 8);
    const bf16_t* kg = Kf + (size_t)(b * SEQ) * 768 + h * 96; const bf16_t* vg = Vt + (size_t)(b * 8 + h) * 64 * SEQ;
    const int kr0 = tid / 12, kc0 = tid % 12, kr1 = (tid + 512) / 12, kc1 = (tid + 512) % 12, vd = tid >> 3, vc = tid & 7;
    u32x4 pk0, pk1 = (u32x4){0, 0, 0, 0}, pv;
    __syncthreads();
    pk0 = *(const u32x4*)(kg + (size_t)kr0 * 768 + kc0 * 8); if (tid < 256) pk1 = *(const u32x4*)(kg + (size_t)kr1 * 768 + kc1 * 8);
    pv = *(const u32x4*)(vg + (size_t)vd * SEQ + vc * 8);
    { bf16_t* ks_ = (bf16_t*)lds; bf16_t* vs_ = (bf16_t*)(lds + KB);
        *(u32x4*)(ks_ + kr0 * KS + kc0 * 8) = pk0; if (tid < 256) *(u32x4*)(ks_ + kr1 * KS + kc1 * 8) = pk1; *(u32x4*)(vs_ + vd * VS + vc * 8) = pv; }
    __syncthreads();
    f32x4 O[4]; float m = -1e30f, lsum = 0.f;
#pragma unroll
    for (int d = 0; d < 4; ++d) O[d] = (f32x4){0.f, 0.f, 0.f, 0.f};
#pragma unroll 1
    for (int kt = 0; kt < nkt; ++kt) {
        const bool pre = (kt + 1 < nkt);
        if (pre) { const size_t ko = (size_t)(kt + 1) * 64;
            pk0 = *(const u32x4*)(kg + (ko + kr0) * 768 + kc0 * 8); if (tid < 256) pk1 = *(const u32x4*)(kg + (ko + kr1) * 768 + kc1 * 8);
            pv = *(const u32x4*)(vg + (size_t)vd * SEQ + ko + vc * 8); }
        if (kt < mykt) {
            const bf16_t* ks_ = (const bf16_t*)(lds + (kt & 1) * BUF); const bf16_t* vs_ = (const bf16_t*)(lds + (kt & 1) * BUF + KB);
            f32x4 s[4];
#pragma unroll
            for (int c4 = 0; c4 < 4; ++c4) { s[c4] = (f32x4){0.f, 0.f, 0.f, 0.f};
#pragma unroll
                for (int ks = 0; ks < 3; ++ks) s[c4] = MFMA(ld_frag(ks_ + (c4 * 16 + fr) * KS + ks * 32 + fq * 8), qf[ks], s[c4]); }
            float mx = -1e30f;
#pragma unroll
            for (int c4 = 0; c4 < 4; ++c4) mx = fmaxf(fmaxf(fmaxf(s[c4][0], s[c4][1]), fmaxf(s[c4][2], s[c4][3])), mx);
            mx = fmaxf(mx, __shfl_xor(mx, 16)); mx = fmaxf(mx, __shfl_xor(mx, 32));
            const float mn = fmaxf(m, mx), alpha = exp2f(m - mn); m = mn;
            float ps = 0.f;
#pragma unroll
            for (int c4 = 0; c4 < 4; ++c4)
#pragma unroll
                for (int e = 0; e < 4; ++e) { s[c4][e] = exp2f(s[c4][e] - mn); ps += s[c4][e]; }
            lsum = lsum * alpha + ps;
#pragma unroll
            for (int d = 0; d < 4; ++d) O[d] = O[d] * alpha;
            const bf16x8 pf0 = pack_frag(s[0], s[1]), pf1 = pack_frag(s[2], s[3]);
#pragma unroll
            for (int d = 0; d < 4; ++d) { const bf16_t* vp = vs_ + (d * 16 + fr) * VS + fq * 4;
                O[d] = MFMA(join_frag(*(const u32x2*)(vp), *(const u32x2*)(vp + 16)), pf0, O[d]);
                O[d] = MFMA(join_frag(*(const u32x2*)(vp + 32), *(const u32x2*)(vp + 48)), pf1, O[d]); }
        }
        if (pre) { bf16_t* ks_ = (bf16_t*)(lds + ((kt + 1) & 1) * BUF); bf16_t* vs_ = (bf16_t*)(lds + ((kt + 1) & 1) * BUF + KB);
            *(u32x4*)(ks_ + kr0 * KS + kc0 * 8) = pk0; if (tid < 256) *(u32x4*)(ks_ + kr1 * KS + kc1 * 8) = pk1; *(u32x4*)(vs_ + vd * VS + vc * 8) = pv; }
        __syncthreads();
    }
    lsum += __shfl_xor(lsum, 16); lsum += __shfl_xor(lsum, 32);
    const float il = 1.f / lsum;
    if (do_store)
#pragma unroll
    for (int d = 0; d < 4; ++d) { bf16_t* zp = Z + (size_t)trow * NZ + h * 64 + d * 16 + fq * 4; const f32x4 z = unpack4(*(const u32x2*)zp);
        f32x4 o;
#pragma unroll
        for (int e = 0; e < 4; ++e) o[e] = O[d][e] * il * siluf_(z[e]);
        *(u32x2*)zp = pack4(o); }
}

__device__ __forceinline__ void scan_item(const Params& p, int l, int bh, unsigned char* lds) {
    const int tid = tid_l(), b = bh >> 3, h = bh & 7;
    const unsigned char* r2 = p.ws + OFF_R2; bf16_t* Z = (bf16_t*)(p.ws + OFF_Z);
    float* Lw = (float*)lds; float* La = Lw + 4096; float* Lb = La + 4096; float* Lk = Lb + 4096; float* Lr = Lk + 4096; float* Lv = Lr + 4096; float* Ly = Lv + 4096;
    const int i = tid >> 3, jp = tid & 7;
    float st[8];
#pragma unroll
    for (int e = 0; e < 8; ++e) st[e] = 0.f;
    const int et = tid >> 3, ep = tid & 7;
#pragma unroll 1
    for (int ck = 0; ck < SEQ / 64; ++ck) {
        const size_t tg = (size_t)b * SEQ + ck * 64 + et; const size_t o = tg * 512 + h * 64 + ep * 8;
        __syncthreads();
        { const u32x4 ur = *(const u32x4*)((const bf16_t*)(r2 + R2_R) + o), uk = *(const u32x4*)((const bf16_t*)(r2 + R2_K) + o), uv = *(const u32x4*)((const bf16_t*)(r2 + R2_V) + o),
                      ukk = *(const u32x4*)((const bf16_t*)(r2 + R2_KK) + o), ub = *(const u32x4*)((const bf16_t*)(r2 + R2_B) + o);
            const f32x4 l0 = *(const f32x4*)((const float*)(r2 + R2_LW) + o), l1 = *(const f32x4*)((const float*)(r2 + R2_LW) + o + 4);
            const int lo = et * 64 + ep * 8;
            *(f32x4*)(Lw + lo) = (f32x4){__expf(l0[0]), __expf(l0[1]), __expf(l0[2]), __expf(l0[3])}; *(f32x4*)(Lw + lo + 4) = (f32x4){__expf(l1[0]), __expf(l1[1]), __expf(l1[2]), __expf(l1[3])};
            *(f32x4*)(La + lo) = (f32x4){-bf_lo(ukk.x), -bf_hi(ukk.x), -bf_lo(ukk.y), -bf_hi(ukk.y)}; *(f32x4*)(La + lo + 4) = (f32x4){-bf_lo(ukk.z), -bf_hi(ukk.z), -bf_lo(ukk.w), -bf_hi(ukk.w)};
            *(f32x4*)(Lb + lo) = (f32x4){bf_lo(ub.x), bf_hi(ub.x), bf_lo(ub.y), bf_hi(ub.y)}; *(f32x4*)(Lb + lo + 4) = (f32x4){bf_lo(ub.z), bf_hi(ub.z), bf_lo(ub.w), bf_hi(ub.w)};
            *(f32x4*)(Lk + lo) = (f32x4){bf_lo(uk.x), bf_hi(uk.x), bf_lo(uk.y), bf_hi(uk.y)}; *(f32x4*)(Lk + lo + 4) = (f32x4){bf_lo(uk.z), bf_hi(uk.z), bf_lo(uk.w), bf_hi(uk.w)};
            *(f32x4*)(Lr + lo) = (f32x4){bf_lo(ur.x), bf_hi(ur.x), bf_lo(ur.y), bf_hi(ur.y)}; *(f32x4*)(Lr + lo + 4) = (f32x4){bf_lo(ur.z), bf_hi(ur.z), bf_lo(ur.w), bf_hi(ur.w)};
            *(f32x4*)(Lv + lo) = (f32x4){bf_lo(uv.x), bf_hi(uv.x), bf_lo(uv.y), bf_hi(uv.y)}; *(f32x4*)(Lv + lo + 4) = (f32x4){bf_lo(uv.z), bf_hi(uv.z), bf_lo(uv.w), bf_hi(uv.w)};
        }
        __syncthreads();
#pragma unroll 1
        for (int t = 0; t < 64; ++t) { const int lo = t * 64 + jp * 8;
            const f32x4 w0 = *(const f32x4*)(Lw + lo), w1 = *(const f32x4*)(Lw + lo + 4), a0 = *(const f32x4*)(La + lo), a1 = *(const f32x4*)(La + lo + 4), b0 = *(const f32x4*)(Lb + lo), b1 = *(const f32x4*)(Lb + lo + 4),
                        k0 = *(const f32x4*)(Lk + lo), k1 = *(const f32x4*)(Lk + lo + 4), r0 = *(const f32x4*)(Lr + lo), r1 = *(const f32x4*)(Lr + lo + 4);
            const float vi = Lv[t * 64 + i];
            float sa = st[0] * a0[0] + st[1] * a0[1] + st[2] * a0[2] + st[3] * a0[3] + st[4] * a1[0] + st[5] * a1[1] + st[6] * a1[2] + st[7] * a1[3];
            sa += __shfl_xor(sa, 1); sa += __shfl_xor(sa, 2); sa += __shfl_xor(sa, 4);
            st[0] = st[0] * w0[0] + sa * b0[0] + vi * k0[0]; st[1] = st[1] * w0[1] + sa * b0[1] + vi * k0[1]; st[2] = st[2] * w0[2] + sa * b0[2] + vi * k0[2]; st[3] = st[3] * w0[3] + sa * b0[3] + vi * k0[3];
            st[4] = st[4] * w1[0] + sa * b1[0] + vi * k1[0]; st[5] = st[5] * w1[1] + sa * b1[1] + vi * k1[1]; st[6] = st[6] * w1[2] + sa * b1[2] + vi * k1[2]; st[7] = st[7] * w1[3] + sa * b1[3] + vi * k1[3];
            float y = st[0] * r0[0] + st[1] * r0[1] + st[2] * r0[2] + st[3] * r0[3] + st[4] * r1[0] + st[5] * r1[1] + st[6] * r1[2] + st[7] * r1[3];
            y += __shfl_xor(y, 1); y += __shfl_xor(y, 2); y += __shfl_xor(y, 4);
            if (jp == 0) Ly[t * 64 + i] = y;
        }
        __syncthreads();
        { const int lo = et * 64 + ep * 8;
            const f32x4 y0 = *(const f32x4*)(Ly + lo), y1 = *(const f32x4*)(Ly + lo + 4), r0 = *(const f32x4*)(Lr + lo), r1 = *(const f32x4*)(Lr + lo + 4), k0 = *(const f32x4*)(Lk + lo), k1 = *(const f32x4*)(Lk + lo + 4),
                        v0 = *(const f32x4*)(Lv + lo), v1 = *(const f32x4*)(Lv + lo + 4);
            const f32x4 rk0 = *(const f32x4*)(p.r_k + (size_t)l * 512 + h * 64 + ep * 8), rk1 = *(const f32x4*)(p.r_k + (size_t)l * 512 + h * 64 + ep * 8 + 4);
            float s = y0[0] + y0[1] + y0[2] + y0[3] + y1[0] + y1[1] + y1[2] + y1[3];
            float dot = r0[0] * k0[0] * rk0[0] + r0[1] * k0[1] * rk0[1] + r0[2] * k0[2] * rk0[2] + r0[3] * k0[3] * rk0[3] + r1[0] * k1[0] * rk1[0] + r1[1] * k1[1] * rk1[1] + r1[2] * k1[2] * rk1[2] + r1[3] * k1[3] * rk1[3];
            s += __shfl_xor(s, 1); s += __shfl_xor(s, 2); s += __shfl_xor(s, 4);
            dot += __shfl_xor(dot, 1); dot += __shfl_xor(dot, 2); dot += __shfl_xor(dot, 4);
            const float mean = s * (1.f / 64.f);
            const f32x4 d0 = y0 - mean, d1 = y1 - mean;
            float q = d0[0] * d0[0] + d0[1] * d0[1] + d0[2] * d0[2] + d0[3] * d0[3] + d1[0] * d1[0] + d1[1] * d1[1] + d1[2] * d1[2] + d1[3] * d1[3];
            q += __shfl_xor(q, 1); q += __shfl_xor(q, 2); q += __shfl_xor(q, 4);
            const float rstd = rsqrtf(q * (1.f / 64.f) + 64e-5f);
            const f32x4 g0 = *(const f32x4*)(p.lnx_g + (size_t)l * 512 + h * 64 + ep * 8), g1 = *(const f32x4*)(p.lnx_g + (size_t)l * 512 + h * 64 + ep * 8 + 4),
                        e0 = *(const f32x4*)(p.lnx_b + (size_t)l * 512 + h * 64 + ep * 8), e1 = *(const f32x4*)(p.lnx_b + (size_t)l * 512 + h * 64 + ep * 8 + 4);
            bf16_t* zp = Z + tg * NZ + 1024 + h * 64 + ep * 8; const u32x4 zu = *(const u32x4*)zp;
            const f32x4 o0 = d0 * rstd * g0 + e0 + v0 * dot, o1 = d1 * rstd * g1 + e1 + v1 * dot;
            u32x4 w; w.x = cvt_pk_bf16(o0[0] * siluf_(bf_lo(zu.x)), o0[1] * siluf_(bf_hi(zu.x))); w.y = cvt_pk_bf16(o0[2] * siluf_(bf_lo(zu.y)), o0[3] * siluf_(bf_hi(zu.y)));
            w.z = cvt_pk_bf16(o1[0] * siluf_(bf_lo(zu.z)), o1[1] * siluf_(bf_hi(zu.z))); w.w = cvt_pk_bf16(o1[2] * siluf_(bf_lo(zu.w)), o1[3] * siluf_(bf_hi(zu.w)));
            *(u32x4*)zp = w; }
    }
}


constexpr int MS = 72;
__device__ __forceinline__ f32x4 nt_tile(const bf16_t* Am, int arow, const bf16_t* Bm, int brow, f32x4 acc, int fq) {
    acc = MFMA(ld_frag(Am + arow * MS + fq * 8), ld_frag(Bm + brow * MS + fq * 8), acc);
    acc = MFMA(ld_frag(Am + arow * MS + 32 + fq * 8), ld_frag(Bm + brow * MS + 32 + fq * 8), acc);
    return acc;
}
#if PROBE_SCAN
#define CHKF_OLD(ptr, n, bit) do { unsigned _c = 0u; for (int _i = tid; _i < (n); _i += NTHREADS) { const float _a = (ptr)[_i]; if (!(fabsf(_a) < 1e30f)) _c = (bit); } if (_c) atomicOr((unsigned*)(p.ws + WS_END + 5 * MiB), _c); } while (0)
#define CHKB_OLD(ptr, bit) do { unsigned _c = 0u; for (int _i = tid; _i < 4096; _i += NTHREADS) { const float _a = bf2f((ptr)[(_i >> 6) * MS + (_i & 63)]); if (!(fabsf(_a) < 1e30f)) _c = (bit); } if (_c) atomicOr((unsigned*)(p.ws + WS_END + 5 * MiB), _c); } while (0)
#endif
#define CHKF(ptr, n, bit)
#define CHKB(ptr, bit)
__device__ __forceinline__ void chunk_item(const Params& p, int item, unsigned char* lds) {
    const int tid = tid_l(), lane = tid & 63, wave = __builtin_amdgcn_readfirstlane(tid >> 6), fr = lane & 15, fq = lane >> 4;
    const int bh = item >> 6, ck = item & 63, b = bh >> 3, h = bh & 7;
    const size_t tok0 = (size_t)b * SEQ + ck * 64;
    const unsigned char* r2 = p.ws + OFF_R2; unsigned char* r1 = p.ws + OFF_R1;
    float* CUM = (float*)lds; float* TF = CUM + 4096; float* XB = TF + 4096; float* TOT = XB + 1024;
    bf16_t* MB = (bf16_t*)(lds + 38912);
    bf16_t *AT_ = MB, *BT_ = MB + 1 * 64 * MS, *KT_ = MB + 2 * 64 * MS, *RT_ = MB + 3 * 64 * MS, *ATT = MB + 4 * 64 * MS, *VT = MB + 5 * 64 * MS, *KHT = MB + 6 * 64 * MS, *BHT = MB + 7 * 64 * MS,
           *MAK = MB + 8 * 64 * MS, *MRB = MB + 9 * 64 * MS, *MRK = MB + 10 * 64 * MS, *TB = MB + 11 * 64 * MS;
    bf16_t *MVT = AT_, *TAT = BT_, *W1T = KT_;
    const float* LWg = (const float*)(r2 + R2_LW);
    __syncthreads();
    { float c[8]; float run = 0.f;
#pragma unroll
        for (int e = 0; e < 8; ++e) { run += LWg[(tok0 + wave * 8 + e) * 512 + h * 64 + lane]; c[e] = run; }
        TOT[wave * 64 + lane] = run;
        __syncthreads();
        float off = 0.f;
#pragma unroll
        for (int w2 = 0; w2 < 7; ++w2) off += (w2 < wave) ? TOT[w2 * 64 + lane] : 0.f;
#pragma unroll
        for (int e = 0; e < 8; ++e) CUM[(wave * 8 + e) * 64 + lane] = off + c[e];
    }
    __syncthreads();
    { const int t = tid & 63, j0 = (tid >> 6) * 8; const size_t o = (tok0 + t) * 512 + h * 64 + j0;
        const u32x4 ur = *(const u32x4*)((const bf16_t*)(r2 + R2_R) + o), uk = *(const u32x4*)((const bf16_t*)(r2 + R2_K) + o), uv = *(const u32x4*)((const bf16_t*)(r2 + R2_V) + o),
                    ukk = *(const u32x4*)((const bf16_t*)(r2 + R2_KK) + o), ub = *(const u32x4*)((const bf16_t*)(r2 + R2_B) + o);
        const unsigned rr[4] = {ur.x, ur.y, ur.z, ur.w}, kr[4] = {uk.x, uk.y, uk.z, uk.w}, vr[4] = {uv.x, uv.y, uv.z, uv.w}, qr[4] = {ukk.x, ukk.y, ukk.z, ukk.w}, br[4] = {ub.x, ub.y, ub.z, ub.w};
        unsigned oa[4], ob[4], ok[4], orr[4];
#pragma unroll
        for (int e2 = 0; e2 < 4; ++e2) { float va[2], vb[2], vk[2], vrr[2];
#pragma unroll
            for (int hh = 0; hh < 2; ++hh) { const int e = 2 * e2 + hh;
                const float cm = CUM[t * 64 + j0 + e], lwv = LWg[o + e], cC = CUM[63 * 64 + j0 + e];
                const float rv = hh ? bf_hi(rr[e2]) : bf_lo(rr[e2]), kv = hh ? bf_hi(kr[e2]) : bf_lo(kr[e2]), vv = hh ? bf_hi(vr[e2]) : bf_lo(vr[e2]), qv = hh ? bf_hi(qr[e2]) : bf_lo(qr[e2]), bv = hh ? bf_hi(br[e2]) : bf_lo(br[e2]);
                const float en = __expf(-cm), eh = __expf(cC - cm);
                va[hh] = -qv * __expf(cm - lwv); vb[hh] = bv * en; vk[hh] = kv * en; vrr[hh] = rv * __expf(cm);
                ATT[(j0 + e) * MS + t] = f2bf(va[hh]); VT[(j0 + e) * MS + t] = f2bf(vv); KHT[(j0 + e) * MS + t] = f2bf(kv * eh); BHT[(j0 + e) * MS + t] = f2bf(bv * eh);
                if (t == 63) ((float*)(r1 + R1_PC))[(size_t)item * 64 + j0 + e] = __expf(cC); }
            oa[e2] = cvt_pk_bf16(va[0], va[1]); ob[e2] = cvt_pk_bf16(vb[0], vb[1]); ok[e2] = cvt_pk_bf16(vk[0], vk[1]); orr[e2] = cvt_pk_bf16(vrr[0], vrr[1]); }
        *(u32x4*)(AT_ + t * MS + j0) = (u32x4){oa[0], oa[1], oa[2], oa[3]}; *(u32x4*)(BT_ + t * MS + j0) = (u32x4){ob[0], ob[1], ob[2], ob[3]};
        *(u32x4*)(KT_ + t * MS + j0) = (u32x4){ok[0], ok[1], ok[2], ok[3]}; *(u32x4*)(RT_ + t * MS + j0) = (u32x4){orr[0], orr[1], orr[2], orr[3]};
    }
    __syncthreads();
#pragma unroll 1
    for (int x = 0; x < 8; ++x) { const int q = wave * 8 + x, mat = q >> 4, tm = (q >> 2) & 3, tn = q & 3;
        const bf16_t* Am = (mat & 1) ? KT_ : BT_; const bf16_t* Bm = (mat & 2) ? RT_ : AT_;
        f32x4 acc = nt_tile(Am, tm * 16 + fr, Bm, tn * 16 + fr, (f32x4){0.f, 0.f, 0.f, 0.f}, fq);
        const int t = tn * 16 + fr, s0 = tm * 16 + fq * 4;
#pragma unroll
        for (int e = 0; e < 4; ++e) { const bool keep = (mat & 2) ? (s0 + e <= t) : (s0 + e < t); acc[e] = keep ? acc[e] : 0.f; }
        if (mat == 0) *(f32x4*)(CUM + t * 64 + s0) = acc;
        else { bf16_t* Om = (mat == 1) ? MAK : (mat == 2) ? MRB : MRK; *(u32x2*)(Om + t * MS + s0) = pack4(acc); }
    }
    __syncthreads();

    if (wave == 0) { const int base = (lane >> 5) * 32, c = lane & 31; float xv[32]; int roff = base * 65; float prev = 0.f;
#pragma unroll
        for (int t = 0; t < 32; ++t) { float a = (t == c) ? 1.f : 0.f;
            asm volatile("" : "+v"(roff), "+v"(prev));
            const float* Lr = CUM + roff + t * 64;
#pragma unroll
            for (int s2 = 0; s2 < t; ++s2) a += Lr[s2] * xv[s2];
            xv[t] = a; prev = a; }
#pragma unroll
        for (int t = 0; t < 32; ++t) { TF[(base + t) * 64 + base + c] = xv[t]; if (base == 0) TF[t * 64 + 32 + c] = 0.f; }
    }
    __syncthreads();
    { const int r = tid >> 4, c0 = (tid & 15) * 2; float x0 = 0.f, x1 = 0.f;
#pragma unroll 8
        for (int k = 0; k < 32; ++k) { const float lv = CUM[(32 + r) * 64 + k]; x0 += lv * TF[k * 64 + c0]; x1 += lv * TF[k * 64 + c0 + 1]; }
        XB[r * 32 + c0] = x0; XB[r * 32 + c0 + 1] = x1;
        __syncthreads();
        float y0 = 0.f, y1 = 0.f;
#pragma unroll 8
        for (int k = 0; k < 32; ++k) { const float tv = TF[(32 + r) * 64 + 32 + k]; y0 += tv * XB[k * 32 + c0]; y1 += tv * XB[k * 32 + c0 + 1]; }
        TF[(32 + r) * 64 + c0] = y0; TF[(32 + r) * 64 + c0 + 1] = y1;
    }
    __syncthreads();
    { const int t = tid >> 3, s0 = (tid & 7) * 8; const f32x4 a = *(const f32x4*)(TF + t * 64 + s0), b2 = *(const f32x4*)(TF + t * 64 + s0 + 4);
        u32x4 w; w.x = cvt_pk_bf16(a[0], a[1]); w.y = cvt_pk_bf16(a[2], a[3]); w.z = cvt_pk_bf16(b2[0], b2[1]); w.w = cvt_pk_bf16(b2[2], b2[3]);
        *(u32x4*)(TB + t * MS + s0) = w; }
    __syncthreads();
#pragma unroll 1
    for (int x = 0; x < 4; ++x) { const int q = wave * 4 + x, mat = q >> 4, tm = (q >> 2) & 3, tn = q & 3;
        const f32x4 acc = nt_tile(mat ? TB : MAK, tm * 16 + fr, mat ? ATT : VT, tn * 16 + fr, (f32x4){0.f, 0.f, 0.f, 0.f}, fq);
        *(u32x2*)((mat ? TAT : MVT) + (tn * 16 + fr) * MS + tm * 16 + fq * 4) = pack4(acc); }
    __syncthreads();
#pragma unroll 1
    for (int x = 0; x < 2; ++x) { const int q = wave * 2 + x, tm = q >> 2, tn = q & 3;
        const f32x4 acc = nt_tile(TB, tm * 16 + fr, MVT, tn * 16 + fr, (f32x4){0.f, 0.f, 0.f, 0.f}, fq);
        *(u32x2*)(W1T + (tn * 16 + fr) * MS + tm * 16 + fq * 4) = pack4(acc); }
    __syncthreads();
#pragma unroll 1
    for (int x = 0; x < 8; ++x) { const int q = wave * 8 + x, o = q >> 4, tm = (q >> 2) & 3, tn = q & 3;
        const int ar = tm * 16 + fr, br_ = tn * 16 + fr; f32x4 acc = (f32x4){0.f, 0.f, 0.f, 0.f};
        if (o == 0) acc = nt_tile(TAT, ar, BHT, br_, acc, fq);
        else if (o == 1) { acc = unpack4(*(const u32x2*)(RT_ + br_ * MS + tm * 16 + fq * 4)); acc = nt_tile(TAT, ar, MRB, br_, acc, fq); }
        else if (o == 2) { acc = nt_tile(KHT, ar, VT, br_, acc, fq); acc = nt_tile(BHT, ar, W1T, br_, acc, fq); }
        else { acc = nt_tile(VT, ar, MRK, br_, acc, fq);
#if EXP_CONSTY
            acc = (f32x4){1.f, 2.f, 3.f, 4.f};
#endif
#if !EXP_NOW1
            acc = nt_tile(W1T, ar, MRB, br_, acc, fq);
#endif
        }
        bf16_t* og = (bf16_t*)(r1 + (size_t)o * 16 * MiB) + (size_t)item * 4096 + br_ * 64 + tm * 16 + fq * 4;
        *(u32x2*)og = pack4(acc); }
}

__device__ __forceinline__ void seq_item(const Params& p, int l, int bh, unsigned char* lds, bf16_t* dstp, int dst_ld, size_t dst_tok0) {
    const int tid = tid_l(), lane = tid & 63, wave = __builtin_amdgcn_readfirstlane(tid >> 6), fr = lane & 15, fq = lane >> 4;
    const int b = bh >> 3, h = bh & 7;
    const unsigned char* r1 = p.ws + OFF_R1;
    constexpr int BUFB = 4 * 64 * MS * 2 + 256;
    bf16_t* SB = (bf16_t*)(lds + 2 * BUFB) + wave * 16 * MS;
    float* YB = (float*)(lds + 2 * BUFB + 4 * 16 * MS * 2);
    const int srow = tid >> 3, sc8 = tid & 7;
    u32x4 pre[4]; float prepc = 0.f;
    __syncthreads();
    { const size_t ci = (size_t)bh * 64;
#pragma unroll
        for (int m = 0; m < 4; ++m) pre[m] = *(const u32x4*)((const bf16_t*)(r1 + (size_t)m * 16 * MiB) + ci * 4096 + srow * 64 + sc8 * 8);
        if (tid < 64) prepc = ((const float*)(r1 + R1_PC))[ci * 64 + tid];
#pragma unroll
        for (int m = 0; m < 4; ++m) *(u32x4*)((bf16_t*)lds + m * 64 * MS + srow * MS + sc8 * 8) = pre[m];
        if (tid < 64) ((float*)(lds + 4 * 64 * MS * 2))[tid] = prepc;
        if (wave < 4) { for (int e = lane; e < 16 * MS / 2; e += 64) ((unsigned*)SB)[e] = 0u; }
    }
    __syncthreads();
    f32x4 Sacc[4];
#pragma unroll
    for (int jt = 0; jt < 4; ++jt) Sacc[jt] = (f32x4){0.f, 0.f, 0.f, 0.f};
#pragma unroll 1
    for (int c = 0; c < 64; ++c) {
        const bool pf = (c + 1 < 64);
        if (pf) { const size_t ci = (size_t)bh * 64 + c + 1;
#pragma unroll
            for (int m = 0; m < 4; ++m) pre[m] = *(const u32x4*)((const bf16_t*)(r1 + (size_t)m * 16 * MiB) + ci * 4096 + srow * 64 + sc8 * 8);
            if (tid < 64) prepc = ((const float*)(r1 + R1_PC))[ci * 64 + tid]; }
        if (wave < 4) {
            if (c < 64) {
                const unsigned char* bufp = lds + (c & 1) * BUFB;
                const bf16_t* GP = (const bf16_t*)bufp; const bf16_t* RA = GP + 64 * MS; const bf16_t* HT = RA + 64 * MS; const bf16_t* YQ = HT + 64 * MS; const float* PC = (const float*)(bufp + 4 * 64 * MS * 2);
#if EXP_NOSTATE
                const bf16x8 sf0 = (bf16x8){0,0,0,0,0,0,0,0}, sf1 = sf0;
#else
                const bf16x8 sf0 = ld_frag(SB + fr * MS + fq * 8), sf1 = ld_frag(SB + fr * MS + 32 + fq * 8);
#endif
                float* yb = YB + (c & 1) * 4096;
#pragma unroll
                for (int tt = 0; tt < 4; ++tt) { f32x4 y = unpack4(*(const u32x2*)(YQ + (tt * 16 + fr) * MS + wave * 16 + fq * 4));
                    y = MFMA(sf0, ld_frag(RA + (tt * 16 + fr) * MS + fq * 8), y); y = MFMA(sf1, ld_frag(RA + (tt * 16 + fr) * MS + 32 + fq * 8), y);
                    *(f32x4*)(yb + (tt * 16 + fr) * 64 + wave * 16 + fq * 4) = y; }
#pragma unroll
                for (int jt = 0; jt < 4; ++jt) { const f32x4 pc = *(const f32x4*)(PC + jt * 16 + fq * 4);
                    f32x4 a = unpack4(*(const u32x2*)(HT + (wave * 16 + fr) * MS + jt * 16 + fq * 4)) + Sacc[jt] * pc;
                    a = MFMA(ld_frag(GP + (jt * 16 + fr) * MS + fq * 8), sf0, a); a = MFMA(ld_frag(GP + (jt * 16 + fr) * MS + 32 + fq * 8), sf1, a);
                    Sacc[jt] = a; }
#pragma unroll
                for (int jt = 0; jt < 4; ++jt) *(u32x2*)(SB + fr * MS + jt * 16 + fq * 4) = pack4(Sacc[jt]);
            }
        }
        if (pf) { unsigned char* bufn = lds + ((c + 1) & 1) * BUFB;
#pragma unroll
            for (int m = 0; m < 4; ++m) *(u32x4*)((bf16_t*)bufn + m * 64 * MS + srow * MS + sc8 * 8) = pre[m];
            if (tid < 64) ((float*)(bufn + 4 * 64 * MS * 2))[tid] = prepc; }
        __syncthreads();
        if (c < 64) {
            const int t = tid >> 3, q = tid & 7; const float* yb = YB + (c & 1) * 4096 + t * 64 + q * 8;
            const f32x4 y0 = *(const f32x4*)yb, y1 = *(const f32x4*)(yb + 4);
            float s1 = y0[0] + y0[1] + y0[2] + y0[3] + y1[0] + y1[1] + y1[2] + y1[3];
            s1 += __shfl_xor(s1, 1); s1 += __shfl_xor(s1, 2); s1 += __shfl_xor(s1, 4);
            const float mean = s1 * (1.f / 64.f); const f32x4 d0 = y0 - mean, d1 = y1 - mean;
            float s2 = d0[0] * d0[0] + d0[1] * d0[1] + d0[2] * d0[2] + d0[3] * d0[3] + d1[0] * d1[0] + d1[1] * d1[1] + d1[2] * d1[2] + d1[3] * d1[3];
            s2 += __shfl_xor(s2, 1); s2 += __shfl_xor(s2, 2); s2 += __shfl_xor(s2, 4);
            const float rstd = rsqrtf(s2 * (1.f / 64.f) + 64e-5f);
            const size_t tg = (size_t)b * SEQ + c * 64 + t; const int ch = h * 64 + q * 8;
            const float dot = ((const float*)(p.ws + OFF_DOT))[tg * 8 + h];
            const u32x4 vu = *(const u32x4*)((const bf16_t*)(p.ws + OFF_R2 + R2_V) + tg * 512 + ch);
            bf16_t* zp = dstp + (tg - dst_tok0) * dst_ld + ch; const u32x4 zu = *(const u32x4*)((const bf16_t*)(p.ws + OFF_Z) + tg * NZ + 1024 + ch);
            const f32x4 g0 = *(const f32x4*)(p.lnx_g + (size_t)l * 512 + ch), g1 = *(const f32x4*)(p.lnx_g + (size_t)l * 512 + ch + 4), e0 = *(const f32x4*)(p.lnx_b + (size_t)l * 512 + ch), e1 = *(const f32x4*)(p.lnx_b + (size_t)l * 512 + ch + 4);
            const f32x4 v0 = (f32x4){bf_lo(vu.x), bf_hi(vu.x), bf_lo(vu.y), bf_hi(vu.y)}, v1 = (f32x4){bf_lo(vu.z), bf_hi(vu.z), bf_lo(vu.w), bf_hi(vu.w)};
            const f32x4 o0 = d0 * rstd * g0 + e0 + v0 * dot, o1 = d1 * rstd * g1 + e1 + v1 * dot;
            u32x4 w; w.x = cvt_pk_bf16(o0[0] * siluf_(bf_lo(zu.x)), o0[1] * siluf_(bf_hi(zu.x))); w.y = cvt_pk_bf16(o0[2] * siluf_(bf_lo(zu.y)), o0[3] * siluf_(bf_hi(zu.y)));
            w.z = cvt_pk_bf16(o1[0] * siluf_(bf_lo(zu.z)), o1[1] * siluf_(bf_hi(zu.z))); w.w = cvt_pk_bf16(o1[2] * siluf_(bf_lo(zu.w)), o1[3] * siluf_(bf_hi(zu.w)));
            *(u32x4*)zp = w;
        }
    }
}

#define XB_TMO      128
#define XB_XCNT(j)  (256  + 64 * (j))
#define XB_XSUB(j)  (1280 + 64 * (j))
#define XB_XGEN(j)  (2304 + 64 * (j))
#define XB_TOP      3328
#define XB_TOPGEN   3392
#define XCD_BAR_WORDS 3456
#define XB_SPIN_CAP (1u << 18)

__device__ __forceinline__ unsigned xb_ld(unsigned* p)              { return __hip_atomic_load(p, __ATOMIC_RELAXED, __HIP_MEMORY_SCOPE_AGENT); }
__device__ __forceinline__ unsigned xb_add(unsigned* p, unsigned v) { return __hip_atomic_fetch_add(p, v, __ATOMIC_RELAXED, __HIP_MEMORY_SCOPE_AGENT); }
__device__ __forceinline__ unsigned xb_xcc_id() { return (unsigned)__builtin_amdgcn_s_getreg((3 << 11) | 20) & 0xFu; }
#define XB_SPIN(cond, bar) do { unsigned _sp = 0; while (cond) { __builtin_amdgcn_s_sleep(1); \
    if ((++_sp & 255u) == 0u) { if (xb_ld(&(bar)[XB_TMO])) break; if (_sp > XB_SPIN_CAP) { atomicAdd(&(bar)[XB_TMO], 1u); break; } } } } while (0)

struct XcdBarrier {
    unsigned* bar; unsigned x;
    volatile LAS unsigned* st;
};

__device__ __forceinline__ XcdBarrier xcd_barrier_post(unsigned* bar, volatile LAS unsigned* st) {
    XcdBarrier b; b.bar = bar; b.x = xb_xcc_id(); b.st = st;
    if (threadIdx.x == 0) (void)xb_add(&bar[XB_XCNT(b.x)], 1u);
    return b;
}
__device__ __forceinline__ void xcd_barrier_complete(unsigned* bar, unsigned x, unsigned& nloc, unsigned& nx) {
    const unsigned G = gridDim.x * gridDim.y * gridDim.z;
    unsigned sum, cnt, mine, sp = 0u;
    for (;;) {
        sum = 0u; cnt = 0u; mine = 0u;
#pragma unroll
        for (unsigned j = 0; j < 16; ++j) { const unsigned c = xb_ld(&bar[XB_XCNT(j)]); sum += c; cnt += (c > 0u) ? 1u : 0u; mine = (j == x) ? c : mine; }
        if (sum == G) break;
        __builtin_amdgcn_s_sleep(1);
        if ((++sp & 255u) == 0u) { if (xb_ld(&bar[XB_TMO])) break; if (sp > XB_SPIN_CAP) { atomicAdd(&bar[XB_TMO], 1u); break; } }
    }
    nloc = mine > 0u ? mine : 1u; nx = cnt > 0u ? cnt : 1u;
}

__device__ __forceinline__ void xcd_barrier(const XcdBarrier& b) {
    asm volatile("s_waitcnt vmcnt(0)" ::: "memory");
    __syncthreads();
    if (threadIdx.x == 0) {
        unsigned* bar = b.bar;
        __builtin_amdgcn_s_waitcnt(0);
        unsigned nloc = b.st[0], nx = b.st[1];
        if (nloc == 0u) { xcd_barrier_complete(bar, b.x, nloc, nx); b.st[0] = nloc; b.st[1] = nx; }
        const unsigned old = xb_add(&bar[XB_XSUB(b.x)], 1u);
        const unsigned gen = old / nloc;
        if (old + 1u == (gen + 1u) * nloc) {
            __builtin_amdgcn_fence(__ATOMIC_RELEASE, "agent");
            asm volatile("s_waitcnt vmcnt(0)" ::: "memory");
            const unsigned og = xb_add(&bar[XB_TOP], 1u);
            const unsigned tg = og / nx;
            if (og + 1u == (tg + 1u) * nx) xb_add(&bar[XB_TOPGEN], 1u);
            else XB_SPIN(xb_ld(&bar[XB_TOPGEN]) == tg, bar);
            __builtin_amdgcn_fence(__ATOMIC_ACQUIRE, "agent");
            xb_add(&bar[XB_XGEN(b.x)], 1u);
            asm volatile("s_waitcnt vmcnt(0)" ::: "memory");
        } else {
            XB_SPIN(xb_ld(&bar[XB_XGEN(b.x)]) == gen, bar);
            __builtin_amdgcn_fence(__ATOMIC_ACQUIRE, "agent");
            asm volatile("s_waitcnt vmcnt(0)" ::: "memory");
        }
    }
    __syncthreads();
}


constexpr int PH_PER_LAYER = 8, PH_PRE = 3, N_PHASES = PH_PRE + NL * PH_PER_LAYER;
__global__ void __launch_bounds__(NTHREADS, 2) trunk_fwd(Params p0) {
    extern __shared__ __attribute__((aligned(16))) unsigned char lds[];
    const int G = gridDim.x, bx = blockIdx.x;
    Params p = p0;
    volatile LAS unsigned* xb_st = (volatile LAS unsigned*)((LAS unsigned char*)lds + (LDS_BYTES - 16));
    if (threadIdx.x == 0) { xb_st[0] = 0u; xb_st[1] = 0u; }
    XcdBarrier xbar; xbar.bar = nullptr; xbar.x = 0; xbar.st = xb_st;
    __syncthreads();
#if EXP_ZERO
    for (int i = threadIdx.x; i < LDS_BYTES / 4; i += NTHREADS) ((unsigned*)lds)[i] = 0u;
    __syncthreads();
    if (p0.ph_lo == 0) { u32x4* z = (u32x4*)(p0.ws + OFF_DOT); const size_t n = (WS_END - OFF_DOT) / 16;
        for (size_t i = (size_t)bx * NTHREADS + threadIdx.x; i < n; i += (size_t)G * NTHREADS) z[i] = (u32x4){0u, 0u, 0u, 0u}; }
#endif
    for (int ph = p0.ph_lo; ph < p0.ph_hi; ++ph) {
        unsigned char* ws = ptr_l(p0.ws); p.ws = ws;
        if (ph == 0) { if (PHEN & 1) for (int rep = 0; rep < REP_P0; ++rep) phase0a(p, lds); }
        else if (ph == 1) { phase_modt(p); }
        else if (ph == 2) { if (PHEN & 2) phase0b(p); }
        else {
            const int l = (ph - PH_PRE) / PH_PER_LAYER, k = (ph - PH_PRE) % PH_PER_LAYER;
            if (k == 0 && (PHEN & 4)) for (int rep = 0; rep < REP_IN; ++rep) {
                pg8::Gemm g{(const bf16_t*)(ws + OFF_H), (const bf16_t*)(ws + OFF_WIN + l * SZ_WIN), DM, DM, DM};
                pg8::PlainOrder S; S.init(M_TOK / 256, NIN / 256, G, bx);
                pg8::EpiIn E{(bf16_t*)(ws + OFF_R1), (bf16_t*)(ws + OFF_Z)};
                pg8::gemm_phase(( LAS unsigned char*)lds, g, S, E);
            } else if (k == 1 && (PHEN & 8)) {
                for (int it = bx; it < 640; it += G) {
                    if (it < 128) { if (PHEN & 512) { for (int rep = 1; rep < REP_GM; ++rep) gmlp_item(p, l, it, lds, false); gmlp_item(p, l, it, lds); } }
                    else if (it < 384) { if (PHEN & 1024) for (int rep = 0; rep < REP_MLA; ++rep) mla_prep_item(p, l, it - 128, lds); }
                    else { if (PHEN & 2048) for (int rep = 0; rep < REP_RW; ++rep) rwkv_prep_item(p, l, it - 384); }
                }
            } else if (k == 2 && (PHEN & 16)) {
                for (int rep = 0; rep < REP_CHUNK; ++rep) for (int it = bx; it < 2048; it += G) { if (USE_CHUNK && (PHEN & 4096)) chunk_item(p, it, lds); }
            } else if (k == 3 && (PHEN & 16)) {
#if !USE_CHUNK
                for (int it = bx; it < 32; it += G) scan_item(p, l, it, lds);
#elif PROBE_SCAN
                for (int it = bx; it < 32; it += G) { if (l == 0 && it < 8) seq_item(p, l, it, lds, (bf16_t*)(ws + WS_END), 512, 0); scan_item(p, l, it, lds); }
#else
                for (int it = bx; it < 32; it += G) { if (PHEN & 8192) seq_item(p, l, it, lds, (bf16_t*)(ws + OFF_Z) + 1024, NZ, 0); }
#endif
                int rank = bx, cnt = G; if (G > 32) { rank = bx - 32; cnt = G - 32; }
                if (rank >= 0) for (int pi = rank; pi < 512; pi += cnt) { const int bh = pi >> 4, j = pi & 15;
                    if (PHEN & 16384) { for (int rep = 1; rep < REP_ATT; ++rep) { attn_item(p, bh >> 3, bh & 7, 31 - j, lds, false); attn_item(p, bh >> 3, bh & 7, j, lds, false); }
                        attn_item(p, bh >> 3, bh & 7, 31 - j, lds); attn_item(p, bh >> 3, bh & 7, j, lds); } }
            } else if (k == 4 && (PHEN & 32)) for (int rep = 0; rep < REP_GMO; ++rep) {
#if PROBE_SCAN
#endif: G = sigmoid(h @ Wg)
                pg8::Gemm g{(const bf16_t*)(ws + OFF_H), (const bf16_t*)(ws + OFF_WG + l * SZ_WG), DM, DM, DM};
                pg8::PlainOrder S; S.init(M_TOK / 256, NG / 256, G, bx);
                pg8::EpiPlain<1> E{(bf16_t*)(ws + OFF_R2), NG};
                pg8::gemm_phase((LAS unsigned char*)lds, g, S, E);
            } else if (k == 5 && (PHEN & 64)) for (int rep = 0; rep < REP_GMO; ++rep) {
                pg8::Gemm g{(const bf16_t*)(ws + OFF_Z), (const bf16_t*)(ws + OFF_WBR + l * SZ_WBR), NZ, 512, 512};
                pg8::MergeOrder S; S.init(M_TOK / 256, DM / 256, G, bx);
                pg8::EpiMerge E{(bf16_t*)(ws + OFF_R3 + R3_MERGED), (const bf16_t*)(ws + OFF_R2)};
                pg8::gemm_phase((LAS unsigned char*)lds, g, S, E);
            } else if (k == 6 && (PHEN & 128)) for (int rep = 0; rep < REP_GMO; ++rep) {
                pg8::Gemm g{(const bf16_t*)(ws + OFF_R3 + R3_MERGED), (const bf16_t*)(ws + OFF_WOUT + l * SZ_WOUT), DM, DM, DM};
                pg8::PlainOrder S; S.init(M_TOK / 256, DM / 256, G, bx);
                pg8::EpiPlain<0> E{(bf16_t*)(ws + OFF_R3 + R3_Y), DM};
                pg8::gemm_phase((LAS unsigned char*)lds, g, S, E);
            } else if (k == 7 && (PHEN & 256)) {
                phase_final(p, l);
            }
        }
#if PROBE_SCAN
        if (ph == N_PHASES - 1 && bx == 0 && threadIdx.x == 0) { const unsigned cd = *(volatile unsigned*)(ws + WS_END + 5 * MiB); p.out[5] = 1000.f * (float)cd; }
        if (ph == 0 && bx == 0 && threadIdx.x == 0) *(unsigned*)(ws + WS_END + 5 * MiB) = 0u;
#endif
        if (ph + 1 < p0.ph_hi) {
            if (ph == p0.ph_lo) {
                if (bx == 0) { unsigned* zb = (unsigned*)ptr_l(p0.ws + WS_END); for (int i = tid_l(); i < XCD_BAR_WORDS; i += NTHREADS) __hip_atomic_store(zb + i, 0u, __ATOMIC_RELAXED, __HIP_MEMORY_SCOPE_AGENT); }
                cg::this_grid().sync();
                xbar = xcd_barrier_post((unsigned*)ptr_l(p0.ws + WS_END), xb_st);
            } else { XcdBarrier b2; b2.bar = (unsigned*)ptr_l(p0.ws + WS_END); b2.x = xbar.x; b2.st = xb_st; xcd_barrier(b2); }
        }
    }
}

extern "C" void kernel_launch(void* const* d_in, const int* in_sizes, int n_in, void* d_out, int out_size, void* d_ws, size_t ws_size, hipStream_t stream) {
    static int grid = 0;
    if (grid == 0) {
        if (n_in != 31 || out_size != M_TOK * DM || ws_size < WS_END + 65536) { fprintf(stderr, "kernel_launch: unexpected shapes (n_in %d out %d ws %zu)\n", n_in, out_size, ws_size); grid = -1; return; }
        int dev = 0, cus = 0, per_cu = 0;
        hipGetDevice(&dev); hipDeviceGetAttribute(&cus, hipDeviceAttributeMultiprocessorCount, dev);
        hipFuncSetAttribute((const void*)trunk_fwd, hipFuncAttributeMaxDynamicSharedMemorySize, LDS_BYTES);
        hipOccupancyMaxActiveBlocksPerMultiprocessor(&per_cu, (const void*)trunk_fwd, NTHREADS, LDS_BYTES);
        if (per_cu < 1) { fprintf(stderr, "kernel_launch: occupancy query says %d blocks per CU\n", per_cu); grid = -1; return; }
        grid = cus * 1;
    }
    if (grid < 0) return;
    Params p{};
    p.x = (const float*)d_in[0]; p.c = (const float*)d_in[1]; p.pos = (const int*)d_in[2]; p.pre_g = (const float*)d_in[3]; p.post_g = (const float*)d_in[4];
    p.w_ada = (const float*)d_in[5]; p.b_ada = (const float*)d_in[6]; p.w_in = (const float*)d_in[7]; p.q_norm = (const float*)d_in[8]; p.w_uq = (const float*)d_in[9];
    p.kv_norm = (const float*)d_in[10]; p.w_ukv = (const float*)d_in[11]; p.ln_g = (const float*)d_in[12]; p.ln_b = (const float*)d_in[13]; p.w_s = (const float*)d_in[14]; p.b_s = (const float*)d_in[15];
    p.mu = (const float*)d_in[16]; p.w0 = (const float*)d_in[17]; p.w2 = (const float*)d_in[18]; p.a0 = (const float*)d_in[19]; p.a2 = (const float*)d_in[20]; p.k_k = (const float*)d_in[21];
    p.k_a = (const float*)d_in[22]; p.r_k = (const float*)d_in[23]; p.lnx_g = (const float*)d_in[24]; p.lnx_b = (const float*)d_in[25]; p.v0 = (const float*)d_in[26]; p.v1 = (const float*)d_in[27];
    p.v2 = (const float*)d_in[28]; p.w_br = (const float*)d_in[29]; p.w_out = (const float*)d_in[30];
    p.out = (float*)d_out; p.ws = (unsigned char*)d_ws;
#if ONE_LAUNCH
    p.ph_lo = 0; p.ph_hi = N_PHASES;
    void* args[] = {&p};
    hipError_t e = hipLaunchCooperativeKernel((const void*)trunk_fwd, dim3(grid), dim3(NTHREADS), args, LDS_BYTES, stream);
    if (e != hipSuccess) fprintf(stderr, "cooperative launch failed: %s (grid %d)\n", hipGetErrorString(e), grid);
#else
    for (int ph = 0; ph < N_PHASES; ++ph) { p.ph_lo = ph; p.ph_hi = ph + 1;
        hipLaunchKernelGGL(trunk_fwd, dim3(grid), dim3(NTHREADS), LDS_BYTES, stream, p); }
#endif
}
```

```cpp
#include <hip/hip_runtime.h>
#include <hip/hip_cooperative_groups.h>
#include <cstdint>
#include <cstdio>
namespace cg = cooperative_groups;

#ifndef PHEN
#define PHEN 0x7fff
#endif
#ifndef TS_K
#define TS_K -1
#endif
#ifndef REP_P0
#define REP_P0 1
#endif
#ifndef REP_GMO
#define REP_GMO 1
#endif
#ifndef REP_GM
#define REP_GM 1
#endif
#ifndef REP_ATT
#define REP_ATT 1
#endif
#ifndef REP_IN
#define REP_IN 1
#endif
#ifndef REP_CHUNK
#define REP_CHUNK 1
#endif
#ifndef REP_MLA
#define REP_MLA 1
#endif
#ifndef REP_RW
#define REP_RW 1
#endif
#ifndef EXP_SYNC2
#define EXP_SYNC2 0
#endif
#ifndef EXP_NODOT
#define EXP_NODOT 0
#endif
#ifndef EXP_CONSTY
#define EXP_CONSTY 0
#endif
#ifndef EXP_NOW1
#define EXP_NOW1 0
#endif
#ifndef EXP_NOSTATE
#define EXP_NOSTATE 0
#endif
#ifndef EXP_ZERO
#define EXP_ZERO 0
#endif
#ifndef USE_CHUNK
#define USE_CHUNK 1
#endif
#ifndef PROBE_SCAN
#define PROBE_SCAN 0
#endif
#ifndef ONE_LAUNCH
#define ONE_LAUNCH 1
#endif

#define LAS __attribute__((address_space(3)))
typedef unsigned short bf16_t;
typedef short bf16x8 __attribute__((ext_vector_type(8)));
typedef short bf16x4 __attribute__((ext_vector_type(4)));
typedef float f32x4 __attribute__((ext_vector_type(4)));
typedef float f32x2 __attribute__((ext_vector_type(2)));
typedef unsigned u32x4 __attribute__((ext_vector_type(4)));
typedef unsigned u32x2 __attribute__((ext_vector_type(2)));

constexpr int M_TOK = 16384, DM = 1024, SEQ = 4096, NBATCH = 4, NL = 4;
constexpr int D_IN_SRC = 7712;
constexpr int NP1 = 3328, NZ = 1536, NIN = 4864, NG = 3072;
constexpr int C_QLAT = 0, C_KVLAT = 256, C_KROPE = 384, C_GMU = 512, C_GMV = 1024, C_RW = 1536, C_RWR = 1536, C_RWK = 2048, C_RWV = 2560, C_WLAT = 3072, C_ALAT = 3136;
constexpr int NTHREADS = 512, NWAVES = 8;
constexpr int LDS_BYTES = 150 * 1024;
constexpr float QSCALE = 0.10206207261596575f * 1.4426950408889634f;

constexpr size_t MiB = 1u << 20;
constexpr size_t OFF_WIN = 0;
constexpr size_t SZ_WIN = (size_t)NIN * DM * 2;
constexpr size_t OFF_WG = 38 * MiB;
constexpr size_t SZ_WG = (size_t)NG * DM * 2;
constexpr size_t OFF_WBR = 62 * MiB;
constexpr size_t SZ_WBR = (size_t)3072 * 512 * 2;
constexpr size_t OFF_WOUT = 74 * MiB;
constexpr size_t SZ_WOUT = (size_t)DM * DM * 2;
constexpr size_t OFF_WUQ = 82 * MiB;
constexpr size_t SZ_WUQ = (size_t)768 * 256 * 2;
constexpr size_t OFF_WUKV = OFF_WUQ + 3 * MiB / 2;
constexpr size_t SZ_WUKV = (size_t)1024 * 128 * 2;
constexpr size_t OFF_SMALL = OFF_WUKV + 1 * MiB;
constexpr size_t OFF_W2T = OFF_SMALL;
constexpr size_t OFF_A2T = OFF_W2T + 256 * 1024;
constexpr size_t OFF_V1T = OFF_A2T + 256 * 1024;
constexpr size_t OFF_V2T = OFF_V1T + 128 * 1024;
constexpr size_t OFF_WS = OFF_V2T + 128 * 1024;
constexpr size_t OFF_MODP = OFF_WS + 512 * 1024;
constexpr size_t OFF_ROPE = OFF_MODP + 3 * MiB / 2;
constexpr size_t OFF_DOT = OFF_ROPE + 2 * MiB;
constexpr size_t OFF_MODT = OFF_DOT + MiB / 2;
constexpr size_t OFF_H = 90 * MiB;
constexpr size_t OFF_Z = 122 * MiB;
constexpr size_t OFF_VF = 170 * MiB;
constexpr size_t OFF_R1 = 186 * MiB;
constexpr size_t OFF_R2 = 298 * MiB;
constexpr size_t OFF_R3 = 410 * MiB;
constexpr size_t WS_END = 474 * MiB;
static_assert(OFF_MODT + 3 * NL * 4 * 1024 * 4 <= OFF_H, "small region");
constexpr size_t R1_GP = 0, R1_RA = 16 * MiB, R1_HT = 32 * MiB, R1_YQ = 48 * MiB, R1_PC = 64 * MiB;
constexpr size_t R2_R = 0, R2_K = 16 * MiB, R2_V = 32 * MiB, R2_KK = 48 * MiB, R2_B = 64 * MiB, R2_LW = 80 * MiB;
constexpr size_t R3_Q = 0, R3_KF = 24 * MiB, R3_VT = 48 * MiB, R3_MERGED = 0, R3_Y = 32 * MiB;

struct Params {
    const float* x; const float* c; const int* pos; const float* pre_g; const float* post_g; const float* w_ada; const float* b_ada; const float* w_in;
    const float* q_norm; const float* w_uq; const float* kv_norm; const float* w_ukv; const float* ln_g; const float* ln_b; const float* w_s; const float* b_s;
    const float* mu; const float* w0; const float* w2; const float* a0; const float* a2; const float* k_k; const float* k_a; const float* r_k;
    const float* lnx_g; const float* lnx_b; const float* v0; const float* v1; const float* v2; const float* w_br; const float* w_out;
    float* out; unsigned char* ws;
    int ph_lo, ph_hi;
};

typedef __bf16 bf16x2_t __attribute__((ext_vector_type(2)));
__device__ __forceinline__ unsigned cvt_pk_bf16(float lo, float hi) { const f32x2 v = {lo, hi}; const bf16x2_t b = __builtin_convertvector(v, bf16x2_t); return __builtin_bit_cast(unsigned, b); }
__device__ __forceinline__ float bf_lo(unsigned u) { return __uint_as_float(u << 16); }
__device__ __forceinline__ float bf_hi(unsigned u) { return __uint_as_float(u & 0xffff0000u); }
__device__ __forceinline__ float bf2f(bf16_t h) { return __uint_as_float(((unsigned)h) << 16); }
__device__ __forceinline__ bf16_t f2bf(float f) { return (bf16_t)(cvt_pk_bf16(f, 0.f) & 0xffffu); }
__device__ __forceinline__ float sigmoidf_(float x) { return 1.f / (1.f + __expf(-x)); }
__device__ __forceinline__ float siluf_(float x) { return x / (1.f + __expf(-x)); }
__device__ __forceinline__ float geluf_(float x) { return 0.5f * x * (1.f + erff(x * 0.70710678118654752f)); }
__device__ __forceinline__ f32x4 unpack4(u32x2 u) { return (f32x4){bf_lo(u.x), bf_hi(u.x), bf_lo(u.y), bf_hi(u.y)}; }
__device__ __forceinline__ u32x2 pack4(f32x4 v) { u32x2 r; r.x = cvt_pk_bf16(v[0], v[1]); r.y = cvt_pk_bf16(v[2], v[3]); return r; }
__device__ __forceinline__ float wave_sum(float v) {
#pragma unroll
    for (int o = 1; o < 64; o <<= 1) v += __shfl_xor(v, o);
    return v;
}
__device__ __forceinline__ bf16x8 ld_frag(const bf16_t* p) { return *(const bf16x8*)p; }
__device__ __forceinline__ bf16x8 pack_frag(f32x4 a, f32x4 b) {
    u32x4 u; u.x = cvt_pk_bf16(a[0], a[1]); u.y = cvt_pk_bf16(a[2], a[3]); u.z = cvt_pk_bf16(b[0], b[1]); u.w = cvt_pk_bf16(b[2], b[3]);
    return __builtin_bit_cast(bf16x8, u);
}
__device__ __forceinline__ bf16x8 join_frag(u32x2 a, u32x2 b) { u32x4 u; u.x = a.x; u.y = a.y; u.z = b.x; u.w = b.y; return __builtin_bit_cast(bf16x8, u); }
__device__ __forceinline__ int tid_l() { int t = threadIdx.x; asm volatile("" : "+v"(t)); return t; }
__device__ __forceinline__ unsigned char* ptr_l(unsigned char* q) { asm volatile("" : "+s"(q)); return q; }
#define MFMA(a, b, c) __builtin_amdgcn_mfma_f32_16x16x32_bf16((a), (b), (c), 0, 0, 0)

namespace pg8 {
constexpr int BM = 256, BK = 64, HALF = 128, HTB = HALF * BK * 2, STAGE_BYTES = 8 * HTB, NXCD = 8, WGM = 8;
__host__ __device__ __forceinline__ int lds_byte(int r, int c) { const int st = (r >> 4) * 2 + (c >> 5), rr = r & 15, cc = c & 31, ob = rr * 64 + cc * 2; return st * 1024 + (ob ^ (((ob >> 9) & 1) << 5)); }
__host__ __device__ __forceinline__ void stage_rc(int b, int& R, int& C) { const int st = b / 1024, sb = b % 1024, swz = sb ^ (((sb >> 9) & 1) << 5); R = (st >> 1) * 16 + swz / 64; C = (st & 1) * 32 + (swz % 64) / 2; }
__host__ __device__ __forceinline__ int perm32(int rho) { const int n = rho >> 4, i = rho & 15; return 8 * (i >> 2) + 4 * n + (i & 3); }

struct Unit { int pm, pn, ak, tag; };
struct Gemm { const bf16_t* A; const bf16_t* Bt; int lda, ldb, K; };

__device__ __forceinline__ void tile_of(int wgid, int nM, int nN, int& pm, int& pn) {
    const int nwg = nM * nN;
    { const int q = nwg / NXCD, r = nwg % NXCD, xcd = wgid % NXCD, off = wgid / NXCD; wgid = (xcd < r ? xcd * (q + 1) : r * (q + 1) + (xcd - r) * q) + off; }
    const int nig = WGM * nN, gid = wgid / nig, fm = gid * WGM, gsz = (nM - fm) < WGM ? (nM - fm) : WGM;
    pm = fm + ((wgid % nig) % gsz); pn = (wgid % nig) / gsz;
}
struct PlainOrder {
    int nM, nN, nwg, G, c;
    __device__ void init(int nM_, int nN_, int G_, int c_) { nM = nM_; nN = nN_; nwg = nM * nN; G = G_; c = c_; }
    __device__ bool next(int i, Unit& u) const { const long L = (long)i * G + c; if (L >= nwg) return false; tile_of((int)L, nM, nN, u.pm, u.pn); u.ak = 0; u.tag = 0; return true; }
};
struct MergeOrder {
    int nM, nN, nwg, G, c;
    __device__ void init(int nM_, int nN_, int G_, int c_) { nM = nM_; nN = nN_; nwg = nM * nN; G = G_; c = c_; }
    __device__ bool next(int i, Unit& u) const { const int ti = i / 3, n = i - 3 * ti; const long L = (long)ti * G + c; if (L >= nwg) return false;
        int pm, pc; tile_of((int)L, nM, nN, pm, pc); u.pm = pm; u.pn = n * nN + pc; u.ak = n * 512; u.tag = n; return true; }
};

template <class Epi, class Sched>
__device__ __forceinline__ void gemm_phase(LAS unsigned char* lds, const Gemm g, const Sched& S, const Epi& E) {
    const int tid = tid_l(), wid = __builtin_amdgcn_readfirstlane(tid >> 6), lane = tid & 63, wr = wid >> 2, wc = wid & 3, fr = lane & 15, fq = lane >> 4;
    const int K = g.K, nt = K / BK;
    unsigned voffA[2], voffB[2];
#pragma unroll
    for (int i = 0; i < 2; ++i) { int R, C; stage_rc(tid * 16 + i * 8192, R, C); const int Rb = (R & ~31) + perm32(R & 31);
        voffA[i] = (unsigned)(R * g.lda + C) * 2u; voffB[i] = (unsigned)(Rb * g.ldb + C) * 2u; }
    const size_t kstep = (size_t)(BK * 2);
    const size_t hstepA = (size_t)HALF * g.lda * 2, hstepB = (size_t)HALF * g.ldb * 2;
    const size_t tstepA = 2 * hstepA, tstepB = 2 * hstepB;
    const unsigned ldsw = (unsigned)wid * 1024u;
    const int aoff = lds_byte(wr * 64 + fr, fq * 8), boff = lds_byte(wc * 32 + fr, fq * 8);
#define PG8_SA(b, h) (((b) * 2 + (h)) * HTB)
#define PG8_SB(b, h) ((4 + (b) * 2 + (h)) * HTB)
#define PG8_STAGE(bufoff, gbase, voff) do { _Pragma("unroll") for (int _i = 0; _i < 2; ++_i) \
        __builtin_amdgcn_global_load_lds((const unsigned*)((const char*)(gbase) + (voff)[_i]), (LAS unsigned*)(lds + (bufoff) + ldsw + _i * 8192), 16, 0, 0); } while (0)
#define PG8_LDA(dst, b, h) do { _Pragma("unroll") for (int m = 0; m < 4; ++m) _Pragma("unroll") for (int k = 0; k < 2; ++k) dst[m][k] = *(const LAS bf16x8*)(lds + PG8_SA(b, h) + aoff + m * 2048 + k * 1024); } while (0)
#define PG8_LDB(dst, b, h) do { _Pragma("unroll") for (int n = 0; n < 2; ++n) _Pragma("unroll") for (int k = 0; k < 2; ++k) dst[n][k] = *(const LAS bf16x8*)(lds + PG8_SB(b, h) + boff + n * 2048 + k * 1024); } while (0)
#define PG8_MMA(ai, bj, At, Bt) do { __builtin_amdgcn_s_setprio(1); _Pragma("unroll") for (int m = 0; m < 4; ++m) _Pragma("unroll") for (int n = 0; n < 2; ++n) _Pragma("unroll") for (int k = 0; k < 2; ++k) \
        acc[ai][bj][m][n] = __builtin_amdgcn_mfma_f32_16x16x32_bf16(Bt[n][k], At[m][k], acc[ai][bj][m][n], 0, 0, 0); __builtin_amdgcn_s_setprio(0); } while (0)
#define PG8_WAIT_V(n) asm volatile("s_waitcnt vmcnt(" #n ")" ::: "memory")
#define PG8_WAIT_L(n) asm volatile("s_waitcnt lgkmcnt(" #n ")" ::: "memory")
#define PG8_BAR __builtin_amdgcn_s_barrier()
#define PG8_SCHED __builtin_amdgcn_sched_barrier(0)
    Unit cur, nxt; int ui = 0;
    if (!S.next(0, cur)) return;
    f32x4 acc[2][2][4][2];
#pragma unroll
    for (int a = 0; a < 2; ++a)
#pragma unroll
        for (int b = 0; b < 2; ++b)
#pragma unroll
            for (int m = 0; m < 4; ++m)
#pragma unroll
                for (int n = 0; n < 2; ++n) acc[a][b][m][n] = (f32x4){0.f, 0.f, 0.f, 0.f};
    bf16x8 At[4][2], B0[2][2], B1[2][2];
    const char* cA = (const char*)g.A + (size_t)cur.pm * tstepA + (size_t)cur.ak * 2; const char* cB = (const char*)g.Bt + (size_t)cur.pn * tstepB;
    PG8_STAGE(PG8_SB(0, 0), cB, voffB); PG8_STAGE(PG8_SB(0, 1), cB + hstepB, voffB); PG8_STAGE(PG8_SA(0, 0), cA, voffA); PG8_STAGE(PG8_SA(0, 1), cA + hstepA, voffA);
    if (wr == 1) PG8_BAR;
    PG8_WAIT_V(2); PG8_BAR;
    PG8_STAGE(PG8_SB(1, 0), cB + kstep, voffB); PG8_STAGE(PG8_SA(1, 0), cA + kstep, voffA); PG8_STAGE(PG8_SB(1, 1), cB + hstepB + kstep, voffB);
    PG8_WAIT_V(6); PG8_BAR;
    for (;;) {
        const bool has_next = S.next(ui + 1, nxt);
        const char* nA = has_next ? (const char*)g.A + (size_t)nxt.pm * tstepA + (size_t)nxt.ak * 2 : cA; const char* nB = has_next ? (const char*)g.Bt + (size_t)nxt.pn * tstepB : cB;
        for (int t = 0; t < nt; t += 2) {
            const bool last = (t == nt - 2);
            const char* a1 = cA + (size_t)(t + 1) * kstep;
            const char* a2 = last ? nA : cA + (size_t)(t + 2) * kstep; const char* b2 = last ? nB : cB + (size_t)(t + 2) * kstep;
            const char* a3 = a2 + kstep; const char* b3 = b2 + kstep;
            PG8_LDB(B0, 0, 0); PG8_LDB(B1, 0, 1); PG8_SCHED; PG8_LDA(At, 0, 0); PG8_STAGE(PG8_SA(1, 1), a1 + hstepA, voffA);
            PG8_WAIT_V(8); PG8_WAIT_L(0); PG8_BAR; PG8_MMA(0, 0, At, B0); PG8_MMA(0, 1, At, B1); PG8_BAR; PG8_SCHED;
            PG8_LDA(At, 0, 1); PG8_STAGE(PG8_SB(0, 0), b2, voffB); PG8_STAGE(PG8_SB(0, 1), b2 + hstepB, voffB); PG8_STAGE(PG8_SA(0, 0), a2, voffA);
            PG8_WAIT_V(8); PG8_WAIT_L(0); PG8_BAR; PG8_MMA(1, 0, At, B0); PG8_MMA(1, 1, At, B1); PG8_BAR; PG8_SCHED;
            PG8_LDB(B0, 1, 0); PG8_LDB(B1, 1, 1); PG8_SCHED; PG8_LDA(At, 1, 0); PG8_STAGE(PG8_SA(0, 1), a2 + hstepA, voffA);
            PG8_WAIT_V(8); PG8_WAIT_L(0); PG8_BAR; PG8_MMA(0, 0, At, B0); PG8_MMA(0, 1, At, B1); PG8_BAR; PG8_SCHED;
            PG8_LDA(At, 1, 1); PG8_STAGE(PG8_SB(1, 0), b3, voffB); PG8_STAGE(PG8_SB(1, 1), b3 + hstepB, voffB); PG8_STAGE(PG8_SA(1, 0), a3, voffA);
            PG8_WAIT_V(8); PG8_WAIT_L(0); PG8_BAR; PG8_MMA(1, 0, At, B0); PG8_MMA(1, 1, At, B1); PG8_BAR; PG8_SCHED;
        }
        if (wr == 0) PG8_BAR;
        E(acc, cur, wr, wc, fr, fq);
        if (!has_next) break;
#pragma unroll
        for (int a = 0; a < 2; ++a)
#pragma unroll
            for (int b = 0; b < 2; ++b)
#pragma unroll
                for (int m = 0; m < 4; ++m)
#pragma unroll
                    for (int n = 0; n < 2; ++n) acc[a][b][m][n] = (f32x4){0.f, 0.f, 0.f, 0.f};
        cur = nxt; cA = nA; cB = nB; ++ui;
        if (wr == 1) PG8_BAR;
    }
    PG8_WAIT_V(0);
    PG8_BAR;
#undef PG8_SA
#undef PG8_SB
#undef PG8_STAGE
#undef PG8_LDA
#undef PG8_LDB
#undef PG8_MMA
#undef PG8_WAIT_V
#undef PG8_WAIT_L
#undef PG8_BAR
#undef PG8_SCHED
}

struct EpiIn {
    bf16_t* P1; bf16_t* Z;
    __device__ __forceinline__ void operator()(const f32x4 (&acc)[2][2][4][2], const Unit& u, int wr, int wc, int fr, int fq) const {
        bf16_t* base; int ld, colt;
        if (u.pn < 13) { base = P1; ld = NP1; colt = u.pn * BM; } else { base = Z; ld = NZ; colt = (u.pn - 13) * BM; }
        const int row0 = u.pm * BM + wr * 64 + fr, col0 = colt + wc * 32 + 8 * fq;
#pragma unroll
        for (int ai = 0; ai < 2; ++ai)
#pragma unroll
            for (int m = 0; m < 4; ++m) { bf16_t* rowp = base + (size_t)(row0 + ai * HALF + m * 16) * ld + col0;
#pragma unroll
                for (int bj = 0; bj < 2; ++bj) { const f32x4 v0 = acc[ai][bj][m][0], v1 = acc[ai][bj][m][1];
                    u32x4 w; w.x = cvt_pk_bf16(v0[0], v0[1]); w.y = cvt_pk_bf16(v0[2], v0[3]); w.z = cvt_pk_bf16(v1[0], v1[1]); w.w = cvt_pk_bf16(v1[2], v1[3]);
                    *(u32x4*)(rowp + bj * HALF) = w; } }
    }
};
template <int ACT> struct EpiPlain {
    bf16_t* O; int ld;
    __device__ __forceinline__ void operator()(const f32x4 (&acc)[2][2][4][2], const Unit& u, int wr, int wc, int fr, int fq) const {
        const int row0 = u.pm * BM + wr * 64 + fr, col0 = u.pn * BM + wc * 32 + 8 * fq;
#pragma unroll
        for (int ai = 0; ai < 2; ++ai)
#pragma unroll
            for (int m = 0; m < 4; ++m) { bf16_t* rowp = O + (size_t)(row0 + ai * HALF + m * 16) * ld + col0;
#pragma unroll
                for (int bj = 0; bj < 2; ++bj) { f32x4 v0 = acc[ai][bj][m][0], v1 = acc[ai][bj][m][1];
                    if (ACT == 1) {
#pragma unroll
                        for (int e = 0; e < 4; ++e) { v0[e] = sigmoidf_(v0[e]); v1[e] = sigmoidf_(v1[e]); } }
                    u32x4 w; w.x = cvt_pk_bf16(v0[0], v0[1]); w.y = cvt_pk_bf16(v0[2], v0[3]); w.z = cvt_pk_bf16(v1[0], v1[1]); w.w = cvt_pk_bf16(v1[2], v1[3]);
                    *(u32x4*)(rowp + bj * HALF) = w; } }
    }
};
struct EpiMerge {
    bf16_t* Mg; const bf16_t* G;
    __device__ __forceinline__ void operator()(const f32x4 (&acc)[2][2][4][2], const Unit& u, int wr, int wc, int fr, int fq) const {
        const int n = u.tag, pc = u.pn - 4 * n;
        const int row0 = u.pm * BM + wr * 64 + fr, col0 = pc * BM + wc * 32 + 8 * fq;
#pragma unroll
        for (int ai = 0; ai < 2; ++ai)
#pragma unroll
            for (int m = 0; m < 4; ++m) { const size_t row = (size_t)(row0 + ai * HALF + m * 16);
#pragma unroll
                for (int bj = 0; bj < 2; ++bj) { const f32x4 v0 = acc[ai][bj][m][0], v1 = acc[ai][bj][m][1];
                    const u32x4 gt = *(const u32x4*)(G + row * NG + n * 1024 + col0 + bj * HALF);
                    bf16_t* mp = Mg + row * DM + col0 + bj * HALF;
                    float o[8];
                    o[0] = bf_lo(gt.x) * v0[0]; o[1] = bf_hi(gt.x) * v0[1]; o[2] = bf_lo(gt.y) * v0[2]; o[3] = bf_hi(gt.y) * v0[3];
                    o[4] = bf_lo(gt.z) * v1[0]; o[5] = bf_hi(gt.z) * v1[1]; o[6] = bf_lo(gt.w) * v1[2]; o[7] = bf_hi(gt.w) * v1[3];
                    if (n > 0) { const u32x4 pv = *(const u32x4*)mp;
                        o[0] += bf_lo(pv.x); o[1] += bf_hi(pv.x); o[2] += bf_lo(pv.y); o[3] += bf_hi(pv.y); o[4] += bf_lo(pv.z); o[5] += bf_hi(pv.z); o[6] += bf_lo(pv.w); o[7] += bf_hi(pv.w); }
                    u32x4 w; w.x = cvt_pk_bf16(o[0], o[1]); w.y = cvt_pk_bf16(o[2], o[3]); w.z = cvt_pk_bf16(o[4], o[5]); w.w = cvt_pk_bf16(o[6], o[7]);
                    *(u32x4*)mp = w; } }
    }
};
}

__device__ __forceinline__ void tr_item(const float* W, int lds_, int k0, int n0s, bf16_t* WT, int ldd, int n0d, int kd0, const float* ksc, float* scr, int lane) {
#pragma unroll
    for (int i = 0; i < 8; ++i) { const int kk = 8 * i + (lane >> 3), n4 = (lane & 7) * 4;
        f32x4 v = (f32x4){0.f, 0.f, 0.f, 0.f}; if (n0s >= 0) { v = *(const f32x4*)(W + (size_t)(k0 + kk) * lds_ + n0s + n4); if (ksc) v = v * ksc[k0 + kk]; }
        float* d = scr + kk * 33 + n4; d[0] = v[0]; d[1] = v[1]; d[2] = v[2]; d[3] = v[3]; }
    asm volatile("s_waitcnt lgkmcnt(0)" ::: "memory");
    const int c = lane & 7;
#pragma unroll
    for (int j = 0; j < 4; ++j) { const int n = (lane >> 3) + 8 * j; const float* s = scr + (8 * c) * 33 + n;
        u32x4 o; o.x = cvt_pk_bf16(s[0 * 33], s[1 * 33]); o.y = cvt_pk_bf16(s[2 * 33], s[3 * 33]); o.z = cvt_pk_bf16(s[4 * 33], s[5 * 33]); o.w = cvt_pk_bf16(s[6 * 33], s[7 * 33]);
        *(u32x4*)(WT + (size_t)(n0d + n) * ldd + kd0 + 8 * c) = o; }
    asm volatile("s_waitcnt lgkmcnt(0)" ::: "memory");
}

__device__ __forceinline__ void phase0a(const Params& p, unsigned char* lds) {
    const int tid = tid_l(), lane = tid & 63, wave = tid >> 6, G = gridDim.x;
    const int gw = blockIdx.x * NWAVES + wave, NGW = G * NWAVES;
    unsigned char* ws = p.ws;
    float* scr = (float*)(lds + wave * 16384);
    constexpr int I_WIN = 152 * 16, I_WG = 96 * 16, I_WBR = 3 * 32 * 8, I_WOUT = 32 * 16, I_WUQ = 24 * 4, I_WUKV = 32 * 2, I_W2 = 16, I_A2 = 16, I_V1 = 8;
    constexpr int I_L = I_WIN + I_WG + I_WBR + I_WOUT + I_WUQ + I_WUKV + I_W2 + I_A2 + I_V1;
    for (int it = gw; it < NL * I_L; it += NGW) {
        const int l = it / I_L; int r = it - l * I_L;
        if (r < I_WIN) { const int nb = r >> 4, kb = r & 15; const int nd = nb * 32;
            int ns; if (nd < 416) ns = nd; else if (nd < 512) ns = -1; else if (nd < 3200) ns = nd - 96; else if (nd < 3328) ns = -1; else ns = nd - 224;
            tr_item(p.w_in + (size_t)l * DM * D_IN_SRC, D_IN_SRC, kb * 64, ns, (bf16_t*)(ws + OFF_WIN + l * SZ_WIN), DM, nd, kb * 64, nullptr, scr, lane); continue; }
        r -= I_WIN;
        if (r < I_WG) { const int nb = r >> 4, kb = r & 15;
            tr_item(p.w_in + (size_t)l * DM * D_IN_SRC, D_IN_SRC, kb * 64, 4640 + nb * 32, (bf16_t*)(ws + OFF_WG + l * SZ_WG), DM, nb * 32, kb * 64, nullptr, scr, lane); continue; }
        r -= I_WG;
        if (r < I_WBR) { const int n = r / 256, r2 = r - n * 256, nb = r2 >> 3, kb = r2 & 7;
            tr_item(p.w_br + ((size_t)(l * 3 + n) * 512) * DM, DM, kb * 64, nb * 32, (bf16_t*)(ws + OFF_WBR + l * SZ_WBR), 512, n * 1024 + nb * 32, kb * 64, nullptr, scr, lane); continue; }
        r -= I_WBR;
        if (r < I_WOUT) { const int nb = r >> 4, kb = r & 15;
            tr_item(p.w_out + (size_t)l * DM * DM, DM, kb * 64, nb * 32, (bf16_t*)(ws + OFF_WOUT + l * SZ_WOUT), DM, nb * 32, kb * 64, nullptr, scr, lane); continue; }
        r -= I_WOUT;
        if (r < I_WUQ) { const int nb = r >> 2, kb = r & 3;
            tr_item(p.w_uq + (size_t)l * 256 * 768, 768, kb * 64, nb * 32, (bf16_t*)(ws + OFF_WUQ + l * SZ_WUQ), 256, nb * 32, kb * 64, p.q_norm + l * 256, scr, lane); continue; }
        r -= I_WUQ;
        if (r < I_WUKV) { const int nb = r >> 1, kb = r & 1;
            tr_item(p.w_ukv + (size_t)l * 128 * 1024, 1024, kb * 64, nb * 32, (bf16_t*)(ws + OFF_WUKV + l * SZ_WUKV), 128, nb * 32, kb * 64, p.kv_norm + l * 128, scr, lane); continue; }
        r -= I_WUKV;
        if (r < I_W2) { tr_item(p.w2 + (size_t)l * 64 * 512, 512, 0, r * 32, (bf16_t*)(ws + OFF_W2T) + (size_t)l * 512 * 64, 64, r * 32, 0, nullptr, scr, lane); continue; }
        r -= I_W2;
        if (r < I_A2) { tr_item(p.a2 + (size_t)l * 64 * 512, 512, 0, r * 32, (bf16_t*)(ws + OFF_A2T) + (size_t)l * 512 * 64, 64, r * 32, 0, nullptr, scr, lane); continue; }
        r -= I_A2;
        if (l >= 1) tr_item(p.v1 + (size_t)(l - 1) * 512 * 32, 32, r * 64, 0, (bf16_t*)(ws + OFF_V1T) + (size_t)(l - 1) * 32 * 512, 512, 0, r * 64, nullptr, scr, lane);
    }
    for (int it = gw; it < NL * 12 * 8; it += NGW) {
        const int l = it / 96, r = it - l * 96, nb = r >> 3, ks = r & 7, n = nb * 256 + lane * 4;
        f32x4 a0 = (f32x4){0.f, 0.f, 0.f, 0.f}, a1 = a0, a2 = a0, a3 = a0;
        const float* w = p.w_ada + (size_t)l * DM * 3072 + n;
#pragma unroll 8
        for (int k = ks * 128; k < ks * 128 + 128; ++k) { const f32x4 wv = *(const f32x4*)(w + (size_t)k * 3072);
            a0 += wv * siluf_(p.c[k]); a1 += wv * siluf_(p.c[DM + k]); a2 += wv * siluf_(p.c[2 * DM + k]); a3 += wv * siluf_(p.c[3 * DM + k]); }
        float* mp = (float*)(ws + OFF_MODP) + ((size_t)(l * 8 + ks) * 4) * 3072 + n;
        *(f32x4*)mp = a0; *(f32x4*)(mp + 3072) = a1; *(f32x4*)(mp + 2 * 3072) = a2; *(f32x4*)(mp + 3 * 3072) = a3;
    }
    const size_t gt = (size_t)blockIdx.x * NTHREADS + tid, GT = (size_t)G * NTHREADS;
    for (size_t i = gt; i < (size_t)3 * 512 * 32; i += GT) { const int l1 = (int)(i / (512 * 32)), r = (int)(i % (512 * 32)), c = r >> 5, k = r & 31;
        ((bf16_t*)(ws + OFF_V2T))[i] = f2bf(p.v2[(size_t)l1 * 32 * 512 + k * 512 + c]); }
    for (size_t i = gt; i < (size_t)NL * 4 * 128 * 128; i += GT) { const int s = (int)(i & 127), t = (int)((i >> 7) & 127);
        ((bf16_t*)(ws + OFF_WS))[i] = f2bf(((s >> 6) <= (t >> 6)) ? p.w_s[i] : 0.f); }
    for (size_t i = gt; i < (size_t)M_TOK * 16; i += GT) { const int t = (int)(i >> 4), k = (int)(i & 15);
        const float inv = powf(10000.f, -(float)(2 * k) / 32.f); const float ang = (float)p.pos[t] * inv;
        ((float*)(ws + OFF_ROPE))[i] = cosf(ang); ((float*)(ws + OFF_ROPE))[(size_t)M_TOK * 16 + i] = sinf(ang); }
    for (size_t i = gt; i < (size_t)M_TOK * DM / 4; i += GT) ((f32x4*)p.out)[i] = ((const f32x4*)p.x)[i];
}

__device__ __forceinline__ f32x4 mod4(const Params& p, int l, int b, int kind, int col) {
    const float* mp = (const float*)(p.ws + OFF_MODP) + ((size_t)(l * 8) * 4 + b) * 3072 + kind * DM + col;
    f32x4 s = *(const f32x4*)(p.b_ada + (size_t)l * 3072 + kind * DM + col);
#pragma unroll
    for (int ks = 0; ks < 8; ++ks) s += *(const f32x4*)(mp + (size_t)ks * 4 * 3072);
    return s;
}
__device__ __forceinline__ void phase_modt(const Params& p) {
    float* T = (float*)(p.ws + OFF_MODT);
    for (int i = blockIdx.x * NTHREADS + tid_l(); i < NL * 4 * 256; i += gridDim.x * NTHREADS) { const int l = i / 1024, r = i - l * 1024, b = r >> 8, col = (r & 255) * 4;
        const f32x4 sh = mod4(p, l, b, 0, col), sc = mod4(p, l, b, 1, col), gt = mod4(p, l, b, 2, col);
        const f32x4 g = *(const f32x4*)(p.pre_g + (size_t)l * DM + col), pg = *(const f32x4*)(p.post_g + (size_t)l * DM + col);
        const size_t o = ((size_t)(l * 4 + b)) * 1024 + col;
        *(f32x4*)(T + o) = g * (sc + 1.f); *(f32x4*)(T + (size_t)NL * 4096 + o) = sh; *(f32x4*)(T + (size_t)2 * NL * 4096 + o) = gt * pg; }
}
__device__ __forceinline__ void normmod_row(const Params& p, int l, int row, const f32x4 (&v)[4], int lane) {
    float ss = 0.f;
#pragma unroll
    for (int j = 0; j < 4; ++j) ss += v[j][0] * v[j][0] + v[j][1] * v[j][1] + v[j][2] * v[j][2] + v[j][3] * v[j][3];
    const float rstd = rsqrtf(wave_sum(ss) * (1.f / DM) + 1e-6f);
    const int b = row / SEQ;
    const float* T = (const float*)(p.ws + OFF_MODT) + ((size_t)(l * 4 + b)) * 1024;
    bf16_t* hrow = (bf16_t*)(p.ws + OFF_H) + (size_t)row * DM;
#pragma unroll
    for (int j = 0; j < 4; ++j) { const int col = 4 * lane + 256 * j;
        const f32x4 a = *(const f32x4*)(T + col), sh = *(const f32x4*)(T + (size_t)NL * 4096 + col);
        f32x4 o = v[j] * rstd * a + sh;
        *(u32x2*)(hrow + col) = pack4(o); }
}
__device__ __forceinline__ void phase0b(const Params& p) {
    const int tidq = tid_l(); const int lane = tidq & 63, gw = blockIdx.x * NWAVES + (tidq >> 6), NGW = gridDim.x * NWAVES;
    for (int row = gw; row < M_TOK; row += NGW) { f32x4 v[4];
#pragma unroll
        for (int j = 0; j < 4; ++j) v[j] = *(const f32x4*)(p.out + (size_t)row * DM + 4 * lane + 256 * j);
        normmod_row(p, 0, row, v, lane); }
}
__device__ __forceinline__ void phase_final(const Params& p, int l) {
    const int tidq = tid_l(); const int lane = tidq & 63, gw = blockIdx.x * NWAVES + (tidq >> 6), NGW = gridDim.x * NWAVES;
    const bf16_t* Y = (const bf16_t*)(p.ws + OFF_R3 + R3_Y);
    for (int row = gw; row < M_TOK; row += NGW) {
        f32x4 y[4]; float ss = 0.f;
#pragma unroll
        for (int j = 0; j < 4; ++j) { y[j] = unpack4(*(const u32x2*)(Y + (size_t)row * DM + 4 * lane + 256 * j)); ss += y[j][0] * y[j][0] + y[j][1] * y[j][1] + y[j][2] * y[j][2] + y[j][3] * y[j][3]; }
        const float rstd = rsqrtf(wave_sum(ss) * (1.f / DM) + 1e-6f);
        const int b = row / SEQ; f32x4 v[4];
        const float* GG = (const float*)(p.ws + OFF_MODT) + (size_t)2 * NL * 4096 + ((size_t)(l * 4 + b)) * 1024;
#pragma unroll
        for (int j = 0; j < 4; ++j) { const int col = 4 * lane + 256 * j;
            const f32x4 xg = *(const f32x4*)(p.out + (size_t)row * DM + col), gg = *(const f32x4*)(GG + col);
            v[j] = xg + gg * (y[j] * rstd);
            *(f32x4*)(p.out + (size_t)row * DM + col) = v[j]; }
        if (l + 1 < NL) normmod_row(p, l + 1, row, v, lane);
    }
}

__device__ __forceinline__ void mla_prep_item(const Params& p, int l, int item, unsigned char* lds) {
    const int tid = tid_l(), lane = tid & 63, wave = tid >> 6, fr = lane & 15, fq = lane >> 4;
    const int t0 = item * 64;
    const bf16_t* P1 = (const bf16_t*)(p.ws + OFF_R1);
    bf16_t* Q = (bf16_t*)(p.ws + OFF_R3 + R3_Q); bf16_t* Kf = (bf16_t*)(p.ws + OFF_R3 + R3_KF); bf16_t* Vt = (bf16_t*)(p.ws + OFF_R3 + R3_VT);
    const bf16_t* Wuq = (const bf16_t*)(p.ws + OFF_WUQ + l * SZ_WUQ); const bf16_t* Wukv = (const bf16_t*)(p.ws + OFF_WUKV + l * SZ_WUKV);
    const float* COS = (const float*)(p.ws + OFF_ROPE); const float* SIN = COS + (size_t)M_TOK * 16;
    float* rq = (float*)lds; float* rkv = rq + 64;
    __syncthreads();
    { const int row = tid >> 3, part = tid & 7; const bf16_t* pr = P1 + (size_t)(t0 + row) * NP1;
        float sq = 0.f, sk = 0.f;
#pragma unroll
        for (int i = 0; i < 4; ++i) { const u32x4 u = *(const u32x4*)(pr + C_QLAT + part * 32 + i * 8);
            sq += bf_lo(u.x) * bf_lo(u.x) + bf_hi(u.x) * bf_hi(u.x) + bf_lo(u.y) * bf_lo(u.y) + bf_hi(u.y) * bf_hi(u.y) + bf_lo(u.z) * bf_lo(u.z) + bf_hi(u.z) * bf_hi(u.z) + bf_lo(u.w) * bf_lo(u.w) + bf_hi(u.w) * bf_hi(u.w); }
#pragma unroll
        for (int i = 0; i < 2; ++i) { const u32x4 u = *(const u32x4*)(pr + C_KVLAT + part * 16 + i * 8);
            sk += bf_lo(u.x) * bf_lo(u.x) + bf_hi(u.x) * bf_hi(u.x) + bf_lo(u.y) * bf_lo(u.y) + bf_hi(u.y) * bf_hi(u.y) + bf_lo(u.z) * bf_lo(u.z) + bf_hi(u.z) * bf_hi(u.z) + bf_lo(u.w) * bf_lo(u.w) + bf_hi(u.w) * bf_hi(u.w); }
        sq += __shfl_xor(sq, 1); sq += __shfl_xor(sq, 2); sq += __shfl_xor(sq, 4);
        sk += __shfl_xor(sk, 1); sk += __shfl_xor(sk, 2); sk += __shfl_xor(sk, 4);
        if (part == 0) { rq[row] = rsqrtf(sq * (1.f / 256.f) + 1e-6f); rkv[row] = rsqrtf(sk * (1.f / 128.f) + 1e-6f); }
        const int i2 = part * 2; const int t = t0 + row;
        const unsigned u1 = *(const unsigned*)(pr + C_KROPE + i2), u2 = *(const unsigned*)(pr + C_KROPE + 16 + i2);
        const float c0 = COS[(size_t)t * 16 + i2], c1 = COS[(size_t)t * 16 + i2 + 1], s0 = SIN[(size_t)t * 16 + i2], s1 = SIN[(size_t)t * 16 + i2 + 1];
        const float x10 = bf_lo(u1), x11 = bf_hi(u1), x20 = bf_lo(u2), x21 = bf_hi(u2);
        const unsigned o1 = cvt_pk_bf16(x10 * c0 - x20 * s0, x11 * c1 - x21 * s1), o2 = cvt_pk_bf16(x20 * c0 + x10 * s0, x21 * c1 + x11 * s1);
#pragma unroll
        for (int h = 0; h < 8; ++h) { *(unsigned*)(Kf + (size_t)t * 768 + h * 96 + 64 + i2) = o1; *(unsigned*)(Kf + (size_t)t * 768 + h * 96 + 80 + i2) = o2; }
    }
    __syncthreads();
#pragma unroll 1
    for (int cb = 0; cb < 4; ++cb) { const int combo = wave * 4 + cb, rt = combo & 3, head = combo >> 2;
        f32x4 acc[6];
#pragma unroll
        for (int ct = 0; ct < 6; ++ct) acc[ct] = (f32x4){0.f, 0.f, 0.f, 0.f};
        const bf16_t* ap = P1 + (size_t)(t0 + rt * 16 + fr) * NP1 + C_QLAT + fq * 8;
        const bf16_t* wp = Wuq + (size_t)(head * 96 + fr) * 256 + fq * 8;
#pragma unroll
        for (int hf = 0; hf < 2; ++hf) { bf16x8 af[4], wf[6][4];
#pragma unroll
            for (int k4 = 0; k4 < 4; ++k4) { af[k4] = ld_frag(ap + (hf * 4 + k4) * 32);
#pragma unroll
                for (int ct = 0; ct < 6; ++ct) wf[ct][k4] = ld_frag(wp + (size_t)ct * 16 * 256 + (hf * 4 + k4) * 32); }
            __builtin_amdgcn_sched_barrier(0);
#pragma unroll
            for (int k4 = 0; k4 < 4; ++k4)
#pragma unroll
                for (int ct = 0; ct < 6; ++ct) acc[ct] = MFMA(wf[ct][k4], af[k4], acc[ct]);
            __builtin_amdgcn_sched_barrier(0); }
        const int t = t0 + rt * 16 + fr; const float rs = rq[rt * 16 + fr] * QSCALE;
        bf16_t* qp = Q + (size_t)t * 768 + head * 96 + fq * 4;
#pragma unroll
        for (int ct = 0; ct < 4; ++ct) *(u32x2*)(qp + ct * 16) = pack4(acc[ct] * rs);
        const f32x4 cs = *(const f32x4*)(COS + (size_t)t * 16 + fq * 4), sn = *(const f32x4*)(SIN + (size_t)t * 16 + fq * 4);
        const f32x4 x1 = acc[4] * rs, x2 = acc[5] * rs;
        *(u32x2*)(qp + 64) = pack4(x1 * cs - x2 * sn); *(u32x2*)(qp + 80) = pack4(x2 * cs + x1 * sn);
    }
#pragma unroll 1
    for (int cb = 0; cb < 4; ++cb) { const int combo = wave * 4 + cb, rt = combo & 3, head = combo >> 2;
        f32x4 ak[4], av[4];
#pragma unroll
        for (int ct = 0; ct < 4; ++ct) { ak[ct] = (f32x4){0.f, 0.f, 0.f, 0.f}; av[ct] = (f32x4){0.f, 0.f, 0.f, 0.f}; }
        const bf16_t* ap = P1 + (size_t)(t0 + rt * 16 + fr) * NP1 + C_KVLAT + fq * 8;
        const bf16_t* wp = Wukv + (size_t)(head * 128 + fr) * 128 + fq * 8;
        { bf16x8 af[4], wk[4][4], wv[4][4];
#pragma unroll
            for (int ks = 0; ks < 4; ++ks) { af[ks] = ld_frag(ap + ks * 32);
#pragma unroll
                for (int ct = 0; ct < 4; ++ct) { wk[ct][ks] = ld_frag(wp + (size_t)ct * 16 * 128 + ks * 32); wv[ct][ks] = ld_frag(wp + (size_t)(64 + ct * 16) * 128 + ks * 32); } }
            __builtin_amdgcn_sched_barrier(0);
#pragma unroll
            for (int ks = 0; ks < 4; ++ks)
#pragma unroll
                for (int ct = 0; ct < 4; ++ct) { ak[ct] = MFMA(wk[ct][ks], af[ks], ak[ct]); av[ct] = MFMA(af[ks], wv[ct][ks], av[ct]); }
            __builtin_amdgcn_sched_barrier(0); }
        const int t = t0 + rt * 16 + fr; const float rs = rkv[rt * 16 + fr];
#pragma unroll
        for (int ct = 0; ct < 4; ++ct) *(u32x2*)(Kf + (size_t)t * 768 + head * 96 + ct * 16 + fq * 4) = pack4(ak[ct] * rs);
        const f32x4 rv = *(const f32x4*)(rkv + rt * 16 + fq * 4);
        const int b = t0 / SEQ, s0 = (t0 % SEQ) + rt * 16 + fq * 4;
#pragma unroll
        for (int ct = 0; ct < 4; ++ct) *(u32x2*)(Vt + ((size_t)(b * 8 + head) * 64 + ct * 16 + fr) * SEQ + s0) = pack4(av[ct] * rv);
    }
}

__device__ __forceinline__ void gmlp_item(const Params& p, int l, int item, unsigned char* lds, bool do_store = true) {
    const int tid = tid_l(), lane = tid & 63, wave = tid >> 6, fr = lane & 15, fq = lane >> 4;
    const int t0 = item * 128;
    const bf16_t* P1 = (const bf16_t*)(p.ws + OFF_R1); bf16_t* Z = (bf16_t*)(p.ws + OFF_Z);
    const bf16_t* Ws = (const bf16_t*)(p.ws + OFF_WS) + (size_t)l * 4 * 128 * 128;
    bf16_t* vb = (bf16_t*)lds;
    constexpr int VS = 520;
    __syncthreads();
    { const int tok = tid >> 2, qd = tid & 3; const bf16_t* pr = P1 + (size_t)(t0 + tok) * NP1 + C_GMV + qd * 128;
        float s = 0.f, s2 = 0.f;
#pragma unroll 4
        for (int i = 0; i < 16; ++i) { const u32x4 u = *(const u32x4*)(pr + i * 8); const unsigned uu[4] = {u.x, u.y, u.z, u.w};
#pragma unroll
            for (int e = 0; e < 4; ++e) { const float a = geluf_(bf_lo(uu[e])), b = geluf_(bf_hi(uu[e])); s += a + b; s2 += a * a + b * b; } }
        s += __shfl_xor(s, 1); s += __shfl_xor(s, 2); s2 += __shfl_xor(s2, 1); s2 += __shfl_xor(s2, 2);
        const float mean = s * (1.f / 512.f), var = fmaxf(s2 * (1.f / 512.f) - mean * mean, 0.f), rstd = rsqrtf(var + 1e-5f);
        const float* lg = p.ln_g + (size_t)l * 512 + qd * 128; const float* lb = p.ln_b + (size_t)l * 512 + qd * 128;
#pragma unroll 4
        for (int i = 0; i < 16; ++i) { const u32x4 u = *(const u32x4*)(pr + i * 8); const unsigned uu[4] = {u.x, u.y, u.z, u.w}; unsigned oo[4];
#pragma unroll
            for (int e = 0; e < 4; ++e) { const float a = (geluf_(bf_lo(uu[e])) - mean) * rstd * lg[i * 8 + 2 * e] + lb[i * 8 + 2 * e], b = (geluf_(bf_hi(uu[e])) - mean) * rstd * lg[i * 8 + 2 * e + 1] + lb[i * 8 + 2 * e + 1];
                oo[e] = cvt_pk_bf16(a, b); }
            *(u32x4*)(vb + (size_t)tok * VS + qd * 128 + i * 8) = (u32x4){oo[0], oo[1], oo[2], oo[3]}; }
    }
    __syncthreads();
#pragma unroll 1
    for (int g = 0; g < 4; ++g) {
        const int cbase = g * 128 + wave * 16;
        bf16x8 vfr[4];
#pragma unroll
        for (int ks = 0; ks < 4; ++ks) { bf16x8 f;
#pragma unroll
            for (int j = 0; j < 8; ++j) f[j] = (short)vb[(size_t)(ks * 32 + fq * 8 + j) * VS + cbase + fr];
            vfr[ks] = f; }
        const bf16_t* wg = Ws + (size_t)g * 128 * 128;
#pragma unroll 1
        for (int tt = 0; tt < 8; ++tt) {
            f32x4 acc = (f32x4){0.f, 0.f, 0.f, 0.f};
            const bf16_t* wp = wg + (size_t)(tt * 16 + fr) * 128 + fq * 8;
#pragma unroll
            for (int ks = 0; ks < 4; ++ks) acc = MFMA(vfr[ks], ld_frag(wp + ks * 32), acc);
            const int tl = tt * 16 + fr, t = t0 + tl, c = cbase + fq * 4;
            const float bs = p.b_s[(size_t)(l * 4 + g) * 128 + tl];
            const f32x4 u = unpack4(*(const u32x2*)(P1 + (size_t)t * NP1 + C_GMU + c));
            bf16_t* zp = Z + (size_t)t * NZ + 512 + c; const f32x4 z = unpack4(*(const u32x2*)zp);
            f32x4 o;
#pragma unroll
            for (int e = 0; e < 4; ++e) o[e] = geluf_(u[e]) * (acc[e] + bs) * siluf_(z[e]);
            if (do_store) *(u32x2*)zp = pack4(o);
        }
    }
}

__device__ __forceinline__ f32x4 mix4(const bf16_t* pr, const bf16_t* pp, bool has_prev, const float* mu) {
    const f32x4 a = unpack4(*(const u32x2*)pr); f32x4 b = (f32x4){0.f, 0.f, 0.f, 0.f}; if (has_prev) b = unpack4(*(const u32x2*)pp);
    const f32x4 m = *(const f32x4*)mu; return a + (b - a) * m;
}
__device__ __forceinline__ void rwkv_prep_item(const Params& p, int l, int item) {
    const int tid = tid_l(), lane = tid & 63, wave = tid >> 6, fr = lane & 15, fq = lane >> 4;
    const int rt = wave >> 1, hh = wave & 1;
    const int t = item * 64 + rt * 16 + fr; const bool hp = (t % SEQ) != 0;
    const bf16_t* P1 = (const bf16_t*)(p.ws + OFF_R1);
    const bf16_t* pr = P1 + (size_t)t * NP1; const bf16_t* pp = pr - NP1;
    const float* mu = p.mu + (size_t)l * 1664 - C_RW;
    const bf16_t* W2T = (const bf16_t*)(p.ws + OFF_W2T) + (size_t)l * 512 * 64; const bf16_t* A2T = (const bf16_t*)(p.ws + OFF_A2T) + (size_t)l * 512 * 64;
    unsigned char* r2 = p.ws + OFF_R2;
    bf16_t* VF = (bf16_t*)(p.ws + OFF_VF);
    bf16x8 fa[2], fw[2];
#pragma unroll
    for (int ks = 0; ks < 2; ++ks) { const int ca = C_ALAT + ks * 32 + fq * 8, cw = C_WLAT + ks * 32 + fq * 8;
        const f32x4 a0 = mix4(pr + ca, pp + ca, hp, mu + ca), a1 = mix4(pr + ca + 4, pp + ca + 4, hp, mu + ca + 4);
        f32x4 w0 = mix4(pr + cw, pp + cw, hp, mu + cw), w1 = mix4(pr + cw + 4, pp + cw + 4, hp, mu + cw + 4);
#pragma unroll
        for (int e = 0; e < 4; ++e) { w0[e] = tanhf(w0[e]); w1[e] = tanhf(w1[e]); }
        fa[ks] = pack_frag(a0, a1); fw[ks] = pack_frag(w0, w1); }
    bf16x8 t1f = (bf16x8){0, 0, 0, 0, 0, 0, 0, 0};
    if (l >= 1) { const bf16_t* V1T = (const bf16_t*)(p.ws + OFF_V1T) + (size_t)(l - 1) * 32 * 512;
        f32x4 c0 = (f32x4){0.f, 0.f, 0.f, 0.f}, c1 = c0;
#pragma unroll 4
        for (int ks = 0; ks < 16; ++ks) { const int cv = C_RWV + ks * 32 + fq * 8;
            const bf16x8 af = pack_frag(mix4(pr + cv, pp + cv, hp, mu + cv), mix4(pr + cv + 4, pp + cv + 4, hp, mu + cv + 4));
            c0 = MFMA(ld_frag(V1T + (size_t)fr * 512 + ks * 32 + fq * 8), af, c0); c1 = MFMA(ld_frag(V1T + (size_t)(16 + fr) * 512 + ks * 32 + fq * 8), af, c1); }
        t1f = pack_frag(c0, c1);
    }
#pragma unroll 1
    for (int hq = 0; hq < 4; ++hq) { const int h = hh * 4 + hq;
        float ss = 0.f;
#pragma unroll
        for (int ct = 0; ct < 4; ++ct) { const int c = h * 64 + ct * 16 + fq * 4;
            const f32x4 kr = mix4(pr + C_RWK + c, pp + C_RWK + c, hp, mu + C_RWK + c) * *(const f32x4*)(p.k_k + (size_t)l * 512 + c);
            ss += kr[0] * kr[0] + kr[1] * kr[1] + kr[2] * kr[2] + kr[3] * kr[3]; }
        ss += __shfl_xor(ss, 16); ss += __shfl_xor(ss, 32);
        const float inv = 1.f / fmaxf(sqrtf(ss), 1e-12f);
        float dsum = 0.f;
#pragma unroll 2
        for (int ct = 0; ct < 4; ++ct) { const int crow = h * 64 + ct * 16 + fr;
            f32x4 aa = (f32x4){0.f, 0.f, 0.f, 0.f}, aw = aa, avm = aa;
#pragma unroll
            for (int ks = 0; ks < 2; ++ks) { aa = MFMA(ld_frag(A2T + (size_t)crow * 64 + ks * 32 + fq * 8), fa[ks], aa); aw = MFMA(ld_frag(W2T + (size_t)crow * 64 + ks * 32 + fq * 8), fw[ks], aw); }
            if (l >= 1) { const bf16_t* V2T = (const bf16_t*)(p.ws + OFF_V2T) + (size_t)(l - 1) * 512 * 32 + (size_t)crow * 32;
                avm = MFMA(join_frag(*(const u32x2*)(V2T + fq * 4), *(const u32x2*)(V2T + 16 + fq * 4)), t1f, avm); }
            const int c = h * 64 + ct * 16 + fq * 4; const size_t o = (size_t)t * 512 + c;
            const f32x4 rs = mix4(pr + C_RWR + c, pp + C_RWR + c, hp, mu + C_RWR + c);
            const f32x4 ksv = mix4(pr + C_RWK + c, pp + C_RWK + c, hp, mu + C_RWK + c);
            f32x4 vs = mix4(pr + C_RWV + c, pp + C_RWV + c, hp, mu + C_RWV + c);
            const f32x4 a0 = *(const f32x4*)(p.a0 + (size_t)l * 512 + c), w0 = *(const f32x4*)(p.w0 + (size_t)l * 512 + c), kkw = *(const f32x4*)(p.k_k + (size_t)l * 512 + c);
            const f32x4 ka = *(const f32x4*)(p.k_a + (size_t)l * 512 + c);
            f32x4 lw, asg;
#pragma unroll
            for (int e = 0; e < 4; ++e) { asg[e] = sigmoidf_(a0[e] + aa[e]); lw[e] = -0.6065306597126334f * sigmoidf_(w0[e] + aw[e]); }
            *(f32x4*)((float*)(r2 + R2_LW) + o) = lw;
            if (l == 0) { *(u32x2*)(VF + o) = pack4(vs); }
            else { const f32x4 vf = unpack4(*(const u32x2*)(VF + o)), v0 = *(const f32x4*)(p.v0 + (size_t)(l - 1) * 512 + c);
#pragma unroll
                for (int e = 0; e < 4; ++e) vs[e] = vs[e] + (vf[e] - vs[e]) * sigmoidf_(v0[e] + avm[e]); }
            const f32x4 kk = ksv * kkw * inv, km = ksv * ((asg - 1.f) * ka + 1.f), bb = kk * asg;
            { const f32x4 rk = *(const f32x4*)(p.r_k + (size_t)l * 512 + c); const f32x4 pr3 = rs * km * rk; dsum += pr3[0] + pr3[1] + pr3[2] + pr3[3]; }
            *(u32x2*)((bf16_t*)(r2 + R2_R) + o) = pack4(rs); *(u32x2*)((bf16_t*)(r2 + R2_K) + o) = pack4(km); *(u32x2*)((bf16_t*)(r2 + R2_V) + o) = pack4(vs);
            *(u32x2*)((bf16_t*)(r2 + R2_KK) + o) = pack4(kk); *(u32x2*)((bf16_t*)(r2 + R2_B) + o) = pack4(bb); }
        dsum += __shfl_xor(dsum, 16); dsum += __shfl_xor(dsum, 32);
        if (fq == 0) ((float*)(p.ws + OFF_DOT))[(size_t)t * 8 + h] = dsum;
    }
}

__device__ __forceinline__ void attn_item(const Params& p, int b, int h, int qb, unsigned char* lds, bool do_store = true) {
    const int tid = tid_l(), lane = tid & 63, wave = tid >> 6, fr = lane & 15, fq = lane >> 4;
    const bf16_t* Q = (const bf16_t*)(p.ws + OFF_R3 + R3_Q); const bf16_t* Kf = (const bf16_t*)(p.ws + OFF_R3 + R3_KF); const bf16_t* Vt = (const bf16_t*)(p.ws + OFF_R3 + R3_VT);
    bf16_t* Z = (bf16_t*)(p.ws + OFF_Z);
    constexpr int KS = 104, VS = 72, KB = 64 * KS * 2, VB = 64 * VS * 2, BUF = KB + VB;
    const int nkt = 2 * qb + 2, mykt = (wave < 4) ? nkt - 1 : nkt;
    const int trow = b * SEQ + qb * 128 + wave * 16 + fr;
    bf16x8 qf[3];
#pragma unroll
    for (int ks = 0; ks < 3; ++ks) qf[ks] = ld_frag(Q + (size_t)trow * 768 + h * 96 + ks * 32 + fq * 8);
    const bf16_t* kg = Kf + (size_t)(b * SEQ) * 768 + h * 96; const bf16_t* vg = Vt + (size_t)(b * 8 + h) * 64 * SEQ;
    const int kr0 = tid / 12, kc0 = tid % 12, kr1 = (tid + 512) / 12, kc1 = (tid + 512) % 12, vd = tid >> 3, vc = tid & 7;
    u32x4 pk0, pk1 = (u32x4){0, 0, 0, 0}, pv;
    __syncthreads();
    pk0 = *(const u32x4*)(kg + (size_t)kr0 * 768 + kc0 * 8); if (tid < 256) pk1 = *(const u32x4*)(kg + (size_t)kr1 * 768 + kc1 * 8);
    pv = *(const u32x4*)(vg + (size_t)vd * SEQ + vc * 8);
    { bf16_t* ks_ = (bf16_t*)lds; bf16_t* vs_ = (bf16_t*)(lds + KB);
        *(u32x4*)(ks_ + kr0 * KS + kc0 * 8) = pk0; if (tid < 256) *(u32x4*)(ks_ + kr1 * KS + kc1 * 8) = pk1; *(u32x4*)(vs_ + vd * VS + vc * 8) = pv; }
    __syncthreads();
    f32x4 O[4]; float m = -1e30f, lsum = 0.f;
#pragma unroll
    for (int d = 0; d < 4; ++d) O[d] = (f32x4){0.f, 0.f, 0.f, 0.f};
#pragma unroll 1
    for (int kt = 0; kt < nkt; ++kt) {
        const bool pre = (kt + 1 < nkt);
        if (pre) { const size_t ko = (size_t)(kt + 1) * 64;
            pk0 = *(const u32x4*)(kg + (ko + kr0) * 768 + kc0 * 8); if (tid < 256) pk1 = *(const u32x4*)(kg + (ko + kr1) * 768 + kc1 * 8);
            pv = *(const u32x4*)(vg + (size_t)vd * SEQ + ko + vc * 8); }
        if (kt < mykt) {
            const bf16_t* ks_ = (const bf16_t*)(lds + (kt & 1) * BUF); const bf16_t* vs_ = (const bf16_t*)(lds + (kt & 1) * BUF + KB);
            f32x4 s[4];
#pragma unroll
            for (int c4 = 0; c4 < 4; ++c4) { s[c4] = (f32x4){0.f, 0.f, 0.f, 0.f};
#pragma unroll
                for (int ks = 0; ks < 3; ++ks) s[c4] = MFMA(ld_frag(ks_ + (c4 * 16 + fr) * KS + ks * 32 + fq * 8), qf[ks], s[c4]); }
            float mx = -1e30f;
#pragma unroll
            for (int c4 = 0; c4 < 4; ++c4) mx = fmaxf(fmaxf(fmaxf(s[c4][0], s[c4][1]), fmaxf(s[c4][2], s[c4][3])), mx);
            mx = fmaxf(mx, __shfl_xor(mx, 16)); mx = fmaxf(mx, __shfl_xor(mx, 32));
            const float mn = fmaxf(m, mx), alpha = exp2f(m - mn); m = mn;
            float ps = 0.f;
#pragma unroll
            for (int c4 = 0; c4 < 4; ++c4)
#pragma unroll
                for (int e = 0; e < 4; ++e) { s[c4][e] = exp2f(s[c4][e] - mn); ps += s[c4][e]; }
            lsum = lsum * alpha + ps;
#pragma unroll
            for (int d = 0; d < 4; ++d) O[d] = O[d] * alpha;
            const bf16x8 pf0 = pack_frag(s[0], s[1]), pf1 = pack_frag(s[2], s[3]);
#pragma unroll
            for (int d = 0; d < 4; ++d) { const bf16_t* vp = vs_ + (d * 16 + fr) * VS + fq * 4;
                O[d] = MFMA(join_frag(*(const u32x2*)(vp), *(const u32x2*)(vp + 16)), pf0, O[d]);
                O[d] = MFMA(join_frag(*(const u32x2*)(vp + 32), *(const u32x2*)(vp + 48)), pf1, O[d]); }
        }
        if (pre) { bf16_t* ks_ = (bf16_t*)(lds + ((kt + 1) & 1) * BUF); bf16_t* vs_ = (bf16_t*)(lds + ((kt + 1) & 1) * BUF + KB);
            *(u32x4*)(ks_ + kr0 * KS + kc0 * 8) = pk0; if (tid < 256) *(u32x4*)(ks_ + kr1 * KS + kc1 * 8) = pk1; *(u32x4*)(vs_ + vd * VS + vc * 8) = pv; }
        __syncthreads();
    }
    lsum += __shfl_xor(lsum, 16); lsum += __shfl_xor(lsum, 32);
    const float il = 1.f / lsum;
    if (do_store)
#pragma unroll
    for (int d = 0; d < 4; ++d) { bf16_t* zp = Z + (size_t)trow * NZ + h * 64 + d * 16 + fq * 4; const f32x4 z = unpack4(*(const u32x2*)zp);
        f32x4 o;
#pragma unroll
        for (int e = 0; e < 4; ++e) o[e] = O[d][e] * il * siluf_(z[e]);
        *(u32x2*)zp = pack4(o); }
}

__device__ __forceinline__ void scan_item(const Params& p, int l, int bh, unsigned char* lds) {
    const int tid = tid_l(), b = bh >> 3, h = bh & 7;
    const unsigned char* r2 = p.ws + OFF_R2; bf16_t* Z = (bf16_t*)(p.ws + OFF_Z);
    float* Lw = (float*)lds; float* La = Lw + 4096; float* Lb = La + 4096; float* Lk = Lb + 4096; float* Lr = Lk + 4096; float* Lv = Lr + 4096; float* Ly = Lv + 4096;
    const int i = tid >> 3, jp = tid & 7;
    float st[8];
#pragma unroll
    for (int e = 0; e < 8; ++e) st[e] = 0.f;
    const int et = tid >> 3, ep = tid & 7;
#pragma unroll 1
    for (int ck = 0; ck < SEQ / 64; ++ck) {
        const size_t tg = (size_t)b * SEQ + ck * 64 + et; const size_t o = tg * 512 + h * 64 + ep * 8;
        __syncthreads();
        { const u32x4 ur = *(const u32x4*)((const bf16_t*)(r2 + R2_R) + o), uk = *(const u32x4*)((const bf16_t*)(r2 + R2_K) + o), uv = *(const u32x4*)((const bf16_t*)(r2 + R2_V) + o),
                      ukk = *(const u32x4*)((const bf16_t*)(r2 + R2_KK) + o), ub = *(const u32x4*)((const bf16_t*)(r2 + R2_B) + o);
            const f32x4 l0 = *(const f32x4*)((const float*)(r2 + R2_LW) + o), l1 = *(const f32x4*)((const float*)(r2 + R2_LW) + o + 4);
            const int lo = et * 64 + ep * 8;
            *(f32x4*)(Lw + lo) = (f32x4){__expf(l0[0]), __expf(l0[1]), __expf(l0[2]), __expf(l0[3])}; *(f32x4*)(Lw + lo + 4) = (f32x4){__expf(l1[0]), __expf(l1[1]), __expf(l1[2]), __expf(l1[3])};
            *(f32x4*)(La + lo) = (f32x4){-bf_lo(ukk.x), -bf_hi(ukk.x), -bf_lo(ukk.y), -bf_hi(ukk.y)}; *(f32x4*)(La + lo + 4) = (f32x4){-bf_lo(ukk.z), -bf_hi(ukk.z), -bf_lo(ukk.w), -bf_hi(ukk.w)};
            *(f32x4*)(Lb + lo) = (f32x4){bf_lo(ub.x), bf_hi(ub.x), bf_lo(ub.y), bf_hi(ub.y)}; *(f32x4*)(Lb + lo + 4) = (f32x4){bf_lo(ub.z), bf_hi(ub.z), bf_lo(ub.w), bf_hi(ub.w)};
            *(f32x4*)(Lk + lo) = (f32x4){bf_lo(uk.x), bf_hi(uk.x), bf_lo(uk.y), bf_hi(uk.y)}; *(f32x4*)(Lk + lo + 4) = (f32x4){bf_lo(uk.z), bf_hi(uk.z), bf_lo(uk.w), bf_hi(uk.w)};
            *(f32x4*)(Lr + lo) = (f32x4){bf_lo(ur.x), bf_hi(ur.x), bf_lo(ur.y), bf_hi(ur.y)}; *(f32x4*)(Lr + lo + 4) = (f32x4){bf_lo(ur.z), bf_hi(ur.z), bf_lo(ur.w), bf_hi(ur.w)};
            *(f32x4*)(Lv + lo) = (f32x4){bf_lo(uv.x), bf_hi(uv.x), bf_lo(uv.y), bf_hi(uv.y)}; *(f32x4*)(Lv + lo + 4) = (f32x4){bf_lo(uv.z), bf_hi(uv.z), bf_lo(uv.w), bf_hi(uv.w)};
        }
        __syncthreads();
#pragma unroll 1
        for (int t = 0; t < 64; ++t) { const int lo = t * 64 + jp * 8;
            const f32x4 w0 = *(const f32x4*)(Lw + lo), w1 = *(const f32x4*)(Lw + lo + 4), a0 = *(const f32x4*)(La + lo), a1 = *(const f32x4*)(La + lo + 4), b0 = *(const f32x4*)(Lb + lo), b1 = *(const f32x4*)(Lb + lo + 4),
                        k0 = *(const f32x4*)(Lk + lo), k1 = *(const f32x4*)(Lk + lo + 4), r0 = *(const f32x4*)(Lr + lo), r1 = *(const f32x4*)(Lr + lo + 4);
            const float vi = Lv[t * 64 + i];
            float sa = st[0] * a0[0] + st[1] * a0[1] + st[2] * a0[2] + st[3] * a0[3] + st[4] * a1[0] + st[5] * a1[1] + st[6] * a1[2] + st[7] * a1[3];
            sa += __shfl_xor(sa, 1); sa += __shfl_xor(sa, 2); sa += __shfl_xor(sa, 4);
            st[0] = st[0] * w0[0] + sa * b0[0] + vi * k0[0]; st[1] = st[1] * w0[1] + sa * b0[1] + vi * k0[1]; st[2] = st[2] * w0[2] + sa * b0[2] + vi * k0[2]; st[3] = st[3] * w0[3] + sa * b0[3] + vi * k0[3];
            st[4] = st[4] * w1[0] + sa * b1[0] + vi * k1[0]; st[5] = st[5] * w1[1] + sa * b1[1] + vi * k1[1]; st[6] = st[6] * w1[2] + sa * b1[2] + vi * k1[2]; st[7] = st[7] * w1[3] + sa * b1[3] + vi * k1[3];
            float y = st[0] * r0[0] + st[1] * r0[1] + st[2] * r0[2] + st[3] * r0[3] + st[4] * r1[0] + st[5] * r1[1] + st[6] * r1[2] + st[7] * r1[3];
            y += __shfl_xor(y, 1); y += __shfl_xor(y, 2); y += __shfl_xor(y, 4);
            if (jp == 0) Ly[t * 64 + i] = y;
        }
        __syncthreads();
        { const int lo = et * 64 + ep * 8;
            const f32x4 y0 = *(const f32x4*)(Ly + lo), y1 = *(const f32x4*)(Ly + lo + 4), r0 = *(const f32x4*)(Lr + lo), r1 = *(const f32x4*)(Lr + lo + 4), k0 = *(const f32x4*)(Lk + lo), k1 = *(const f32x4*)(Lk + lo + 4),
                        v0 = *(const f32x4*)(Lv + lo), v1 = *(const f32x4*)(Lv + lo + 4);
            const f32x4 rk0 = *(const f32x4*)(p.r_k + (size_t)l * 512 + h * 64 + ep * 8), rk1 = *(const f32x4*)(p.r_k + (size_t)l * 512 + h * 64 + ep * 8 + 4);
            float s = y0[0] + y0[1] + y0[2] + y0[3] + y1[0] + y1[1] + y1[2] + y1[3];
            float dot = r0[0] * k0[0] * rk0[0] + r0[1] * k0[1] * rk0[1] + r0[2] * k0[2] * rk0[2] + r0[3] * k0[3] * rk0[3] + r1[0] * k1[0] * rk1[0] + r1[1] * k1[1] * rk1[1] + r1[2] * k1[2] * rk1[2] + r1[3] * k1[3] * rk1[3];
            s += __shfl_xor(s, 1); s += __shfl_xor(s, 2); s += __shfl_xor(s, 4);
            dot += __shfl_xor(dot, 1); dot += __shfl_xor(dot, 2); dot += __shfl_xor(dot, 4);
            const float mean = s * (1.f / 64.f);
            const f32x4 d0 = y0 - mean, d1 = y1 - mean;
            float q = d0[0] * d0[0] + d0[1] * d0[1] + d0[2] * d0[2] + d0[3] * d0[3] + d1[0] * d1[0] + d1[1] * d1[1] + d1[2] * d1[2] + d1[3] * d1[3];
            q += __shfl_xor(q, 1); q += __shfl_xor(q, 2); q += __shfl_xor(q, 4);
            const float rstd = rsqrtf(q * (1.f / 64.f) + 64e-5f);
            const f32x4 g0 = *(const f32x4*)(p.lnx_g + (size_t)l * 512 + h * 64 + ep * 8), g1 = *(const f32x4*)(p.lnx_g + (size_t)l * 512 + h * 64 + ep * 8 + 4),
                        e0 = *(const f32x4*)(p.lnx_b + (size_t)l * 512 + h * 64 + ep * 8), e1 = *(const f32x4*)(p.lnx_b + (size_t)l * 512 + h * 64 + ep * 8 + 4);
            bf16_t* zp = Z + tg * NZ + 1024 + h * 64 + ep * 8; const u32x4 zu = *(const u32x4*)zp;
            const f32x4 o0 = d0 * rstd * g0 + e0 + v0 * dot, o1 = d1 * rstd * g1 + e1 + v1 * dot;
            u32x4 w; w.x = cvt_pk_bf16(o0[0] * siluf_(bf_lo(zu.x)), o0[1] * siluf_(bf_hi(zu.x))); w.y = cvt_pk_bf16(o0[2] * siluf_(bf_lo(zu.y)), o0[3] * siluf_(bf_hi(zu.y)));
            w.z = cvt_pk_bf16(o1[0] * siluf_(bf_lo(zu.z)), o1[1] * siluf_(bf_hi(zu.z))); w.w = cvt_pk_bf16(o1[2] * siluf_(bf_lo(zu.w)), o1[3] * siluf_(bf_hi(zu.w)));
            *(u32x4*)zp = w; }
    }
}


constexpr int MS = 72;
__device__ __forceinline__ f32x4 nt_tile(const bf16_t* Am, int arow, const bf16_t* Bm, int brow, f32x4 acc, int fq) {
    acc = MFMA(ld_frag(Am + arow * MS + fq * 8), ld_frag(Bm + brow * MS + fq * 8), acc);
    acc = MFMA(ld_frag(Am + arow * MS + 32 + fq * 8), ld_frag(Bm + brow * MS + 32 + fq * 8), acc);
    return acc;
}
#if PROBE_SCAN
#define CHKF_OLD(ptr, n, bit) do { unsigned _c = 0u; for (int _i = tid; _i < (n); _i += NTHREADS) { const float _a = (ptr)[_i]; if (!(fabsf(_a) < 1e30f)) _c = (bit); } if (_c) atomicOr((unsigned*)(p.ws + WS_END + 5 * MiB), _c); } while (0)
#define CHKB_OLD(ptr, bit) do { unsigned _c = 0u; for (int _i = tid; _i < 4096; _i += NTHREADS) { const float _a = bf2f((ptr)[(_i >> 6) * MS + (_i & 63)]); if (!(fabsf(_a) < 1e30f)) _c = (bit); } if (_c) atomicOr((unsigned*)(p.ws + WS_END + 5 * MiB), _c); } while (0)
#endif
#define CHKF(ptr, n, bit)
#define CHKB(ptr, bit)
__device__ __forceinline__ void chunk_item(const Params& p, int item, unsigned char* lds) {
    const int tid = tid_l(), lane = tid & 63, wave = __builtin_amdgcn_readfirstlane(tid >> 6), fr = lane & 15, fq = lane >> 4;
    const int bh = item >> 6, ck = item & 63, b = bh >> 3, h = bh & 7;
    const size_t tok0 = (size_t)b * SEQ + ck * 64;
    const unsigned char* r2 = p.ws + OFF_R2; unsigned char* r1 = p.ws + OFF_R1;
    float* CUM = (float*)lds; float* TF = CUM + 4096; float* XB = TF + 4096; float* TOT = XB + 1024;
    bf16_t* MB = (bf16_t*)(lds + 38912);
    bf16_t *AT_ = MB, *BT_ = MB + 1 * 64 * MS, *KT_ = MB + 2 * 64 * MS, *RT_ = MB + 3 * 64 * MS, *ATT = MB + 4 * 64 * MS, *VT = MB + 5 * 64 * MS, *KHT = MB + 6 * 64 * MS, *BHT = MB + 7 * 64 * MS,
           *MAK = MB + 8 * 64 * MS, *MRB = MB + 9 * 64 * MS, *MRK = MB + 10 * 64 * MS, *TB = MB + 11 * 64 * MS;
    bf16_t *MVT = AT_, *TAT = BT_, *W1T = KT_;
    const float* LWg = (const float*)(r2 + R2_LW);
    __syncthreads();
    { float c[8]; float run = 0.f;
#pragma unroll
        for (int e = 0; e < 8; ++e) { run += LWg[(tok0 + wave * 8 + e) * 512 + h * 64 + lane]; c[e] = run; }
        TOT[wave * 64 + lane] = run;
        __syncthreads();
        float off = 0.f;
#pragma unroll
        for (int w2 = 0; w2 < 7; ++w2) off += (w2 < wave) ? TOT[w2 * 64 + lane] : 0.f;
#pragma unroll
        for (int e = 0; e < 8; ++e) CUM[(wave * 8 + e) * 64 + lane] = off + c[e];
    }
    __syncthreads();
    { const int t = tid & 63, j0 = (tid >> 6) * 8; const size_t o = (tok0 + t) * 512 + h * 64 + j0;
        const u32x4 ur = *(const u32x4*)((const bf16_t*)(r2 + R2_R) + o), uk = *(const u32x4*)((const bf16_t*)(r2 + R2_K) + o), uv = *(const u32x4*)((const bf16_t*)(r2 + R2_V) + o),
                    ukk = *(const u32x4*)((const bf16_t*)(r2 + R2_KK) + o), ub = *(const u32x4*)((const bf16_t*)(r2 + R2_B) + o);
        const unsigned rr[4] = {ur.x, ur.y, ur.z, ur.w}, kr[4] = {uk.x, uk.y, uk.z, uk.w}, vr[4] = {uv.x, uv.y, uv.z, uv.w}, qr[4] = {ukk.x, ukk.y, ukk.z, ukk.w}, br[4] = {ub.x, ub.y, ub.z, ub.w};
        unsigned oa[4], ob[4], ok[4], orr[4];
#pragma unroll
        for (int e2 = 0; e2 < 4; ++e2) { float va[2], vb[2], vk[2], vrr[2];
#pragma unroll
            for (int hh = 0; hh < 2; ++hh) { const int e = 2 * e2 + hh;
                const float cm = CUM[t * 64 + j0 + e], lwv = LWg[o + e], cC = CUM[63 * 64 + j0 + e];
                const float rv = hh ? bf_hi(rr[e2]) : bf_lo(rr[e2]), kv = hh ? bf_hi(kr[e2]) : bf_lo(kr[e2]), vv = hh ? bf_hi(vr[e2]) : bf_lo(vr[e2]), qv = hh ? bf_hi(qr[e2]) : bf_lo(qr[e2]), bv = hh ? bf_hi(br[e2]) : bf_lo(br[e2]);
                const float en = __expf(-cm), eh = __expf(cC - cm);
                va[hh] = -qv * __expf(cm - lwv); vb[hh] = bv * en; vk[hh] = kv * en; vrr[hh] = rv * __expf(cm);
                ATT[(j0 + e) * MS + t] = f2bf(va[hh]); VT[(j0 + e) * MS + t] = f2bf(vv); KHT[(j0 + e) * MS + t] = f2bf(kv * eh); BHT[(j0 + e) * MS + t] = f2bf(bv * eh);
                if (t == 63) ((float*)(r1 + R1_PC))[(size_t)item * 64 + j0 + e] = __expf(cC); }
            oa[e2] = cvt_pk_bf16(va[0], va[1]); ob[e2] = cvt_pk_bf16(vb[0], vb[1]); ok[e2] = cvt_pk_bf16(vk[0], vk[1]); orr[e2] = cvt_pk_bf16(vrr[0], vrr[1]); }
        *(u32x4*)(AT_ + t * MS + j0) = (u32x4){oa[0], oa[1], oa[2], oa[3]}; *(u32x4*)(BT_ + t * MS + j0) = (u32x4){ob[0], ob[1], ob[2], ob[3]};
        *(u32x4*)(KT_ + t * MS + j0) = (u32x4){ok[0], ok[1], ok[2], ok[3]}; *(u32x4*)(RT_ + t * MS + j0) = (u32x4){orr[0], orr[1], orr[2], orr[3]};
    }
    __syncthreads();
#pragma unroll 1
    for (int x = 0; x < 8; ++x) { const int q = wave * 8 + x, mat = q >> 4, tm = (q >> 2) & 3, tn = q & 3;
        const bf16_t* Am = (mat & 1) ? KT_ : BT_; const bf16_t* Bm = (mat & 2) ? RT_ : AT_;
        f32x4 acc = nt_tile(Am, tm * 16 + fr, Bm, tn * 16 + fr, (f32x4){0.f, 0.f, 0.f, 0.f}, fq);
        const int t = tn * 16 + fr, s0 = tm * 16 + fq * 4;
#pragma unroll
        for (int e = 0; e < 4; ++e) { const bool keep = (mat & 2) ? (s0 + e <= t) : (s0 + e < t); acc[e] = keep ? acc[e] : 0.f; }
        if (mat == 0) *(f32x4*)(CUM + t * 64 + s0) = acc;
        else { bf16_t* Om = (mat == 1) ? MAK : (mat == 2) ? MRB : MRK; *(u32x2*)(Om + t * MS + s0) = pack4(acc); }
    }
    __syncthreads();

    if (wave == 0) { const int base = (lane >> 5) * 32, c = lane & 31; float xv[32]; int roff = base * 65; float prev = 0.f;
#pragma unroll
        for (int t = 0; t < 32; ++t) { float a = (t == c) ? 1.f : 0.f;
            asm volatile("" : "+v"(roff), "+v"(prev));
            const float* Lr = CUM + roff + t * 64;
#pragma unroll
            for (int s2 = 0; s2 < t; ++s2) a += Lr[s2] * xv[s2];
            xv[t] = a; prev = a; }
#pragma unroll
        for (int t = 0; t < 32; ++t) { TF[(base + t) * 64 + base + c] = xv[t]; if (base == 0) TF[t * 64 + 32 + c] = 0.f; }
    }
    __syncthreads();
    { const int r = tid >> 4, c0 = (tid & 15) * 2; float x0 = 0.f, x1 = 0.f;
#pragma unroll 8
        for (int k = 0; k < 32; ++k) { const float lv = CUM[(32 + r) * 64 + k]; x0 += lv * TF[k * 64 + c0]; x1 += lv * TF[k * 64 + c0 + 1]; }
        XB[r * 32 + c0] = x0; XB[r * 32 + c0 + 1] = x1;
        __syncthreads();
        float y0 = 0.f, y1 = 0.f;
#pragma unroll 8
        for (int k = 0; k < 32; ++k) { const float tv = TF[(32 + r) * 64 + 32 + k]; y0 += tv * XB[k * 32 + c0]; y1 += tv * XB[k * 32 + c0 + 1]; }
        TF[(32 + r) * 64 + c0] = y0; TF[(32 + r) * 64 + c0 + 1] = y1;
    }
    __syncthreads();
    { const int t = tid >> 3, s0 = (tid & 7) * 8; const f32x4 a = *(const f32x4*)(TF + t * 64 + s0), b2 = *(const f32x4*)(TF + t * 64 + s0 + 4);
        u32x4 w; w.x = cvt_pk_bf16(a[0], a[1]); w.y = cvt_pk_bf16(a[2], a[3]); w.z = cvt_pk_bf16(b2[0], b2[1]); w.w = cvt_pk_bf16(b2[2], b2[3]);
        *(u32x4*)(TB + t * MS + s0) = w; }
    __syncthreads();
#pragma unroll 1
    for (int x = 0; x < 4; ++x) { const int q = wave * 4 + x, mat = q >> 4, tm = (q >> 2) & 3, tn = q & 3;
        const f32x4 acc = nt_tile(mat ? TB : MAK, tm * 16 + fr, mat ? ATT : VT, tn * 16 + fr, (f32x4){0.f, 0.f, 0.f, 0.f}, fq);
        *(u32x2*)((mat ? TAT : MVT) + (tn * 16 + fr) * MS + tm * 16 + fq * 4) = pack4(acc); }
    __syncthreads();
#pragma unroll 1
    for (int x = 0; x < 2; ++x) { const int q = wave * 2 + x, tm = q >> 2, tn = q & 3;
        const f32x4 acc = nt_tile(TB, tm * 16 + fr, MVT, tn * 16 + fr, (f32x4){0.f, 0.f, 0.f, 0.f}, fq);
        *(u32x2*)(W1T + (tn * 16 + fr) * MS + tm * 16 + fq * 4) = pack4(acc); }
    __syncthreads();
#pragma unroll 1
    for (int x = 0; x < 8; ++x) { const int q = wave * 8 + x, o = q >> 4, tm = (q >> 2) & 3, tn = q & 3;
        const int ar = tm * 16 + fr, br_ = tn * 16 + fr; f32x4 acc = (f32x4){0.f, 0.f, 0.f, 0.f};
        if (o == 0) acc = nt_tile(TAT, ar, BHT, br_, acc, fq);
        else if (o == 1) { acc = unpack4(*(const u32x2*)(RT_ + br_ * MS + tm * 16 + fq * 4)); acc = nt_tile(TAT, ar, MRB, br_, acc, fq); }
        else if (o == 2) { acc = nt_tile(KHT, ar, VT, br_, acc, fq); acc = nt_tile(BHT, ar, W1T, br_, acc, fq); }
        else { acc = nt_tile(VT, ar, MRK, br_, acc, fq);
#if EXP_CONSTY
            acc = (f32x4){1.f, 2.f, 3.f, 4.f};
#endif
#if !EXP_NOW1
            acc = nt_tile(W1T, ar, MRB, br_, acc, fq);
#endif
        }
        bf16_t* og = (bf16_t*)(r1 + (size_t)o * 16 * MiB) + (size_t)item * 4096 + br_ * 64 + tm * 16 + fq * 4;
        *(u32x2*)og = pack4(acc); }
}

__device__ __forceinline__ void seq_item(const Params& p, int l, int bh, unsigned char* lds, bf16_t* dstp, int dst_ld, size_t dst_tok0) {
    const int tid = tid_l(), lane = tid & 63, wave = __builtin_amdgcn_readfirstlane(tid >> 6), fr = lane & 15, fq = lane >> 4;
    const int b = bh >> 3, h = bh & 7;
    const unsigned char* r1 = p.ws + OFF_R1;
    constexpr int BUFB = 4 * 64 * MS * 2 + 256;
    bf16_t* SB = (bf16_t*)(lds + 2 * BUFB) + wave * 16 * MS;
    float* YB = (float*)(lds + 2 * BUFB + 4 * 16 * MS * 2);
    const int srow = tid >> 3, sc8 = tid & 7;
    u32x4 pre[4]; float prepc = 0.f;
    __syncthreads();
    { const size_t ci = (size_t)bh * 64;
#pragma unroll
        for (int m = 0; m < 4; ++m) pre[m] = *(const u32x4*)((const bf16_t*)(r1 + (size_t)m * 16 * MiB) + ci * 4096 + srow * 64 + sc8 * 8);
        if (tid < 64) prepc = ((const float*)(r1 + R1_PC))[ci * 64 + tid];
#pragma unroll
        for (int m = 0; m < 4; ++m) *(u32x4*)((bf16_t*)lds + m * 64 * MS + srow * MS + sc8 * 8) = pre[m];
        if (tid < 64) ((float*)(lds + 4 * 64 * MS * 2))[tid] = prepc;
        if (wave < 4) { for (int e = lane; e < 16 * MS / 2; e += 64) ((unsigned*)SB)[e] = 0u; }
    }
    __syncthreads();
    f32x4 Sacc[4];
#pragma unroll
    for (int jt = 0; jt < 4; ++jt) Sacc[jt] = (f32x4){0.f, 0.f, 0.f, 0.f};
#pragma unroll 1
    for (int c = 0; c < 64; ++c) {
        const bool pf = (c + 1 < 64);
        if (pf) { const size_t ci = (size_t)bh * 64 + c + 1;
#pragma unroll
            for (int m = 0; m < 4; ++m) pre[m] = *(const u32x4*)((const bf16_t*)(r1 + (size_t)m * 16 * MiB) + ci * 4096 + srow * 64 + sc8 * 8);
            if (tid < 64) prepc = ((const float*)(r1 + R1_PC))[ci * 64 + tid]; }
        if (wave < 4) {
            if (c < 64) {
                const unsigned char* bufp = lds + (c & 1) * BUFB;
                const bf16_t* GP = (const bf16_t*)bufp; const bf16_t* RA = GP + 64 * MS; const bf16_t* HT = RA + 64 * MS; const bf16_t* YQ = HT + 64 * MS; const float* PC = (const float*)(bufp + 4 * 64 * MS * 2);
#if EXP_NOSTATE
                const bf16x8 sf0 = (bf16x8){0,0,0,0,0,0,0,0}, sf1 = sf0;
#else
                const bf16x8 sf0 = ld_frag(SB + fr * MS + fq * 8), sf1 = ld_frag(SB + fr * MS + 32 + fq * 8);
#endif
                float* yb = YB + (c & 1) * 4096;
#pragma unroll
                for (int tt = 0; tt < 4; ++tt) { f32x4 y = unpack4(*(const u32x2*)(YQ + (tt * 16 + fr) * MS + wave * 16 + fq * 4));
                    y = MFMA(sf0, ld_frag(RA + (tt * 16 + fr) * MS + fq * 8), y); y = MFMA(sf1, ld_frag(RA + (tt * 16 + fr) * MS + 32 + fq * 8), y);
                    *(f32x4*)(yb + (tt * 16 + fr) * 64 + wave * 16 + fq * 4) = y; }
#pragma unroll
                for (int jt = 0; jt < 4; ++jt) { const f32x4 pc = *(const f32x4*)(PC + jt * 16 + fq * 4);
                    f32x4 a = unpack4(*(const u32x2*)(HT + (wave * 16 + fr) * MS + jt * 16 + fq * 4)) + Sacc[jt] * pc;
                    a = MFMA(ld_frag(GP + (jt * 16 + fr) * MS + fq * 8), sf0, a); a = MFMA(ld_frag(GP + (jt * 16 + fr) * MS + 32 + fq * 8), sf1, a);
                    Sacc[jt] = a; }
#pragma unroll
                for (int jt = 0; jt < 4; ++jt) *(u32x2*)(SB + fr * MS + jt * 16 + fq * 4) = pack4(Sacc[jt]);
            }
        }
        if (pf) { unsigned char* bufn = lds + ((c + 1) & 1) * BUFB;
#pragma unroll
            for (int m = 0; m < 4; ++m) *(u32x4*)((bf16_t*)bufn + m * 64 * MS + srow * MS + sc8 * 8) = pre[m];
            if (tid < 64) ((float*)(bufn + 4 * 64 * MS * 2))[tid] = prepc; }
        __syncthreads();
        if (c < 64) {
            const int t = tid >> 3, q = tid & 7; const float* yb = YB + (c & 1) * 4096 + t * 64 + q * 8;
            const f32x4 y0 = *(const f32x4*)yb, y1 = *(const f32x4*)(yb + 4);
            float s1 = y0[0] + y0[1] + y0[2] + y0[3] + y1[0] + y1[1] + y1[2] + y1[3];
            s1 += __shfl_xor(s1, 1); s1 += __shfl_xor(s1, 2); s1 += __shfl_xor(s1, 4);
            const float mean = s1 * (1.f / 64.f); const f32x4 d0 = y0 - mean, d1 = y1 - mean;
            float s2 = d0[0] * d0[0] + d0[1] * d0[1] + d0[2] * d0[2] + d0[3] * d0[3] + d1[0] * d1[0] + d1[1] * d1[1] + d1[2] * d1[2] + d1[3] * d1[3];
            s2 += __shfl_xor(s2, 1); s2 += __shfl_xor(s2, 2); s2 += __shfl_xor(s2, 4);
            const float rstd = rsqrtf(s2 * (1.f / 64.f) + 64e-5f);
            const size_t tg = (size_t)b * SEQ + c * 64 + t; const int ch = h * 64 + q * 8;
            const float dot = ((const float*)(p.ws + OFF_DOT))[tg * 8 + h];
            const u32x4 vu = *(const u32x4*)((const bf16_t*)(p.ws + OFF_R2 + R2_V) + tg * 512 + ch);
            bf16_t* zp = dstp + (tg - dst_tok0) * dst_ld + ch; const u32x4 zu = *(const u32x4*)((const bf16_t*)(p.ws + OFF_Z) + tg * NZ + 1024 + ch);
            const f32x4 g0 = *(const f32x4*)(p.lnx_g + (size_t)l * 512 + ch), g1 = *(const f32x4*)(p.lnx_g + (size_t)l * 512 + ch + 4), e0 = *(const f32x4*)(p.lnx_b + (size_t)l * 512 + ch), e1 = *(const f32x4*)(p.lnx_b + (size_t)l * 512 + ch + 4);
            const f32x4 v0 = (f32x4){bf_lo(vu.x), bf_hi(vu.x), bf_lo(vu.y), bf_hi(vu.y)}, v1 = (f32x4){bf_lo(vu.z), bf_hi(vu.z), bf_lo(vu.w), bf_hi(vu.w)};
            const f32x4 o0 = d0 * rstd * g0 + e0 + v0 * dot, o1 = d1 * rstd * g1 + e1 + v1 * dot;
            u32x4 w; w.x = cvt_pk_bf16(o0[0] * siluf_(bf_lo(zu.x)), o0[1] * siluf_(bf_hi(zu.x))); w.y = cvt_pk_bf16(o0[2] * siluf_(bf_lo(zu.y)), o0[3] * siluf_(bf_hi(zu.y)));
            w.z = cvt_pk_bf16(o1[0] * siluf_(bf_lo(zu.z)), o1[1] * siluf_(bf_hi(zu.z))); w.w = cvt_pk_bf16(o1[2] * siluf_(bf_lo(zu.w)), o1[3] * siluf_(bf_hi(zu.w)));
            *(u32x4*)zp = w;
        }
    }
}

#define XB_TMO      128
#define XB_XCNT(j)  (256  + 64 * (j))
#define XB_XSUB(j)  (1280 + 64 * (j))
#define XB_XGEN(j)  (2304 + 64 * (j))
#define XB_TOP      3328
#define XB_TOPGEN   3392
#define XCD_BAR_WORDS 3456
#define XB_SPIN_CAP (1u << 18)

__device__ __forceinline__ unsigned xb_ld(unsigned* p)              { return __hip_atomic_load(p, __ATOMIC_RELAXED, __HIP_MEMORY_SCOPE_AGENT); }
__device__ __forceinline__ unsigned xb_add(unsigned* p, unsigned v) { return __hip_atomic_fetch_add(p, v, __ATOMIC_RELAXED, __HIP_MEMORY_SCOPE_AGENT); }
__device__ __forceinline__ unsigned xb_xcc_id() { return (unsigned)__builtin_amdgcn_s_getreg((3 << 11) | 20) & 0xFu; }
#define XB_SPIN(cond, bar) do { unsigned _sp = 0; while (cond) { __builtin_amdgcn_s_sleep(1); \
    if ((++_sp & 255u) == 0u) { if (xb_ld(&(bar)[XB_TMO])) break; if (_sp > XB_SPIN_CAP) { atomicAdd(&(bar)[XB_TMO], 1u); break; } } } } while (0)

struct XcdBarrier {
    unsigned* bar; unsigned x;
    volatile LAS unsigned* st;
};

__device__ __forceinline__ XcdBarrier xcd_barrier_post(unsigned* bar, volatile LAS unsigned* st) {
    XcdBarrier b; b.bar = bar; b.x = xb_xcc_id(); b.st = st;
    if (threadIdx.x == 0) (void)xb_add(&bar[XB_XCNT(b.x)], 1u);
    return b;
}
__device__ __forceinline__ void xcd_barrier_complete(unsigned* bar, unsigned x, unsigned& nloc, unsigned& nx) {
    const unsigned G = gridDim.x * gridDim.y * gridDim.z;
    unsigned sum, cnt, mine, sp = 0u;
    for (;;) {
        sum = 0u; cnt = 0u; mine = 0u;
#pragma unroll
        for (unsigned j = 0; j < 16; ++j) { const unsigned c = xb_ld(&bar[XB_XCNT(j)]); sum += c; cnt += (c > 0u) ? 1u : 0u; mine = (j == x) ? c : mine; }
        if (sum == G) break;
        __builtin_amdgcn_s_sleep(1);
        if ((++sp & 255u) == 0u) { if (xb_ld(&bar[XB_TMO])) break; if (sp > XB_SPIN_CAP) { atomicAdd(&bar[XB_TMO], 1u); break; } }
    }
    nloc = mine > 0u ? mine : 1u; nx = cnt > 0u ? cnt : 1u;
}

__device__ __forceinline__ void xcd_barrier(const XcdBarrier& b) {
    asm volatile("s_waitcnt vmcnt(0)" ::: "memory");
    __syncthreads();
    if (threadIdx.x == 0) {
        unsigned* bar = b.bar;
        __builtin_amdgcn_s_waitcnt(0);
        unsigned nloc = b.st[0], nx = b.st[1];
        if (nloc == 0u) { xcd_barrier_complete(bar, b.x, nloc, nx); b.st[0] = nloc; b.st[1] = nx; }
        const unsigned old = xb_add(&bar[XB_XSUB(b.x)], 1u);
        const unsigned gen = old / nloc;
        if (old + 1u == (gen + 1u) * nloc) {
            __builtin_amdgcn_fence(__ATOMIC_RELEASE, "agent");
            asm volatile("s_waitcnt vmcnt(0)" ::: "memory");
            const unsigned og = xb_add(&bar[XB_TOP], 1u);
            const unsigned tg = og / nx;
            if (og + 1u == (tg + 1u) * nx) xb_add(&bar[XB_TOPGEN], 1u);
            else XB_SPIN(xb_ld(&bar[XB_TOPGEN]) == tg, bar);
            __builtin_amdgcn_fence(__ATOMIC_ACQUIRE, "agent");
            xb_add(&bar[XB_XGEN(b.x)], 1u);
            asm volatile("s_waitcnt vmcnt(0)" ::: "memory");
        } else {
            XB_SPIN(xb_ld(&bar[XB_XGEN(b.x)]) == gen, bar);
            __builtin_amdgcn_fence(__ATOMIC_ACQUIRE, "agent");
            asm volatile("s_waitcnt vmcnt(0)" ::: "memory");
        }
    }
    __syncthreads();
}


constexpr int PH_PER_LAYER = 8, PH_PRE = 3, N_PHASES = PH_PRE + NL * PH_PER_LAYER;
__global__ void __launch_bounds__(NTHREADS, 2) trunk_fwd(Params p0) {
    extern __shared__ __attribute__((aligned(16))) unsigned char lds[];
    const int G = gridDim.x, bx = blockIdx.x;
    Params p = p0;
    volatile LAS unsigned* xb_st = (volatile LAS unsigned*)((LAS unsigned char*)lds + (LDS_BYTES - 16));
    if (threadIdx.x == 0) { xb_st[0] = 0u; xb_st[1] = 0u; }
    XcdBarrier xbar; xbar.bar = nullptr; xbar.x = 0; xbar.st = xb_st;
    __syncthreads();
#if EXP_ZERO
    for (int i = threadIdx.x; i < LDS_BYTES / 4; i += NTHREADS) ((unsigned*)lds)[i] = 0u;
    __syncthreads();
    if (p0.ph_lo == 0) { u32x4* z = (u32x4*)(p0.ws + OFF_DOT); const size_t n = (WS_END - OFF_DOT) / 16;
        for (size_t i = (size_t)bx * NTHREADS + threadIdx.x; i < n; i += (size_t)G * NTHREADS) z[i] = (u32x4){0u, 0u, 0u, 0u}; }
#endif
    for (int ph = p0.ph_lo; ph < p0.ph_hi; ++ph) {
        unsigned char* ws = ptr_l(p0.ws); p.ws = ws;
#if TS_K >= 0
        if (bx == 0 && threadIdx.x == 0) ((unsigned long long*)(ws + WS_END + 32768))[ph] = __builtin_amdgcn_s_memrealtime();
#endif
        if (ph == 0) { if (PHEN & 1) for (int rep = 0; rep < REP_P0; ++rep) phase0a(p, lds); }
        else if (ph == 1) { phase_modt(p); }
        else if (ph == 2) { if (PHEN & 2) phase0b(p); }
        else {
            const int l = (ph - PH_PRE) / PH_PER_LAYER, k = (ph - PH_PRE) % PH_PER_LAYER;
            if (k == 0 && (PHEN & 4)) for (int rep = 0; rep < REP_IN; ++rep) {
                pg8::Gemm g{(const bf16_t*)(ws + OFF_H), (const bf16_t*)(ws + OFF_WIN + l * SZ_WIN), DM, DM, DM};
                pg8::PlainOrder S; S.init(M_TOK / 256, NIN / 256, G, bx);
                pg8::EpiIn E{(bf16_t*)(ws + OFF_R1), (bf16_t*)(ws + OFF_Z)};
                pg8::gemm_phase(( LAS unsigned char*)lds, g, S, E);
            } else if (k == 1 && (PHEN & 8)) {
                for (int it = bx; it < 640; it += G) {
                    if (it < 128) { if (PHEN & 512) { for (int rep = 1; rep < REP_GM; ++rep) gmlp_item(p, l, it, lds, false); gmlp_item(p, l, it, lds); } }
                    else if (it < 384) { if (PHEN & 1024) for (int rep = 0; rep < REP_MLA; ++rep) mla_prep_item(p, l, it - 128, lds); }
                    else { if (PHEN & 2048) for (int rep = 0; rep < REP_RW; ++rep) rwkv_prep_item(p, l, it - 384); }
                }
            } else if (k == 2 && (PHEN & 16)) {
                for (int rep = 0; rep < REP_CHUNK; ++rep) for (int it = bx; it < 2048; it += G) { if (USE_CHUNK && (PHEN & 4096)) chunk_item(p, it, lds); }
            } else if (k == 3 && (PHEN & 16)) {
#if !USE_CHUNK
                for (int it = bx; it < 32; it += G) scan_item(p, l, it, lds);
#elif PROBE_SCAN
                for (int it = bx; it < 32; it += G) { if (l == 0 && it < 8) seq_item(p, l, it, lds, (bf16_t*)(ws + WS_END), 512, 0); scan_item(p, l, it, lds); }
#else
                for (int it = bx; it < 32; it += G) { if (PHEN & 8192) seq_item(p, l, it, lds, (bf16_t*)(ws + OFF_Z) + 1024, NZ, 0); }
#endif
                {
                    unsigned* ctr = (unsigned*)(ptr_l(p0.ws) + WS_END + 16384) + l * 16;
                    volatile LAS unsigned* slot = (volatile LAS unsigned*)((LAS unsigned char*)lds + (LDS_BYTES - 8));
                    for (;;) {
                        __syncthreads();
                        if (tid_l() == 0) *slot = __hip_atomic_fetch_add(ctr, 1u, __ATOMIC_RELAXED, __HIP_MEMORY_SCOPE_AGENT);
                        __syncthreads();
                        const unsigned i = *slot;
                        if (i >= 1024u) break;
                        const int qb = 31 - (int)(i >> 5), bh = (int)(i & 31);
                        attn_item(p, bh >> 3, bh & 7, qb, lds);
                    }
                }
            } else if (k == 4 && (PHEN & 32)) for (int rep = 0; rep < REP_GMO; ++rep) {
#if PROBE_SCAN
#endif: G = sigmoid(h @ Wg)
                pg8::Gemm g{(const bf16_t*)(ws + OFF_H), (const bf16_t*)(ws + OFF_WG + l * SZ_WG), DM, DM, DM};
                pg8::PlainOrder S; S.init(M_TOK / 256, NG / 256, G, bx);
                pg8::EpiPlain<1> E{(bf16_t*)(ws + OFF_R2), NG};
                pg8::gemm_phase((LAS unsigned char*)lds, g, S, E);
            } else if (k == 5 && (PHEN & 64)) for (int rep = 0; rep < REP_GMO; ++rep) {
                pg8::Gemm g{(const bf16_t*)(ws + OFF_Z), (const bf16_t*)(ws + OFF_WBR + l * SZ_WBR), NZ, 512, 512};
                pg8::MergeOrder S; S.init(M_TOK / 256, DM / 256, G, bx);
                pg8::EpiMerge E{(bf16_t*)(ws + OFF_R3 + R3_MERGED), (const bf16_t*)(ws + OFF_R2)};
                pg8::gemm_phase((LAS unsigned char*)lds, g, S, E);
            } else if (k == 6 && (PHEN & 128)) for (int rep = 0; rep < REP_GMO; ++rep) {
                pg8::Gemm g{(const bf16_t*)(ws + OFF_R3 + R3_MERGED), (const bf16_t*)(ws + OFF_WOUT + l * SZ_WOUT), DM, DM, DM};
                pg8::PlainOrder S; S.init(M_TOK / 256, DM / 256, G, bx);
                pg8::EpiPlain<0> E{(bf16_t*)(ws + OFF_R3 + R3_Y), DM};
                pg8::gemm_phase((LAS unsigned char*)lds, g, S, E);
            } else if (k == 7 && (PHEN & 256)) {
                phase_final(p, l);
            }
        }
#if PROBE_SCAN
        if (ph == N_PHASES - 1 && bx == 0 && threadIdx.x == 0) { const unsigned cd = *(volatile unsigned*)(ws + WS_END + 5 * MiB); p.out[5] = 1000.f * (float)cd; }
        if (ph == 0 && bx == 0 && threadIdx.x == 0) *(unsigned*)(ws + WS_END + 5 * MiB) = 0u;
#endif
#if TS_K >= 0
        if (ph == N_PHASES - 1 && bx == 0 && threadIdx.x == 0) { unsigned long long* ts = (unsigned long long*)(ws + WS_END + 32768); const unsigned long long tend = __builtin_amdgcn_s_memrealtime(); unsigned long long sum = 0;
            if (TS_K < 8) { for (int l2 = 0; l2 < NL; ++l2) { const int a = PH_PRE + l2 * PH_PER_LAYER + TS_K; sum += ((a + 1 < N_PHASES) ? ts[a + 1] : tend) - ts[a]; } }
            else sum = ts[PH_PRE] - ts[0];
            p.out[5] = 10.f * (float)sum; }
#endif
        if (ph + 1 < p0.ph_hi) {
            if (ph == p0.ph_lo) {
                if (bx == 0) { const int tz = tid_l(); if (tz < 64) __hip_atomic_store((unsigned*)(ptr_l(p0.ws) + WS_END + 16384) + tz, 0u, __ATOMIC_RELAXED, __HIP_MEMORY_SCOPE_AGENT); }
                if (bx == 0) { unsigned* zb = (unsigned*)ptr_l(p0.ws + WS_END); for (int i = tid_l(); i < XCD_BAR_WORDS; i += NTHREADS) __hip_atomic_store(zb + i, 0u, __ATOMIC_RELAXED, __HIP_MEMORY_SCOPE_AGENT); }
                cg::this_grid().sync();
                xbar = xcd_barrier_post((unsigned*)ptr_l(p0.ws + WS_END), xb_st);
            } else { XcdBarrier b2; b2.bar = (unsigned*)ptr_l(p0.ws + WS_END); b2.x = xbar.x; b2.st = xb_st; xcd_barrier(b2); }
        }
    }
}

extern "C" void kernel_launch(void* const* d_in, const int* in_sizes, int n_in, void* d_out, int out_size, void* d_ws, size_t ws_size, hipStream_t stream) {
    static int grid = 0;
    if (grid == 0) {
        if (n_in != 31 || out_size != M_TOK * DM || ws_size < WS_END + 65536) { fprintf(stderr, "kernel_launch: unexpected shapes (n_in %d out %d ws %zu)\n", n_in, out_size, ws_size); grid = -1; return; }
        int dev = 0, cus = 0, per_cu = 0;
        hipGetDevice(&dev); hipDeviceGetAttribute(&cus, hipDeviceAttributeMultiprocessorCount, dev);
        hipFuncSetAttribute((const void*)trunk_fwd, hipFuncAttributeMaxDynamicSharedMemorySize, LDS_BYTES);
        hipOccupancyMaxActiveBlocksPerMultiprocessor(&per_cu, (const void*)trunk_fwd, NTHREADS, LDS_BYTES);
        if (per_cu < 1) { fprintf(stderr, "kernel_launch: occupancy query says %d blocks per CU\n", per_cu); grid = -1; return; }
        grid = cus * 1;
    }
    if (grid < 0) return;
    Params p{};
    p.x = (const float*)d_in[0]; p.c = (const float*)d_in[1]; p.pos = (const int*)d_in[2]; p.pre_g = (const float*)d_in[3]; p.post_g = (const float*)d_in[4];
    p.w_ada = (const float*)d_in[5]; p.b_ada = (const float*)d_in[6]; p.w_in = (const float*)d_in[7]; p.q_norm = (const float*)d_in[8]; p.w_uq = (const float*)d_in[9];
    p.kv_norm = (const float*)d_in[10]; p.w_ukv = (const float*)d_in[11]; p.ln_g = (const float*)d_in[12]; p.ln_b = (const float*)d_in[13]; p.w_s = (const float*)d_in[14]; p.b_s = (const float*)d_in[15];
    p.mu = (const float*)d_in[16]; p.w0 = (const float*)d_in[17]; p.w2 = (const float*)d_in[18]; p.a0 = (const float*)d_in[19]; p.a2 = (const float*)d_in[20]; p.k_k = (const float*)d_in[21];
    p.k_a = (const float*)d_in[22]; p.r_k = (const float*)d_in[23]; p.lnx_g = (const float*)d_in[24]; p.lnx_b = (const float*)d_in[25]; p.v0 = (const float*)d_in[26]; p.v1 = (const float*)d_in[27];
    p.v2 = (const float*)d_in[28]; p.w_br = (const float*)d_in[29]; p.w_out = (const float*)d_in[30];
    p.out = (float*)d_out; p.ws = (unsigned char*)d_ws;
#if ONE_LAUNCH
    p.ph_lo = 0; p.ph_hi = N_PHASES;
    void* args[] = {&p};
    hipError_t e = hipLaunchCooperativeKernel((const void*)trunk_fwd, dim3(grid), dim3(NTHREADS), args, LDS_BYTES, stream);
    if (e != hipSuccess) fprintf(stderr, "cooperative launch failed: %s (grid %d)\n", hipGetErrorString(e), grid);
#else
    for (int ph = 0; ph < N_PHASES; ++ph) { p.ph_lo = ph; p.ph_hi = ph + 1;
        hipLaunchKernelGGL(trunk_fwd, dim3(grid), dim3(NTHREADS), LDS_BYTES, stream, p); }
#endif
}
```

```cpp
#include <hip/hip_runtime.h>
#include <hip/hip_cooperative_groups.h>
#include <cstdint>
#include <cstdio>
namespace cg = cooperative_groups;

#ifndef PHEN
#define PHEN 0x7fff
#endif
#ifndef TS_K
#define TS_K -1
#endif
#ifndef REP_P0
#define REP_P0 1
#endif
#ifndef REP_GMO
#define REP_GMO 1
#endif
#ifndef REP_GM
#define REP_GM 1
#endif
#ifndef REP_ATT
#define REP_ATT 1
#endif
#ifndef REP_IN
#define REP_IN 1
#endif
#ifndef REP_CHUNK
#define REP_CHUNK 1
#endif
#ifndef REP_MLA
#define REP_MLA 1
#endif
#ifndef REP_RW
#define REP_RW 1
#endif
#ifndef EXP_SYNC2
#define EXP_SYNC2 0
#endif
#ifndef EXP_NODOT
#define EXP_NODOT 0
#endif
#ifndef EXP_CONSTY
#define EXP_CONSTY 0
#endif
#ifndef EXP_NOW1
#define EXP_NOW1 0
#endif
#ifndef EXP_NOSTATE
#define EXP_NOSTATE 0
#endif
#ifndef EXP_ZERO
#define EXP_ZERO 0
#endif
#ifndef USE_CHUNK
#define USE_CHUNK 1
#endif
#ifndef PROBE_SCAN
#define PROBE_SCAN 0
#endif
#ifndef ONE_LAUNCH
#define ONE_LAUNCH 1
#endif

#define LAS __attribute__((address_space(3)))
typedef unsigned short bf16_t;
typedef short bf16x8 __attribute__((ext_vector_type(8)));
typedef short bf16x4 __attribute__((ext_vector_type(4)));
typedef float f32x4 __attribute__((ext_vector_type(4)));
typedef float f32x2 __attribute__((ext_vector_type(2)));
typedef unsigned u32x4 __attribute__((ext_vector_type(4)));
typedef unsigned u32x2 __attribute__((ext_vector_type(2)));

constexpr int M_TOK = 16384, DM = 1024, SEQ = 4096, NBATCH = 4, NL = 4;
constexpr int D_IN_SRC = 7712;
constexpr int NP1 = 3328, NZ = 1536, NIN = 4864, NG = 3072;
constexpr int C_QLAT = 0, C_KVLAT = 256, C_KROPE = 384, C_GMU = 512, C_GMV = 1024, C_RW = 1536, C_RWR = 1536, C_RWK = 2048, C_RWV = 2560, C_WLAT = 3072, C_ALAT = 3136;
constexpr int NTHREADS = 512, NWAVES = 8;
constexpr int LDS_BYTES = 150 * 1024;
constexpr float QSCALE = 0.10206207261596575f * 1.4426950408889634f;

constexpr size_t MiB = 1u << 20;
constexpr size_t OFF_WIN = 0;
constexpr size_t SZ_WIN = (size_t)NIN * DM * 2;
constexpr size_t OFF_WG = 38 * MiB;
constexpr size_t SZ_WG = (size_t)NG * DM * 2;
constexpr size_t OFF_WBR = 62 * MiB;
constexpr size_t SZ_WBR = (size_t)3072 * 512 * 2;
constexpr size_t OFF_WOUT = 74 * MiB;
constexpr size_t SZ_WOUT = (size_t)DM * DM * 2;
constexpr size_t OFF_WUQ = 82 * MiB;
constexpr size_t SZ_WUQ = (size_t)768 * 256 * 2;
constexpr size_t OFF_WUKV = OFF_WUQ + 3 * MiB / 2;
constexpr size_t SZ_WUKV = (size_t)1024 * 128 * 2;
constexpr size_t OFF_SMALL = OFF_WUKV + 1 * MiB;
constexpr size_t OFF_W2T = OFF_SMALL;
constexpr size_t OFF_A2T = OFF_W2T + 256 * 1024;
constexpr size_t OFF_V1T = OFF_A2T + 256 * 1024;
constexpr size_t OFF_V2T = OFF_V1T + 128 * 1024;
constexpr size_t OFF_WS = OFF_V2T + 128 * 1024;
constexpr size_t OFF_MODP = OFF_WS + 512 * 1024;
constexpr size_t OFF_ROPE = OFF_MODP + 3 * MiB / 2;
constexpr size_t OFF_DOT = OFF_ROPE + 2 * MiB;
constexpr size_t OFF_MODT = OFF_DOT + MiB / 2;
constexpr size_t OFF_H = 90 * MiB;
constexpr size_t OFF_Z = 122 * MiB;
constexpr size_t OFF_VF = 170 * MiB;
constexpr size_t OFF_R1 = 186 * MiB;
constexpr size_t OFF_R2 = 298 * MiB;
constexpr size_t OFF_R3 = 410 * MiB;
constexpr size_t WS_END = 474 * MiB;
static_assert(OFF_MODT + 3 * NL * 4 * 1024 * 4 <= OFF_H, "small region");
constexpr size_t R1_GP = 0, R1_RA = 16 * MiB, R1_HT = 32 * MiB, R1_YQ = 48 * MiB, R1_PC = 64 * MiB;
constexpr size_t R2_R = 0, R2_K = 16 * MiB, R2_V = 32 * MiB, R2_KK = 48 * MiB, R2_B = 64 * MiB, R2_LW = 80 * MiB;
constexpr size_t R3_Q = 0, R3_KF = 24 * MiB, R3_VT = 48 * MiB, R3_MERGED = 0, R3_Y = 32 * MiB;

struct Params {
    const float* x; const float* c; const int* pos; const float* pre_g; const float* post_g; const float* w_ada; const float* b_ada; const float* w_in;
    const float* q_norm; const float* w_uq; const float* kv_norm; const float* w_ukv; const float* ln_g; const float* ln_b; const float* w_s; const float* b_s;
    const float* mu; const float* w0; const float* w2; const float* a0; const float* a2; const float* k_k; const float* k_a; const float* r_k;
    const float* lnx_g; const float* lnx_b; const float* v0; const float* v1; const float* v2; const float* w_br; const float* w_out;
    float* out; unsigned char* ws;
    int ph_lo, ph_hi;
};

typedef __bf16 bf16x2_t __attribute__((ext_vector_type(2)));
__device__ __forceinline__ unsigned cvt_pk_bf16(float lo, float hi) { const f32x2 v = {lo, hi}; const bf16x2_t b = __builtin_convertvector(v, bf16x2_t); return __builtin_bit_cast(unsigned, b); }
__device__ __forceinline__ float bf_lo(unsigned u) { return __uint_as_float(u << 16); }
__device__ __forceinline__ float bf_hi(unsigned u) { return __uint_as_float(u & 0xffff0000u); }
__device__ __forceinline__ float bf2f(bf16_t h) { return __uint_as_float(((unsigned)h) << 16); }
__device__ __forceinline__ bf16_t f2bf(float f) { return (bf16_t)(cvt_pk_bf16(f, 0.f) & 0xffffu); }
__device__ __forceinline__ float sigmoidf_(float x) { return 1.f / (1.f + __expf(-x)); }
__device__ __forceinline__ float siluf_(float x) { return x / (1.f + __expf(-x)); }
__device__ __forceinline__ float geluf_(float x) { return 0.5f * x * (1.f + erff(x * 0.70710678118654752f)); }
__device__ __forceinline__ f32x4 unpack4(u32x2 u) { return (f32x4){bf_lo(u.x), bf_hi(u.x), bf_lo(u.y), bf_hi(u.y)}; }
__device__ __forceinline__ u32x2 pack4(f32x4 v) { u32x2 r; r.x = cvt_pk_bf16(v[0], v[1]); r.y = cvt_pk_bf16(v[2], v[3]); return r; }
__device__ __forceinline__ float wave_sum(float v) {
#pragma unroll
    for (int o = 1; o < 64; o <<= 1) v += __shfl_xor(v, o);
    return v;
}
__device__ __forceinline__ bf16x8 ld_frag(const bf16_t* p) { return *(const bf16x8*)p; }
__device__ __forceinline__ bf16x8 pack_frag(f32x4 a, f32x4 b) {
    u32x4 u; u.x = cvt_pk_bf16(a[0], a[1]); u.y = cvt_pk_bf16(a[2], a[3]); u.z = cvt_pk_bf16(b[0], b[1]); u.w = cvt_pk_bf16(b[2], b[3]);
    return __builtin_bit_cast(bf16x8, u);
}
__device__ __forceinline__ bf16x8 join_frag(u32x2 a, u32x2 b) { u32x4 u; u.x = a.x; u.y = a.y; u.z = b.x; u.w = b.y; return __builtin_bit_cast(bf16x8, u); }
__device__ __forceinline__ int tid_l() { int t = threadIdx.x; asm volatile("" : "+v"(t)); return t; }
__device__ __forceinline__ unsigned char* ptr_l(unsigned char* q) { asm volatile("" : "+s"(q)); return q; }
#define MFMA(a, b, c) __builtin_amdgcn_mfma_f32_16x16x32_bf16((a), (b), (c), 0, 0, 0)

namespace pg8 {
constexpr int BM = 256, BK = 64, HALF = 128, HTB = HALF * BK * 2, STAGE_BYTES = 8 * HTB, NXCD = 8, WGM = 8;
__host__ __device__ __forceinline__ int lds_byte(int r, int c) { const int st = (r >> 4) * 2 + (c >> 5), rr = r & 15, cc = c & 31, ob = rr * 64 + cc * 2; return st * 1024 + (ob ^ (((ob >> 9) & 1) << 5)); }
__host__ __device__ __forceinline__ void stage_rc(int b, int& R, int& C) { const int st = b / 1024, sb = b % 1024, swz = sb ^ (((sb >> 9) & 1) << 5); R = (st >> 1) * 16 + swz / 64; C = (st & 1) * 32 + (swz % 64) / 2; }
__host__ __device__ __forceinline__ int perm32(int rho) { const int n = rho >> 4, i = rho & 15; return 8 * (i >> 2) + 4 * n + (i & 3); }

struct Unit { int pm, pn, ak, tag; };
struct Gemm { const bf16_t* A; const bf16_t* Bt; int lda, ldb, K; };

__device__ __forceinline__ void tile_of(int wgid, int nM, int nN, int& pm, int& pn) {
    const int nwg = nM * nN;
    { const int q = nwg / NXCD, r = nwg % NXCD, xcd = wgid % NXCD, off = wgid / NXCD; wgid = (xcd < r ? xcd * (q + 1) : r * (q + 1) + (xcd - r) * q) + off; }
    const int nig = WGM * nN, gid = wgid / nig, fm = gid * WGM, gsz = (nM - fm) < WGM ? (nM - fm) : WGM;
    pm = fm + ((wgid % nig) % gsz); pn = (wgid % nig) / gsz;
}
struct PlainOrder {
    int nM, nN, nwg, G, c;
    __device__ void init(int nM_, int nN_, int G_, int c_) { nM = nM_; nN = nN_; nwg = nM * nN; G = G_; c = c_; }
    __device__ bool next(int i, Unit& u) const { const long L = (long)i * G + c; if (L >= nwg) return false; tile_of((int)L, nM, nN, u.pm, u.pn); u.ak = 0; u.tag = 0; return true; }
};
struct MergeOrder {
    int nM, nN, nwg, G, c;
    __device__ void init(int nM_, int nN_, int G_, int c_) { nM = nM_; nN = nN_; nwg = nM * nN; G = G_; c = c_; }
    __device__ bool next(int i, Unit& u) const { const int ti = i / 3, n = i - 3 * ti; const long L = (long)ti * G + c; if (L >= nwg) return false;
        int pm, pc; tile_of((int)L, nM, nN, pm, pc); u.pm = pm; u.pn = n * nN + pc; u.ak = n * 512; u.tag = n; return true; }
};

template <class Epi, class Sched>
__device__ __forceinline__ void gemm_phase(LAS unsigned char* lds, const Gemm g, const Sched& S, const Epi& E) {
    const int tid = tid_l(), wid = __builtin_amdgcn_readfirstlane(tid >> 6), lane = tid & 63, wr = wid >> 2, wc = wid & 3, fr = lane & 15, fq = lane >> 4;
    const int K = g.K, nt = K / BK;
    unsigned voffA[2], voffB[2];
#pragma unroll
    for (int i = 0; i < 2; ++i) { int R, C; stage_rc(tid * 16 + i * 8192, R, C); const int Rb = (R & ~31) + perm32(R & 31);
        voffA[i] = (unsigned)(R * g.lda + C) * 2u; voffB[i] = (unsigned)(Rb * g.ldb + C) * 2u; }
    const size_t kstep = (size_t)(BK * 2);
    const size_t hstepA = (size_t)HALF * g.lda * 2, hstepB = (size_t)HALF * g.ldb * 2;
    const size_t tstepA = 2 * hstepA, tstepB = 2 * hstepB;
    const unsigned ldsw = (unsigned)wid * 1024u;
    const int aoff = lds_byte(wr * 64 + fr, fq * 8), boff = lds_byte(wc * 32 + fr, fq * 8);
#define PG8_SA(b, h) (((b) * 2 + (h)) * HTB)
#define PG8_SB(b, h) ((4 + (b) * 2 + (h)) * HTB)
#define PG8_STAGE(bufoff, gbase, voff) do { _Pragma("unroll") for (int _i = 0; _i < 2; ++_i) \
        __builtin_amdgcn_global_load_lds((const unsigned*)((const char*)(gbase) + (voff)[_i]), (LAS unsigned*)(lds + (bufoff) + ldsw + _i * 8192), 16, 0, 0); } while (0)
#define PG8_LDA(dst, b, h) do { _Pragma("unroll") for (int m = 0; m < 4; ++m) _Pragma("unroll") for (int k = 0; k < 2; ++k) dst[m][k] = *(const LAS bf16x8*)(lds + PG8_SA(b, h) + aoff + m * 2048 + k * 1024); } while (0)
#define PG8_LDB(dst, b, h) do { _Pragma("unroll") for (int n = 0; n < 2; ++n) _Pragma("unroll") for (int k = 0; k < 2; ++k) dst[n][k] = *(const LAS bf16x8*)(lds + PG8_SB(b, h) + boff + n * 2048 + k * 1024); } while (0)
#define PG8_MMA(ai, bj, At, Bt) do { __builtin_amdgcn_s_setprio(1); _Pragma("unroll") for (int m = 0; m < 4; ++m) _Pragma("unroll") for (int n = 0; n < 2; ++n) _Pragma("unroll") for (int k = 0; k < 2; ++k) \
        acc[ai][bj][m][n] = __builtin_amdgcn_mfma_f32_16x16x32_bf16(Bt[n][k], At[m][k], acc[ai][bj][m][n], 0, 0, 0); __builtin_amdgcn_s_setprio(0); } while (0)
#define PG8_WAIT_V(n) asm volatile("s_waitcnt vmcnt(" #n ")" ::: "memory")
#define PG8_WAIT_L(n) asm volatile("s_waitcnt lgkmcnt(" #n ")" ::: "memory")
#define PG8_BAR __builtin_amdgcn_s_barrier()
#define PG8_SCHED __builtin_amdgcn_sched_barrier(0)
    Unit cur, nxt; int ui = 0;
    if (!S.next(0, cur)) return;
    f32x4 acc[2][2][4][2];
#pragma unroll
    for (int a = 0; a < 2; ++a)
#pragma unroll
        for (int b = 0; b < 2; ++b)
#pragma unroll
            for (int m = 0; m < 4; ++m)
#pragma unroll
                for (int n = 0; n < 2; ++n) acc[a][b][m][n] = (f32x4){0.f, 0.f, 0.f, 0.f};
    bf16x8 At[4][2], B0[2][2], B1[2][2];
    const char* cA = (const char*)g.A + (size_t)cur.pm * tstepA + (size_t)cur.ak * 2; const char* cB = (const char*)g.Bt + (size_t)cur.pn * tstepB;
    PG8_STAGE(PG8_SB(0, 0), cB, voffB); PG8_STAGE(PG8_SB(0, 1), cB + hstepB, voffB); PG8_STAGE(PG8_SA(0, 0), cA, voffA); PG8_STAGE(PG8_SA(0, 1), cA + hstepA, voffA);
    if (wr == 1) PG8_BAR;
    PG8_WAIT_V(2); PG8_BAR;
    PG8_STAGE(PG8_SB(1, 0), cB + kstep, voffB); PG8_STAGE(PG8_SA(1, 0), cA + kstep, voffA); PG8_STAGE(PG8_SB(1, 1), cB + hstepB + kstep, voffB);
    PG8_WAIT_V(6); PG8_BAR;
    for (;;) {
        const bool has_next = S.next(ui + 1, nxt);
        const char* nA = has_next ? (const char*)g.A + (size_t)nxt.pm * tstepA + (size_t)nxt.ak * 2 : cA; const char* nB = has_next ? (const char*)g.Bt + (size_t)nxt.pn * tstepB : cB;
        for (int t = 0; t < nt; t += 2) {
            const bool last = (t == nt - 2);
            const char* a1 = cA + (size_t)(t + 1) * kstep;
            const char* a2 = last ? nA : cA + (size_t)(t + 2) * kstep; const char* b2 = last ? nB : cB + (size_t)(t + 2) * kstep;
            const char* a3 = a2 + kstep; const char* b3 = b2 + kstep;
            PG8_LDB(B0, 0, 0); PG8_LDB(B1, 0, 1); PG8_SCHED; PG8_LDA(At, 0, 0); PG8_STAGE(PG8_SA(1, 1), a1 + hstepA, voffA);
            PG8_WAIT_V(8); PG8_WAIT_L(0); PG8_BAR; PG8_MMA(0, 0, At, B0); PG8_MMA(0, 1, At, B1); PG8_BAR; PG8_SCHED;
            PG8_LDA(At, 0, 1); PG8_STAGE(PG8_SB(0, 0), b2, voffB); PG8_STAGE(PG8_SB(0, 1), b2 + hstepB, voffB); PG8_STAGE(PG8_SA(0, 0), a2, voffA);
            PG8_WAIT_V(8); PG8_WAIT_L(0); PG8_BAR; PG8_MMA(1, 0, At, B0); PG8_MMA(1, 1, At, B1); PG8_BAR; PG8_SCHED;
            PG8_LDB(B0, 1, 0); PG8_LDB(B1, 1, 1); PG8_SCHED; PG8_LDA(At, 1, 0); PG8_STAGE(PG8_SA(0, 1), a2 + hstepA, voffA);
            PG8_WAIT_V(8); PG8_WAIT_L(0); PG8_BAR; PG8_MMA(0, 0, At, B0); PG8_MMA(0, 1, At, B1); PG8_BAR; PG8_SCHED;
            PG8_LDA(At, 1, 1); PG8_STAGE(PG8_SB(1, 0), b3, voffB); PG8_STAGE(PG8_SB(1, 1), b3 + hstepB, voffB); PG8_STAGE(PG8_SA(1, 0), a3, voffA);
            PG8_WAIT_V(8); PG8_WAIT_L(0); PG8_BAR; PG8_MMA(1, 0, At, B0); PG8_MMA(1, 1, At, B1); PG8_BAR; PG8_SCHED;
        }
        if (wr == 0) PG8_BAR;
        E(acc, cur, wr, wc, fr, fq);
        if (!has_next) break;
#pragma unroll
        for (int a = 0; a < 2; ++a)
#pragma unroll
            for (int b = 0; b < 2; ++b)
#pragma unroll
                for (int m = 0; m < 4; ++m)
#pragma unroll
                    for (int n = 0; n < 2; ++n) acc[a][b][m][n] = (f32x4){0.f, 0.f, 0.f, 0.f};
        cur = nxt; cA = nA; cB = nB; ++ui;
        if (wr == 1) PG8_BAR;
    }
    PG8_WAIT_V(0);
    PG8_BAR;
#undef PG8_SA
#undef PG8_SB
#undef PG8_STAGE
#undef PG8_LDA
#undef PG8_LDB
#undef PG8_MMA
#undef PG8_WAIT_V
#undef PG8_WAIT_L
#undef PG8_BAR
#undef PG8_SCHED
}

struct EpiIn {
    bf16_t* P1; bf16_t* Z;
    __device__ __forceinline__ void operator()(const f32x4 (&acc)[2][2][4][2], const Unit& u, int wr, int wc, int fr, int fq) const {
        bf16_t* base; int ld, colt;
        if (u.pn < 13) { base = P1; ld = NP1; colt = u.pn * BM; } else { base = Z; ld = NZ; colt = (u.pn - 13) * BM; }
        const int row0 = u.pm * BM + wr * 64 + fr, col0 = colt + wc * 32 + 8 * fq;
#pragma unroll
        for (int ai = 0; ai < 2; ++ai)
#pragma unroll
            for (int m = 0; m < 4; ++m) { bf16_t* rowp = base + (size_t)(row0 + ai * HALF + m * 16) * ld + col0;
#pragma unroll
                for (int bj = 0; bj < 2; ++bj) { const f32x4 v0 = acc[ai][bj][m][0], v1 = acc[ai][bj][m][1];
                    u32x4 w; w.x = cvt_pk_bf16(v0[0], v0[1]); w.y = cvt_pk_bf16(v0[2], v0[3]); w.z = cvt_pk_bf16(v1[0], v1[1]); w.w = cvt_pk_bf16(v1[2], v1[3]);
                    *(u32x4*)(rowp + bj * HALF) = w; } }
    }
};
template <int ACT> struct EpiPlain {
    bf16_t* O; int ld;
    __device__ __forceinline__ void operator()(const f32x4 (&acc)[2][2][4][2], const Unit& u, int wr, int wc, int fr, int fq) const {
        const int row0 = u.pm * BM + wr * 64 + fr, col0 = u.pn * BM + wc * 32 + 8 * fq;
#pragma unroll
        for (int ai = 0; ai < 2; ++ai)
#pragma unroll
            for (int m = 0; m < 4; ++m) { bf16_t* rowp = O + (size_t)(row0 + ai * HALF + m * 16) * ld + col0;
#pragma unroll
                for (int bj = 0; bj < 2; ++bj) { f32x4 v0 = acc[ai][bj][m][0], v1 = acc[ai][bj][m][1];
                    if (ACT == 1) {
#pragma unroll
                        for (int e = 0; e < 4; ++e) { v0[e] = sigmoidf_(v0[e]); v1[e] = sigmoidf_(v1[e]); } }
                    u32x4 w; w.x = cvt_pk_bf16(v0[0], v0[1]); w.y = cvt_pk_bf16(v0[2], v0[3]); w.z = cvt_pk_bf16(v1[0], v1[1]); w.w = cvt_pk_bf16(v1[2], v1[3]);
                    *(u32x4*)(rowp + bj * HALF) = w; } }
    }
};
struct EpiMerge {
    bf16_t* Mg; const bf16_t* G;
    __device__ __forceinline__ void operator()(const f32x4 (&acc)[2][2][4][2], const Unit& u, int wr, int wc, int fr, int fq) const {
        const int n = u.tag, pc = u.pn - 4 * n;
        const int row0 = u.pm * BM + wr * 64 + fr, col0 = pc * BM + wc * 32 + 8 * fq;
#pragma unroll
        for (int ai = 0; ai < 2; ++ai)
#pragma unroll
            for (int m = 0; m < 4; ++m) { const size_t row = (size_t)(row0 + ai * HALF + m * 16);
#pragma unroll
                for (int bj = 0; bj < 2; ++bj) { const f32x4 v0 = acc[ai][bj][m][0], v1 = acc[ai][bj][m][1];
                    const u32x4 gt = *(const u32x4*)(G + row * NG + n * 1024 + col0 + bj * HALF);
                    bf16_t* mp = Mg + row * DM + col0 + bj * HALF;
                    float o[8];
                    o[0] = bf_lo(gt.x) * v0[0]; o[1] = bf_hi(gt.x) * v0[1]; o[2] = bf_lo(gt.y) * v0[2]; o[3] = bf_hi(gt.y) * v0[3];
                    o[4] = bf_lo(gt.z) * v1[0]; o[5] = bf_hi(gt.z) * v1[1]; o[6] = bf_lo(gt.w) * v1[2]; o[7] = bf_hi(gt.w) * v1[3];
                    if (n > 0) { const u32x4 pv = *(const u32x4*)mp;
                        o[0] += bf_lo(pv.x); o[1] += bf_hi(pv.x); o[2] += bf_lo(pv.y); o[3] += bf_hi(pv.y); o[4] += bf_lo(pv.z); o[5] += bf_hi(pv.z); o[6] += bf_lo(pv.w); o[7] += bf_hi(pv.w); }
                    u32x4 w; w.x = cvt_pk_bf16(o[0], o[1]); w.y = cvt_pk_bf16(o[2], o[3]); w.z = cvt_pk_bf16(o[4], o[5]); w.w = cvt_pk_bf16(o[6], o[7]);
                    *(u32x4*)mp = w; } }
    }
};
}

__device__ __forceinline__ void tr_item(const float* W, int lds_, int k0, int n0s, bf16_t* WT, int ldd, int n0d, int kd0, const float* ksc, float* scr, int lane) {
#pragma unroll
    for (int i = 0; i < 8; ++i) { const int kk = 8 * i + (lane >> 3), n4 = (lane & 7) * 4;
        f32x4 v = (f32x4){0.f, 0.f, 0.f, 0.f}; if (n0s >= 0) { v = *(const f32x4*)(W + (size_t)(k0 + kk) * lds_ + n0s + n4); if (ksc) v = v * ksc[k0 + kk]; }
        float* d = scr + kk * 33 + n4; d[0] = v[0]; d[1] = v[1]; d[2] = v[2]; d[3] = v[3]; }
    asm volatile("s_waitcnt lgkmcnt(0)" ::: "memory");
    const int c = lane & 7;
#pragma unroll
    for (int j = 0; j < 4; ++j) { const int n = (lane >> 3) + 8 * j; const float* s = scr + (8 * c) * 33 + n;
        u32x4 o; o.x = cvt_pk_bf16(s[0 * 33], s[1 * 33]); o.y = cvt_pk_bf16(s[2 * 33], s[3 * 33]); o.z = cvt_pk_bf16(s[4 * 33], s[5 * 33]); o.w = cvt_pk_bf16(s[6 * 33], s[7 * 33]);
        *(u32x4*)(WT + (size_t)(n0d + n) * ldd + kd0 + 8 * c) = o; }
    asm volatile("s_waitcnt lgkmcnt(0)" ::: "memory");
}

__device__ __forceinline__ void phase0a(const Params& p, unsigned char* lds) {
    const int tid = tid_l(), lane = tid & 63, wave = tid >> 6, G = gridDim.x;
    const int gw = blockIdx.x * NWAVES + wave, NGW = G * NWAVES;
    unsigned char* ws = p.ws;
    float* scr = (float*)(lds + wave * 16384);
    constexpr int I_WIN = 152 * 16, I_WG = 96 * 16, I_WBR = 3 * 32 * 8, I_WOUT = 32 * 16, I_WUQ = 24 * 4, I_WUKV = 32 * 2, I_W2 = 16, I_A2 = 16, I_V1 = 8;
    constexpr int I_L = I_WIN + I_WG + I_WBR + I_WOUT + I_WUQ + I_WUKV + I_W2 + I_A2 + I_V1;
    for (int it = gw; it < NL * I_L; it += NGW) {
        const int l = it / I_L; int r = it - l * I_L;
        if (r < I_WIN) { const int nb = r >> 4, kb = r & 15; const int nd = nb * 32;
            int ns; if (nd < 416) ns = nd; else if (nd < 512) ns = -1; else if (nd < 3200) ns = nd - 96; else if (nd < 3328) ns = -1; else ns = nd - 224;
            tr_item(p.w_in + (size_t)l * DM * D_IN_SRC, D_IN_SRC, kb * 64, ns, (bf16_t*)(ws + OFF_WIN + l * SZ_WIN), DM, nd, kb * 64, nullptr, scr, lane); continue; }
        r -= I_WIN;
        if (r < I_WG) { const int nb = r >> 4, kb = r & 15;
            tr_item(p.w_in + (size_t)l * DM * D_IN_SRC, D_IN_SRC, kb * 64, 4640 + nb * 32, (bf16_t*)(ws + OFF_WG + l * SZ_WG), DM, nb * 32, kb * 64, nullptr, scr, lane); continue; }
        r -= I_WG;
        if (r < I_WBR) { const int n = r / 256, r2 = r - n * 256, nb = r2 >> 3, kb = r2 & 7;
            tr_item(p.w_br + ((size_t)(l * 3 + n) * 512) * DM, DM, kb * 64, nb * 32, (bf16_t*)(ws + OFF_WBR + l * SZ_WBR), 512, n * 1024 + nb * 32, kb * 64, nullptr, scr, lane); continue; }
        r -= I_WBR;
        if (r < I_WOUT) { const int nb = r >> 4, kb = r & 15;
            tr_item(p.w_out + (size_t)l * DM * DM, DM, kb * 64, nb * 32, (bf16_t*)(ws + OFF_WOUT + l * SZ_WOUT), DM, nb * 32, kb * 64, nullptr, scr, lane); continue; }
        r -= I_WOUT;
        if (r < I_WUQ) { const int nb = r >> 2, kb = r & 3;
            tr_item(p.w_uq + (size_t)l * 256 * 768, 768, kb * 64, nb * 32, (bf16_t*)(ws + OFF_WUQ + l * SZ_WUQ), 256, nb * 32, kb * 64, p.q_norm + l * 256, scr, lane); continue; }
        r -= I_WUQ;
        if (r < I_WUKV) { const int nb = r >> 1, kb = r & 1;
            tr_item(p.w_ukv + (size_t)l * 128 * 1024, 1024, kb * 64, nb * 32, (bf16_t*)(ws + OFF_WUKV + l * SZ_WUKV), 128, nb * 32, kb * 64, p.kv_norm + l * 128, scr, lane); continue; }
        r -= I_WUKV;
        if (r < I_W2) { tr_item(p.w2 + (size_t)l * 64 * 512, 512, 0, r * 32, (bf16_t*)(ws + OFF_W2T) + (size_t)l * 512 * 64, 64, r * 32, 0, nullptr, scr, lane); continue; }
        r -= I_W2;
        if (r < I_A2) { tr_item(p.a2 + (size_t)l * 64 * 512, 512, 0, r * 32, (bf16_t*)(ws + OFF_A2T) + (size_t)l * 512 * 64, 64, r * 32, 0, nullptr, scr, lane); continue; }
        r -= I_A2;
        if (l >= 1) tr_item(p.v1 + (size_t)(l - 1) * 512 * 32, 32, r * 64, 0, (bf16_t*)(ws + OFF_V1T) + (size_t)(l - 1) * 32 * 512, 512, 0, r * 64, nullptr, scr, lane);
    }
    for (int it = gw; it < NL * 12 * 8; it += NGW) {
        const int l = it / 96, r = it - l * 96, nb = r >> 3, ks = r & 7, n = nb * 256 + lane * 4;
        f32x4 a0 = (f32x4){0.f, 0.f, 0.f, 0.f}, a1 = a0, a2 = a0, a3 = a0;
        const float* w = p.w_ada + (size_t)l * DM * 3072 + n;
#pragma unroll 8
        for (int k = ks * 128; k < ks * 128 + 128; ++k) { const f32x4 wv = *(const f32x4*)(w + (size_t)k * 3072);
            a0 += wv * siluf_(p.c[k]); a1 += wv * siluf_(p.c[DM + k]); a2 += wv * siluf_(p.c[2 * DM + k]); a3 += wv * siluf_(p.c[3 * DM + k]); }
        float* mp = (float*)(ws + OFF_MODP) + ((size_t)(l * 8 + ks) * 4) * 3072 + n;
        *(f32x4*)mp = a0; *(f32x4*)(mp + 3072) = a1; *(f32x4*)(mp + 2 * 3072) = a2; *(f32x4*)(mp + 3 * 3072) = a3;
    }
    const size_t gt = (size_t)blockIdx.x * NTHREADS + tid, GT = (size_t)G * NTHREADS;
    for (size_t i = gt; i < (size_t)3 * 512 * 32; i += GT) { const int l1 = (int)(i / (512 * 32)), r = (int)(i % (512 * 32)), c = r >> 5, k = r & 31;
        ((bf16_t*)(ws + OFF_V2T))[i] = f2bf(p.v2[(size_t)l1 * 32 * 512 + k * 512 + c]); }
    for (size_t i = gt; i < (size_t)NL * 4 * 128 * 128; i += GT) { const int s = (int)(i & 127), t = (int)((i >> 7) & 127);
        ((bf16_t*)(ws + OFF_WS))[i] = f2bf(((s >> 6) <= (t >> 6)) ? p.w_s[i] : 0.f); }
    for (size_t i = gt; i < (size_t)M_TOK * 16; i += GT) { const int t = (int)(i >> 4), k = (int)(i & 15);
        const float inv = powf(10000.f, -(float)(2 * k) / 32.f); const float ang = (float)p.pos[t] * inv;
        ((float*)(ws + OFF_ROPE))[i] = cosf(ang); ((float*)(ws + OFF_ROPE))[(size_t)M_TOK * 16 + i] = sinf(ang); }
    for (size_t i = gt; i < (size_t)M_TOK * DM / 4; i += GT) ((f32x4*)p.out)[i] = ((const f32x4*)p.x)[i];
}

__device__ __forceinline__ f32x4 mod4(const Params& p, int l, int b, int kind, int col) {
    const float* mp = (const float*)(p.ws + OFF_MODP) + ((size_t)(l * 8) * 4 + b) * 3072 + kind * DM + col;
    f32x4 s = *(const f32x4*)(p.b_ada + (size_t)l * 3072 + kind * DM + col);
#pragma unroll
    for (int ks = 0; ks < 8; ++ks) s += *(const f32x4*)(mp + (size_t)ks * 4 * 3072);
    return s;
}
__device__ __forceinline__ void phase_modt(const Params& p) {
    float* T = (float*)(p.ws + OFF_MODT);
    for (int i = blockIdx.x * NTHREADS + tid_l(); i < NL * 4 * 256; i += gridDim.x * NTHREADS) { const int l = i / 1024, r = i - l * 1024, b = r >> 8, col = (r & 255) * 4;
        const f32x4 sh = mod4(p, l, b, 0, col), sc = mod4(p, l, b, 1, col), gt = mod4(p, l, b, 2, col);
        const f32x4 g = *(const f32x4*)(p.pre_g + (size_t)l * DM + col), pg = *(const f32x4*)(p.post_g + (size_t)l * DM + col);
        const size_t o = ((size_t)(l * 4 + b)) * 1024 + col;
        *(f32x4*)(T + o) = g * (sc + 1.f); *(f32x4*)(T + (size_t)NL * 4096 + o) = sh; *(f32x4*)(T + (size_t)2 * NL * 4096 + o) = gt * pg; }
}
__device__ __forceinline__ void normmod_row(const Params& p, int l, int row, const f32x4 (&v)[4], int lane) {
    float ss = 0.f;
#pragma unroll
    for (int j = 0; j < 4; ++j) ss += v[j][0] * v[j][0] + v[j][1] * v[j][1] + v[j][2] * v[j][2] + v[j][3] * v[j][3];
    const float rstd = rsqrtf(wave_sum(ss) * (1.f / DM) + 1e-6f);
    const int b = row / SEQ;
    const float* T = (const float*)(p.ws + OFF_MODT) + ((size_t)(l * 4 + b)) * 1024;
    bf16_t* hrow = (bf16_t*)(p.ws + OFF_H) + (size_t)row * DM;
#pragma unroll
    for (int j = 0; j < 4; ++j) { const int col = 4 * lane + 256 * j;
        const f32x4 a = *(const f32x4*)(T + col), sh = *(const f32x4*)(T + (size_t)NL * 4096 + col);
        f32x4 o = v[j] * rstd * a + sh;
        *(u32x2*)(hrow + col) = pack4(o); }
}
__device__ __forceinline__ void phase0b(const Params& p) {
    const int tidq = tid_l(); const int lane = tidq & 63, gw = blockIdx.x * NWAVES + (tidq >> 6), NGW = gridDim.x * NWAVES;
    for (int row = gw; row < M_TOK; row += NGW) { f32x4 v[4];
#pragma unroll
        for (int j = 0; j < 4; ++j) v[j] = *(const f32x4*)(p.out + (size_t)row * DM + 4 * lane + 256 * j);
        normmod_row(p, 0, row, v, lane); }
}
__device__ __forceinline__ void phase_final(const Params& p, int l) {
    const int tidq = tid_l(); const int lane = tidq & 63, gw = blockIdx.x * NWAVES + (tidq >> 6), NGW = gridDim.x * NWAVES;
    const bf16_t* Y = (const bf16_t*)(p.ws + OFF_R3 + R3_Y);
    for (int row = gw; row < M_TOK; row += NGW) {
        f32x4 y[4]; float ss = 0.f;
#pragma unroll
        for (int j = 0; j < 4; ++j) { y[j] = unpack4(*(const u32x2*)(Y + (size_t)row * DM + 4 * lane + 256 * j)); ss += y[j][0] * y[j][0] + y[j][1] * y[j][1] + y[j][2] * y[j][2] + y[j][3] * y[j][3]; }
        const float rstd = rsqrtf(wave_sum(ss) * (1.f / DM) + 1e-6f);
        const int b = row / SEQ; f32x4 v[4];
        const float* GG = (const float*)(p.ws + OFF_MODT) + (size_t)2 * NL * 4096 + ((size_t)(l * 4 + b)) * 1024;
#pragma unroll
        for (int j = 0; j < 4; ++j) { const int col = 4 * lane + 256 * j;
            const f32x4 xg = *(const f32x4*)(p.out + (size_t)row * DM + col), gg = *(const f32x4*)(GG + col);
            v[j] = xg + gg * (y[j] * rstd);
            *(f32x4*)(p.out + (size_t)row * DM + col) = v[j]; }
        if (l + 1 < NL) normmod_row(p, l + 1, row, v, lane);
    }
}

__device__ __forceinline__ void mla_prep_item(const Params& p, int l, int item, unsigned char* lds) {
    const int tid = tid_l(), lane = tid & 63, wave = tid >> 6, fr = lane & 15, fq = lane >> 4;
    const int t0 = item * 64;
    const bf16_t* P1 = (const bf16_t*)(p.ws + OFF_R1);
    bf16_t* Q = (bf16_t*)(p.ws + OFF_R3 + R3_Q); bf16_t* Kf = (bf16_t*)(p.ws + OFF_R3 + R3_KF); bf16_t* Vt = (bf16_t*)(p.ws + OFF_R3 + R3_VT);
    const bf16_t* Wuq = (const bf16_t*)(p.ws + OFF_WUQ + l * SZ_WUQ); const bf16_t* Wukv = (const bf16_t*)(p.ws + OFF_WUKV + l * SZ_WUKV);
    const float* COS = (const float*)(p.ws + OFF_ROPE); const float* SIN = COS + (size_t)M_TOK * 16;
    float* rq = (float*)lds; float* rkv = rq + 64;
    __syncthreads();
    { const int row = tid >> 3, part = tid & 7; const bf16_t* pr = P1 + (size_t)(t0 + row) * NP1;
        float sq = 0.f, sk = 0.f;
#pragma unroll
        for (int i = 0; i < 4; ++i) { const u32x4 u = *(const u32x4*)(pr + C_QLAT + part * 32 + i * 8);
            sq += bf_lo(u.x) * bf_lo(u.x) + bf_hi(u.x) * bf_hi(u.x) + bf_lo(u.y) * bf_lo(u.y) + bf_hi(u.y) * bf_hi(u.y) + bf_lo(u.z) * bf_lo(u.z) + bf_hi(u.z) * bf_hi(u.z) + bf_lo(u.w) * bf_lo(u.w) + bf_hi(u.w) * bf_hi(u.w); }
#pragma unroll
        for (int i = 0; i < 2; ++i) { const u32x4 u = *(const u32x4*)(pr + C_KVLAT + part * 16 + i * 8);
            sk += bf_lo(u.x) * bf_lo(u.x) + bf_hi(u.x) * bf_hi(u.x) + bf_lo(u.y) * bf_lo(u.y) + bf_hi(u.y) * bf_hi(u.y) + bf_lo(u.z) * bf_lo(u.z) + bf_hi(u.z) * bf_hi(u.z) + bf_lo(u.w) * bf_lo(u.w) + bf_hi(u.w) * bf_hi(u.w); }
        sq += __shfl_xor(sq, 1); sq += __shfl_xor(sq, 2); sq += __shfl_xor(sq, 4);
        sk += __shfl_xor(sk, 1); sk += __shfl_xor(sk, 2); sk += __shfl_xor(sk, 4);
        if (part == 0) { rq[row] = rsqrtf(sq * (1.f / 256.f) + 1e-6f); rkv[row] = rsqrtf(sk * (1.f / 128.f) + 1e-6f); }
        const int i2 = part * 2; const int t = t0 + row;
        const unsigned u1 = *(const unsigned*)(pr + C_KROPE + i2), u2 = *(const unsigned*)(pr + C_KROPE + 16 + i2);
        const float c0 = COS[(size_t)t * 16 + i2], c1 = COS[(size_t)t * 16 + i2 + 1], s0 = SIN[(size_t)t * 16 + i2], s1 = SIN[(size_t)t * 16 + i2 + 1];
        const float x10 = bf_lo(u1), x11 = bf_hi(u1), x20 = bf_lo(u2), x21 = bf_hi(u2);
        const unsigned o1 = cvt_pk_bf16(x10 * c0 - x20 * s0, x11 * c1 - x21 * s1), o2 = cvt_pk_bf16(x20 * c0 + x10 * s0, x21 * c1 + x11 * s1);
#pragma unroll
        for (int h = 0; h < 8; ++h) { *(unsigned*)(Kf + (size_t)t * 768 + h * 96 + 64 + i2) = o1; *(unsigned*)(Kf + (size_t)t * 768 + h * 96 + 80 + i2) = o2; }
    }
    __syncthreads();
    { const int head = wave;
        f32x4 acc[4][6];
#pragma unroll
        for (int rt = 0; rt < 4; ++rt)
#pragma unroll
            for (int ct = 0; ct < 6; ++ct) acc[rt][ct] = (f32x4){0.f, 0.f, 0.f, 0.f};
        const bf16_t* wp = Wuq + (size_t)(head * 96 + fr) * 256 + fq * 8;
#pragma unroll 1
        for (int hf = 0; hf < 2; ++hf) { bf16x8 wf[6][4];
#pragma unroll
            for (int k4 = 0; k4 < 4; ++k4)
#pragma unroll
                for (int ct = 0; ct < 6; ++ct) wf[ct][k4] = ld_frag(wp + (size_t)ct * 16 * 256 + (hf * 4 + k4) * 32);
#pragma unroll
            for (int rt = 0; rt < 4; ++rt) { const bf16_t* ap = P1 + (size_t)(t0 + rt * 16 + fr) * NP1 + C_QLAT + fq * 8 + hf * 128; bf16x8 af[4];
#pragma unroll
                for (int k4 = 0; k4 < 4; ++k4) af[k4] = ld_frag(ap + k4 * 32);
#pragma unroll
                for (int k4 = 0; k4 < 4; ++k4)
#pragma unroll
                    for (int ct = 0; ct < 6; ++ct) acc[rt][ct] = MFMA(wf[ct][k4], af[k4], acc[rt][ct]); } }
#pragma unroll
        for (int rt = 0; rt < 4; ++rt) {
            const int t = t0 + rt * 16 + fr; const float rs = rq[rt * 16 + fr] * QSCALE;
            bf16_t* qp = Q + (size_t)t * 768 + head * 96 + fq * 4;
#pragma unroll
            for (int ct = 0; ct < 4; ++ct) *(u32x2*)(qp + ct * 16) = pack4(acc[rt][ct] * rs);
            const f32x4 cs = *(const f32x4*)(COS + (size_t)t * 16 + fq * 4), sn = *(const f32x4*)(SIN + (size_t)t * 16 + fq * 4);
            const f32x4 x1 = acc[rt][4] * rs, x2 = acc[rt][5] * rs;
            *(u32x2*)(qp + 64) = pack4(x1 * cs - x2 * sn); *(u32x2*)(qp + 80) = pack4(x2 * cs + x1 * sn); }
    }
    { const int head = wave; const int b = t0 / SEQ;
        const bf16_t* wp = Wukv + (size_t)(head * 128 + fr) * 128 + fq * 8;
#pragma unroll 1
        for (int part = 0; part < 2; ++part) {
            bf16x8 wf[4][4]; f32x4 ac[4][4];
#pragma unroll
            for (int ks = 0; ks < 4; ++ks)
#pragma unroll
                for (int ct = 0; ct < 4; ++ct) wf[ct][ks] = ld_frag(wp + (size_t)(part * 64 + ct * 16) * 128 + ks * 32);
#pragma unroll
            for (int rt = 0; rt < 4; ++rt) { const bf16_t* ap = P1 + (size_t)(t0 + rt * 16 + fr) * NP1 + C_KVLAT + fq * 8; bf16x8 af[4];
#pragma unroll
                for (int ks = 0; ks < 4; ++ks) af[ks] = ld_frag(ap + ks * 32);
#pragma unroll
                for (int ct = 0; ct < 4; ++ct) { ac[rt][ct] = (f32x4){0.f, 0.f, 0.f, 0.f};
#pragma unroll
                    for (int ks = 0; ks < 4; ++ks) ac[rt][ct] = part ? MFMA(af[ks], wf[ct][ks], ac[rt][ct]) : MFMA(wf[ct][ks], af[ks], ac[rt][ct]); } }
#pragma unroll
            for (int rt = 0; rt < 4; ++rt) {
                if (part == 0) { const int t = t0 + rt * 16 + fr; const float rs = rkv[rt * 16 + fr];
#pragma unroll
                    for (int ct = 0; ct < 4; ++ct) *(u32x2*)(Kf + (size_t)t * 768 + head * 96 + ct * 16 + fq * 4) = pack4(ac[rt][ct] * rs); }
                else { const f32x4 rv = *(const f32x4*)(rkv + rt * 16 + fq * 4); const int s0 = (t0 % SEQ) + rt * 16 + fq * 4;
#pragma unroll
                    for (int ct = 0; ct < 4; ++ct) *(u32x2*)(Vt + ((size_t)(b * 8 + head) * 64 + ct * 16 + fr) * SEQ + s0) = pack4(ac[rt][ct] * rv); } }
        }
    }
}

__device__ __forceinline__ void gmlp_item(const Params& p, int l, int item, unsigned char* lds, bool do_store = true) {
    const int tid = tid_l(), lane = tid & 63, wave = tid >> 6, fr = lane & 15, fq = lane >> 4;
    const int t0 = item * 128;
    const bf16_t* P1 = (const bf16_t*)(p.ws + OFF_R1); bf16_t* Z = (bf16_t*)(p.ws + OFF_Z);
    const bf16_t* Ws = (const bf16_t*)(p.ws + OFF_WS) + (size_t)l * 4 * 128 * 128;
    bf16_t* vb = (bf16_t*)lds;
    constexpr int VS = 520;
    __syncthreads();
    { const int tok = tid >> 2, qd = tid & 3; const bf16_t* pr = P1 + (size_t)(t0 + tok) * NP1 + C_GMV + qd * 128;
        float s = 0.f, s2 = 0.f;
#pragma unroll 4
        for (int i = 0; i < 16; ++i) { const u32x4 u = *(const u32x4*)(pr + i * 8); const unsigned uu[4] = {u.x, u.y, u.z, u.w};
#pragma unroll
            for (int e = 0; e < 4; ++e) { const float a = geluf_(bf_lo(uu[e])), b = geluf_(bf_hi(uu[e])); s += a + b; s2 += a * a + b * b; } }
        s += __shfl_xor(s, 1); s += __shfl_xor(s, 2); s2 += __shfl_xor(s2, 1); s2 += __shfl_xor(s2, 2);
        const float mean = s * (1.f / 512.f), var = fmaxf(s2 * (1.f / 512.f) - mean * mean, 0.f), rstd = rsqrtf(var + 1e-5f);
        const float* lg = p.ln_g + (size_t)l * 512 + qd * 128; const float* lb = p.ln_b + (size_t)l * 512 + qd * 128;
#pragma unroll 4
        for (int i = 0; i < 16; ++i) { const u32x4 u = *(const u32x4*)(pr + i * 8); const unsigned uu[4] = {u.x, u.y, u.z, u.w}; unsigned oo[4];
#pragma unroll
            for (int e = 0; e < 4; ++e) { const float a = (geluf_(bf_lo(uu[e])) - mean) * rstd * lg[i * 8 + 2 * e] + lb[i * 8 + 2 * e], b = (geluf_(bf_hi(uu[e])) - mean) * rstd * lg[i * 8 + 2 * e + 1] + lb[i * 8 + 2 * e + 1];
                oo[e] = cvt_pk_bf16(a, b); }
            *(u32x4*)(vb + (size_t)tok * VS + qd * 128 + i * 8) = (u32x4){oo[0], oo[1], oo[2], oo[3]}; }
    }
    __syncthreads();
#pragma unroll 1
    for (int g = 0; g < 4; ++g) {
        const int cbase = g * 128 + wave * 16;
        bf16x8 vfr[4];
#pragma unroll
        for (int ks = 0; ks < 4; ++ks) { bf16x8 f;
#pragma unroll
            for (int j = 0; j < 8; ++j) f[j] = (short)vb[(size_t)(ks * 32 + fq * 8 + j) * VS + cbase + fr];
            vfr[ks] = f; }
        const bf16_t* wg = Ws + (size_t)g * 128 * 128;
#pragma unroll 1
        for (int tt = 0; tt < 8; ++tt) {
            f32x4 acc = (f32x4){0.f, 0.f, 0.f, 0.f};
            const bf16_t* wp = wg + (size_t)(tt * 16 + fr) * 128 + fq * 8;
#pragma unroll
            for (int ks = 0; ks < 4; ++ks) acc = MFMA(vfr[ks], ld_frag(wp + ks * 32), acc);
            const int tl = tt * 16 + fr, t = t0 + tl, c = cbase + fq * 4;
            const float bs = p.b_s[(size_t)(l * 4 + g) * 128 + tl];
            const f32x4 u = unpack4(*(const u32x2*)(P1 + (size_t)t * NP1 + C_GMU + c));
            bf16_t* zp = Z + (size_t)t * NZ + 512 + c; const f32x4 z = unpack4(*(const u32x2*)zp);
            f32x4 o;
#pragma unroll
            for (int e = 0; e < 4; ++e) o[e] = geluf_(u[e]) * (acc[e] + bs) * siluf_(z[e]);
            if (do_store) *(u32x2*)zp = pack4(o);
        }
    }
}

__device__ __forceinline__ f32x4 mix4(const bf16_t* pr, const bf16_t* pp, bool has_prev, const float* mu) {
    const f32x4 a = unpack4(*(const u32x2*)pr); f32x4 b = (f32x4){0.f, 0.f, 0.f, 0.f}; if (has_prev) b = unpack4(*(const u32x2*)pp);
    const f32x4 m = *(const f32x4*)mu; return a + (b - a) * m;
}
__device__ __forceinline__ void rwkv_prep_item(const Params& p, int l, int item) {
    const int tid = tid_l(), lane = tid & 63, wave = tid >> 6, fr = lane & 15, fq = lane >> 4;
    const int rt = wave >> 1, hh = wave & 1;
    const int t = item * 64 + rt * 16 + fr; const bool hp = (t % SEQ) != 0;
    const bf16_t* P1 = (const bf16_t*)(p.ws + OFF_R1);
    const bf16_t* pr = P1 + (size_t)t * NP1; const bf16_t* pp = pr - NP1;
    const float* mu = p.mu + (size_t)l * 1664 - C_RW;
    const bf16_t* W2T = (const bf16_t*)(p.ws + OFF_W2T) + (size_t)l * 512 * 64; const bf16_t* A2T = (const bf16_t*)(p.ws + OFF_A2T) + (size_t)l * 512 * 64;
    unsigned char* r2 = p.ws + OFF_R2;
    bf16_t* VF = (bf16_t*)(p.ws + OFF_VF);
    bf16x8 fa[2], fw[2];
#pragma unroll
    for (int ks = 0; ks < 2; ++ks) { const int ca = C_ALAT + ks * 32 + fq * 8, cw = C_WLAT + ks * 32 + fq * 8;
        const f32x4 a0 = mix4(pr + ca, pp + ca, hp, mu + ca), a1 = mix4(pr + ca + 4, pp + ca + 4, hp, mu + ca + 4);
        f32x4 w0 = mix4(pr + cw, pp + cw, hp, mu + cw), w1 = mix4(pr + cw + 4, pp + cw + 4, hp, mu + cw + 4);
#pragma unroll
        for (int e = 0; e < 4; ++e) { w0[e] = tanhf(w0[e]); w1[e] = tanhf(w1[e]); }
        fa[ks] = pack_frag(a0, a1); fw[ks] = pack_frag(w0, w1); }
    bf16x8 t1f = (bf16x8){0, 0, 0, 0, 0, 0, 0, 0};
    if (l >= 1) { const bf16_t* V1T = (const bf16_t*)(p.ws + OFF_V1T) + (size_t)(l - 1) * 32 * 512;
        f32x4 c0 = (f32x4){0.f, 0.f, 0.f, 0.f}, c1 = c0;
#pragma unroll 4
        for (int ks = 0; ks < 16; ++ks) { const int cv = C_RWV + ks * 32 + fq * 8;
            const bf16x8 af = pack_frag(mix4(pr + cv, pp + cv, hp, mu + cv), mix4(pr + cv + 4, pp + cv + 4, hp, mu + cv + 4));
            c0 = MFMA(ld_frag(V1T + (size_t)fr * 512 + ks * 32 + fq * 8), af, c0); c1 = MFMA(ld_frag(V1T + (size_t)(16 + fr) * 512 + ks * 32 + fq * 8), af, c1); }
        t1f = pack_frag(c0, c1);
    }
#pragma unroll 1
    for (int hq = 0; hq < 4; ++hq) { const int h = hh * 4 + hq;
        float ss = 0.f;
#pragma unroll
        for (int ct = 0; ct < 4; ++ct) { const int c = h * 64 + ct * 16 + fq * 4;
            const f32x4 kr = mix4(pr + C_RWK + c, pp + C_RWK + c, hp, mu + C_RWK + c) * *(const f32x4*)(p.k_k + (size_t)l * 512 + c);
            ss += kr[0] * kr[0] + kr[1] * kr[1] + kr[2] * kr[2] + kr[3] * kr[3]; }
        ss += __shfl_xor(ss, 16); ss += __shfl_xor(ss, 32);
        const float inv = 1.f / fmaxf(sqrtf(ss), 1e-12f);
        float dsum = 0.f;
#pragma unroll 2
        for (int ct = 0; ct < 4; ++ct) { const int crow = h * 64 + ct * 16 + fr;
            f32x4 aa = (f32x4){0.f, 0.f, 0.f, 0.f}, aw = aa, avm = aa;
#pragma unroll
            for (int ks = 0; ks < 2; ++ks) { aa = MFMA(ld_frag(A2T + (size_t)crow * 64 + ks * 32 + fq * 8), fa[ks], aa); aw = MFMA(ld_frag(W2T + (size_t)crow * 64 + ks * 32 + fq * 8), fw[ks], aw); }
            if (l >= 1) { const bf16_t* V2T = (const bf16_t*)(p.ws + OFF_V2T) + (size_t)(l - 1) * 512 * 32 + (size_t)crow * 32;
                avm = MFMA(join_frag(*(const u32x2*)(V2T + fq * 4), *(const u32x2*)(V2T + 16 + fq * 4)), t1f, avm); }
            const int c = h * 64 + ct * 16 + fq * 4; const size_t o = (size_t)t * 512 + c;
            const f32x4 rs = mix4(pr + C_RWR + c, pp + C_RWR + c, hp, mu + C_RWR + c);
            const f32x4 ksv = mix4(pr + C_RWK + c, pp + C_RWK + c, hp, mu + C_RWK + c);
            f32x4 vs = mix4(pr + C_RWV + c, pp + C_RWV + c, hp, mu + C_RWV + c);
            const f32x4 a0 = *(const f32x4*)(p.a0 + (size_t)l * 512 + c), w0 = *(const f32x4*)(p.w0 + (size_t)l * 512 + c), kkw = *(const f32x4*)(p.k_k + (size_t)l * 512 + c);
            const f32x4 ka = *(const f32x4*)(p.k_a + (size_t)l * 512 + c);
            f32x4 lw, asg;
#pragma unroll
            for (int e = 0; e < 4; ++e) { asg[e] = sigmoidf_(a0[e] + aa[e]); lw[e] = -0.6065306597126334f * sigmoidf_(w0[e] + aw[e]); }
            *(f32x4*)((float*)(r2 + R2_LW) + o) = lw;
            if (l == 0) { *(u32x2*)(VF + o) = pack4(vs); }
            else { const f32x4 vf = unpack4(*(const u32x2*)(VF + o)), v0 = *(const f32x4*)(p.v0 + (size_t)(l - 1) * 512 + c);
#pragma unroll
                for (int e = 0; e < 4; ++e) vs[e] = vs[e] + (vf[e] - vs[e]) * sigmoidf_(v0[e] + avm[e]); }
            const f32x4 kk = ksv * kkw * inv, km = ksv * ((asg - 1.f) * ka + 1.f), bb = kk * asg;
            { const f32x4 rk = *(const f32x4*)(p.r_k + (size_t)l * 512 + c); const f32x4 pr3 = rs * km * rk; dsum += pr3[0] + pr3[1] + pr3[2] + pr3[3]; }
            *(u32x2*)((bf16_t*)(r2 + R2_R) + o) = pack4(rs); *(u32x2*)((bf16_t*)(r2 + R2_K) + o) = pack4(km); *(u32x2*)((bf16_t*)(r2 + R2_V) + o) = pack4(vs);
            *(u32x2*)((bf16_t*)(r2 + R2_KK) + o) = pack4(kk); *(u32x2*)((bf16_t*)(r2 + R2_B) + o) = pack4(bb); }
        dsum += __shfl_xor(dsum, 16); dsum += __shfl_xor(dsum, 32);
        if (fq == 0) ((float*)(p.ws + OFF_DOT))[(size_t)t * 8 + h] = dsum;
    }
}

__device__ __forceinline__ void attn_item(const Params& p, int b, int h, int qb, unsigned char* lds, bool do_store = true) {
    const int tid = tid_l(), lane = tid & 63, wave = tid >> 6, fr = lane & 15, fq = lane >> 4;
    const bf16_t* Q = (const bf16_t*)(p.ws + OFF_R3 + R3_Q); const bf16_t* Kf = (const bf16_t*)(p.ws + OFF_R3 + R3_KF); const bf16_t* Vt = (const bf16_t*)(p.ws + OFF_R3 + R3_VT);
    bf16_t* Z = (bf16_t*)(p.ws + OFF_Z);
    constexpr int KS = 104, VS = 72, KB = 64 * KS * 2, VB = 64 * VS * 2, BUF = KB + VB;
    const int nkt = 4 * qb + 4, mykt = 4 * qb + (wave >> 1) + 1;
    const int trow0 = b * SEQ + qb * 256 + wave * 32 + fr;
    bf16x8 qf[2][3];
#pragma unroll
    for (int r = 0; r < 2; ++r)
#pragma unroll
        for (int ks = 0; ks < 3; ++ks) qf[r][ks] = ld_frag(Q + (size_t)(trow0 + r * 16) * 768 + h * 96 + ks * 32 + fq * 8);
    const bf16_t* kg = Kf + (size_t)(b * SEQ) * 768 + h * 96; const bf16_t* vg = Vt + (size_t)(b * 8 + h) * 64 * SEQ;
    const int kr0 = tid / 12, kc0 = tid % 12, kr1 = (tid + 512) / 12, kc1 = (tid + 512) % 12, vd = tid >> 3, vc = tid & 7;
    u32x4 pk0, pk1 = (u32x4){0, 0, 0, 0}, pv;
    __syncthreads();
    pk0 = *(const u32x4*)(kg + (size_t)kr0 * 768 + kc0 * 8); if (tid < 256) pk1 = *(const u32x4*)(kg + (size_t)kr1 * 768 + kc1 * 8);
    pv = *(const u32x4*)(vg + (size_t)vd * SEQ + vc * 8);
    { bf16_t* ks_ = (bf16_t*)lds; bf16_t* vs_ = (bf16_t*)(lds + KB);
        *(u32x4*)(ks_ + kr0 * KS + kc0 * 8) = pk0; if (tid < 256) *(u32x4*)(ks_ + kr1 * KS + kc1 * 8) = pk1; *(u32x4*)(vs_ + vd * VS + vc * 8) = pv; }
    __syncthreads();
    f32x4 O[2][4]; float m[2] = {-1e30f, -1e30f}, lsum[2] = {0.f, 0.f};
#pragma unroll
    for (int r = 0; r < 2; ++r)
#pragma unroll
        for (int d = 0; d < 4; ++d) O[r][d] = (f32x4){0.f, 0.f, 0.f, 0.f};
#pragma unroll 1
    for (int kt = 0; kt < nkt; ++kt) {
        const bool pre = (kt + 1 < nkt);
        if (pre) { const size_t ko = (size_t)(kt + 1) * 64;
            pk0 = *(const u32x4*)(kg + (ko + kr0) * 768 + kc0 * 8); if (tid < 256) pk1 = *(const u32x4*)(kg + (ko + kr1) * 768 + kc1 * 8);
            pv = *(const u32x4*)(vg + (size_t)vd * SEQ + ko + vc * 8); }
        if (kt < mykt) {
            const bf16_t* ks_ = (const bf16_t*)(lds + (kt & 1) * BUF); const bf16_t* vs_ = (const bf16_t*)(lds + (kt & 1) * BUF + KB);
            f32x4 s[2][4];
#pragma unroll
            for (int c4 = 0; c4 < 4; ++c4) { s[0][c4] = (f32x4){0.f, 0.f, 0.f, 0.f}; s[1][c4] = s[0][c4];
#pragma unroll
                for (int ks = 0; ks < 3; ++ks) { const bf16x8 kf = ld_frag(ks_ + (c4 * 16 + fr) * KS + ks * 32 + fq * 8);
                    s[0][c4] = MFMA(kf, qf[0][ks], s[0][c4]); s[1][c4] = MFMA(kf, qf[1][ks], s[1][c4]); } }
            bf16x8 pf[2][2];
#pragma unroll
            for (int r = 0; r < 2; ++r) {
                float mx = -1e30f;
#pragma unroll
                for (int c4 = 0; c4 < 4; ++c4) mx = fmaxf(fmaxf(fmaxf(s[r][c4][0], s[r][c4][1]), fmaxf(s[r][c4][2], s[r][c4][3])), mx);
                mx = fmaxf(mx, __shfl_xor(mx, 16)); mx = fmaxf(mx, __shfl_xor(mx, 32));
                const float mn = fmaxf(m[r], mx), alpha = exp2f(m[r] - mn); m[r] = mn;
                float ps = 0.f;
#pragma unroll
                for (int c4 = 0; c4 < 4; ++c4)
#pragma unroll
                    for (int e = 0; e < 4; ++e) { s[r][c4][e] = exp2f(s[r][c4][e] - mn); ps += s[r][c4][e]; }
                lsum[r] = lsum[r] * alpha + ps;
#pragma unroll
                for (int d = 0; d < 4; ++d) O[r][d] = O[r][d] * alpha;
                pf[r][0] = pack_frag(s[r][0], s[r][1]); pf[r][1] = pack_frag(s[r][2], s[r][3]); }
#pragma unroll
            for (int d = 0; d < 4; ++d) { const bf16_t* vp = vs_ + (d * 16 + fr) * VS + fq * 4;
                const bf16x8 v0 = join_frag(*(const u32x2*)(vp), *(const u32x2*)(vp + 16)), v1 = join_frag(*(const u32x2*)(vp + 32), *(const u32x2*)(vp + 48));
#pragma unroll
                for (int r = 0; r < 2; ++r) { O[r][d] = MFMA(v0, pf[r][0], O[r][d]); O[r][d] = MFMA(v1, pf[r][1], O[r][d]); } }
        }
        if (pre) { bf16_t* ks_ = (bf16_t*)(lds + ((kt + 1) & 1) * BUF); bf16_t* vs_ = (bf16_t*)(lds + ((kt + 1) & 1) * BUF + KB);
            *(u32x4*)(ks_ + kr0 * KS + kc0 * 8) = pk0; if (tid < 256) *(u32x4*)(ks_ + kr1 * KS + kc1 * 8) = pk1; *(u32x4*)(vs_ + vd * VS + vc * 8) = pv; }
        __syncthreads();
    }
    if (do_store)
#pragma unroll
    for (int r = 0; r < 2; ++r) { float ls = lsum[r]; ls += __shfl_xor(ls, 16); ls += __shfl_xor(ls, 32); const float il = 1.f / ls;
#pragma unroll
        for (int d = 0; d < 4; ++d) { bf16_t* zp = Z + (size_t)(trow0 + r * 16) * NZ + h * 64 + d * 16 + fq * 4; const f32x4 z = unpack4(*(const u32x2*)zp);
            f32x4 o;
#pragma unroll
            for (int e = 0; e < 4; ++e) o[e] = O[r][d][e] * il * siluf_(z[e]);
            *(u32x2*)zp = pack4(o); } }
}

__device__ __forceinline__ void scan_item(const Params& p, int l, int bh, unsigned char* lds) {
    const int tid = tid_l(), b = bh >> 3, h = bh & 7;
    const unsigned char* r2 = p.ws + OFF_R2; bf16_t* Z = (bf16_t*)(p.ws + OFF_Z);
    float* Lw = (float*)lds; float* La = Lw + 4096; float* Lb = La + 4096; float* Lk = Lb + 4096; float* Lr = Lk + 4096; float* Lv = Lr + 4096; float* Ly = Lv + 4096;
    const int i = tid >> 3, jp = tid & 7;
    float st[8];
#pragma unroll
    for (int e = 0; e < 8; ++e) st[e] = 0.f;
    const int et = tid >> 3, ep = tid & 7;
#pragma unroll 1
    for (int ck = 0; ck < SEQ / 64; ++ck) {
        const size_t tg = (size_t)b * SEQ + ck * 64 + et; const size_t o = tg * 512 + h * 64 + ep * 8;
        __syncthreads();
        { const u32x4 ur = *(const u32x4*)((const bf16_t*)(r2 + R2_R) + o), uk = *(const u32x4*)((const bf16_t*)(r2 + R2_K) + o), uv = *(const u32x4*)((const bf16_t*)(r2 + R2_V) + o),
                      ukk = *(const u32x4*)((const bf16_t*)(r2 + R2_KK) + o), ub = *(const u32x4*)((const bf16_t*)(r2 + R2_B) + o);
            const f32x4 l0 = *(const f32x4*)((const float*)(r2 + R2_LW) + o), l1 = *(const f32x4*)((const float*)(r2 + R2_LW) + o + 4);
            const int lo = et * 64 + ep * 8;
            *(f32x4*)(Lw + lo) = (f32x4){__expf(l0[0]), __expf(l0[1]), __expf(l0[2]), __expf(l0[3])}; *(f32x4*)(Lw + lo + 4) = (f32x4){__expf(l1[0]), __expf(l1[1]), __expf(l1[2]), __expf(l1[3])};
            *(f32x4*)(La + lo) = (f32x4){-bf_lo(ukk.x), -bf_hi(ukk.x), -bf_lo(ukk.y), -bf_hi(ukk.y)}; *(f32x4*)(La + lo + 4) = (f32x4){-bf_lo(ukk.z), -bf_hi(ukk.z), -bf_lo(ukk.w), -bf_hi(ukk.w)};
            *(f32x4*)(Lb + lo) = (f32x4){bf_lo(ub.x), bf_hi(ub.x), bf_lo(ub.y), bf_hi(ub.y)}; *(f32x4*)(Lb + lo + 4) = (f32x4){bf_lo(ub.z), bf_hi(ub.z), bf_lo(ub.w), bf_hi(ub.w)};
            *(f32x4*)(Lk + lo) = (f32x4){bf_lo(uk.x), bf_hi(uk.x), bf_lo(uk.y), bf_hi(uk.y)}; *(f32x4*)(Lk + lo + 4) = (f32x4){bf_lo(uk.z), bf_hi(uk.z), bf_lo(uk.w), bf_hi(uk.w)};
            *(f32x4*)(Lr + lo) = (f32x4){bf_lo(ur.x), bf_hi(ur.x), bf_lo(ur.y), bf_hi(ur.y)}; *(f32x4*)(Lr + lo + 4) = (f32x4){bf_lo(ur.z), bf_hi(ur.z), bf_lo(ur.w), bf_hi(ur.w)};
            *(f32x4*)(Lv + lo) = (f32x4){bf_lo(uv.x), bf_hi(uv.x), bf_lo(uv.y), bf_hi(uv.y)}; *(f32x4*)(Lv + lo + 4) = (f32x4){bf_lo(uv.z), bf_hi(uv.z), bf_lo(uv.w), bf_hi(uv.w)};
        }
        __syncthreads();
#pragma unroll 1
        for (int t = 0; t < 64; ++t) { const int lo = t * 64 + jp * 8;
            const f32x4 w0 = *(const f32x4*)(Lw + lo), w1 = *(const f32x4*)(Lw + lo + 4), a0 = *(const f32x4*)(La + lo), a1 = *(const f32x4*)(La + lo + 4), b0 = *(const f32x4*)(Lb + lo), b1 = *(const f32x4*)(Lb + lo + 4),
                        k0 = *(const f32x4*)(Lk + lo), k1 = *(const f32x4*)(Lk + lo + 4), r0 = *(const f32x4*)(Lr + lo), r1 = *(const f32x4*)(Lr + lo + 4);
            const float vi = Lv[t * 64 + i];
            float sa = st[0] * a0[0] + st[1] * a0[1] + st[2] * a0[2] + st[3] * a0[3] + st[4] * a1[0] + st[5] * a1[1] + st[6] * a1[2] + st[7] * a1[3];
            sa += __shfl_xor(sa, 1); sa += __shfl_xor(sa, 2); sa += __shfl_xor(sa, 4);
            st[0] = st[0] * w0[0] + sa * b0[0] + vi * k0[0]; st[1] = st[1] * w0[1] + sa * b0[1] + vi * k0[1]; st[2] = st[2] * w0[2] + sa * b0[2] + vi * k0[2]; st[3] = st[3] * w0[3] + sa * b0[3] + vi * k0[3];
            st[4] = st[4] * w1[0] + sa * b1[0] + vi * k1[0]; st[5] = st[5] * w1[1] + sa * b1[1] + vi * k1[1]; st[6] = st[6] * w1[2] + sa * b1[2] + vi * k1[2]; st[7] = st[7] * w1[3] + sa * b1[3] + vi * k1[3];
            float y = st[0] * r0[0] + st[1] * r0[1] + st[2] * r0[2] + st[3] * r0[3] + st[4] * r1[0] + st[5] * r1[1] + st[6] * r1[2] + st[7] * r1[3];
            y += __shfl_xor(y, 1); y += __shfl_xor(y, 2); y += __shfl_xor(y, 4);
            if (jp == 0) Ly[t * 64 + i] = y;
        }
        __syncthreads();
        { const int lo = et * 64 + ep * 8;
            const f32x4 y0 = *(const f32x4*)(Ly + lo), y1 = *(const f32x4*)(Ly + lo + 4), r0 = *(const f32x4*)(Lr + lo), r1 = *(const f32x4*)(Lr + lo + 4), k0 = *(const f32x4*)(Lk + lo), k1 = *(const f32x4*)(Lk + lo + 4),
                        v0 = *(const f32x4*)(Lv + lo), v1 = *(const f32x4*)(Lv + lo + 4);
            const f32x4 rk0 = *(const f32x4*)(p.r_k + (size_t)l * 512 + h * 64 + ep * 8), rk1 = *(const f32x4*)(p.r_k + (size_t)l * 512 + h * 64 + ep * 8 + 4);
            float s = y0[0] + y0[1] + y0[2] + y0[3] + y1[0] + y1[1] + y1[2] + y1[3];
            float dot = r0[0] * k0[0] * rk0[0] + r0[1] * k0[1] * rk0[1] + r0[2] * k0[2] * rk0[2] + r0[3] * k0[3] * rk0[3] + r1[0] * k1[0] * rk1[0] + r1[1] * k1[1] * rk1[1] + r1[2] * k1[2] * rk1[2] + r1[3] * k1[3] * rk1[3];
            s += __shfl_xor(s, 1); s += __shfl_xor(s, 2); s += __shfl_xor(s, 4);
            dot += __shfl_xor(dot, 1); dot += __shfl_xor(dot, 2); dot += __shfl_xor(dot, 4);
            const float mean = s * (1.f / 64.f);
            const f32x4 d0 = y0 - mean, d1 = y1 - mean;
            float q = d0[0] * d0[0] + d0[1] * d0[1] + d0[2] * d0[2] + d0[3] * d0[3] + d1[0] * d1[0] + d1[1] * d1[1] + d1[2] * d1[2] + d1[3] * d1[3];
            q += __shfl_xor(q, 1); q += __shfl_xor(q, 2); q += __shfl_xor(q, 4);
            const float rstd = rsqrtf(q * (1.f / 64.f) + 64e-5f);
            const f32x4 g0 = *(const f32x4*)(p.lnx_g + (size_t)l * 512 + h * 64 + ep * 8), g1 = *(const f32x4*)(p.lnx_g + (size_t)l * 512 + h * 64 + ep * 8 + 4),
                        e0 = *(const f32x4*)(p.lnx_b + (size_t)l * 512 + h * 64 + ep * 8), e1 = *(const f32x4*)(p.lnx_b + (size_t)l * 512 + h * 64 + ep * 8 + 4);
            bf16_t* zp = Z + tg * NZ + 1024 + h * 64 + ep * 8; const u32x4 zu = *(const u32x4*)zp;
            const f32x4 o0 = d0 * rstd * g0 + e0 + v0 * dot, o1 = d1 * rstd * g1 + e1 + v1 * dot;
            u32x4 w; w.x = cvt_pk_bf16(o0[0] * siluf_(bf_lo(zu.x)), o0[1] * siluf_(bf_hi(zu.x))); w.y = cvt_pk_bf16(o0[2] * siluf_(bf_lo(zu.y)), o0[3] * siluf_(bf_hi(zu.y)));
            w.z = cvt_pk_bf16(o1[0] * siluf_(bf_lo(zu.z)), o1[1] * siluf_(bf_hi(zu.z))); w.w = cvt_pk_bf16(o1[2] * siluf_(bf_lo(zu.w)), o1[3] * siluf_(bf_hi(zu.w)));
            *(u32x4*)zp = w; }
    }
}


constexpr int MS = 72;
__device__ __forceinline__ f32x4 nt_tile(const bf16_t* Am, int arow, const bf16_t* Bm, int brow, f32x4 acc, int fq) {
    acc = MFMA(ld_frag(Am + arow * MS + fq * 8), ld_frag(Bm + brow * MS + fq * 8), acc);
    acc = MFMA(ld_frag(Am + arow * MS + 32 + fq * 8), ld_frag(Bm + brow * MS + 32 + fq * 8), acc);
    return acc;
}
#if PROBE_SCAN
#define CHKF_OLD(ptr, n, bit) do { unsigned _c = 0u; for (int _i = tid; _i < (n); _i += NTHREADS) { const float _a = (ptr)[_i]; if (!(fabsf(_a) < 1e30f)) _c = (bit); } if (_c) atomicOr((unsigned*)(p.ws + WS_END + 5 * MiB), _c); } while (0)
#define CHKB_OLD(ptr, bit) do { unsigned _c = 0u; for (int _i = tid; _i < 4096; _i += NTHREADS) { const float _a = bf2f((ptr)[(_i >> 6) * MS + (_i & 63)]); if (!(fabsf(_a) < 1e30f)) _c = (bit); } if (_c) atomicOr((unsigned*)(p.ws + WS_END + 5 * MiB), _c); } while (0)
#endif
#define CHKF(ptr, n, bit)
#define CHKB(ptr, bit)
__device__ __forceinline__ void chunk_item(const Params& p, int item, unsigned char* lds) {
    const int tid = tid_l(), lane = tid & 63, wave = __builtin_amdgcn_readfirstlane(tid >> 6), fr = lane & 15, fq = lane >> 4;
    const int bh = item >> 6, ck = item & 63, b = bh >> 3, h = bh & 7;
    const size_t tok0 = (size_t)b * SEQ + ck * 64;
    const unsigned char* r2 = p.ws + OFF_R2; unsigned char* r1 = p.ws + OFF_R1;
    float* CUM = (float*)lds; float* TF = CUM + 4096; float* XB = TF + 4096; float* TOT = XB + 1024;
    bf16_t* MB = (bf16_t*)(lds + 38912);
    bf16_t *AT_ = MB, *BT_ = MB + 1 * 64 * MS, *KT_ = MB + 2 * 64 * MS, *RT_ = MB + 3 * 64 * MS, *ATT = MB + 4 * 64 * MS, *VT = MB + 5 * 64 * MS, *KHT = MB + 6 * 64 * MS, *BHT = MB + 7 * 64 * MS,
           *MAK = MB + 8 * 64 * MS, *MRB = MB + 9 * 64 * MS, *MRK = MB + 10 * 64 * MS, *TB = MB + 11 * 64 * MS;
    bf16_t *MVT = AT_, *TAT = BT_, *W1T = KT_;
    const float* LWg = (const float*)(r2 + R2_LW);
    __syncthreads();
    { float c[8]; float run = 0.f;
#pragma unroll
        for (int e = 0; e < 8; ++e) { run += LWg[(tok0 + wave * 8 + e) * 512 + h * 64 + lane]; c[e] = run; }
        TOT[wave * 64 + lane] = run;
        __syncthreads();
        float off = 0.f;
#pragma unroll
        for (int w2 = 0; w2 < 7; ++w2) off += (w2 < wave) ? TOT[w2 * 64 + lane] : 0.f;
#pragma unroll
        for (int e = 0; e < 8; ++e) CUM[(wave * 8 + e) * 64 + lane] = off + c[e];
    }
    __syncthreads();
    { const int t = tid & 63, j0 = (tid >> 6) * 8; const size_t o = (tok0 + t) * 512 + h * 64 + j0;
        const u32x4 ur = *(const u32x4*)((const bf16_t*)(r2 + R2_R) + o), uk = *(const u32x4*)((const bf16_t*)(r2 + R2_K) + o), uv = *(const u32x4*)((const bf16_t*)(r2 + R2_V) + o),
                    ukk = *(const u32x4*)((const bf16_t*)(r2 + R2_KK) + o), ub = *(const u32x4*)((const bf16_t*)(r2 + R2_B) + o);
        const unsigned rr[4] = {ur.x, ur.y, ur.z, ur.w}, kr[4] = {uk.x, uk.y, uk.z, uk.w}, vr[4] = {uv.x, uv.y, uv.z, uv.w}, qr[4] = {ukk.x, ukk.y, ukk.z, ukk.w}, br[4] = {ub.x, ub.y, ub.z, ub.w};
        unsigned oa[4], ob[4], ok[4], orr[4];
#pragma unroll
        for (int e2 = 0; e2 < 4; ++e2) { float va[2], vb[2], vk[2], vrr[2];
#pragma unroll
            for (int hh = 0; hh < 2; ++hh) { const int e = 2 * e2 + hh;
                const float cm = CUM[t * 64 + j0 + e], lwv = LWg[o + e], cC = CUM[63 * 64 + j0 + e];
                const float rv = hh ? bf_hi(rr[e2]) : bf_lo(rr[e2]), kv = hh ? bf_hi(kr[e2]) : bf_lo(kr[e2]), vv = hh ? bf_hi(vr[e2]) : bf_lo(vr[e2]), qv = hh ? bf_hi(qr[e2]) : bf_lo(qr[e2]), bv = hh ? bf_hi(br[e2]) : bf_lo(br[e2]);
                const float en = __expf(-cm), eh = __expf(cC - cm);
                va[hh] = -qv * __expf(cm - lwv); vb[hh] = bv * en; vk[hh] = kv * en; vrr[hh] = rv * __expf(cm);
                ATT[(j0 + e) * MS + t] = f2bf(va[hh]); VT[(j0 + e) * MS + t] = f2bf(vv); KHT[(j0 + e) * MS + t] = f2bf(kv * eh); BHT[(j0 + e) * MS + t] = f2bf(bv * eh);
                if (t == 63) ((float*)(r1 + R1_PC))[(size_t)item * 64 + j0 + e] = __expf(cC); }
            oa[e2] = cvt_pk_bf16(va[0], va[1]); ob[e2] = cvt_pk_bf16(vb[0], vb[1]); ok[e2] = cvt_pk_bf16(vk[0], vk[1]); orr[e2] = cvt_pk_bf16(vrr[0], vrr[1]); }
        *(u32x4*)(AT_ + t * MS + j0) = (u32x4){oa[0], oa[1], oa[2], oa[3]}; *(u32x4*)(BT_ + t * MS + j0) = (u32x4){ob[0], ob[1], ob[2], ob[3]};
        *(u32x4*)(KT_ + t * MS + j0) = (u32x4){ok[0], ok[1], ok[2], ok[3]}; *(u32x4*)(RT_ + t * MS + j0) = (u32x4){orr[0], orr[1], orr[2], orr[3]};
    }
    __syncthreads();
#pragma unroll 1
    for (int x = 0; x < 8; ++x) { const int q = wave * 8 + x, mat = q >> 4, tm = (q >> 2) & 3, tn = q & 3;
        const bf16_t* Am = (mat & 1) ? KT_ : BT_; const bf16_t* Bm = (mat & 2) ? RT_ : AT_;
        f32x4 acc = nt_tile(Am, tm * 16 + fr, Bm, tn * 16 + fr, (f32x4){0.f, 0.f, 0.f, 0.f}, fq);
        const int t = tn * 16 + fr, s0 = tm * 16 + fq * 4;
#pragma unroll
        for (int e = 0; e < 4; ++e) { const bool keep = (mat & 2) ? (s0 + e <= t) : (s0 + e < t); acc[e] = keep ? acc[e] : 0.f; }
        if (mat == 0) *(f32x4*)(CUM + t * 64 + s0) = acc;
        else { bf16_t* Om = (mat == 1) ? MAK : (mat == 2) ? MRB : MRK; *(u32x2*)(Om + t * MS + s0) = pack4(acc); }
    }
    __syncthreads();

    if (wave == 0) { const int base = (lane >> 5) * 32, c = lane & 31; float xv[32]; int roff = base * 65; float prev = 0.f;
#pragma unroll
        for (int t = 0; t < 32; ++t) { float a = (t == c) ? 1.f : 0.f;
            asm volatile("" : "+v"(roff), "+v"(prev));
            const float* Lr = CUM + roff + t * 64;
#pragma unroll
            for (int s2 = 0; s2 < t; ++s2) a += Lr[s2] * xv[s2];
            xv[t] = a; prev = a; }
#pragma unroll
        for (int t = 0; t < 32; ++t) { TF[(base + t) * 64 + base + c] = xv[t]; if (base == 0) TF[t * 64 + 32 + c] = 0.f; }
    }
    __syncthreads();
    { const int r = tid >> 4, c0 = (tid & 15) * 2; float x0 = 0.f, x1 = 0.f;
#pragma unroll 8
        for (int k = 0; k < 32; ++k) { const float lv = CUM[(32 + r) * 64 + k]; x0 += lv * TF[k * 64 + c0]; x1 += lv * TF[k * 64 + c0 + 1]; }
        XB[r * 32 + c0] = x0; XB[r * 32 + c0 + 1] = x1;
        __syncthreads();
        float y0 = 0.f, y1 = 0.f;
#pragma unroll 8
        for (int k = 0; k < 32; ++k) { const float tv = TF[(32 + r) * 64 + 32 + k]; y0 += tv * XB[k * 32 + c0]; y1 += tv * XB[k * 32 + c0 + 1]; }
        TF[(32 + r) * 64 + c0] = y0; TF[(32 + r) * 64 + c0 + 1] = y1;
    }
    __syncthreads();
    { const int t = tid >> 3, s0 = (tid & 7) * 8; const f32x4 a = *(const f32x4*)(TF + t * 64 + s0), b2 = *(const f32x4*)(TF + t * 64 + s0 + 4);
        u32x4 w; w.x = cvt_pk_bf16(a[0], a[1]); w.y = cvt_pk_bf16(a[2], a[3]); w.z = cvt_pk_bf16(b2[0], b2[1]); w.w = cvt_pk_bf16(b2[2], b2[3]);
        *(u32x4*)(TB + t * MS + s0) = w; }
    __syncthreads();
#pragma unroll 1
    for (int x = 0; x < 4; ++x) { const int q = wave * 4 + x, mat = q >> 4, tm = (q >> 2) & 3, tn = q & 3;
        const f32x4 acc = nt_tile(mat ? TB : MAK, tm * 16 + fr, mat ? ATT : VT, tn * 16 + fr, (f32x4){0.f, 0.f, 0.f, 0.f}, fq);
        *(u32x2*)((mat ? TAT : MVT) + (tn * 16 + fr) * MS + tm * 16 + fq * 4) = pack4(acc); }
    __syncthreads();
#pragma unroll 1
    for (int x = 0; x < 2; ++x) { const int q = wave * 2 + x, tm = q >> 2, tn = q & 3;
        const f32x4 acc = nt_tile(TB, tm * 16 + fr, MVT, tn * 16 + fr, (f32x4){0.f, 0.f, 0.f, 0.f}, fq);
        *(u32x2*)(W1T + (tn * 16 + fr) * MS + tm * 16 + fq * 4) = pack4(acc); }
    __syncthreads();
#pragma unroll 1
    for (int x = 0; x < 8; ++x) { const int q = wave * 8 + x, o = q >> 4, tm = (q >> 2) & 3, tn = q & 3;
        const int ar = tm * 16 + fr, br_ = tn * 16 + fr; f32x4 acc = (f32x4){0.f, 0.f, 0.f, 0.f};
        if (o == 0) acc = nt_tile(TAT, ar, BHT, br_, acc, fq);
        else if (o == 1) { acc = unpack4(*(const u32x2*)(RT_ + br_ * MS + tm * 16 + fq * 4)); acc = nt_tile(TAT, ar, MRB, br_, acc, fq); }
        else if (o == 2) { acc = nt_tile(KHT, ar, VT, br_, acc, fq); acc = nt_tile(BHT, ar, W1T, br_, acc, fq); }
        else { acc = nt_tile(VT, ar, MRK, br_, acc, fq);
#if EXP_CONSTY
            acc = (f32x4){1.f, 2.f, 3.f, 4.f};
#endif
#if !EXP_NOW1
            acc = nt_tile(W1T, ar, MRB, br_, acc, fq);
#endif
        }
        bf16_t* og = (bf16_t*)(r1 + (size_t)o * 16 * MiB) + (size_t)item * 4096 + br_ * 64 + tm * 16 + fq * 4;
        *(u32x2*)og = pack4(acc); }
}

__device__ __forceinline__ void seq_compute(const unsigned char* bufp, bf16_t* SB, float* yb, f32x4 (&Sacc)[4], int wave, int fr, int fq) {
    const bf16_t* GP = (const bf16_t*)bufp; const bf16_t* RA = GP + 64 * MS; const bf16_t* HT = RA + 64 * MS; const bf16_t* YQ = HT + 64 * MS; const float* PC = (const float*)(bufp + 4 * 64 * MS * 2);
    const bf16x8 sf0 = ld_frag(SB + fr * MS + fq * 8), sf1 = ld_frag(SB + fr * MS + 32 + fq * 8);
#pragma unroll
    for (int tt = 0; tt < 4; ++tt) { f32x4 y = unpack4(*(const u32x2*)(YQ + (tt * 16 + fr) * MS + wave * 16 + fq * 4));
        y = MFMA(sf0, ld_frag(RA + (tt * 16 + fr) * MS + fq * 8), y); y = MFMA(sf1, ld_frag(RA + (tt * 16 + fr) * MS + 32 + fq * 8), y);
        *(f32x4*)(yb + (tt * 16 + fr) * 64 + wave * 16 + fq * 4) = y; }
#pragma unroll
    for (int jt = 0; jt < 4; ++jt) { const f32x4 pc = *(const f32x4*)(PC + jt * 16 + fq * 4);
        f32x4 a = unpack4(*(const u32x2*)(HT + (wave * 16 + fr) * MS + jt * 16 + fq * 4)) + Sacc[jt] * pc;
        a = MFMA(ld_frag(GP + (jt * 16 + fr) * MS + fq * 8), sf0, a); a = MFMA(ld_frag(GP + (jt * 16 + fr) * MS + 32 + fq * 8), sf1, a);
        Sacc[jt] = a; }
#pragma unroll
    for (int jt = 0; jt < 4; ++jt) *(u32x2*)(SB + fr * MS + jt * 16 + fq * 4) = pack4(Sacc[jt]);
}
__device__ __forceinline__ void seq_epilogue(const Params& p, int l, const float* yb, float dot, u32x4 vu, u32x4 zu, bf16_t* zp, int ch) {
    const f32x4 y0 = *(const f32x4*)yb, y1 = *(const f32x4*)(yb + 4);
    float s1 = y0[0] + y0[1] + y0[2] + y0[3] + y1[0] + y1[1] + y1[2] + y1[3];
    s1 += __shfl_xor(s1, 1); s1 += __shfl_xor(s1, 2); s1 += __shfl_xor(s1, 4);
    const float mean = s1 * (1.f / 64.f); const f32x4 d0 = y0 - mean, d1 = y1 - mean;
    float s2 = d0[0] * d0[0] + d0[1] * d0[1] + d0[2] * d0[2] + d0[3] * d0[3] + d1[0] * d1[0] + d1[1] * d1[1] + d1[2] * d1[2] + d1[3] * d1[3];
    s2 += __shfl_xor(s2, 1); s2 += __shfl_xor(s2, 2); s2 += __shfl_xor(s2, 4);
    const float rstd = rsqrtf(s2 * (1.f / 64.f) + 64e-5f);
    const f32x4 g0 = *(const f32x4*)(p.lnx_g + (size_t)l * 512 + ch), g1 = *(const f32x4*)(p.lnx_g + (size_t)l * 512 + ch + 4), e0 = *(const f32x4*)(p.lnx_b + (size_t)l * 512 + ch), e1 = *(const f32x4*)(p.lnx_b + (size_t)l * 512 + ch + 4);
    const f32x4 v0 = (f32x4){bf_lo(vu.x), bf_hi(vu.x), bf_lo(vu.y), bf_hi(vu.y)}, v1 = (f32x4){bf_lo(vu.z), bf_hi(vu.z), bf_lo(vu.w), bf_hi(vu.w)};
    const f32x4 o0 = d0 * rstd * g0 + e0 + v0 * dot, o1 = d1 * rstd * g1 + e1 + v1 * dot;
    u32x4 w; w.x = cvt_pk_bf16(o0[0] * siluf_(bf_lo(zu.x)), o0[1] * siluf_(bf_hi(zu.x))); w.y = cvt_pk_bf16(o0[2] * siluf_(bf_lo(zu.y)), o0[3] * siluf_(bf_hi(zu.y)));
    w.z = cvt_pk_bf16(o1[0] * siluf_(bf_lo(zu.z)), o1[1] * siluf_(bf_hi(zu.z))); w.w = cvt_pk_bf16(o1[2] * siluf_(bf_lo(zu.w)), o1[3] * siluf_(bf_hi(zu.w)));
    *(u32x4*)zp = w;
}
__device__ __forceinline__ void seq_item(const Params& p, int l, int bh, unsigned char* lds, bf16_t* dstp, int dst_ld, size_t dst_tok0) {
    const int tid = tid_l(), lane = tid & 63, wave = __builtin_amdgcn_readfirstlane(tid >> 6), fr = lane & 15, fq = lane >> 4;
    const int b = bh >> 3, h = bh & 7;
    const unsigned char* r1 = p.ws + OFF_R1;
    constexpr int BUFB = 4 * 64 * MS * 2 + 256;
    bf16_t* SB = (bf16_t*)(lds + 2 * BUFB) + wave * 16 * MS;
    float* YB = (float*)(lds + 2 * BUFB + 4 * 16 * MS * 2);
    const int srow = tid >> 3, sc8 = tid & 7;
    u32x4 preA[4], preB[4]; float pcA = 0.f, pcB = 0.f;
#define SEQ_LOAD(PRE, PC, CI) do { const size_t _ci = (CI); _Pragma("unroll") for (int m = 0; m < 4; ++m) PRE[m] = *(const u32x4*)((const bf16_t*)(r1 + (size_t)m * 16 * MiB) + _ci * 4096 + srow * 64 + sc8 * 8); \
        if (tid < 64) PC = ((const float*)(r1 + R1_PC))[_ci * 64 + tid]; } while (0)
#define SEQ_STORE(PRE, PC, BUFP) do { unsigned char* _b = (BUFP); _Pragma("unroll") for (int m = 0; m < 4; ++m) *(u32x4*)((bf16_t*)_b + m * 64 * MS + srow * MS + sc8 * 8) = PRE[m]; \
        if (tid < 64) ((float*)(_b + 4 * 64 * MS * 2))[tid] = PC; } while (0)
    __syncthreads();
    SEQ_LOAD(preA, pcA, (size_t)bh * 64);
    SEQ_LOAD(preB, pcB, (size_t)bh * 64 + 1);
    SEQ_STORE(preA, pcA, lds);
    if (wave < 4) { for (int e = lane; e < 16 * MS / 2; e += 64) ((unsigned*)SB)[e] = 0u; }
    __syncthreads();
    f32x4 Sacc[4];
#pragma unroll
    for (int jt = 0; jt < 4; ++jt) Sacc[jt] = (f32x4){0.f, 0.f, 0.f, 0.f};
#define SEQ_ITER(C, PRE_NEXT, PC_NEXT, PRE_LOAD, PC_LOAD) do { const int c = (C); \
        if (c + 2 < 64) SEQ_LOAD(PRE_LOAD, PC_LOAD, (size_t)bh * 64 + c + 2); \
        const int et = tid >> 3, eq = tid & 7; const size_t tg = (size_t)b * SEQ + c * 64 + et; const int ch = h * 64 + eq * 8; \
        const float dot = ((const float*)(p.ws + OFF_DOT))[tg * 8 + h]; \
        const u32x4 vu = *(const u32x4*)((const bf16_t*)(p.ws + OFF_R2 + R2_V) + tg * 512 + ch); \
        const u32x4 zu = *(const u32x4*)((const bf16_t*)(p.ws + OFF_Z) + tg * NZ + 1024 + ch); \
        if (wave < 4) seq_compute(lds + (c & 1) * BUFB, SB, YB + (c & 1) * 4096, Sacc, wave, fr, fq); \
        if (c + 1 < 64) SEQ_STORE(PRE_NEXT, PC_NEXT, lds + ((c + 1) & 1) * BUFB); \
        __syncthreads(); \
        seq_epilogue(p, l, YB + (c & 1) * 4096 + et * 64 + eq * 8, dot, vu, zu, dstp + (tg - dst_tok0) * dst_ld + ch, ch); } while (0)
#pragma unroll 1
    for (int c2 = 0; c2 < 64; c2 += 2) { SEQ_ITER(c2, preB, pcB, preA, pcA); SEQ_ITER(c2 + 1, preA, pcA, preB, pcB); }
#undef SEQ_ITER
#undef SEQ_LOAD
#undef SEQ_STORE
}

#define XB_TMO      128
#define XB_XCNT(j)  (256  + 64 * (j))
#define XB_XSUB(j)  (1280 + 64 * (j))
#define XB_XGEN(j)  (2304 + 64 * (j))
#define XB_TOP      3328
#define XB_TOPGEN   3392
#define XCD_BAR_WORDS 3456
#define XB_SPIN_CAP (1u << 18)

__device__ __forceinline__ unsigned xb_ld(unsigned* p)              { return __hip_atomic_load(p, __ATOMIC_RELAXED, __HIP_MEMORY_SCOPE_AGENT); }
__device__ __forceinline__ unsigned xb_add(unsigned* p, unsigned v) { return __hip_atomic_fetch_add(p, v, __ATOMIC_RELAXED, __HIP_MEMORY_SCOPE_AGENT); }
__device__ __forceinline__ unsigned xb_xcc_id() { return (unsigned)__builtin_amdgcn_s_getreg((3 << 11) | 20) & 0xFu; }
#define XB_SPIN(cond, bar) do { unsigned _sp = 0; while (cond) { __builtin_amdgcn_s_sleep(1); \
    if ((++_sp & 255u) == 0u) { if (xb_ld(&(bar)[XB_TMO])) break; if (_sp > XB_SPIN_CAP) { atomicAdd(&(bar)[XB_TMO], 1u); break; } } } } while (0)

struct XcdBarrier {
    unsigned* bar; unsigned x;
    volatile LAS unsigned* st;
};

__device__ __forceinline__ XcdBarrier xcd_barrier_post(unsigned* bar, volatile LAS unsigned* st) {
    XcdBarrier b; b.bar = bar; b.x = xb_xcc_id(); b.st = st;
    if (threadIdx.x == 0) (void)xb_add(&bar[XB_XCNT(b.x)], 1u);
    return b;
}
__device__ __forceinline__ void xcd_barrier_complete(unsigned* bar, unsigned x, unsigned& nloc, unsigned& nx) {
    const unsigned G = gridDim.x * gridDim.y * gridDim.z;
    unsigned sum, cnt, mine, sp = 0u;
    for (;;) {
        sum = 0u; cnt = 0u; mine = 0u;
#pragma unroll
        for (unsigned j = 0; j < 16; ++j) { const unsigned c = xb_ld(&bar[XB_XCNT(j)]); sum += c; cnt += (c > 0u) ? 1u : 0u; mine = (j == x) ? c : mine; }
        if (sum == G) break;
        __builtin_amdgcn_s_sleep(1);
        if ((++sp & 255u) == 0u) { if (xb_ld(&bar[XB_TMO])) break; if (sp > XB_SPIN_CAP) { atomicAdd(&bar[XB_TMO], 1u); break; } }
    }
    nloc = mine > 0u ? mine : 1u; nx = cnt > 0u ? cnt : 1u;
}

__device__ __forceinline__ void xcd_barrier(const XcdBarrier& b) {
    asm volatile("s_waitcnt vmcnt(0)" ::: "memory");
    __syncthreads();
    if (threadIdx.x == 0) {
        unsigned* bar = b.bar;
        __builtin_amdgcn_s_waitcnt(0);
        unsigned nloc = b.st[0], nx = b.st[1];
        if (nloc == 0u) { xcd_barrier_complete(bar, b.x, nloc, nx); b.st[0] = nloc; b.st[1] = nx; }
        const unsigned old = xb_add(&bar[XB_XSUB(b.x)], 1u);
        const unsigned gen = old / nloc;
        if (old + 1u == (gen + 1u) * nloc) {
            __builtin_amdgcn_fence(__ATOMIC_RELEASE, "agent");
            asm volatile("s_waitcnt vmcnt(0)" ::: "memory");
            const unsigned og = xb_add(&bar[XB_TOP], 1u);
            const unsigned tg = og / nx;
            if (og + 1u == (tg + 1u) * nx) xb_add(&bar[XB_TOPGEN], 1u);
            else XB_SPIN(xb_ld(&bar[XB_TOPGEN]) == tg, bar);
            __builtin_amdgcn_fence(__ATOMIC_ACQUIRE, "agent");
            xb_add(&bar[XB_XGEN(b.x)], 1u);
            asm volatile("s_waitcnt vmcnt(0)" ::: "memory");
        } else {
            XB_SPIN(xb_ld(&bar[XB_XGEN(b.x)]) == gen, bar);
            __builtin_amdgcn_fence(__ATOMIC_ACQUIRE, "agent");
            asm volatile("s_waitcnt vmcnt(0)" ::: "memory");
        }
    }
    __syncthreads();
}


constexpr int PH_PER_LAYER = 8, PH_PRE = 3, N_PHASES = PH_PRE + NL * PH_PER_LAYER;
__global__ void __launch_bounds__(NTHREADS, 2) trunk_fwd(Params p0) {
    extern __shared__ __attribute__((aligned(16))) unsigned char lds[];
    const int G = gridDim.x, bx = blockIdx.x;
    Params p = p0;
    volatile LAS unsigned* xb_st = (volatile LAS unsigned*)((LAS unsigned char*)lds + (LDS_BYTES - 16));
    if (threadIdx.x == 0) { xb_st[0] = 0u; xb_st[1] = 0u; }
    XcdBarrier xbar; xbar.bar = nullptr; xbar.x = 0; xbar.st = xb_st;
    __syncthreads();
#if EXP_ZERO
    for (int i = threadIdx.x; i < LDS_BYTES / 4; i += NTHREADS) ((unsigned*)lds)[i] = 0u;
    __syncthreads();
    if (p0.ph_lo == 0) { u32x4* z = (u32x4*)(p0.ws + OFF_DOT); const size_t n = (WS_END - OFF_DOT) / 16;
        for (size_t i = (size_t)bx * NTHREADS + threadIdx.x; i < n; i += (size_t)G * NTHREADS) z[i] = (u32x4){0u, 0u, 0u, 0u}; }
#endif
    for (int ph = p0.ph_lo; ph < p0.ph_hi; ++ph) {
        unsigned char* ws = ptr_l(p0.ws); p.ws = ws;
#if TS_K >= 0
        if (bx == 0 && threadIdx.x == 0) ((unsigned long long*)(ws + WS_END + 32768))[ph] = __builtin_amdgcn_s_memrealtime();
#endif
        if (ph == 0) { if (PHEN & 1) for (int rep = 0; rep < REP_P0; ++rep) phase0a(p, lds); }
        else if (ph == 1) { phase_modt(p); }
        else if (ph == 2) { if (PHEN & 2) phase0b(p); }
        else {
            const int l = (ph - PH_PRE) / PH_PER_LAYER, k = (ph - PH_PRE) % PH_PER_LAYER;
            if (k == 0 && (PHEN & 4)) for (int rep = 0; rep < REP_IN; ++rep) {
                pg8::Gemm g{(const bf16_t*)(ws + OFF_H), (const bf16_t*)(ws + OFF_WIN + l * SZ_WIN), DM, DM, DM};
                pg8::PlainOrder S; S.init(M_TOK / 256, NIN / 256, G, bx);
                pg8::EpiIn E{(bf16_t*)(ws + OFF_R1), (bf16_t*)(ws + OFF_Z)};
                pg8::gemm_phase(( LAS unsigned char*)lds, g, S, E);
            } else if (k == 1 && (PHEN & 8)) {
                for (int it = bx; it < 640; it += G) {
                    if (it < 128) { if (PHEN & 512) { for (int rep = 1; rep < REP_GM; ++rep) gmlp_item(p, l, it, lds, false); gmlp_item(p, l, it, lds); } }
                    else if (it < 384) { if (PHEN & 1024) for (int rep = 0; rep < REP_MLA; ++rep) mla_prep_item(p, l, it - 128, lds); }
                    else { if (PHEN & 2048) for (int rep = 0; rep < REP_RW; ++rep) rwkv_prep_item(p, l, it - 384); }
                }
            } else if (k == 2 && (PHEN & 16)) {
                for (int rep = 0; rep < REP_CHUNK; ++rep) for (int it = bx; it < 2048; it += G) { if (USE_CHUNK && (PHEN & 4096)) chunk_item(p, it, lds); }
            } else if (k == 3 && (PHEN & 16)) {
#if !USE_CHUNK
                for (int it = bx; it < 32; it += G) scan_item(p, l, it, lds);
#elif PROBE_SCAN
                for (int it = bx; it < 32; it += G) { if (l == 0 && it < 8) seq_item(p, l, it, lds, (bf16_t*)(ws + WS_END), 512, 0); scan_item(p, l, it, lds); }
#else
                for (int it = bx; it < 32; it += G) { if (PHEN & 8192) seq_item(p, l, it, lds, (bf16_t*)(ws + OFF_Z) + 1024, NZ, 0); }
#endif
                {
                    unsigned* ctr = (unsigned*)(ptr_l(p0.ws) + WS_END + 16384) + l * 16;
                    volatile LAS unsigned* slot = (volatile LAS unsigned*)((LAS unsigned char*)lds + (LDS_BYTES - 8));
                    for (;;) {
                        __syncthreads();
                        if (tid_l() == 0) *slot = __hip_atomic_fetch_add(ctr, 1u, __ATOMIC_RELAXED, __HIP_MEMORY_SCOPE_AGENT);
                        __syncthreads();
                        const unsigned i = *slot;
                        if (i >= 512u) break;
                        const int qb = 15 - (int)(i >> 5), bh = (int)(i & 31);
                        attn_item(p, bh >> 3, bh & 7, qb, lds);
                    }
                }
            } else if (k == 4 && (PHEN & 32)) for (int rep = 0; rep < REP_GMO; ++rep) {
#if PROBE_SCAN
#endif: G = sigmoid(h @ Wg)
                pg8::Gemm g{(const bf16_t*)(ws + OFF_H), (const bf16_t*)(ws + OFF_WG + l * SZ_WG), DM, DM, DM};
                pg8::PlainOrder S; S.init(M_TOK / 256, NG / 256, G, bx);
                pg8::EpiPlain<1> E{(bf16_t*)(ws + OFF_R2), NG};
                pg8::gemm_phase((LAS unsigned char*)lds, g, S, E);
            } else if (k == 5 && (PHEN & 64)) for (int rep = 0; rep < REP_GMO; ++rep) {
                pg8::Gemm g{(const bf16_t*)(ws + OFF_Z), (const bf16_t*)(ws + OFF_WBR + l * SZ_WBR), NZ, 512, 512};
                pg8::MergeOrder S; S.init(M_TOK / 256, DM / 256, G, bx);
                pg8::EpiMerge E{(bf16_t*)(ws + OFF_R3 + R3_MERGED), (const bf16_t*)(ws + OFF_R2)};
                pg8::gemm_phase((LAS unsigned char*)lds, g, S, E);
            } else if (k == 6 && (PHEN & 128)) for (int rep = 0; rep < REP_GMO; ++rep) {
                pg8::Gemm g{(const bf16_t*)(ws + OFF_R3 + R3_MERGED), (const bf16_t*)(ws + OFF_WOUT + l * SZ_WOUT), DM, DM, DM};
                pg8::PlainOrder S; S.init(M_TOK / 256, DM / 256, G, bx);
                pg8::EpiPlain<0> E{(bf16_t*)(ws + OFF_R3 + R3_Y), DM};
                pg8::gemm_phase((LAS unsigned char*)lds, g, S, E);
            } else if (k == 7 && (PHEN & 256)) {
                phase_final(p, l);
            }
        }
#if PROBE_SCAN
        if (ph == N_PHASES - 1 && bx == 0 && threadIdx.x == 0) { const unsigned cd = *(volatile unsigned*)(ws + WS_END + 5 * MiB); p.out[5] = 1000.f * (float)cd; }
        if (ph == 0 && bx == 0 && threadIdx.x == 0) *(unsigned*)(ws + WS_END + 5 * MiB) = 0u;
#endif
#if TS_K >= 0
        if (ph == N_PHASES - 1 && bx == 0 && threadIdx.x == 0) { unsigned long long* ts = (unsigned long long*)(ws + WS_END + 32768); const unsigned long long tend = __builtin_amdgcn_s_memrealtime(); unsigned long long sum = 0;
            if (TS_K < 8) { for (int l2 = 0; l2 < NL; ++l2) { const int a = PH_PRE + l2 * PH_PER_LAYER + TS_K; sum += ((a + 1 < N_PHASES) ? ts[a + 1] : tend) - ts[a]; } }
            else sum = ts[PH_PRE] - ts[0];
            p.out[5] = 10.f * (float)sum; }
#endif
        if (ph + 1 < p0.ph_hi) {
            if (ph == p0.ph_lo) {
                if (bx == 0) { const int tz = tid_l(); if (tz < 64) __hip_atomic_store((unsigned*)(ptr_l(p0.ws) + WS_END + 16384) + tz, 0u, __ATOMIC_RELAXED, __HIP_MEMORY_SCOPE_AGENT); }
                if (bx == 0) { unsigned* zb = (unsigned*)ptr_l(p0.ws + WS_END); for (int i = tid_l(); i < XCD_BAR_WORDS; i += NTHREADS) __hip_atomic_store(zb + i, 0u, __ATOMIC_RELAXED, __HIP_MEMORY_SCOPE_AGENT); }
                cg::this_grid().sync();
                xbar = xcd_barrier_post((unsigned*)ptr_l(p0.ws + WS_END), xb_st);
            } else { XcdBarrier b2; b2.bar = (unsigned*)ptr_l(p0.ws + WS_END); b2.x = xbar.x; b2.st = xb_st; xcd_barrier(b2); }
        }
    }
}

extern "C" void kernel_launch(void* const* d_in, const int* in_sizes, int n_in, void* d_out, int out_size, void* d_ws, size_t ws_size, hipStream_t stream) {
    static int grid = 0;
    if (grid == 0) {
        if (n_in != 31 || out_size != M_TOK * DM || ws_size < WS_END + 65536) { fprintf(stderr, "kernel_launch: unexpected shapes (n_in %d out %d ws %zu)\n", n_in, out_size, ws_size); grid = -1; return; }
        int dev = 0, cus = 0, per_cu = 0;
        hipGetDevice(&dev); hipDeviceGetAttribute(&cus, hipDeviceAttributeMultiprocessorCount, dev);
        hipFuncSetAttribute((const void*)trunk_fwd, hipFuncAttributeMaxDynamicSharedMemorySize, LDS_BYTES);
        hipOccupancyMaxActiveBlocksPerMultiprocessor(&per_cu, (const void*)trunk_fwd, NTHREADS, LDS_BYTES);
        if (per_cu < 1) { fprintf(stderr, "kernel_launch: occupancy query says %d blocks per CU\n", per_cu); grid = -1; return; }
        grid = cus * 1;
    }
    if (grid < 0) return;
    Params p{};
    p.x = (const float*)d_in[0]; p.c = (const float*)d_in[1]; p.pos = (const int*)d_in[2]; p.pre_g = (const float*)d_in[3]; p.post_g = (const float*)d_in[4];
    p.w_ada = (const float*)d_in[5]; p.b_ada = (const float*)d_in[6]; p.w_in = (const float*)d_in[7]; p.q_norm = (const float*)d_in[8]; p.w_uq = (const float*)d_in[9];
    p.kv_norm = (const float*)d_in[10]; p.w_ukv = (const float*)d_in[11]; p.ln_g = (const float*)d_in[12]; p.ln_b = (const float*)d_in[13]; p.w_s = (const float*)d_in[14]; p.b_s = (const float*)d_in[15];
    p.mu = (const float*)d_in[16]; p.w0 = (const float*)d_in[17]; p.w2 = (const float*)d_in[18]; p.a0 = (const float*)d_in[19]; p.a2 = (const float*)d_in[20]; p.k_k = (const float*)d_in[21];
    p.k_a = (const float*)d_in[22]; p.r_k = (const float*)d_in[23]; p.lnx_g = (const float*)d_in[24]; p.lnx_b = (const float*)d_in[25]; p.v0 = (const float*)d_in[26]; p.v1 = (const float*)d_in[27];
    p.v2 = (const float*)d_in[28]; p.w_br = (const float*)d_in[29]; p.w_out = (const float*)d_in[30];
    p.out = (float*)d_out; p.ws = (unsigned char*)d_ws;
#if ONE_LAUNCH
    p.ph_lo = 0; p.ph_hi = N_PHASES;
    void* args[] = {&p};
    hipError_t e = hipLaunchCooperativeKernel((const void*)trunk_fwd, dim3(grid), dim3(NTHREADS), args, LDS_BYTES, stream);
    if (e != hipSuccess) fprintf(stderr, "cooperative launch failed: %s (grid %d)\n", hipGetErrorString(e), grid);
#else
    for (int ph = 0; ph < N_PHASES; ++ph) { p.ph_lo = ph; p.ph_hi = ph + 1;
        hipLaunchKernelGGL(trunk_fwd, dim3(grid), dim3(NTHREADS), LDS_BYTES, stream, p); }
#endif
}
```

```cpp
#include <hip/hip_runtime.h>
#include <hip/hip_cooperative_groups.h>
#include <cstdint>
#include <cstdio>
namespace cg = cooperative_groups;

#ifndef PHEN
#define PHEN 0x7fff
#endif
#ifndef TS_K
#define TS_K -1
#endif
#ifndef REP_P0
#define REP_P0 1
#endif
#ifndef REP_GMO
#define REP_GMO 1
#endif
#ifndef REP_GM
#define REP_GM 1
#endif
#ifndef REP_ATT
#define REP_ATT 1
#endif
#ifndef REP_IN
#define REP_IN 1
#endif
#ifndef REP_CHUNK
#define REP_CHUNK 1
#endif
#ifndef REP_MLA
#define REP_MLA 1
#endif
#ifndef REP_RW
#define REP_RW 1
#endif
#ifndef EXP_SYNC2
#define EXP_SYNC2 0
#endif
#ifndef EXP_NODOT
#define EXP_NODOT 0
#endif
#ifndef EXP_CONSTY
#define EXP_CONSTY 0
#endif
#ifndef EXP_NOW1
#define EXP_NOW1 0
#endif
#ifndef EXP_NOSTATE
#define EXP_NOSTATE 0
#endif
#ifndef EXP_ZERO
#define EXP_ZERO 0
#endif
#ifndef USE_CHUNK
#define USE_CHUNK 1
#endif
#ifndef PROBE_SCAN
#define PROBE_SCAN 0
#endif
#ifndef ONE_LAUNCH
#define ONE_LAUNCH 1
#endif

#define LAS __attribute__((address_space(3)))
typedef unsigned short bf16_t;
typedef short bf16x8 __attribute__((ext_vector_type(8)));
typedef short bf16x4 __attribute__((ext_vector_type(4)));
typedef float f32x4 __attribute__((ext_vector_type(4)));
typedef float f32x2 __attribute__((ext_vector_type(2)));
typedef unsigned u32x4 __attribute__((ext_vector_type(4)));
typedef unsigned u32x2 __attribute__((ext_vector_type(2)));

constexpr int M_TOK = 16384, DM = 1024, SEQ = 4096, NBATCH = 4, NL = 4;
constexpr int D_IN_SRC = 7712;
constexpr int NP1 = 3328, NZ = 1536, NIN = 4864, NG = 3072;
constexpr int C_QLAT = 0, C_KVLAT = 256, C_KROPE = 384, C_GMU = 512, C_GMV = 1024, C_RW = 1536, C_RWR = 1536, C_RWK = 2048, C_RWV = 2560, C_WLAT = 3072, C_ALAT = 3136;
constexpr int NTHREADS = 512, NWAVES = 8;
constexpr int LDS_BYTES = 150 * 1024;
constexpr float QSCALE = 0.10206207261596575f * 1.4426950408889634f;

constexpr size_t MiB = 1u << 20;
constexpr size_t OFF_WIN = 0;
constexpr size_t SZ_WIN = (size_t)NIN * DM * 2;
constexpr size_t OFF_WG = 38 * MiB;
constexpr size_t SZ_WG = (size_t)NG * DM * 2;
constexpr size_t OFF_WBR = 62 * MiB;
constexpr size_t SZ_WBR = (size_t)3072 * 512 * 2;
constexpr size_t OFF_WOUT = 74 * MiB;
constexpr size_t SZ_WOUT = (size_t)DM * DM * 2;
constexpr size_t OFF_WUQ = 82 * MiB;
constexpr size_t SZ_WUQ = (size_t)768 * 256 * 2;
constexpr size_t OFF_WUKV = OFF_WUQ + 3 * MiB / 2;
constexpr size_t SZ_WUKV = (size_t)1024 * 128 * 2;
constexpr size_t OFF_SMALL = OFF_WUKV + 1 * MiB;
constexpr size_t OFF_W2T = OFF_SMALL;
constexpr size_t OFF_A2T = OFF_W2T + 256 * 1024;
constexpr size_t OFF_V1T = OFF_A2T + 256 * 1024;
constexpr size_t OFF_V2T = OFF_V1T + 128 * 1024;
constexpr size_t OFF_WS = OFF_V2T + 128 * 1024;
constexpr size_t OFF_MODP = OFF_WS + 512 * 1024;
constexpr size_t OFF_ROPE = OFF_MODP + 3 * MiB / 2;
constexpr size_t OFF_DOT = OFF_ROPE + 2 * MiB;
constexpr size_t OFF_MODT = OFF_DOT + MiB / 2;
constexpr size_t OFF_H = 90 * MiB;
constexpr size_t OFF_Z = 122 * MiB;
constexpr size_t OFF_VF = 170 * MiB;
constexpr size_t OFF_R1 = 186 * MiB;
constexpr size_t OFF_R2 = 298 * MiB;
constexpr size_t OFF_R3 = 410 * MiB;
constexpr size_t WS_END = 474 * MiB;
static_assert(OFF_MODT + 3 * NL * 4 * 1024 * 4 <= OFF_H, "small region");
constexpr size_t R1_GP = 0, R1_RA = 16 * MiB, R1_HT = 32 * MiB, R1_YQ = 48 * MiB, R1_PC = 64 * MiB;
constexpr size_t R2_R = 0, R2_K = 16 * MiB, R2_V = 32 * MiB, R2_KK = 48 * MiB, R2_B = 64 * MiB, R2_LW = 80 * MiB;
constexpr size_t R3_Q = 0, R3_KF = 24 * MiB, R3_VT = 48 * MiB, R3_MERGED = 0, R3_Y = 32 * MiB;

struct Params {
    const float* x; const float* c; const int* pos; const float* pre_g; const float* post_g; const float* w_ada; const float* b_ada; const float* w_in;
    const float* q_norm; const float* w_uq; const float* kv_norm; const float* w_ukv; const float* ln_g; const float* ln_b; const float* w_s; const float* b_s;
    const float* mu; const float* w0; const float* w2; const float* a0; const float* a2; const float* k_k; const float* k_a; const float* r_k;
    const float* lnx_g; const float* lnx_b; const float* v0; const float* v1; const float* v2; const float* w_br; const float* w_out;
    float* out; unsigned char* ws;
    int ph_lo, ph_hi;
};

typedef __bf16 bf16x2_t __attribute__((ext_vector_type(2)));
__device__ __forceinline__ unsigned cvt_pk_bf16(float lo, float hi) { const f32x2 v = {lo, hi}; const bf16x2_t b = __builtin_convertvector(v, bf16x2_t); return __builtin_bit_cast(unsigned, b); }
__device__ __forceinline__ float bf_lo(unsigned u) { return __uint_as_float(u << 16); }
__device__ __forceinline__ float bf_hi(unsigned u) { return __uint_as_float(u & 0xffff0000u); }
__device__ __forceinline__ float bf2f(bf16_t h) { return __uint_as_float(((unsigned)h) << 16); }
__device__ __forceinline__ bf16_t f2bf(float f) { return (bf16_t)(cvt_pk_bf16(f, 0.f) & 0xffffu); }
__device__ __forceinline__ float sigmoidf_(float x) { return 1.f / (1.f + __expf(-x)); }
__device__ __forceinline__ float siluf_(float x) { return x / (1.f + __expf(-x)); }
__device__ __forceinline__ float geluf_(float x) { return 0.5f * x * (1.f + erff(x * 0.70710678118654752f)); }
__device__ __forceinline__ f32x4 unpack4(u32x2 u) { return (f32x4){bf_lo(u.x), bf_hi(u.x), bf_lo(u.y), bf_hi(u.y)}; }
__device__ __forceinline__ u32x2 pack4(f32x4 v) { u32x2 r; r.x = cvt_pk_bf16(v[0], v[1]); r.y = cvt_pk_bf16(v[2], v[3]); return r; }
__device__ __forceinline__ float wave_sum(float v) {
#pragma unroll
    for (int o = 1; o < 64; o <<= 1) v += __shfl_xor(v, o);
    return v;
}
__device__ __forceinline__ bf16x8 ld_frag(const bf16_t* p) { return *(const bf16x8*)p; }
__device__ __forceinline__ bf16x8 pack_frag(f32x4 a, f32x4 b) {
    u32x4 u; u.x = cvt_pk_bf16(a[0], a[1]); u.y = cvt_pk_bf16(a[2], a[3]); u.z = cvt_pk_bf16(b[0], b[1]); u.w = cvt_pk_bf16(b[2], b[3]);
    return __builtin_bit_cast(bf16x8, u);
}
__device__ __forceinline__ bf16x8 join_frag(u32x2 a, u32x2 b) { u32x4 u; u.x = a.x; u.y = a.y; u.z = b.x; u.w = b.y; return __builtin_bit_cast(bf16x8, u); }
__device__ __forceinline__ int tid_l() { int t = threadIdx.x; asm volatile("" : "+v"(t)); return t; }
__device__ __forceinline__ unsigned char* ptr_l(unsigned char* q) { asm volatile("" : "+s"(q)); return q; }
#define MFMA(a, b, c) __builtin_amdgcn_mfma_f32_16x16x32_bf16((a), (b), (c), 0, 0, 0)

namespace pg8 {
constexpr int BM = 256, BK = 64, HALF = 128, HTB = HALF * BK * 2, STAGE_BYTES = 8 * HTB, NXCD = 8, WGM = 8;
__host__ __device__ __forceinline__ int lds_byte(int r, int c) { const int st = (r >> 4) * 2 + (c >> 5), rr = r & 15, cc = c & 31, ob = rr * 64 + cc * 2; return st * 1024 + (ob ^ (((ob >> 9) & 1) << 5)); }
__host__ __device__ __forceinline__ void stage_rc(int b, int& R, int& C) { const int st = b / 1024, sb = b % 1024, swz = sb ^ (((sb >> 9) & 1) << 5); R = (st >> 1) * 16 + swz / 64; C = (st & 1) * 32 + (swz % 64) / 2; }
__host__ __device__ __forceinline__ int perm32(int rho) { const int n = rho >> 4, i = rho & 15; return 8 * (i >> 2) + 4 * n + (i & 3); }

struct Unit { int pm, pn, ak, tag; };
struct Gemm { const bf16_t* A; const bf16_t* Bt; int lda, ldb, K; };

__device__ __forceinline__ void tile_of(int wgid, int nM, int nN, int& pm, int& pn) {
    const int nwg = nM * nN;
    { const int q = nwg / NXCD, r = nwg % NXCD, xcd = wgid % NXCD, off = wgid / NXCD; wgid = (xcd < r ? xcd * (q + 1) : r * (q + 1) + (xcd - r) * q) + off; }
    const int nig = WGM * nN, gid = wgid / nig, fm = gid * WGM, gsz = (nM - fm) < WGM ? (nM - fm) : WGM;
    pm = fm + ((wgid % nig) % gsz); pn = (wgid % nig) / gsz;
}
struct PlainOrder {
    int nM, nN, nwg, G, c;
    __device__ void init(int nM_, int nN_, int G_, int c_) { nM = nM_; nN = nN_; nwg = nM * nN; G = G_; c = c_; }
    __device__ bool next(int i, Unit& u) const { const long L = (long)i * G + c; if (L >= nwg) return false; tile_of((int)L, nM, nN, u.pm, u.pn); u.ak = 0; u.tag = 0; return true; }
};
struct MergeOrder {
    int nM, nN, nwg, G, c;
    __device__ void init(int nM_, int nN_, int G_, int c_) { nM = nM_; nN = nN_; nwg = nM * nN; G = G_; c = c_; }
    __device__ bool next(int i, Unit& u) const { const int ti = i / 3, n = i - 3 * ti; const long L = (long)ti * G + c; if (L >= nwg) return false;
        int pm, pc; tile_of((int)L, nM, nN, pm, pc); u.pm = pm; u.pn = n * nN + pc; u.ak = n * 512; u.tag = n; return true; }
};

template <class Epi, class Sched>
__device__ __forceinline__ void gemm_phase(LAS unsigned char* lds, const Gemm g, const Sched& S, const Epi& E) {
    const int tid = tid_l(), wid = __builtin_amdgcn_readfirstlane(tid >> 6), lane = tid & 63, wr = wid >> 2, wc = wid & 3, fr = lane & 15, fq = lane >> 4;
    const int K = g.K, nt = K / BK;
    unsigned voffA[2], voffB[2];
#pragma unroll
    for (int i = 0; i < 2; ++i) { int R, C; stage_rc(tid * 16 + i * 8192, R, C); const int Rb = (R & ~31) + perm32(R & 31);
        voffA[i] = (unsigned)(R * g.lda + C) * 2u; voffB[i] = (unsigned)(Rb * g.ldb + C) * 2u; }
    const size_t kstep = (size_t)(BK * 2);
    const size_t hstepA = (size_t)HALF * g.lda * 2, hstepB = (size_t)HALF * g.ldb * 2;
    const size_t tstepA = 2 * hstepA, tstepB = 2 * hstepB;
    const unsigned ldsw = (unsigned)wid * 1024u;
    const int aoff = lds_byte(wr * 64 + fr, fq * 8), boff = lds_byte(wc * 32 + fr, fq * 8);
#define PG8_SA(b, h) (((b) * 2 + (h)) * HTB)
#define PG8_SB(b, h) ((4 + (b) * 2 + (h)) * HTB)
#define PG8_STAGE(bufoff, gbase, voff) do { _Pragma("unroll") for (int _i = 0; _i < 2; ++_i) \
        __builtin_amdgcn_global_load_lds((const unsigned*)((const char*)(gbase) + (voff)[_i]), (LAS unsigned*)(lds + (bufoff) + ldsw + _i * 8192), 16, 0, 0); } while (0)
#define PG8_LDA(dst, b, h) do { _Pragma("unroll") for (int m = 0; m < 4; ++m) _Pragma("unroll") for (int k = 0; k < 2; ++k) dst[m][k] = *(const LAS bf16x8*)(lds + PG8_SA(b, h) + aoff + m * 2048 + k * 1024); } while (0)
#define PG8_LDB(dst, b, h) do { _Pragma("unroll") for (int n = 0; n < 2; ++n) _Pragma("unroll") for (int k = 0; k < 2; ++k) dst[n][k] = *(const LAS bf16x8*)(lds + PG8_SB(b, h) + boff + n * 2048 + k * 1024); } while (0)
#define PG8_MMA(ai, bj, At, Bt) do { __builtin_amdgcn_s_setprio(1); _Pragma("unroll") for (int m = 0; m < 4; ++m) _Pragma("unroll") for (int n = 0; n < 2; ++n) _Pragma("unroll") for (int k = 0; k < 2; ++k) \
        acc[ai][bj][m][n] = __builtin_amdgcn_mfma_f32_16x16x32_bf16(Bt[n][k], At[m][k], acc[ai][bj][m][n], 0, 0, 0); __builtin_amdgcn_s_setprio(0); } while (0)
#define PG8_WAIT_V(n) asm volatile("s_waitcnt vmcnt(" #n ")" ::: "memory")
#define PG8_WAIT_L(n) asm volatile("s_waitcnt lgkmcnt(" #n ")" ::: "memory")
#define PG8_BAR __builtin_amdgcn_s_barrier()
#define PG8_SCHED __builtin_amdgcn_sched_barrier(0)
    Unit cur, nxt; int ui = 0;
    if (!S.next(0, cur)) return;
    f32x4 acc[2][2][4][2];
#pragma unroll
    for (int a = 0; a < 2; ++a)
#pragma unroll
        for (int b = 0; b < 2; ++b)
#pragma unroll
            for (int m = 0; m < 4; ++m)
#pragma unroll
                for (int n = 0; n < 2; ++n) acc[a][b][m][n] = (f32x4){0.f, 0.f, 0.f, 0.f};
    bf16x8 At[4][2], B0[2][2], B1[2][2];
    const char* cA = (const char*)g.A + (size_t)cur.pm * tstepA + (size_t)cur.ak * 2; const char* cB = (const char*)g.Bt + (size_t)cur.pn * tstepB;
    PG8_STAGE(PG8_SB(0, 0), cB, voffB); PG8_STAGE(PG8_SB(0, 1), cB + hstepB, voffB); PG8_STAGE(PG8_SA(0, 0), cA, voffA); PG8_STAGE(PG8_SA(0, 1), cA + hstepA, voffA);
    if (wr == 1) PG8_BAR;
    PG8_WAIT_V(2); PG8_BAR;
    PG8_STAGE(PG8_SB(1, 0), cB + kstep, voffB); PG8_STAGE(PG8_SA(1, 0), cA + kstep, voffA); PG8_STAGE(PG8_SB(1, 1), cB + hstepB + kstep, voffB);
    PG8_WAIT_V(6); PG8_BAR;
    for (;;) {
        const bool has_next = S.next(ui + 1, nxt);
        const char* nA = has_next ? (const char*)g.A + (size_t)nxt.pm * tstepA + (size_t)nxt.ak * 2 : cA; const char* nB = has_next ? (const char*)g.Bt + (size_t)nxt.pn * tstepB : cB;
        for (int t = 0; t < nt; t += 2) {
            const bool last = (t == nt - 2);
            const char* a1 = cA + (size_t)(t + 1) * kstep;
            const char* a2 = last ? nA : cA + (size_t)(t + 2) * kstep; const char* b2 = last ? nB : cB + (size_t)(t + 2) * kstep;
            const char* a3 = a2 + kstep; const char* b3 = b2 + kstep;
            PG8_LDB(B0, 0, 0); PG8_LDB(B1, 0, 1); PG8_SCHED; PG8_LDA(At, 0, 0); PG8_STAGE(PG8_SA(1, 1), a1 + hstepA, voffA);
            PG8_WAIT_V(8); PG8_WAIT_L(0); PG8_BAR; PG8_MMA(0, 0, At, B0); PG8_MMA(0, 1, At, B1); PG8_BAR; PG8_SCHED;
            PG8_LDA(At, 0, 1); PG8_STAGE(PG8_SB(0, 0), b2, voffB); PG8_STAGE(PG8_SB(0, 1), b2 + hstepB, voffB); PG8_STAGE(PG8_SA(0, 0), a2, voffA);
            PG8_WAIT_V(8); PG8_WAIT_L(0); PG8_BAR; PG8_MMA(1, 0, At, B0); PG8_MMA(1, 1, At, B1); PG8_BAR; PG8_SCHED;
            PG8_LDB(B0, 1, 0); PG8_LDB(B1, 1, 1); PG8_SCHED; PG8_LDA(At, 1, 0); PG8_STAGE(PG8_SA(0, 1), a2 + hstepA, voffA);
            PG8_WAIT_V(8); PG8_WAIT_L(0); PG8_BAR; PG8_MMA(0, 0, At, B0); PG8_MMA(0, 1, At, B1); PG8_BAR; PG8_SCHED;
            PG8_LDA(At, 1, 1); PG8_STAGE(PG8_SB(1, 0), b3, voffB); PG8_STAGE(PG8_SB(1, 1), b3 + hstepB, voffB); PG8_STAGE(PG8_SA(1, 0), a3, voffA);
            PG8_WAIT_V(8); PG8_WAIT_L(0); PG8_BAR; PG8_MMA(1, 0, At, B0); PG8_MMA(1, 1, At, B1); PG8_BAR; PG8_SCHED;
        }
        if (wr == 0) PG8_BAR;
        E(acc, cur, wr, wc, fr, fq);
        if (!has_next) break;
#pragma unroll
        for (int a = 0; a < 2; ++a)
#pragma unroll
            for (int b = 0; b < 2; ++b)
#pragma unroll
                for (int m = 0; m < 4; ++m)
#pragma unroll
                    for (int n = 0; n < 2; ++n) acc[a][b][m][n] = (f32x4){0.f, 0.f, 0.f, 0.f};
        cur = nxt; cA = nA; cB = nB; ++ui;
        if (wr == 1) PG8_BAR;
    }
    PG8_WAIT_V(0);
    PG8_BAR;
#undef PG8_SA
#undef PG8_SB
#undef PG8_STAGE
#undef PG8_LDA
#undef PG8_LDB
#undef PG8_MMA
#undef PG8_WAIT_V
#undef PG8_WAIT_L
#undef PG8_BAR
#undef PG8_SCHED
}

struct EpiIn {
    bf16_t* P1; bf16_t* Z;
    __device__ __forceinline__ void operator()(const f32x4 (&acc)[2][2][4][2], const Unit& u, int wr, int wc, int fr, int fq) const {
        bf16_t* base; int ld, colt;
        if (u.pn < 13) { base = P1; ld = NP1; colt = u.pn * BM; } else { base = Z; ld = NZ; colt = (u.pn - 13) * BM; }
        const int row0 = u.pm * BM + wr * 64 + fr, col0 = colt + wc * 32 + 8 * fq;
#pragma unroll
        for (int ai = 0; ai < 2; ++ai)
#pragma unroll
            for (int m = 0; m < 4; ++m) { bf16_t* rowp = base + (size_t)(row0 + ai * HALF + m * 16) * ld + col0;
#pragma unroll
                for (int bj = 0; bj < 2; ++bj) { const f32x4 v0 = acc[ai][bj][m][0], v1 = acc[ai][bj][m][1];
                    u32x4 w; w.x = cvt_pk_bf16(v0[0], v0[1]); w.y = cvt_pk_bf16(v0[2], v0[3]); w.z = cvt_pk_bf16(v1[0], v1[1]); w.w = cvt_pk_bf16(v1[2], v1[3]);
                    *(u32x4*)(rowp + bj * HALF) = w; } }
    }
};
template <int ACT> struct EpiPlain {
    bf16_t* O; int ld;
    __device__ __forceinline__ void operator()(const f32x4 (&acc)[2][2][4][2], const Unit& u, int wr, int wc, int fr, int fq) const {
        const int row0 = u.pm * BM + wr * 64 + fr, col0 = u.pn * BM + wc * 32 + 8 * fq;
#pragma unroll
        for (int ai = 0; ai < 2; ++ai)
#pragma unroll
            for (int m = 0; m < 4; ++m) { bf16_t* rowp = O + (size_t)(row0 + ai * HALF + m * 16) * ld + col0;
#pragma unroll
                for (int bj = 0; bj < 2; ++bj) { f32x4 v0 = acc[ai][bj][m][0], v1 = acc[ai][bj][m][1];
                    if (ACT == 1) {
#pragma unroll
                        for (int e = 0; e < 4; ++e) { v0[e] = sigmoidf_(v0[e]); v1[e] = sigmoidf_(v1[e]); } }
                    u32x4 w; w.x = cvt_pk_bf16(v0[0], v0[1]); w.y = cvt_pk_bf16(v0[2], v0[3]); w.z = cvt_pk_bf16(v1[0], v1[1]); w.w = cvt_pk_bf16(v1[2], v1[3]);
                    *(u32x4*)(rowp + bj * HALF) = w; } }
    }
};
struct EpiMerge {
    bf16_t* Mg; const bf16_t* G;
    __device__ __forceinline__ void operator()(const f32x4 (&acc)[2][2][4][2], const Unit& u, int wr, int wc, int fr, int fq) const {
        const int n = u.tag, pc = u.pn - 4 * n;
        const int row0 = u.pm * BM + wr * 64 + fr, col0 = pc * BM + wc * 32 + 8 * fq;
#pragma unroll
        for (int ai = 0; ai < 2; ++ai)
#pragma unroll
            for (int m = 0; m < 4; ++m) { const size_t row = (size_t)(row0 + ai * HALF + m * 16);
#pragma unroll
                for (int bj = 0; bj < 2; ++bj) { const f32x4 v0 = acc[ai][bj][m][0], v1 = acc[ai][bj][m][1];
                    const u32x4 gt = *(const u32x4*)(G + row * NG + n * 1024 + col0 + bj * HALF);
                    bf16_t* mp = Mg + row * DM + col0 + bj * HALF;
                    float o[8];
                    o[0] = bf_lo(gt.x) * v0[0]; o[1] = bf_hi(gt.x) * v0[1]; o[2] = bf_lo(gt.y) * v0[2]; o[3] = bf_hi(gt.y) * v0[3];
                    o[4] = bf_lo(gt.z) * v1[0]; o[5] = bf_hi(gt.z) * v1[1]; o[6] = bf_lo(gt.w) * v1[2]; o[7] = bf_hi(gt.w) * v1[3];
                    if (n > 0) { const u32x4 pv = *(const u32x4*)mp;
                        o[0] += bf_lo(pv.x); o[1] += bf_hi(pv.x); o[2] += bf_lo(pv.y); o[3] += bf_hi(pv.y); o[4] += bf_lo(pv.z); o[5] += bf_hi(pv.z); o[6] += bf_lo(pv.w); o[7] += bf_hi(pv.w); }
                    u32x4 w; w.x = cvt_pk_bf16(o[0], o[1]); w.y = cvt_pk_bf16(o[2], o[3]); w.z = cvt_pk_bf16(o[4], o[5]); w.w = cvt_pk_bf16(o[6], o[7]);
                    *(u32x4*)mp = w; } }
    }
};
}

__device__ __forceinline__ void tr_item(const float* W, int lds_, int k0, int n0s, bf16_t* WT, int ldd, int n0d, int kd0, const float* ksc, float* scr, int lane) {
#pragma unroll
    for (int i = 0; i < 8; ++i) { const int kk = 8 * i + (lane >> 3), n4 = (lane & 7) * 4;
        f32x4 v = (f32x4){0.f, 0.f, 0.f, 0.f}; if (n0s >= 0) { v = *(const f32x4*)(W + (size_t)(k0 + kk) * lds_ + n0s + n4); if (ksc) v = v * ksc[k0 + kk]; }
        float* d = scr + kk * 33 + n4; d[0] = v[0]; d[1] = v[1]; d[2] = v[2]; d[3] = v[3]; }
    asm volatile("s_waitcnt lgkmcnt(0)" ::: "memory");
    const int c = lane & 7;
#pragma unroll
    for (int j = 0; j < 4; ++j) { const int n = (lane >> 3) + 8 * j; const float* s = scr + (8 * c) * 33 + n;
        u32x4 o; o.x = cvt_pk_bf16(s[0 * 33], s[1 * 33]); o.y = cvt_pk_bf16(s[2 * 33], s[3 * 33]); o.z = cvt_pk_bf16(s[4 * 33], s[5 * 33]); o.w = cvt_pk_bf16(s[6 * 33], s[7 * 33]);
        *(u32x4*)(WT + (size_t)(n0d + n) * ldd + kd0 + 8 * c) = o; }
    asm volatile("s_waitcnt lgkmcnt(0)" ::: "memory");
}

__device__ __forceinline__ void phase0a(const Params& p, unsigned char* lds) {
    const int tid = tid_l(), lane = tid & 63, wave = tid >> 6, G = gridDim.x;
    const int gw = blockIdx.x * NWAVES + wave, NGW = G * NWAVES;
    unsigned char* ws = p.ws;
    float* scr = (float*)(lds + wave * 16384);
    constexpr int I_WIN = 152 * 16, I_WG = 96 * 16, I_WBR = 3 * 32 * 8, I_WOUT = 32 * 16, I_WUQ = 24 * 4, I_WUKV = 32 * 2, I_W2 = 16, I_A2 = 16, I_V1 = 8;
    constexpr int I_L = I_WIN + I_WG + I_WBR + I_WOUT + I_WUQ + I_WUKV + I_W2 + I_A2 + I_V1;
    for (int it = gw; it < NL * I_L; it += NGW) {
        const int l = it / I_L; int r = it - l * I_L;
        if (r < I_WIN) { const int nb = r >> 4, kb = r & 15; const int nd = nb * 32;
            int ns; if (nd < 416) ns = nd; else if (nd < 512) ns = -1; else if (nd < 3200) ns = nd - 96; else if (nd < 3328) ns = -1; else ns = nd - 224;
            tr_item(p.w_in + (size_t)l * DM * D_IN_SRC, D_IN_SRC, kb * 64, ns, (bf16_t*)(ws + OFF_WIN + l * SZ_WIN), DM, nd, kb * 64, nullptr, scr, lane); continue; }
        r -= I_WIN;
        if (r < I_WG) { const int nb = r >> 4, kb = r & 15;
            tr_item(p.w_in + (size_t)l * DM * D_IN_SRC, D_IN_SRC, kb * 64, 4640 + nb * 32, (bf16_t*)(ws + OFF_WG + l * SZ_WG), DM, nb * 32, kb * 64, nullptr, scr, lane); continue; }
        r -= I_WG;
        if (r < I_WBR) { const int n = r / 256, r2 = r - n * 256, nb = r2 >> 3, kb = r2 & 7;
            tr_item(p.w_br + ((size_t)(l * 3 + n) * 512) * DM, DM, kb * 64, nb * 32, (bf16_t*)(ws + OFF_WBR + l * SZ_WBR), 512, n * 1024 + nb * 32, kb * 64, nullptr, scr, lane); continue; }
        r -= I_WBR;
        if (r < I_WOUT) { const int nb = r >> 4, kb = r & 15;
            tr_item(p.w_out + (size_t)l * DM * DM, DM, kb * 64, nb * 32, (bf16_t*)(ws + OFF_WOUT + l * SZ_WOUT), DM, nb * 32, kb * 64, nullptr, scr, lane); continue; }
        r -= I_WOUT;
        if (r < I_WUQ) { const int nb = r >> 2, kb = r & 3;
            tr_item(p.w_uq + (size_t)l * 256 * 768, 768, kb * 64, nb * 32, (bf16_t*)(ws + OFF_WUQ + l * SZ_WUQ), 256, nb * 32, kb * 64, p.q_norm + l * 256, scr, lane); continue; }
        r -= I_WUQ;
        if (r < I_WUKV) { const int nb = r >> 1, kb = r & 1;
            tr_item(p.w_ukv + (size_t)l * 128 * 1024, 1024, kb * 64, nb * 32, (bf16_t*)(ws + OFF_WUKV + l * SZ_WUKV), 128, nb * 32, kb * 64, p.kv_norm + l * 128, scr, lane); continue; }
        r -= I_WUKV;
        if (r < I_W2) { tr_item(p.w2 + (size_t)l * 64 * 512, 512, 0, r * 32, (bf16_t*)(ws + OFF_W2T) + (size_t)l * 512 * 64, 64, r * 32, 0, nullptr, scr, lane); continue; }
        r -= I_W2;
        if (r < I_A2) { tr_item(p.a2 + (size_t)l * 64 * 512, 512, 0, r * 32, (bf16_t*)(ws + OFF_A2T) + (size_t)l * 512 * 64, 64, r * 32, 0, nullptr, scr, lane); continue; }
        r -= I_A2;
        if (l >= 1) tr_item(p.v1 + (size_t)(l - 1) * 512 * 32, 32, r * 64, 0, (bf16_t*)(ws + OFF_V1T) + (size_t)(l - 1) * 32 * 512, 512, 0, r * 64, nullptr, scr, lane);
    }
    for (int it = gw; it < NL * 12 * 8; it += NGW) {
        const int l = it / 96, r = it - l * 96, nb = r >> 3, ks = r & 7, n = nb * 256 + lane * 4;
        f32x4 a0 = (f32x4){0.f, 0.f, 0.f, 0.f}, a1 = a0, a2 = a0, a3 = a0;
        const float* w = p.w_ada + (size_t)l * DM * 3072 + n;
#pragma unroll 8
        for (int k = ks * 128; k < ks * 128 + 128; ++k) { const f32x4 wv = *(const f32x4*)(w + (size_t)k * 3072);
            a0 += wv * siluf_(p.c[k]); a1 += wv * siluf_(p.c[DM + k]); a2 += wv * siluf_(p.c[2 * DM + k]); a3 += wv * siluf_(p.c[3 * DM + k]); }
        float* mp = (float*)(ws + OFF_MODP) + ((size_t)(l * 8 + ks) * 4) * 3072 + n;
        *(f32x4*)mp = a0; *(f32x4*)(mp + 3072) = a1; *(f32x4*)(mp + 2 * 3072) = a2; *(f32x4*)(mp + 3 * 3072) = a3;
    }
    const size_t gt = (size_t)blockIdx.x * NTHREADS + tid, GT = (size_t)G * NTHREADS;
    for (size_t i = gt; i < (size_t)3 * 512 * 32; i += GT) { const int l1 = (int)(i / (512 * 32)), r = (int)(i % (512 * 32)), c = r >> 5, k = r & 31;
        ((bf16_t*)(ws + OFF_V2T))[i] = f2bf(p.v2[(size_t)l1 * 32 * 512 + k * 512 + c]); }
    for (size_t i = gt; i < (size_t)NL * 4 * 128 * 128; i += GT) { const int s = (int)(i & 127), t = (int)((i >> 7) & 127);
        ((bf16_t*)(ws + OFF_WS))[i] = f2bf(((s >> 6) <= (t >> 6)) ? p.w_s[i] : 0.f); }
    for (size_t i = gt; i < (size_t)M_TOK * 16; i += GT) { const int t = (int)(i >> 4), k = (int)(i & 15);
        const float inv = powf(10000.f, -(float)(2 * k) / 32.f); const float ang = (float)p.pos[t] * inv;
        ((float*)(ws + OFF_ROPE))[i] = cosf(ang); ((float*)(ws + OFF_ROPE))[(size_t)M_TOK * 16 + i] = sinf(ang); }
    for (size_t i = gt; i < (size_t)M_TOK * DM / 4; i += GT) ((f32x4*)p.out)[i] = ((const f32x4*)p.x)[i];
}

__device__ __forceinline__ f32x4 mod4(const Params& p, int l, int b, int kind, int col) {
    const float* mp = (const float*)(p.ws + OFF_MODP) + ((size_t)(l * 8) * 4 + b) * 3072 + kind * DM + col;
    f32x4 s = *(const f32x4*)(p.b_ada + (size_t)l * 3072 + kind * DM + col);
#pragma unroll
    for (int ks = 0; ks < 8; ++ks) s += *(const f32x4*)(mp + (size_t)ks * 4 * 3072);
    return s;
}
__device__ __forceinline__ void phase_modt(const Params& p) {
    float* T = (float*)(p.ws + OFF_MODT);
    for (int i = blockIdx.x * NTHREADS + tid_l(); i < NL * 4 * 256; i += gridDim.x * NTHREADS) { const int l = i / 1024, r = i - l * 1024, b = r >> 8, col = (r & 255) * 4;
        const f32x4 sh = mod4(p, l, b, 0, col), sc = mod4(p, l, b, 1, col), gt = mod4(p, l, b, 2, col);
        const f32x4 g = *(const f32x4*)(p.pre_g + (size_t)l * DM + col), pg = *(const f32x4*)(p.post_g + (size_t)l * DM + col);
        const size_t o = ((size_t)(l * 4 + b)) * 1024 + col;
        *(f32x4*)(T + o) = g * (sc + 1.f); *(f32x4*)(T + (size_t)NL * 4096 + o) = sh; *(f32x4*)(T + (size_t)2 * NL * 4096 + o) = gt * pg; }
}
__device__ __forceinline__ void normmod_row(const Params& p, int l, int row, const f32x4 (&v)[4], int lane) {
    float ss = 0.f;
#pragma unroll
    for (int j = 0; j < 4; ++j) ss += v[j][0] * v[j][0] + v[j][1] * v[j][1] + v[j][2] * v[j][2] + v[j][3] * v[j][3];
    const float rstd = rsqrtf(wave_sum(ss) * (1.f / DM) + 1e-6f);
    const int b = row / SEQ;
    const float* T = (const float*)(p.ws + OFF_MODT) + ((size_t)(l * 4 + b)) * 1024;
    bf16_t* hrow = (bf16_t*)(p.ws + OFF_H) + (size_t)row * DM;
#pragma unroll
    for (int j = 0; j < 4; ++j) { const int col = 4 * lane + 256 * j;
        const f32x4 a = *(const f32x4*)(T + col), sh = *(const f32x4*)(T + (size_t)NL * 4096 + col);
        f32x4 o = v[j] * rstd * a + sh;
        *(u32x2*)(hrow + col) = pack4(o); }
}
__device__ __forceinline__ void phase0b(const Params& p) {
    const int tidq = tid_l(); const int lane = tidq & 63, gw = blockIdx.x * NWAVES + (tidq >> 6), NGW = gridDim.x * NWAVES;
    for (int row = gw; row < M_TOK; row += NGW) { f32x4 v[4];
#pragma unroll
        for (int j = 0; j < 4; ++j) v[j] = *(const f32x4*)(p.out + (size_t)row * DM + 4 * lane + 256 * j);
        normmod_row(p, 0, row, v, lane); }
}
__device__ __forceinline__ void phase_final(const Params& p, int l) {
    const int tidq = tid_l(); const int lane = tidq & 63, gw = blockIdx.x * NWAVES + (tidq >> 6), NGW = gridDim.x * NWAVES;
    const bf16_t* Y = (const bf16_t*)(p.ws + OFF_R3 + R3_Y);
    for (int row = gw; row < M_TOK; row += NGW) {
        f32x4 y[4]; float ss = 0.f;
#pragma unroll
        for (int j = 0; j < 4; ++j) { y[j] = unpack4(*(const u32x2*)(Y + (size_t)row * DM + 4 * lane + 256 * j)); ss += y[j][0] * y[j][0] + y[j][1] * y[j][1] + y[j][2] * y[j][2] + y[j][3] * y[j][3]; }
        const float rstd = rsqrtf(wave_sum(ss) * (1.f / DM) + 1e-6f);
        const int b = row / SEQ; f32x4 v[4];
        const float* GG = (const float*)(p.ws + OFF_MODT) + (size_t)2 * NL * 4096 + ((size_t)(l * 4 + b)) * 1024;
#pragma unroll
        for (int j = 0; j < 4; ++j) { const int col = 4 * lane + 256 * j;
            const f32x4 xg = *(const f32x4*)(p.out + (size_t)row * DM + col), gg = *(const f32x4*)(GG + col);
            v[j] = xg + gg * (y[j] * rstd);
            *(f32x4*)(p.out + (size_t)row * DM + col) = v[j]; }
        if (l + 1 < NL) normmod_row(p, l + 1, row, v, lane);
    }
}

__device__ __forceinline__ void mla_prep_item(const Params& p, int l, int item, unsigned char* lds) {
    const int tid = tid_l(), lane = tid & 63, wave = tid >> 6, fr = lane & 15, fq = lane >> 4;
    const int t0 = item * 64;
    const bf16_t* P1 = (const bf16_t*)(p.ws + OFF_R1);
    bf16_t* Q = (bf16_t*)(p.ws + OFF_R3 + R3_Q); bf16_t* Kf = (bf16_t*)(p.ws + OFF_R3 + R3_KF); bf16_t* Vt = (bf16_t*)(p.ws + OFF_R3 + R3_VT);
    const bf16_t* Wuq = (const bf16_t*)(p.ws + OFF_WUQ + l * SZ_WUQ); const bf16_t* Wukv = (const bf16_t*)(p.ws + OFF_WUKV + l * SZ_WUKV);
    const float* COS = (const float*)(p.ws + OFF_ROPE); const float* SIN = COS + (size_t)M_TOK * 16;
    float* rq = (float*)lds; float* rkv = rq + 64;
    __syncthreads();
    { const int row = tid >> 3, part = tid & 7; const bf16_t* pr = P1 + (size_t)(t0 + row) * NP1;
        float sq = 0.f, sk = 0.f;
#pragma unroll
        for (int i = 0; i < 4; ++i) { const u32x4 u = *(const u32x4*)(pr + C_QLAT + part * 32 + i * 8);
            sq += bf_lo(u.x) * bf_lo(u.x) + bf_hi(u.x) * bf_hi(u.x) + bf_lo(u.y) * bf_lo(u.y) + bf_hi(u.y) * bf_hi(u.y) + bf_lo(u.z) * bf_lo(u.z) + bf_hi(u.z) * bf_hi(u.z) + bf_lo(u.w) * bf_lo(u.w) + bf_hi(u.w) * bf_hi(u.w); }
#pragma unroll
        for (int i = 0; i < 2; ++i) { const u32x4 u = *(const u32x4*)(pr + C_KVLAT + part * 16 + i * 8);
            sk += bf_lo(u.x) * bf_lo(u.x) + bf_hi(u.x) * bf_hi(u.x) + bf_lo(u.y) * bf_lo(u.y) + bf_hi(u.y) * bf_hi(u.y) + bf_lo(u.z) * bf_lo(u.z) + bf_hi(u.z) * bf_hi(u.z) + bf_lo(u.w) * bf_lo(u.w) + bf_hi(u.w) * bf_hi(u.w); }
        sq += __shfl_xor(sq, 1); sq += __shfl_xor(sq, 2); sq += __shfl_xor(sq, 4);
        sk += __shfl_xor(sk, 1); sk += __shfl_xor(sk, 2); sk += __shfl_xor(sk, 4);
        if (part == 0) { rq[row] = rsqrtf(sq * (1.f / 256.f) + 1e-6f); rkv[row] = rsqrtf(sk * (1.f / 128.f) + 1e-6f); }
        const int i2 = part * 2; const int t = t0 + row;
        const unsigned u1 = *(const unsigned*)(pr + C_KROPE + i2), u2 = *(const unsigned*)(pr + C_KROPE + 16 + i2);
        const float c0 = COS[(size_t)t * 16 + i2], c1 = COS[(size_t)t * 16 + i2 + 1], s0 = SIN[(size_t)t * 16 + i2], s1 = SIN[(size_t)t * 16 + i2 + 1];
        const float x10 = bf_lo(u1), x11 = bf_hi(u1), x20 = bf_lo(u2), x21 = bf_hi(u2);
        const unsigned o1 = cvt_pk_bf16(x10 * c0 - x20 * s0, x11 * c1 - x21 * s1), o2 = cvt_pk_bf16(x20 * c0 + x10 * s0, x21 * c1 + x11 * s1);
#pragma unroll
        for (int h = 0; h < 8; ++h) { *(unsigned*)(Kf + (size_t)t * 768 + h * 96 + 64 + i2) = o1; *(unsigned*)(Kf + (size_t)t * 768 + h * 96 + 80 + i2) = o2; }
    }
    __syncthreads();
    { const int head = wave;
        f32x4 acc[4][6];
#pragma unroll
        for (int rt = 0; rt < 4; ++rt)
#pragma unroll
            for (int ct = 0; ct < 6; ++ct) acc[rt][ct] = (f32x4){0.f, 0.f, 0.f, 0.f};
        const bf16_t* wp = Wuq + (size_t)(head * 96 + fr) * 256 + fq * 8;
#pragma unroll 1
        for (int hf = 0; hf < 2; ++hf) { bf16x8 wf[6][4];
#pragma unroll
            for (int k4 = 0; k4 < 4; ++k4)
#pragma unroll
                for (int ct = 0; ct < 6; ++ct) wf[ct][k4] = ld_frag(wp + (size_t)ct * 16 * 256 + (hf * 4 + k4) * 32);
#pragma unroll
            for (int rt = 0; rt < 4; ++rt) { const bf16_t* ap = P1 + (size_t)(t0 + rt * 16 + fr) * NP1 + C_QLAT + fq * 8 + hf * 128; bf16x8 af[4];
#pragma unroll
                for (int k4 = 0; k4 < 4; ++k4) af[k4] = ld_frag(ap + k4 * 32);
#pragma unroll
                for (int k4 = 0; k4 < 4; ++k4)
#pragma unroll
                    for (int ct = 0; ct < 6; ++ct) acc[rt][ct] = MFMA(wf[ct][k4], af[k4], acc[rt][ct]); } }
#pragma unroll
        for (int rt = 0; rt < 4; ++rt) {
            const int t = t0 + rt * 16 + fr; const float rs = rq[rt * 16 + fr] * QSCALE;
            bf16_t* qp = Q + (size_t)t * 768 + head * 96 + fq * 4;
#pragma unroll
            for (int ct = 0; ct < 4; ++ct) *(u32x2*)(qp + ct * 16) = pack4(acc[rt][ct] * rs);
            const f32x4 cs = *(const f32x4*)(COS + (size_t)t * 16 + fq * 4), sn = *(const f32x4*)(SIN + (size_t)t * 16 + fq * 4);
            const f32x4 x1 = acc[rt][4] * rs, x2 = acc[rt][5] * rs;
            *(u32x2*)(qp + 64) = pack4(x1 * cs - x2 * sn); *(u32x2*)(qp + 80) = pack4(x2 * cs + x1 * sn); }
    }
    { const int head = wave; const int b = t0 / SEQ;
        const bf16_t* wp = Wukv + (size_t)(head * 128 + fr) * 128 + fq * 8;
#pragma unroll 1
        for (int part = 0; part < 2; ++part) {
            bf16x8 wf[4][4]; f32x4 ac[4][4];
#pragma unroll
            for (int ks = 0; ks < 4; ++ks)
#pragma unroll
                for (int ct = 0; ct < 4; ++ct) wf[ct][ks] = ld_frag(wp + (size_t)(part * 64 + ct * 16) * 128 + ks * 32);
#pragma unroll
            for (int rt = 0; rt < 4; ++rt) { const bf16_t* ap = P1 + (size_t)(t0 + rt * 16 + fr) * NP1 + C_KVLAT + fq * 8; bf16x8 af[4];
#pragma unroll
                for (int ks = 0; ks < 4; ++ks) af[ks] = ld_frag(ap + ks * 32);
#pragma unroll
                for (int ct = 0; ct < 4; ++ct) { ac[rt][ct] = (f32x4){0.f, 0.f, 0.f, 0.f};
#pragma unroll
                    for (int ks = 0; ks < 4; ++ks) ac[rt][ct] = part ? MFMA(af[ks], wf[ct][ks], ac[rt][ct]) : MFMA(wf[ct][ks], af[ks], ac[rt][ct]); } }
#pragma unroll
            for (int rt = 0; rt < 4; ++rt) {
                if (part == 0) { const int t = t0 + rt * 16 + fr; const float rs = rkv[rt * 16 + fr];
#pragma unroll
                    for (int ct = 0; ct < 4; ++ct) *(u32x2*)(Kf + (size_t)t * 768 + head * 96 + ct * 16 + fq * 4) = pack4(ac[rt][ct] * rs); }
                else { const f32x4 rv = *(const f32x4*)(rkv + rt * 16 + fq * 4); const int s0 = (t0 % SEQ) + rt * 16 + fq * 4;
#pragma unroll
                    for (int ct = 0; ct < 4; ++ct) *(u32x2*)(Vt + ((size_t)(b * 8 + head) * 64 + ct * 16 + fr) * SEQ + s0) = pack4(ac[rt][ct] * rv); } }
        }
    }
}

__device__ __forceinline__ void gmlp_item(const Params& p, int l, int item, unsigned char* lds, bool do_store = true) {
    const int tid = tid_l(), lane = tid & 63, wave = tid >> 6, fr = lane & 15, fq = lane >> 4;
    const int t0 = item * 128;
    const bf16_t* P1 = (const bf16_t*)(p.ws + OFF_R1); bf16_t* Z = (bf16_t*)(p.ws + OFF_Z);
    const bf16_t* Ws = (const bf16_t*)(p.ws + OFF_WS) + (size_t)l * 4 * 128 * 128;
    bf16_t* vb = (bf16_t*)lds;
    constexpr int VS = 520;
    __syncthreads();
    { const int tok = tid >> 2, qd = tid & 3; const bf16_t* pr = P1 + (size_t)(t0 + tok) * NP1 + C_GMV + qd * 128;
        float s = 0.f, s2 = 0.f;
#pragma unroll 4
        for (int i = 0; i < 16; ++i) { const u32x4 u = *(const u32x4*)(pr + i * 8); const unsigned uu[4] = {u.x, u.y, u.z, u.w};
#pragma unroll
            for (int e = 0; e < 4; ++e) { const float a = geluf_(bf_lo(uu[e])), b = geluf_(bf_hi(uu[e])); s += a + b; s2 += a * a + b * b; } }
        s += __shfl_xor(s, 1); s += __shfl_xor(s, 2); s2 += __shfl_xor(s2, 1); s2 += __shfl_xor(s2, 2);
        const float mean = s * (1.f / 512.f), var = fmaxf(s2 * (1.f / 512.f) - mean * mean, 0.f), rstd = rsqrtf(var + 1e-5f);
        const float* lg = p.ln_g + (size_t)l * 512 + qd * 128; const float* lb = p.ln_b + (size_t)l * 512 + qd * 128;
#pragma unroll 4
        for (int i = 0; i < 16; ++i) { const u32x4 u = *(const u32x4*)(pr + i * 8); const unsigned uu[4] = {u.x, u.y, u.z, u.w}; unsigned oo[4];
#pragma unroll
            for (int e = 0; e < 4; ++e) { const float a = (geluf_(bf_lo(uu[e])) - mean) * rstd * lg[i * 8 + 2 * e] + lb[i * 8 + 2 * e], b = (geluf_(bf_hi(uu[e])) - mean) * rstd * lg[i * 8 + 2 * e + 1] + lb[i * 8 + 2 * e + 1];
                oo[e] = cvt_pk_bf16(a, b); }
            *(u32x4*)(vb + (size_t)tok * VS + qd * 128 + i * 8) = (u32x4){oo[0], oo[1], oo[2], oo[3]}; }
    }
    __syncthreads();
#pragma unroll 1
    for (int g = 0; g < 4; ++g) {
        const int cbase = g * 128 + wave * 16;
        bf16x8 vfr[4];
#pragma unroll
        for (int ks = 0; ks < 4; ++ks) { bf16x8 f;
#pragma unroll
            for (int j = 0; j < 8; ++j) f[j] = (short)vb[(size_t)(ks * 32 + fq * 8 + j) * VS + cbase + fr];
            vfr[ks] = f; }
        const bf16_t* wg = Ws + (size_t)g * 128 * 128;
#pragma unroll 1
        for (int tt = 0; tt < 8; ++tt) {
            f32x4 acc = (f32x4){0.f, 0.f, 0.f, 0.f};
            const bf16_t* wp = wg + (size_t)(tt * 16 + fr) * 128 + fq * 8;
#pragma unroll
            for (int ks = 0; ks < 4; ++ks) acc = MFMA(vfr[ks], ld_frag(wp + ks * 32), acc);
            const int tl = tt * 16 + fr, t = t0 + tl, c = cbase + fq * 4;
            const float bs = p.b_s[(size_t)(l * 4 + g) * 128 + tl];
            const f32x4 u = unpack4(*(const u32x2*)(P1 + (size_t)t * NP1 + C_GMU + c));
            bf16_t* zp = Z + (size_t)t * NZ + 512 + c; const f32x4 z = unpack4(*(const u32x2*)zp);
            f32x4 o;
#pragma unroll
            for (int e = 0; e < 4; ++e) o[e] = geluf_(u[e]) * (acc[e] + bs) * siluf_(z[e]);
            if (do_store) *(u32x2*)zp = pack4(o);
        }
    }
}

__device__ __forceinline__ f32x4 mix4(const bf16_t* pr, const bf16_t* pp, bool has_prev, const float* mu) {
    const f32x4 a = unpack4(*(const u32x2*)pr); f32x4 b = (f32x4){0.f, 0.f, 0.f, 0.f}; if (has_prev) b = unpack4(*(const u32x2*)pp);
    const f32x4 m = *(const f32x4*)mu; return a + (b - a) * m;
}
__device__ __forceinline__ void rwkv_prep_item(const Params& p, int l, int item, unsigned char* lds) {
    const int tid = tid_l(), lane = tid & 63, wave = __builtin_amdgcn_readfirstlane(tid >> 6), fr = lane & 15, fq = lane >> 4;
    const int t0 = item * 64;
    const bf16_t* P1 = (const bf16_t*)(p.ws + OFF_R1);
    const float* mu = p.mu + (size_t)l * 1664 - C_RW;
    const bf16_t* W2T = (const bf16_t*)(p.ws + OFF_W2T) + (size_t)l * 512 * 64; const bf16_t* A2T = (const bf16_t*)(p.ws + OFF_A2T) + (size_t)l * 512 * 64;
    unsigned char* r2 = p.ws + OFF_R2;
    bf16_t* VF = (bf16_t*)(p.ws + OFF_VF);
    constexpr int LS = 136, TS = 40, PS = 36;
    bf16_t* LAT = (bf16_t*)lds; bf16_t* T1 = (bf16_t*)(lds + 64 * LS * 2); float* T1P = (float*)(lds + 64 * LS * 2 + 64 * TS * 2);
    __syncthreads();
    { const int tt = tid >> 3, part = tid & 7; const int t = t0 + tt; const bool hp = (t % SEQ) != 0;
        const bf16_t* pr = P1 + (size_t)t * NP1; const bf16_t* pp = pr - NP1; const int c0 = C_WLAT + part * 16;
        f32x4 x[4];
#pragma unroll
        for (int e = 0; e < 4; ++e) { x[e] = mix4(pr + c0 + e * 4, pp + c0 + e * 4, hp, mu + c0 + e * 4);
            if (part < 4) {
#pragma unroll
                for (int k = 0; k < 4; ++k) x[e][k] = tanhf(x[e][k]); } }
        u32x4 w0, w1; w0.x = cvt_pk_bf16(x[0][0], x[0][1]); w0.y = cvt_pk_bf16(x[0][2], x[0][3]); w0.z = cvt_pk_bf16(x[1][0], x[1][1]); w0.w = cvt_pk_bf16(x[1][2], x[1][3]);
        w1.x = cvt_pk_bf16(x[2][0], x[2][1]); w1.y = cvt_pk_bf16(x[2][2], x[2][3]); w1.z = cvt_pk_bf16(x[3][0], x[3][1]); w1.w = cvt_pk_bf16(x[3][2], x[3][3]);
        *(u32x4*)(LAT + tt * LS + part * 16) = w0; *(u32x4*)(LAT + tt * LS + part * 16 + 8) = w1; }
    if (l >= 1) { const int rt = wave & 3, kh = wave >> 2; const int t = t0 + rt * 16 + fr; const bool hp = (t % SEQ) != 0;
        const bf16_t* pr = P1 + (size_t)t * NP1; const bf16_t* pp = pr - NP1;
        const bf16_t* V1T = (const bf16_t*)(p.ws + OFF_V1T) + (size_t)(l - 1) * 32 * 512;
        f32x4 c0 = (f32x4){0.f, 0.f, 0.f, 0.f}, c1 = c0;
#pragma unroll 4
        for (int k8 = 0; k8 < 8; ++k8) { const int ks = kh * 8 + k8; const int cv = C_RWV + ks * 32 + fq * 8;
            const bf16x8 af = pack_frag(mix4(pr + cv, pp + cv, hp, mu + cv), mix4(pr + cv + 4, pp + cv + 4, hp, mu + cv + 4));
            c0 = MFMA(ld_frag(V1T + (size_t)fr * 512 + ks * 32 + fq * 8), af, c0); c1 = MFMA(ld_frag(V1T + (size_t)(16 + fr) * 512 + ks * 32 + fq * 8), af, c1); }
        if (kh == 1) { *(f32x4*)(T1P + (rt * 16 + fr) * PS + fq * 4) = c0; *(f32x4*)(T1P + (rt * 16 + fr) * PS + 16 + fq * 4) = c1; }
        __syncthreads();
        if (kh == 0) { c0 += *(const f32x4*)(T1P + (rt * 16 + fr) * PS + fq * 4); c1 += *(const f32x4*)(T1P + (rt * 16 + fr) * PS + 16 + fq * 4);
            *(u32x2*)(T1 + (rt * 16 + fr) * TS + fq * 4) = pack4(c0); *(u32x2*)(T1 + (rt * 16 + fr) * TS + 16 + fq * 4) = pack4(c1); }
    }
    __syncthreads();
    { const int h = wave;
        bf16x8 wa[4][2], ww[4][2], wv2[4];
#pragma unroll
        for (int ct = 0; ct < 4; ++ct) { const int crow = h * 64 + ct * 16 + fr;
#pragma unroll
            for (int ks = 0; ks < 2; ++ks) { wa[ct][ks] = ld_frag(A2T + (size_t)crow * 64 + ks * 32 + fq * 8); ww[ct][ks] = ld_frag(W2T + (size_t)crow * 64 + ks * 32 + fq * 8); }
            wv2[ct] = (bf16x8){0, 0, 0, 0, 0, 0, 0, 0};
            if (l >= 1) wv2[ct] = ld_frag((const bf16_t*)(p.ws + OFF_V2T) + (size_t)(l - 1) * 512 * 32 + (size_t)crow * 32 + fq * 8); }
#pragma unroll 1
        for (int rt = 0; rt < 4; ++rt) { const int tl = rt * 16 + fr, t = t0 + tl; const bool hp = (t % SEQ) != 0;
            const bf16_t* pr = P1 + (size_t)t * NP1; const bf16_t* pp = pr - NP1;
            const bf16x8 fw0 = ld_frag(LAT + tl * LS + fq * 8), fw1 = ld_frag(LAT + tl * LS + 32 + fq * 8), fa0 = ld_frag(LAT + tl * LS + 64 + fq * 8), fa1 = ld_frag(LAT + tl * LS + 96 + fq * 8);
            bf16x8 t1f = (bf16x8){0, 0, 0, 0, 0, 0, 0, 0}; if (l >= 1) t1f = ld_frag(T1 + tl * TS + fq * 8);
            f32x4 ksv[4]; float ss = 0.f;
#pragma unroll
            for (int ct = 0; ct < 4; ++ct) { const int c = h * 64 + ct * 16 + fq * 4;
                ksv[ct] = mix4(pr + C_RWK + c, pp + C_RWK + c, hp, mu + C_RWK + c);
                const f32x4 kr = ksv[ct] * *(const f32x4*)(p.k_k + (size_t)l * 512 + c);
                ss += kr[0] * kr[0] + kr[1] * kr[1] + kr[2] * kr[2] + kr[3] * kr[3]; }
            ss += __shfl_xor(ss, 16); ss += __shfl_xor(ss, 32);
            const float inv = 1.f / fmaxf(sqrtf(ss), 1e-12f);
            float dsum = 0.f;
#pragma unroll
            for (int ct = 0; ct < 4; ++ct) {
                f32x4 aa = (f32x4){0.f, 0.f, 0.f, 0.f}, aw = aa, avm = aa;
                aa = MFMA(wa[ct][0], fa0, aa); aa = MFMA(wa[ct][1], fa1, aa); aw = MFMA(ww[ct][0], fw0, aw); aw = MFMA(ww[ct][1], fw1, aw);
                if (l >= 1) avm = MFMA(wv2[ct], t1f, avm);
                const int c = h * 64 + ct * 16 + fq * 4; const size_t o = (size_t)t * 512 + c;
                const f32x4 rs = mix4(pr + C_RWR + c, pp + C_RWR + c, hp, mu + C_RWR + c);
                f32x4 vs = mix4(pr + C_RWV + c, pp + C_RWV + c, hp, mu + C_RWV + c);
                const f32x4 a0 = *(const f32x4*)(p.a0 + (size_t)l * 512 + c), w0 = *(const f32x4*)(p.w0 + (size_t)l * 512 + c), kkw = *(const f32x4*)(p.k_k + (size_t)l * 512 + c);
                const f32x4 ka = *(const f32x4*)(p.k_a + (size_t)l * 512 + c);
                f32x4 lw, asg;
#pragma unroll
                for (int e = 0; e < 4; ++e) { asg[e] = sigmoidf_(a0[e] + aa[e]); lw[e] = -0.6065306597126334f * sigmoidf_(w0[e] + aw[e]); }
                *(f32x4*)((float*)(r2 + R2_LW) + o) = lw;
                if (l == 0) { *(u32x2*)(VF + o) = pack4(vs); }
                else { const f32x4 vf = unpack4(*(const u32x2*)(VF + o)), v0 = *(const f32x4*)(p.v0 + (size_t)(l - 1) * 512 + c);
#pragma unroll
                    for (int e = 0; e < 4; ++e) vs[e] = vs[e] + (vf[e] - vs[e]) * sigmoidf_(v0[e] + avm[e]); }
                const f32x4 kk = ksv[ct] * kkw * inv, km = ksv[ct] * ((asg - 1.f) * ka + 1.f), bb = kk * asg;
                { const f32x4 rk = *(const f32x4*)(p.r_k + (size_t)l * 512 + c); const f32x4 pr3 = rs * km * rk; dsum += pr3[0] + pr3[1] + pr3[2] + pr3[3]; }
                *(u32x2*)((bf16_t*)(r2 + R2_R) + o) = pack4(rs); *(u32x2*)((bf16_t*)(r2 + R2_K) + o) = pack4(km); *(u32x2*)((bf16_t*)(r2 + R2_V) + o) = pack4(vs);
                *(u32x2*)((bf16_t*)(r2 + R2_KK) + o) = pack4(kk); *(u32x2*)((bf16_t*)(r2 + R2_B) + o) = pack4(bb); }
            dsum += __shfl_xor(dsum, 16); dsum += __shfl_xor(dsum, 32);
            if (fq == 0) ((float*)(p.ws + OFF_DOT))[(size_t)t * 8 + h] = dsum;
        }
    }
}

__device__ __forceinline__ void attn_item(const Params& p, int b, int h, int qb, unsigned char* lds, bool do_store = true) {
    const int tid = tid_l(), lane = tid & 63, wave = tid >> 6, fr = lane & 15, fq = lane >> 4;
    const bf16_t* Q = (const bf16_t*)(p.ws + OFF_R3 + R3_Q); const bf16_t* Kf = (const bf16_t*)(p.ws + OFF_R3 + R3_KF); const bf16_t* Vt = (const bf16_t*)(p.ws + OFF_R3 + R3_VT);
    bf16_t* Z = (bf16_t*)(p.ws + OFF_Z);
    constexpr int KS = 104, VS = 72, KB = 64 * KS * 2, VB = 64 * VS * 2, BUF = KB + VB;
    const int nkt = 4 * qb + 4, mykt = 4 * qb + (wave >> 1) + 1;
    const int trow0 = b * SEQ + qb * 256 + wave * 32 + fr;
    bf16x8 qf[2][3];
#pragma unroll
    for (int r = 0; r < 2; ++r)
#pragma unroll
        for (int ks = 0; ks < 3; ++ks) qf[r][ks] = ld_frag(Q + (size_t)(trow0 + r * 16) * 768 + h * 96 + ks * 32 + fq * 8);
    const bf16_t* kg = Kf + (size_t)(b * SEQ) * 768 + h * 96; const bf16_t* vg = Vt + (size_t)(b * 8 + h) * 64 * SEQ;
    const int kr0 = tid / 12, kc0 = tid % 12, kr1 = (tid + 512) / 12, kc1 = (tid + 512) % 12, vd = tid >> 3, vc = tid & 7;
    u32x4 pk0, pk1 = (u32x4){0, 0, 0, 0}, pv;
    __syncthreads();
    pk0 = *(const u32x4*)(kg + (size_t)kr0 * 768 + kc0 * 8); if (tid < 256) pk1 = *(const u32x4*)(kg + (size_t)kr1 * 768 + kc1 * 8);
    pv = *(const u32x4*)(vg + (size_t)vd * SEQ + vc * 8);
    { bf16_t* ks_ = (bf16_t*)lds; bf16_t* vs_ = (bf16_t*)(lds + KB);
        *(u32x4*)(ks_ + kr0 * KS + kc0 * 8) = pk0; if (tid < 256) *(u32x4*)(ks_ + kr1 * KS + kc1 * 8) = pk1; *(u32x4*)(vs_ + vd * VS + vc * 8) = pv; }
    __syncthreads();
    f32x4 O[2][4]; float m[2] = {-1e30f, -1e30f}, lsum[2] = {0.f, 0.f};
#pragma unroll
    for (int r = 0; r < 2; ++r)
#pragma unroll
        for (int d = 0; d < 4; ++d) O[r][d] = (f32x4){0.f, 0.f, 0.f, 0.f};
#pragma unroll 1
    for (int kt = 0; kt < nkt; ++kt) {
        const bool pre = (kt + 1 < nkt);
        if (pre) { const size_t ko = (size_t)(kt + 1) * 64;
            pk0 = *(const u32x4*)(kg + (ko + kr0) * 768 + kc0 * 8); if (tid < 256) pk1 = *(const u32x4*)(kg + (ko + kr1) * 768 + kc1 * 8);
            pv = *(const u32x4*)(vg + (size_t)vd * SEQ + ko + vc * 8); }
        if (kt < mykt) {
            const bf16_t* ks_ = (const bf16_t*)(lds + (kt & 1) * BUF); const bf16_t* vs_ = (const bf16_t*)(lds + (kt & 1) * BUF + KB);
            f32x4 s[2][4];
#pragma unroll
            for (int c4 = 0; c4 < 4; ++c4) { s[0][c4] = (f32x4){0.f, 0.f, 0.f, 0.f}; s[1][c4] = s[0][c4];
#pragma unroll
                for (int ks = 0; ks < 3; ++ks) { const bf16x8 kf = ld_frag(ks_ + (c4 * 16 + fr) * KS + ks * 32 + fq * 8);
                    s[0][c4] = MFMA(kf, qf[0][ks], s[0][c4]); s[1][c4] = MFMA(kf, qf[1][ks], s[1][c4]); } }
            bf16x8 pf[2][2];
#pragma unroll
            for (int r = 0; r < 2; ++r) {
                float mx = -1e30f;
#pragma unroll
                for (int c4 = 0; c4 < 4; ++c4) mx = fmaxf(fmaxf(fmaxf(s[r][c4][0], s[r][c4][1]), fmaxf(s[r][c4][2], s[r][c4][3])), mx);
                mx = fmaxf(mx, __shfl_xor(mx, 16)); mx = fmaxf(mx, __shfl_xor(mx, 32));
                const float mn = fmaxf(m[r], mx), alpha = exp2f(m[r] - mn); m[r] = mn;
                float ps = 0.f;
#pragma unroll
                for (int c4 = 0; c4 < 4; ++c4)
#pragma unroll
                    for (int e = 0; e < 4; ++e) { s[r][c4][e] = exp2f(s[r][c4][e] - mn); ps += s[r][c4][e]; }
                lsum[r] = lsum[r] * alpha + ps;
#pragma unroll
                for (int d = 0; d < 4; ++d) O[r][d] = O[r][d] * alpha;
                pf[r][0] = pack_frag(s[r][0], s[r][1]); pf[r][1] = pack_frag(s[r][2], s[r][3]); }
#pragma unroll
            for (int d = 0; d < 4; ++d) { const bf16_t* vp = vs_ + (d * 16 + fr) * VS + fq * 4;
                const bf16x8 v0 = join_frag(*(const u32x2*)(vp), *(const u32x2*)(vp + 16)), v1 = join_frag(*(const u32x2*)(vp + 32), *(const u32x2*)(vp + 48));
#pragma unroll
                for (int r = 0; r < 2; ++r) { O[r][d] = MFMA(v0, pf[r][0], O[r][d]); O[r][d] = MFMA(v1, pf[r][1], O[r][d]); } }
        }
        if (pre) { bf16_t* ks_ = (bf16_t*)(lds + ((kt + 1) & 1) * BUF); bf16_t* vs_ = (bf16_t*)(lds + ((kt + 1) & 1) * BUF + KB);
            *(u32x4*)(ks_ + kr0 * KS + kc0 * 8) = pk0; if (tid < 256) *(u32x4*)(ks_ + kr1 * KS + kc1 * 8) = pk1; *(u32x4*)(vs_ + vd * VS + vc * 8) = pv; }
        __syncthreads();
    }
    if (do_store)
#pragma unroll
    for (int r = 0; r < 2; ++r) { float ls = lsum[r]; ls += __shfl_xor(ls, 16); ls += __shfl_xor(ls, 32); const float il = 1.f / ls;
#pragma unroll
        for (int d = 0; d < 4; ++d) { bf16_t* zp = Z + (size_t)(trow0 + r * 16) * NZ + h * 64 + d * 16 + fq * 4; const f32x4 z = unpack4(*(const u32x2*)zp);
            f32x4 o;
#pragma unroll
            for (int e = 0; e < 4; ++e) o[e] = O[r][d][e] * il * siluf_(z[e]);
            *(u32x2*)zp = pack4(o); } }
}

__device__ __forceinline__ void scan_item(const Params& p, int l, int bh, unsigned char* lds) {
    const int tid = tid_l(), b = bh >> 3, h = bh & 7;
    const unsigned char* r2 = p.ws + OFF_R2; bf16_t* Z = (bf16_t*)(p.ws + OFF_Z);
    float* Lw = (float*)lds; float* La = Lw + 4096; float* Lb = La + 4096; float* Lk = Lb + 4096; float* Lr = Lk + 4096; float* Lv = Lr + 4096; float* Ly = Lv + 4096;
    const int i = tid >> 3, jp = tid & 7;
    float st[8];
#pragma unroll
    for (int e = 0; e < 8; ++e) st[e] = 0.f;
    const int et = tid >> 3, ep = tid & 7;
#pragma unroll 1
    for (int ck = 0; ck < SEQ / 64; ++ck) {
        const size_t tg = (size_t)b * SEQ + ck * 64 + et; const size_t o = tg * 512 + h * 64 + ep * 8;
        __syncthreads();
        { const u32x4 ur = *(const u32x4*)((const bf16_t*)(r2 + R2_R) + o), uk = *(const u32x4*)((const bf16_t*)(r2 + R2_K) + o), uv = *(const u32x4*)((const bf16_t*)(r2 + R2_V) + o),
                      ukk = *(const u32x4*)((const bf16_t*)(r2 + R2_KK) + o), ub = *(const u32x4*)((const bf16_t*)(r2 + R2_B) + o);
            const f32x4 l0 = *(const f32x4*)((const float*)(r2 + R2_LW) + o), l1 = *(const f32x4*)((const float*)(r2 + R2_LW) + o + 4);
            const int lo = et * 64 + ep * 8;
            *(f32x4*)(Lw + lo) = (f32x4){__expf(l0[0]), __expf(l0[1]), __expf(l0[2]), __expf(l0[3])}; *(f32x4*)(Lw + lo + 4) = (f32x4){__expf(l1[0]), __expf(l1[1]), __expf(l1[2]), __expf(l1[3])};
            *(f32x4*)(La + lo) = (f32x4){-bf_lo(ukk.x), -bf_hi(ukk.x), -bf_lo(ukk.y), -bf_hi(ukk.y)}; *(f32x4*)(La + lo + 4) = (f32x4){-bf_lo(ukk.z), -bf_hi(ukk.z), -bf_lo(ukk.w), -bf_hi(ukk.w)};
            *(f32x4*)(Lb + lo) = (f32x4){bf_lo(ub.x), bf_hi(ub.x), bf_lo(ub.y), bf_hi(ub.y)}; *(f32x4*)(Lb + lo + 4) = (f32x4){bf_lo(ub.z), bf_hi(ub.z), bf_lo(ub.w), bf_hi(ub.w)};
            *(f32x4*)(Lk + lo) = (f32x4){bf_lo(uk.x), bf_hi(uk.x), bf_lo(uk.y), bf_hi(uk.y)}; *(f32x4*)(Lk + lo + 4) = (f32x4){bf_lo(uk.z), bf_hi(uk.z), bf_lo(uk.w), bf_hi(uk.w)};
            *(f32x4*)(Lr + lo) = (f32x4){bf_lo(ur.x), bf_hi(ur.x), bf_lo(ur.y), bf_hi(ur.y)}; *(f32x4*)(Lr + lo + 4) = (f32x4){bf_lo(ur.z), bf_hi(ur.z), bf_lo(ur.w), bf_hi(ur.w)};
            *(f32x4*)(Lv + lo) = (f32x4){bf_lo(uv.x), bf_hi(uv.x), bf_lo(uv.y), bf_hi(uv.y)}; *(f32x4*)(Lv + lo + 4) = (f32x4){bf_lo(uv.z), bf_hi(uv.z), bf_lo(uv.w), bf_hi(uv.w)};
        }
        __syncthreads();
#pragma unroll 1
        for (int t = 0; t < 64; ++t) { const int lo = t * 64 + jp * 8;
            const f32x4 w0 = *(const f32x4*)(Lw + lo), w1 = *(const f32x4*)(Lw + lo + 4), a0 = *(const f32x4*)(La + lo), a1 = *(const f32x4*)(La + lo + 4), b0 = *(const f32x4*)(Lb + lo), b1 = *(const f32x4*)(Lb + lo + 4),
                        k0 = *(const f32x4*)(Lk + lo), k1 = *(const f32x4*)(Lk + lo + 4), r0 = *(const f32x4*)(Lr + lo), r1 = *(const f32x4*)(Lr + lo + 4);
            const float vi = Lv[t * 64 + i];
            float sa = st[0] * a0[0] + st[1] * a0[1] + st[2] * a0[2] + st[3] * a0[3] + st[4] * a1[0] + st[5] * a1[1] + st[6] * a1[2] + st[7] * a1[3];
            sa += __shfl_xor(sa, 1); sa += __shfl_xor(sa, 2); sa += __shfl_xor(sa, 4);
            st[0] = st[0] * w0[0] + sa * b0[0] + vi * k0[0]; st[1] = st[1] * w0[1] + sa * b0[1] + vi * k0[1]; st[2] = st[2] * w0[2] + sa * b0[2] + vi * k0[2]; st[3] = st[3] * w0[3] + sa * b0[3] + vi * k0[3];
            st[4] = st[4] * w1[0] + sa * b1[0] + vi * k1[0]; st[5] = st[5] * w1[1] + sa * b1[1] + vi * k1[1]; st[6] = st[6] * w1[2] + sa * b1[2] + vi * k1[2]; st[7] = st[7] * w1[3] + sa * b1[3] + vi * k1[3];
            float y = st[0] * r0[0] + st[1] * r0[1] + st[2] * r0[2] + st[3] * r0[3] + st[4] * r1[0] + st[5] * r1[1] + st[6] * r1[2] + st[7] * r1[3];
            y += __shfl_xor(y, 1); y += __shfl_xor(y, 2); y += __shfl_xor(y, 4);
            if (jp == 0) Ly[t * 64 + i] = y;
        }
        __syncthreads();
        { const int lo = et * 64 + ep * 8;
            const f32x4 y0 = *(const f32x4*)(Ly + lo), y1 = *(const f32x4*)(Ly + lo + 4), r0 = *(const f32x4*)(Lr + lo), r1 = *(const f32x4*)(Lr + lo + 4), k0 = *(const f32x4*)(Lk + lo), k1 = *(const f32x4*)(Lk + lo + 4),
                        v0 = *(const f32x4*)(Lv + lo), v1 = *(const f32x4*)(Lv + lo + 4);
            const f32x4 rk0 = *(const f32x4*)(p.r_k + (size_t)l * 512 + h * 64 + ep * 8), rk1 = *(const f32x4*)(p.r_k + (size_t)l * 512 + h * 64 + ep * 8 + 4);
            float s = y0[0] + y0[1] + y0[2] + y0[3] + y1[0] + y1[1] + y1[2] + y1[3];
            float dot = r0[0] * k0[0] * rk0[0] + r0[1] * k0[1] * rk0[1] + r0[2] * k0[2] * rk0[2] + r0[3] * k0[3] * rk0[3] + r1[0] * k1[0] * rk1[0] + r1[1] * k1[1] * rk1[1] + r1[2] * k1[2] * rk1[2] + r1[3] * k1[3] * rk1[3];
            s += __shfl_xor(s, 1); s += __shfl_xor(s, 2); s += __shfl_xor(s, 4);
            dot += __shfl_xor(dot, 1); dot += __shfl_xor(dot, 2); dot += __shfl_xor(dot, 4);
            const float mean = s * (1.f / 64.f);
            const f32x4 d0 = y0 - mean, d1 = y1 - mean;
            float q = d0[0] * d0[0] + d0[1] * d0[1] + d0[2] * d0[2] + d0[3] * d0[3] + d1[0] * d1[0] + d1[1] * d1[1] + d1[2] * d1[2] + d1[3] * d1[3];
            q += __shfl_xor(q, 1); q += __shfl_xor(q, 2); q += __shfl_xor(q, 4);
            const float rstd = rsqrtf(q * (1.f / 64.f) + 64e-5f);
            const f32x4 g0 = *(const f32x4*)(p.lnx_g + (size_t)l * 512 + h * 64 + ep * 8), g1 = *(const f32x4*)(p.lnx_g + (size_t)l * 512 + h * 64 + ep * 8 + 4),
                        e0 = *(const f32x4*)(p.lnx_b + (size_t)l * 512 + h * 64 + ep * 8), e1 = *(const f32x4*)(p.lnx_b + (size_t)l * 512 + h * 64 + ep * 8 + 4);
            bf16_t* zp = Z + tg * NZ + 1024 + h * 64 + ep * 8; const u32x4 zu = *(const u32x4*)zp;
            const f32x4 o0 = d0 * rstd * g0 + e0 + v0 * dot, o1 = d1 * rstd * g1 + e1 + v1 * dot;
            u32x4 w; w.x = cvt_pk_bf16(o0[0] * siluf_(bf_lo(zu.x)), o0[1] * siluf_(bf_hi(zu.x))); w.y = cvt_pk_bf16(o0[2] * siluf_(bf_lo(zu.y)), o0[3] * siluf_(bf_hi(zu.y)));
            w.z = cvt_pk_bf16(o1[0] * siluf_(bf_lo(zu.z)), o1[1] * siluf_(bf_hi(zu.z))); w.w = cvt_pk_bf16(o1[2] * siluf_(bf_lo(zu.w)), o1[3] * siluf_(bf_hi(zu.w)));
            *(u32x4*)zp = w; }
    }
}


constexpr int MS = 72;
__device__ __forceinline__ f32x4 nt_tile(const bf16_t* Am, int arow, const bf16_t* Bm, int brow, f32x4 acc, int fq) {
    acc = MFMA(ld_frag(Am + arow * MS + fq * 8), ld_frag(Bm + brow * MS + fq * 8), acc);
    acc = MFMA(ld_frag(Am + arow * MS + 32 + fq * 8), ld_frag(Bm + brow * MS + 32 + fq * 8), acc);
    return acc;
}
#if PROBE_SCAN
#define CHKF_OLD(ptr, n, bit) do { unsigned _c = 0u; for (int _i = tid; _i < (n); _i += NTHREADS) { const float _a = (ptr)[_i]; if (!(fabsf(_a) < 1e30f)) _c = (bit); } if (_c) atomicOr((unsigned*)(p.ws + WS_END + 5 * MiB), _c); } while (0)
#define CHKB_OLD(ptr, bit) do { unsigned _c = 0u; for (int _i = tid; _i < 4096; _i += NTHREADS) { const float _a = bf2f((ptr)[(_i >> 6) * MS + (_i & 63)]); if (!(fabsf(_a) < 1e30f)) _c = (bit); } if (_c) atomicOr((unsigned*)(p.ws + WS_END + 5 * MiB), _c); } while (0)
#endif
#define CHKF(ptr, n, bit)
#define CHKB(ptr, bit)
struct ChunkIn { u32x4 ur, uk, uv, ukk, ub; f32x4 lwa, lwb; };
__device__ __forceinline__ void chunk_load(const Params& p, int item, ChunkIn& in, int tid) {
    const int bh = item >> 6, ck = item & 63, b = bh >> 3, h = bh & 7;
    const size_t tok0 = (size_t)b * SEQ + ck * 64;
    const unsigned char* r2 = p.ws + OFF_R2; const float* LWg = (const float*)(r2 + R2_LW);
    const int t = tid & 63, j0 = (tid >> 6) * 8; const size_t o = (tok0 + t) * 512 + h * 64 + j0;
    in.ur = *(const u32x4*)((const bf16_t*)(r2 + R2_R) + o); in.uk = *(const u32x4*)((const bf16_t*)(r2 + R2_K) + o); in.uv = *(const u32x4*)((const bf16_t*)(r2 + R2_V) + o);
    in.ukk = *(const u32x4*)((const bf16_t*)(r2 + R2_KK) + o); in.ub = *(const u32x4*)((const bf16_t*)(r2 + R2_B) + o);
    in.lwa = *(const f32x4*)(LWg + o); in.lwb = *(const f32x4*)(LWg + o + 4);
}
__device__ __forceinline__ void chunk_item(const Params& p, int item, int next_item, ChunkIn& in, unsigned char* lds) {
    const int tid = tid_l(), lane = tid & 63, wave = __builtin_amdgcn_readfirstlane(tid >> 6), fr = lane & 15, fq = lane >> 4;
    const int bh = item >> 6, ck = item & 63, b = bh >> 3, h = bh & 7;
    const size_t tok0 = (size_t)b * SEQ + ck * 64;
    const unsigned char* r2 = p.ws + OFF_R2; unsigned char* r1 = p.ws + OFF_R1;
    float* CUM = (float*)lds; float* TF = CUM + 4096; float* XB = TF + 4096; float* TOT = XB + 1024;
    bf16_t* MB = (bf16_t*)(lds + 38912);
    bf16_t *AT_ = MB, *BT_ = MB + 1 * 64 * MS, *KT_ = MB + 2 * 64 * MS, *RT_ = MB + 3 * 64 * MS, *ATT = MB + 4 * 64 * MS, *VT = MB + 5 * 64 * MS, *KHT = MB + 6 * 64 * MS, *BHT = MB + 7 * 64 * MS,
           *MAK = MB + 8 * 64 * MS, *MRB = MB + 9 * 64 * MS, *MRK = MB + 10 * 64 * MS, *TB = MB + 11 * 64 * MS;
    bf16_t *MVT = AT_, *TAT = BT_, *W1T = KT_;
    const float* LWg = (const float*)(r2 + R2_LW);
    __syncthreads();
    { const int t = tid & 63, j0 = (tid >> 6) * 8;
        const u32x4 ur = in.ur, uk = in.uk, uv = in.uv, ukk = in.ukk, ub = in.ub; const float lwl[8] = {in.lwa[0], in.lwa[1], in.lwa[2], in.lwa[3], in.lwb[0], in.lwb[1], in.lwb[2], in.lwb[3]};
        float cml[8], cCl[8];
#pragma unroll
        for (int e = 0; e < 8; ++e) cml[e] = lwl[e];
#pragma unroll
        for (int d = 1; d < 64; d <<= 1)
#pragma unroll
            for (int e = 0; e < 8; ++e) { const float o2 = __shfl_up(cml[e], d); cml[e] += (t >= d) ? o2 : 0.f; }
#pragma unroll
        for (int e = 0; e < 8; ++e) cCl[e] = __shfl(cml[e], 63);
        const unsigned rr[4] = {ur.x, ur.y, ur.z, ur.w}, kr[4] = {uk.x, uk.y, uk.z, uk.w}, vr[4] = {uv.x, uv.y, uv.z, uv.w}, qr[4] = {ukk.x, ukk.y, ukk.z, ukk.w}, br[4] = {ub.x, ub.y, ub.z, ub.w};
        unsigned oa[4], ob[4], ok[4], orr[4];
#pragma unroll
        for (int e2 = 0; e2 < 4; ++e2) { float va[2], vb[2], vk[2], vrr[2];
#pragma unroll
            for (int hh = 0; hh < 2; ++hh) { const int e = 2 * e2 + hh;
                const float cm = cml[e], lwv = lwl[e], cC = cCl[e];
                const float rv = hh ? bf_hi(rr[e2]) : bf_lo(rr[e2]), kv = hh ? bf_hi(kr[e2]) : bf_lo(kr[e2]), vv = hh ? bf_hi(vr[e2]) : bf_lo(vr[e2]), qv = hh ? bf_hi(qr[e2]) : bf_lo(qr[e2]), bv = hh ? bf_hi(br[e2]) : bf_lo(br[e2]);
                const float en = __expf(-cm), eh = __expf(cC - cm);
                va[hh] = -qv * __expf(cm - lwv); vb[hh] = bv * en; vk[hh] = kv * en; vrr[hh] = rv * __expf(cm);
                ATT[(j0 + e) * MS + t] = f2bf(va[hh]); VT[(j0 + e) * MS + t] = f2bf(vv); KHT[(j0 + e) * MS + t] = f2bf(kv * eh); BHT[(j0 + e) * MS + t] = f2bf(bv * eh);
                if (t == 63) ((float*)(r1 + R1_PC))[(size_t)item * 64 + j0 + e] = __expf(cC); }
            oa[e2] = cvt_pk_bf16(va[0], va[1]); ob[e2] = cvt_pk_bf16(vb[0], vb[1]); ok[e2] = cvt_pk_bf16(vk[0], vk[1]); orr[e2] = cvt_pk_bf16(vrr[0], vrr[1]); }
        *(u32x4*)(AT_ + t * MS + j0) = (u32x4){oa[0], oa[1], oa[2], oa[3]}; *(u32x4*)(BT_ + t * MS + j0) = (u32x4){ob[0], ob[1], ob[2], ob[3]};
        *(u32x4*)(KT_ + t * MS + j0) = (u32x4){ok[0], ok[1], ok[2], ok[3]}; *(u32x4*)(RT_ + t * MS + j0) = (u32x4){orr[0], orr[1], orr[2], orr[3]};
    }
    if (next_item >= 0) chunk_load(p, next_item, in, tid);
    __syncthreads();
#pragma unroll 1
    for (int x = 0; x < 8; ++x) { const int q = wave * 8 + x, mat = q >> 4, tm = (q >> 2) & 3, tn = q & 3;
        const bf16_t* Am = (mat & 1) ? KT_ : BT_; const bf16_t* Bm = (mat & 2) ? RT_ : AT_;
        f32x4 acc = nt_tile(Am, tm * 16 + fr, Bm, tn * 16 + fr, (f32x4){0.f, 0.f, 0.f, 0.f}, fq);
        const int t = tn * 16 + fr, s0 = tm * 16 + fq * 4;
#pragma unroll
        for (int e = 0; e < 4; ++e) { const bool keep = (mat & 2) ? (s0 + e <= t) : (s0 + e < t); acc[e] = keep ? acc[e] : 0.f; }
        if (mat == 0) *(f32x4*)(CUM + t * 64 + s0) = acc;
        else { bf16_t* Om = (mat == 1) ? MAK : (mat == 2) ? MRB : MRK; *(u32x2*)(Om + t * MS + s0) = pack4(acc); }
    }
    __syncthreads();

    if (wave == 0) { const int base = (lane >> 5) * 32, c = lane & 31; float xv[32]; int roff = base * 65; float prev = 0.f;
#pragma unroll
        for (int t = 0; t < 32; ++t) { float a = (t == c) ? 1.f : 0.f;
            asm volatile("" : "+v"(roff), "+v"(prev));
            const float* Lr = CUM + roff + t * 64;
#pragma unroll
            for (int s2 = 0; s2 < t; ++s2) a += Lr[s2] * xv[s2];
            xv[t] = a; prev = a; }
#pragma unroll
        for (int t = 0; t < 32; ++t) { TF[(base + t) * 64 + base + c] = xv[t]; if (base == 0) TF[t * 64 + 32 + c] = 0.f; }
    } else {
#pragma unroll 1
        for (int q = wave - 1; q < 16; q += 7) { const int tm = q >> 2, tn = q & 3;
            const f32x4 acc = nt_tile(MAK, tm * 16 + fr, VT, tn * 16 + fr, (f32x4){0.f, 0.f, 0.f, 0.f}, fq);
            *(u32x2*)(MVT + (tn * 16 + fr) * MS + tm * 16 + fq * 4) = pack4(acc); }
    }
    __syncthreads();
    { const int r = tid >> 4, c0 = (tid & 15) * 2; float x0 = 0.f, x1 = 0.f;
#pragma unroll 8
        for (int k = 0; k < 32; ++k) { const float lv = CUM[(32 + r) * 64 + k]; x0 += lv * TF[k * 64 + c0]; x1 += lv * TF[k * 64 + c0 + 1]; }
        XB[r * 32 + c0] = x0; XB[r * 32 + c0 + 1] = x1;
        __syncthreads();
        float y0 = 0.f, y1 = 0.f;
#pragma unroll 8
        for (int k = 0; k < 32; ++k) { const float tv = TF[(32 + r) * 64 + 32 + k]; y0 += tv * XB[k * 32 + c0]; y1 += tv * XB[k * 32 + c0 + 1]; }
        TF[(32 + r) * 64 + c0] = y0; TF[(32 + r) * 64 + c0 + 1] = y1;
    }
    __syncthreads();
    { const int t = tid >> 3, s0 = (tid & 7) * 8; const f32x4 a = *(const f32x4*)(TF + t * 64 + s0), b2 = *(const f32x4*)(TF + t * 64 + s0 + 4);
        u32x4 w; w.x = cvt_pk_bf16(a[0], a[1]); w.y = cvt_pk_bf16(a[2], a[3]); w.z = cvt_pk_bf16(b2[0], b2[1]); w.w = cvt_pk_bf16(b2[2], b2[3]);
        *(u32x4*)(TB + t * MS + s0) = w; }
    __syncthreads();
#pragma unroll 1
    for (int x = 0; x < 2; ++x) { const int q = wave * 2 + x, tm = q >> 2, tn = q & 3;
        const f32x4 acc = nt_tile(TB, tm * 16 + fr, ATT, tn * 16 + fr, (f32x4){0.f, 0.f, 0.f, 0.f}, fq);
        *(u32x2*)(TAT + (tn * 16 + fr) * MS + tm * 16 + fq * 4) = pack4(acc); }
    __syncthreads();
#pragma unroll 1
    for (int x = 0; x < 2; ++x) { const int q = wave * 2 + x, tm = q >> 2, tn = q & 3;
        const f32x4 acc = nt_tile(TB, tm * 16 + fr, MVT, tn * 16 + fr, (f32x4){0.f, 0.f, 0.f, 0.f}, fq);
        *(u32x2*)(W1T + (tn * 16 + fr) * MS + tm * 16 + fq * 4) = pack4(acc); }
    __syncthreads();
#pragma unroll 1
    for (int x = 0; x < 8; ++x) { const int q = wave * 8 + x, o = q >> 4, tm = (q >> 2) & 3, tn = q & 3;
        const int ar = tm * 16 + fr, br_ = tn * 16 + fr; f32x4 acc = (f32x4){0.f, 0.f, 0.f, 0.f};
        if (o == 0) acc = nt_tile(TAT, ar, BHT, br_, acc, fq);
        else if (o == 1) { acc = unpack4(*(const u32x2*)(RT_ + br_ * MS + tm * 16 + fq * 4)); acc = nt_tile(TAT, ar, MRB, br_, acc, fq); }
        else if (o == 2) { acc = nt_tile(KHT, ar, VT, br_, acc, fq); acc = nt_tile(BHT, ar, W1T, br_, acc, fq); }
        else { acc = nt_tile(VT, ar, MRK, br_, acc, fq);
#if EXP_CONSTY
            acc = (f32x4){1.f, 2.f, 3.f, 4.f};
#endif
#if !EXP_NOW1
            acc = nt_tile(W1T, ar, MRB, br_, acc, fq);
#endif
        }
        bf16_t* og = (bf16_t*)(r1 + (size_t)o * 16 * MiB) + (size_t)item * 4096 + br_ * 64 + tm * 16 + fq * 4;
        *(u32x2*)og = pack4(acc); }
}

__device__ __forceinline__ void seq_compute(const unsigned char* bufp, bf16_t* SB, float* yb, f32x4 (&Sacc)[4], int wave, int fr, int fq) {
    const bf16_t* GP = (const bf16_t*)bufp; const bf16_t* RA = GP + 64 * MS; const bf16_t* HT = RA + 64 * MS; const bf16_t* YQ = HT + 64 * MS; const float* PC = (const float*)(bufp + 4 * 64 * MS * 2);
    const bf16x8 sf0 = ld_frag(SB + fr * MS + fq * 8), sf1 = ld_frag(SB + fr * MS + 32 + fq * 8);
#pragma unroll
    for (int tt = 0; tt < 4; ++tt) { f32x4 y = unpack4(*(const u32x2*)(YQ + (tt * 16 + fr) * MS + wave * 16 + fq * 4));
        y = MFMA(sf0, ld_frag(RA + (tt * 16 + fr) * MS + fq * 8), y); y = MFMA(sf1, ld_frag(RA + (tt * 16 + fr) * MS + 32 + fq * 8), y);
        *(f32x4*)(yb + (tt * 16 + fr) * 64 + wave * 16 + fq * 4) = y; }
#pragma unroll
    for (int jt = 0; jt < 4; ++jt) { const f32x4 pc = *(const f32x4*)(PC + jt * 16 + fq * 4);
        f32x4 a = unpack4(*(const u32x2*)(HT + (wave * 16 + fr) * MS + jt * 16 + fq * 4)) + Sacc[jt] * pc;
        a = MFMA(ld_frag(GP + (jt * 16 + fr) * MS + fq * 8), sf0, a); a = MFMA(ld_frag(GP + (jt * 16 + fr) * MS + 32 + fq * 8), sf1, a);
        Sacc[jt] = a; }
#pragma unroll
    for (int jt = 0; jt < 4; ++jt) *(u32x2*)(SB + fr * MS + jt * 16 + fq * 4) = pack4(Sacc[jt]);
}
__device__ __forceinline__ void seq_epilogue(const Params& p, int l, const float* yb, float dot, u32x4 vu, u32x4 zu, bf16_t* zp, int ch) {
    const f32x4 y0 = *(const f32x4*)yb, y1 = *(const f32x4*)(yb + 4);
    float s1 = y0[0] + y0[1] + y0[2] + y0[3] + y1[0] + y1[1] + y1[2] + y1[3];
    s1 += __shfl_xor(s1, 1); s1 += __shfl_xor(s1, 2); s1 += __shfl_xor(s1, 4);
    const float mean = s1 * (1.f / 64.f); const f32x4 d0 = y0 - mean, d1 = y1 - mean;
    float s2 = d0[0] * d0[0] + d0[1] * d0[1] + d0[2] * d0[2] + d0[3] * d0[3] + d1[0] * d1[0] + d1[1] * d1[1] + d1[2] * d1[2] + d1[3] * d1[3];
    s2 += __shfl_xor(s2, 1); s2 += __shfl_xor(s2, 2); s2 += __shfl_xor(s2, 4);
    const float rstd = rsqrtf(s2 * (1.f / 64.f) + 64e-5f);
    const f32x4 g0 = *(const f32x4*)(p.lnx_g + (size_t)l * 512 + ch), g1 = *(const f32x4*)(p.lnx_g + (size_t)l * 512 + ch + 4), e0 = *(const f32x4*)(p.lnx_b + (size_t)l * 512 + ch), e1 = *(const f32x4*)(p.lnx_b + (size_t)l * 512 + ch + 4);
    const f32x4 v0 = (f32x4){bf_lo(vu.x), bf_hi(vu.x), bf_lo(vu.y), bf_hi(vu.y)}, v1 = (f32x4){bf_lo(vu.z), bf_hi(vu.z), bf_lo(vu.w), bf_hi(vu.w)};
    const f32x4 o0 = d0 * rstd * g0 + e0 + v0 * dot, o1 = d1 * rstd * g1 + e1 + v1 * dot;
    u32x4 w; w.x = cvt_pk_bf16(o0[0] * siluf_(bf_lo(zu.x)), o0[1] * siluf_(bf_hi(zu.x))); w.y = cvt_pk_bf16(o0[2] * siluf_(bf_lo(zu.y)), o0[3] * siluf_(bf_hi(zu.y)));
    w.z = cvt_pk_bf16(o1[0] * siluf_(bf_lo(zu.z)), o1[1] * siluf_(bf_hi(zu.z))); w.w = cvt_pk_bf16(o1[2] * siluf_(bf_lo(zu.w)), o1[3] * siluf_(bf_hi(zu.w)));
    *(u32x4*)zp = w;
}
__device__ __forceinline__ void seq_item(const Params& p, int l, int bh, unsigned char* lds, bf16_t* dstp, int dst_ld, size_t dst_tok0) {
    const int tid = tid_l(), lane = tid & 63, wave = __builtin_amdgcn_readfirstlane(tid >> 6), fr = lane & 15, fq = lane >> 4;
    const int b = bh >> 3, h = bh & 7;
    const unsigned char* r1 = p.ws + OFF_R1;
    constexpr int BUFB = 4 * 64 * MS * 2 + 256;
    bf16_t* SB = (bf16_t*)(lds + 2 * BUFB) + wave * 16 * MS;
    float* YB = (float*)(lds + 2 * BUFB + 4 * 16 * MS * 2);
    const int srow = tid >> 3, sc8 = tid & 7;
    u32x4 preA[4], preB[4]; float pcA = 0.f, pcB = 0.f;
#define SEQ_LOAD(PRE, PC, CI) do { const size_t _ci = (CI); _Pragma("unroll") for (int m = 0; m < 4; ++m) PRE[m] = *(const u32x4*)((const bf16_t*)(r1 + (size_t)m * 16 * MiB) + _ci * 4096 + srow * 64 + sc8 * 8); \
        if (tid < 64) PC = ((const float*)(r1 + R1_PC))[_ci * 64 + tid]; } while (0)
#define SEQ_STORE(PRE, PC, BUFP) do { unsigned char* _b = (BUFP); _Pragma("unroll") for (int m = 0; m < 4; ++m) *(u32x4*)((bf16_t*)_b + m * 64 * MS + srow * MS + sc8 * 8) = PRE[m]; \
        if (tid < 64) ((float*)(_b + 4 * 64 * MS * 2))[tid] = PC; } while (0)
    __syncthreads();
    SEQ_LOAD(preA, pcA, (size_t)bh * 64);
    SEQ_LOAD(preB, pcB, (size_t)bh * 64 + 1);
    SEQ_STORE(preA, pcA, lds);
    if (wave < 4) { for (int e = lane; e < 16 * MS / 2; e += 64) ((unsigned*)SB)[e] = 0u; }
    __syncthreads();
    f32x4 Sacc[4];
#pragma unroll
    for (int jt = 0; jt < 4; ++jt) Sacc[jt] = (f32x4){0.f, 0.f, 0.f, 0.f};
#define SEQ_ITER(C, PRE_NEXT, PC_NEXT, PRE_LOAD, PC_LOAD) do { const int c = (C); \
        if (c + 2 < 64) SEQ_LOAD(PRE_LOAD, PC_LOAD, (size_t)bh * 64 + c + 2); \
        const int et = tid >> 3, eq = tid & 7; const size_t tg = (size_t)b * SEQ + c * 64 + et; const int ch = h * 64 + eq * 8; \
        const float dot = ((const float*)(p.ws + OFF_DOT))[tg * 8 + h]; \
        const u32x4 vu = *(const u32x4*)((const bf16_t*)(p.ws + OFF_R2 + R2_V) + tg * 512 + ch); \
        const u32x4 zu = *(const u32x4*)((const bf16_t*)(p.ws + OFF_Z) + tg * NZ + 1024 + ch); \
        if (wave < 4) seq_compute(lds + (c & 1) * BUFB, SB, YB + (c & 1) * 4096, Sacc, wave, fr, fq); \
        if (c + 1 < 64) SEQ_STORE(PRE_NEXT, PC_NEXT, lds + ((c + 1) & 1) * BUFB); \
        __syncthreads(); \
        seq_epilogue(p, l, YB + (c & 1) * 4096 + et * 64 + eq * 8, dot, vu, zu, dstp + (tg - dst_tok0) * dst_ld + ch, ch); } while (0)
#pragma unroll 1
    for (int c2 = 0; c2 < 64; c2 += 2) { SEQ_ITER(c2, preB, pcB, preA, pcA); SEQ_ITER(c2 + 1, preA, pcA, preB, pcB); }
#undef SEQ_ITER
#undef SEQ_LOAD
#undef SEQ_STORE
}

#define XB_TMO      128
#define XB_XCNT(j)  (256  + 64 * (j))
#define XB_XSUB(j)  (1280 + 64 * (j))
#define XB_XGEN(j)  (2304 + 64 * (j))
#define XB_TOP      3328
#define XB_TOPGEN   3392
#define XCD_BAR_WORDS 3456
#define XB_SPIN_CAP (1u << 18)

__device__ __forceinline__ unsigned xb_ld(unsigned* p)              { return __hip_atomic_load(p, __ATOMIC_RELAXED, __HIP_MEMORY_SCOPE_AGENT); }
__device__ __forceinline__ unsigned xb_add(unsigned* p, unsigned v) { return __hip_atomic_fetch_add(p, v, __ATOMIC_RELAXED, __HIP_MEMORY_SCOPE_AGENT); }
__device__ __forceinline__ unsigned xb_xcc_id() { return (unsigned)__builtin_amdgcn_s_getreg((3 << 11) | 20) & 0xFu; }
#define XB_SPIN(cond, bar) do { unsigned _sp = 0; while (cond) { __builtin_amdgcn_s_sleep(1); \
    if ((++_sp & 255u) == 0u) { if (xb_ld(&(bar)[XB_TMO])) break; if (_sp > XB_SPIN_CAP) { atomicAdd(&(bar)[XB_TMO], 1u); break; } } } } while (0)

struct XcdBarrier {
    unsigned* bar; unsigned x;
    volatile LAS unsigned* st;
};

__device__ __forceinline__ XcdBarrier xcd_barrier_post(unsigned* bar, volatile LAS unsigned* st) {
    XcdBarrier b; b.bar = bar; b.x = xb_xcc_id(); b.st = st;
    if (threadIdx.x == 0) (void)xb_add(&bar[XB_XCNT(b.x)], 1u);
    return b;
}
__device__ __forceinline__ void xcd_barrier_complete(unsigned* bar, unsigned x, unsigned& nloc, unsigned& nx) {
    const unsigned G = gridDim.x * gridDim.y * gridDim.z;
    unsigned sum, cnt, mine, sp = 0u;
    for (;;) {
        sum = 0u; cnt = 0u; mine = 0u;
#pragma unroll
        for (unsigned j = 0; j < 16; ++j) { const unsigned c = xb_ld(&bar[XB_XCNT(j)]); sum += c; cnt += (c > 0u) ? 1u : 0u; mine = (j == x) ? c : mine; }
        if (sum == G) break;
        __builtin_amdgcn_s_sleep(1);
        if ((++sp & 255u) == 0u) { if (xb_ld(&bar[XB_TMO])) break; if (sp > XB_SPIN_CAP) { atomicAdd(&bar[XB_TMO], 1u); break; } }
    }
    nloc = mine > 0u ? mine : 1u; nx = cnt > 0u ? cnt : 1u;
}

__device__ __forceinline__ void xcd_barrier(const XcdBarrier& b) {
    asm volatile("s_waitcnt vmcnt(0)" ::: "memory");
    __syncthreads();
    if (threadIdx.x == 0) {
        unsigned* bar = b.bar;
        __builtin_amdgcn_s_waitcnt(0);
        unsigned nloc = b.st[0], nx = b.st[1];
        if (nloc == 0u) { xcd_barrier_complete(bar, b.x, nloc, nx); b.st[0] = nloc; b.st[1] = nx; }
        const unsigned old = xb_add(&bar[XB_XSUB(b.x)], 1u);
        const unsigned gen = old / nloc;
        if (old + 1u == (gen + 1u) * nloc) {
            __builtin_amdgcn_fence(__ATOMIC_RELEASE, "agent");
            asm volatile("s_waitcnt vmcnt(0)" ::: "memory");
            const unsigned og = xb_add(&bar[XB_TOP], 1u);
            const unsigned tg = og / nx;
            if (og + 1u == (tg + 1u) * nx) xb_add(&bar[XB_TOPGEN], 1u);
            else XB_SPIN(xb_ld(&bar[XB_TOPGEN]) == tg, bar);
            __builtin_amdgcn_fence(__ATOMIC_ACQUIRE, "agent");
            xb_add(&bar[XB_XGEN(b.x)], 1u);
            asm volatile("s_waitcnt vmcnt(0)" ::: "memory");
        } else {
            XB_SPIN(xb_ld(&bar[XB_XGEN(b.x)]) == gen, bar);
            __builtin_amdgcn_fence(__ATOMIC_ACQUIRE, "agent");
            asm volatile("s_waitcnt vmcnt(0)" ::: "memory");
        }
    }
    __syncthreads();
}


constexpr int PH_PER_LAYER = 8, PH_PRE = 3, N_PHASES = PH_PRE + NL * PH_PER_LAYER;
__global__ void __launch_bounds__(NTHREADS, 2) trunk_fwd(Params p0) {
    extern __shared__ __attribute__((aligned(16))) unsigned char lds[];
    const int G = gridDim.x, bx = blockIdx.x;
    Params p = p0;
    volatile LAS unsigned* xb_st = (volatile LAS unsigned*)((LAS unsigned char*)lds + (LDS_BYTES - 16));
    if (threadIdx.x == 0) { xb_st[0] = 0u; xb_st[1] = 0u; }
    XcdBarrier xbar; xbar.bar = nullptr; xbar.x = 0; xbar.st = xb_st;
    __syncthreads();
#if EXP_ZERO
    for (int i = threadIdx.x; i < LDS_BYTES / 4; i += NTHREADS) ((unsigned*)lds)[i] = 0u;
    __syncthreads();
    if (p0.ph_lo == 0) { u32x4* z = (u32x4*)(p0.ws + OFF_DOT); const size_t n = (WS_END - OFF_DOT) / 16;
        for (size_t i = (size_t)bx * NTHREADS + threadIdx.x; i < n; i += (size_t)G * NTHREADS) z[i] = (u32x4){0u, 0u, 0u, 0u}; }
#endif
    for (int ph = p0.ph_lo; ph < p0.ph_hi; ++ph) {
        unsigned char* ws = ptr_l(p0.ws); p.ws = ws;
#if TS_K >= 0
        if (bx == 0 && threadIdx.x == 0) ((unsigned long long*)(ws + WS_END + 32768))[ph] = __builtin_amdgcn_s_memrealtime();
#endif
        if (ph == 0) { if (PHEN & 1) for (int rep = 0; rep < REP_P0; ++rep) phase0a(p, lds); }
        else if (ph == 1) { phase_modt(p); }
        else if (ph == 2) { if (PHEN & 2) phase0b(p); }
        else {
            const int l = (ph - PH_PRE) / PH_PER_LAYER, k = (ph - PH_PRE) % PH_PER_LAYER;
            if (k == 0 && (PHEN & 4)) for (int rep = 0; rep < REP_IN; ++rep) {
                pg8::Gemm g{(const bf16_t*)(ws + OFF_H), (const bf16_t*)(ws + OFF_WIN + l * SZ_WIN), DM, DM, DM};
                pg8::PlainOrder S; S.init(M_TOK / 256, NIN / 256, G, bx);
                pg8::EpiIn E{(bf16_t*)(ws + OFF_R1), (bf16_t*)(ws + OFF_Z)};
                pg8::gemm_phase(( LAS unsigned char*)lds, g, S, E);
            } else if (k == 1 && (PHEN & 8)) {
                for (int it = bx; it < 640; it += G) {
                    if (it < 128) { if (PHEN & 512) { for (int rep = 1; rep < REP_GM; ++rep) gmlp_item(p, l, it, lds, false); gmlp_item(p, l, it, lds); } }
                    else if (it < 384) { if (PHEN & 1024) for (int rep = 0; rep < REP_MLA; ++rep) mla_prep_item(p, l, it - 128, lds); }
                    else { if (PHEN & 2048) for (int rep = 0; rep < REP_RW; ++rep) rwkv_prep_item(p, l, it - 384, lds); }
                }
            } else if (k == 2 && (PHEN & 16)) {
                for (int rep = 0; rep < REP_CHUNK; ++rep) { ChunkIn cin; chunk_load(p, bx & 2047, cin, tid_l());
                    for (int it = bx; it < 2048; it += G) chunk_item(p, it, (it + G < 2048) ? it + G : -1, cin, lds); }
            } else if (k == 3 && (PHEN & 16)) {
#if !USE_CHUNK
                for (int it = bx; it < 32; it += G) scan_item(p, l, it, lds);
#elif PROBE_SCAN
                for (int it = bx; it < 32; it += G) { if (l == 0 && it < 8) seq_item(p, l, it, lds, (bf16_t*)(ws + WS_END), 512, 0); scan_item(p, l, it, lds); }
#else
                for (int it = bx; it < 32; it += G) { if (PHEN & 8192) seq_item(p, l, it, lds, (bf16_t*)(ws + OFF_Z) + 1024, NZ, 0); }
#endif
                {
                    unsigned* ctr = (unsigned*)(ptr_l(p0.ws) + WS_END + 16384) + l * 16;
                    volatile LAS unsigned* slot = (volatile LAS unsigned*)((LAS unsigned char*)lds + (LDS_BYTES - 8));
                    for (;;) {
                        __syncthreads();
                        if (tid_l() == 0) *slot = __hip_atomic_fetch_add(ctr, 1u, __ATOMIC_RELAXED, __HIP_MEMORY_SCOPE_AGENT);
                        __syncthreads();
                        const unsigned i = *slot;
                        if (i >= 512u) break;
                        const int qb = 15 - (int)(i >> 5), bh = (int)(i & 31);
                        attn_item(p, bh >> 3, bh & 7, qb, lds);
                    }
                }
            } else if (k == 4 && (PHEN & 32)) for (int rep = 0; rep < REP_GMO; ++rep) {
#if PROBE_SCAN
#endif: G = sigmoid(h @ Wg)
                pg8::Gemm g{(const bf16_t*)(ws + OFF_H), (const bf16_t*)(ws + OFF_WG + l * SZ_WG), DM, DM, DM};
                pg8::PlainOrder S; S.init(M_TOK / 256, NG / 256, G, bx);
                pg8::EpiPlain<1> E{(bf16_t*)(ws + OFF_R2), NG};
                pg8::gemm_phase((LAS unsigned char*)lds, g, S, E);
            } else if (k == 5 && (PHEN & 64)) for (int rep = 0; rep < REP_GMO; ++rep) {
                pg8::Gemm g{(const bf16_t*)(ws + OFF_Z), (const bf16_t*)(ws + OFF_WBR + l * SZ_WBR), NZ, 512, 512};
                pg8::MergeOrder S; S.init(M_TOK / 256, DM / 256, G, bx);
                pg8::EpiMerge E{(bf16_t*)(ws + OFF_R3 + R3_MERGED), (const bf16_t*)(ws + OFF_R2)};
                pg8::gemm_phase((LAS unsigned char*)lds, g, S, E);
            } else if (k == 6 && (PHEN & 128)) for (int rep = 0; rep < REP_GMO; ++rep) {
                pg8::Gemm g{(const bf16_t*)(ws + OFF_R3 + R3_MERGED), (const bf16_t*)(ws + OFF_WOUT + l * SZ_WOUT), DM, DM, DM};
                pg8::PlainOrder S; S.init(M_TOK / 256, DM / 256, G, bx);
                pg8::EpiPlain<0> E{(bf16_t*)(ws + OFF_R3 + R3_Y), DM};
                pg8::gemm_phase((LAS unsigned char*)lds, g, S, E);
            } else if (k == 7 && (PHEN & 256)) {
                phase_final(p, l);
            }
        }
#if PROBE_SCAN
        if (ph == N_PHASES - 1 && bx == 0 && threadIdx.x == 0) { const unsigned cd = *(volatile unsigned*)(ws + WS_END + 5 * MiB); p.out[5] = 1000.f * (float)cd; }
        if (ph == 0 && bx == 0 && threadIdx.x == 0) *(unsigned*)(ws + WS_END + 5 * MiB) = 0u;
#endif
#if TS_K >= 0
        if (ph == N_PHASES - 1 && bx == 0 && threadIdx.x == 0) { unsigned long long* ts = (unsigned long long*)(ws + WS_END + 32768); const unsigned long long tend = __builtin_amdgcn_s_memrealtime(); unsigned long long sum = 0;
            if (TS_K < 8) { for (int l2 = 0; l2 < NL; ++l2) { const int a = PH_PRE + l2 * PH_PER_LAYER + TS_K; sum += ((a + 1 < N_PHASES) ? ts[a + 1] : tend) - ts[a]; } }
            else sum = ts[PH_PRE] - ts[0];
            p.out[5] = 10.f * (float)sum; }
#endif
        if (ph + 1 < p0.ph_hi) {
            if (ph == p0.ph_lo) {
                if (bx == 0) { const int tz = tid_l(); if (tz < 64) __hip_atomic_store((unsigned*)(ptr_l(p0.ws) + WS_END + 16384) + tz, 0u, __ATOMIC_RELAXED, __HIP_MEMORY_SCOPE_AGENT); }
                if (bx == 0) { unsigned* zb = (unsigned*)ptr_l(p0.ws + WS_END); for (int i = tid_l(); i < XCD_BAR_WORDS; i += NTHREADS) __hip_atomic_store(zb + i, 0u, __ATOMIC_RELAXED, __HIP_MEMORY_SCOPE_AGENT); }
                cg::this_grid().sync();
                xbar = xcd_barrier_post((unsigned*)ptr_l(p0.ws + WS_END), xb_st);
            } else { XcdBarrier b2; b2.bar = (unsigned*)ptr_l(p0.ws + WS_END); b2.x = xbar.x; b2.st = xb_st; xcd_barrier(b2); }
        }
    }
}

extern "C" void kernel_launch(void* const* d_in, const int* in_sizes, int n_in, void* d_out, int out_size, void* d_ws, size_t ws_size, hipStream_t stream) {
    static int grid = 0;
    if (grid == 0) {
        if (n_in != 31 || out_size != M_TOK * DM || ws_size < WS_END + 65536) { fprintf(stderr, "kernel_launch: unexpected shapes (n_in %d out %d ws %zu)\n", n_in, out_size, ws_size); grid = -1; return; }
        int dev = 0, cus = 0, per_cu = 0;
        hipGetDevice(&dev); hipDeviceGetAttribute(&cus, hipDeviceAttributeMultiprocessorCount, dev);
        hipFuncSetAttribute((const void*)trunk_fwd, hipFuncAttributeMaxDynamicSharedMemorySize, LDS_BYTES);
        hipOccupancyMaxActiveBlocksPerMultiprocessor(&per_cu, (const void*)trunk_fwd, NTHREADS, LDS_BYTES);
        if (per_cu < 1) { fprintf(stderr, "kernel_launch: occupancy query says %d blocks per CU\n", per_cu); grid = -1; return; }
        grid = cus * 1;
    }
    if (grid < 0) return;
    Params p{};
    p.x = (const float*)d_in[0]; p.c = (const float*)d_in[1]; p.pos = (const int*)d_in[2]; p.pre_g = (const float*)d_in[3]; p.post_g = (const float*)d_in[4];
    p.w_ada = (const float*)d_in[5]; p.b_ada = (const float*)d_in[6]; p.w_in = (const float*)d_in[7]; p.q_norm = (const float*)d_in[8]; p.w_uq = (const float*)d_in[9];
    p.kv_norm = (const float*)d_in[10]; p.w_ukv = (const float*)d_in[11]; p.ln_g = (const float*)d_in[12]; p.ln_b = (const float*)d_in[13]; p.w_s = (const float*)d_in[14]; p.b_s = (const float*)d_in[15];
    p.mu = (const float*)d_in[16]; p.w0 = (const float*)d_in[17]; p.w2 = (const float*)d_in[18]; p.a0 = (const float*)d_in[19]; p.a2 = (const float*)d_in[20]; p.k_k = (const float*)d_in[21];
    p.k_a = (const float*)d_in[22]; p.r_k = (const float*)d_in[23]; p.lnx_g = (const float*)d_in[24]; p.lnx_b = (const float*)d_in[25]; p.v0 = (const float*)d_in[26]; p.v1 = (const float*)d_in[27];
    p.v2 = (const float*)d_in[28]; p.w_br = (const float*)d_in[29]; p.w_out = (const float*)d_in[30];
    p.out = (float*)d_out; p.ws = (unsigned char*)d_ws;
#if ONE_LAUNCH
    p.ph_lo = 0; p.ph_hi = N_PHASES;
    void* args[] = {&p};
    hipError_t e = hipLaunchCooperativeKernel((const void*)trunk_fwd, dim3(grid), dim3(NTHREADS), args, LDS_BYTES, stream);
    if (e != hipSuccess) fprintf(stderr, "cooperative launch failed: %s (grid %d)\n", hipGetErrorString(e), grid);
#else
    for (int ph = 0; ph < N_PHASES; ++ph) { p.ph_lo = ph; p.ph_hi = ph + 1;
        hipLaunchKernelGGL(trunk_fwd, dim3(grid), dim3(NTHREADS), LDS_BYTES, stream, p); }
#endif
}
```

```cpp
#include <hip/hip_runtime.h>
#include <hip/hip_cooperative_groups.h>
#include <cstdint>
#include <cstdio>
namespace cg = cooperative_groups;

#ifndef PHEN
#define PHEN 0x7fff
#endif
#ifndef TS_K
#define TS_K -1
#endif
#ifndef REP_P0
#define REP_P0 1
#endif
#ifndef REP_GMO
#define REP_GMO 1
#endif
#ifndef REP_GM
#define REP_GM 1
#endif
#ifndef REP_ATT
#define REP_ATT 1
#endif
#ifndef REP_IN
#define REP_IN 1
#endif
#ifndef REP_CHUNK
#define REP_CHUNK 1
#endif
#ifndef REP_MLA
#define REP_MLA 1
#endif
#ifndef REP_RW
#define REP_RW 1
#endif
#ifndef EXP_SYNC2
#define EXP_SYNC2 0
#endif
#ifndef EXP_NODOT
#define EXP_NODOT 0
#endif
#ifndef EXP_CONSTY
#define EXP_CONSTY 0
#endif
#ifndef EXP_NOW1
#define EXP_NOW1 0
#endif
#ifndef EXP_NOSTATE
#define EXP_NOSTATE 0
#endif
#ifndef EXP_ZERO
#define EXP_ZERO 0
#endif
#ifndef USE_CHUNK
#define USE_CHUNK 1
#endif
#ifndef PROBE_SCAN
#define PROBE_SCAN 0
#endif
#ifndef ONE_LAUNCH
#define ONE_LAUNCH 1
#endif

#define LAS __attribute__((address_space(3)))
typedef unsigned short bf16_t;
typedef short bf16x8 __attribute__((ext_vector_type(8)));
typedef short bf16x4 __attribute__((ext_vector_type(4)));
typedef float f32x4 __attribute__((ext_vector_type(4)));
typedef float f32x2 __attribute__((ext_vector_type(2)));
typedef unsigned u32x4 __attribute__((ext_vector_type(4)));
typedef unsigned u32x2 __attribute__((ext_vector_type(2)));

constexpr int M_TOK = 16384, DM = 1024, SEQ = 4096, NBATCH = 4, NL = 4;
constexpr int D_IN_SRC = 7712;
constexpr int NP1 = 3328, NZ = 1536, NIN = 4864, NG = 3072;
constexpr int C_QLAT = 0, C_KVLAT = 256, C_KROPE = 384, C_GMU = 512, C_GMV = 1024, C_RW = 1536, C_RWR = 1536, C_RWK = 2048, C_RWV = 2560, C_WLAT = 3072, C_ALAT = 3136;
constexpr int NTHREADS = 512, NWAVES = 8;
constexpr int LDS_BYTES = 150 * 1024;
constexpr float QSCALE = 0.10206207261596575f * 1.4426950408889634f;

constexpr size_t MiB = 1u << 20;
constexpr size_t OFF_WIN = 0;
constexpr size_t SZ_WIN = (size_t)NIN * DM * 2;
constexpr size_t OFF_WG = 38 * MiB;
constexpr size_t SZ_WG = (size_t)NG * DM * 2;
constexpr size_t OFF_WBR = 62 * MiB;
constexpr size_t SZ_WBR = (size_t)3072 * 512 * 2;
constexpr size_t OFF_WOUT = 74 * MiB;
constexpr size_t SZ_WOUT = (size_t)DM * DM * 2;
constexpr size_t OFF_WUQ = 82 * MiB;
constexpr size_t SZ_WUQ = (size_t)768 * 256 * 2;
constexpr size_t OFF_WUKV = OFF_WUQ + 3 * MiB / 2;
constexpr size_t SZ_WUKV = (size_t)1024 * 128 * 2;
constexpr size_t OFF_SMALL = OFF_WUKV + 1 * MiB;
constexpr size_t OFF_W2T = OFF_SMALL;
constexpr size_t OFF_A2T = OFF_W2T + 256 * 1024;
constexpr size_t OFF_V1T = OFF_A2T + 256 * 1024;
constexpr size_t OFF_V2T = OFF_V1T + 128 * 1024;
constexpr size_t OFF_WS = OFF_V2T + 128 * 1024;
constexpr size_t OFF_MODP = OFF_WS + 512 * 1024;
constexpr size_t OFF_ROPE = OFF_MODP + 3 * MiB / 2;
constexpr size_t OFF_DOT = OFF_ROPE + 2 * MiB;
constexpr size_t OFF_MODT = OFF_DOT + MiB / 2;
constexpr size_t OFF_H = 90 * MiB;
constexpr size_t OFF_Z = 122 * MiB;
constexpr size_t OFF_VF = 170 * MiB;
constexpr size_t OFF_R1 = 186 * MiB;
constexpr size_t OFF_R2 = 298 * MiB;
constexpr size_t OFF_R3 = 410 * MiB;
constexpr size_t WS_END = 474 * MiB;
static_assert(OFF_MODT + 3 * NL * 4 * 1024 * 4 <= OFF_H, "small region");
constexpr size_t R1_GP = 0, R1_RA = 16 * MiB, R1_HT = 32 * MiB, R1_YQ = 48 * MiB, R1_PC = 64 * MiB;
constexpr size_t R2_R = 0, R2_K = 16 * MiB, R2_V = 32 * MiB, R2_KK = 48 * MiB, R2_B = 64 * MiB, R2_LW = 80 * MiB;
constexpr size_t R3_Q = 0, R3_KF = 24 * MiB, R3_VT = 48 * MiB, R3_MERGED = 0, R3_Y = 32 * MiB;

struct Params {
    const float* x; const float* c; const int* pos; const float* pre_g; const float* post_g; const float* w_ada; const float* b_ada; const float* w_in;
    const float* q_norm; const float* w_uq; const float* kv_norm; const float* w_ukv; const float* ln_g; const float* ln_b; const float* w_s; const float* b_s;
    const float* mu; const float* w0; const float* w2; const float* a0; const float* a2; const float* k_k; const float* k_a; const float* r_k;
    const float* lnx_g; const float* lnx_b; const float* v0; const float* v1; const float* v2; const float* w_br; const float* w_out;
    float* out; unsigned char* ws;
    int ph_lo, ph_hi;
};

typedef __bf16 bf16x2_t __attribute__((ext_vector_type(2)));
__device__ __forceinline__ unsigned cvt_pk_bf16(float lo, float hi) { const f32x2 v = {lo, hi}; const bf16x2_t b = __builtin_convertvector(v, bf16x2_t); return __builtin_bit_cast(unsigned, b); }
__device__ __forceinline__ float bf_lo(unsigned u) { return __uint_as_float(u << 16); }
__device__ __forceinline__ float bf_hi(unsigned u) { return __uint_as_float(u & 0xffff0000u); }
__device__ __forceinline__ float bf2f(bf16_t h) { return __uint_as_float(((unsigned)h) << 16); }
__device__ __forceinline__ bf16_t f2bf(float f) { return (bf16_t)(cvt_pk_bf16(f, 0.f) & 0xffffu); }
__device__ __forceinline__ float sigmoidf_(float x) { return __builtin_amdgcn_rcpf(1.f + __builtin_amdgcn_exp2f(x * -1.4426950408889634f)); }
__device__ __forceinline__ float siluf_(float x) { return x * __builtin_amdgcn_rcpf(1.f + __builtin_amdgcn_exp2f(x * -1.4426950408889634f)); }
__device__ __forceinline__ float tanhf_(float x) { return 1.f - 2.f * __builtin_amdgcn_rcpf(1.f + __builtin_amdgcn_exp2f(x * 2.8853900817779268f)); }
__device__ __forceinline__ float geluf_(float v) {
    const float av = fabsf(v), t = __builtin_amdgcn_rcpf(av * 0.2316418882f + 1.0f);
    float q = t * 0.5307027145f + (-0.7265760135f); q = q * t + 0.7107068705f; q = q * t + (-0.142248368f); q = q * t + 0.127414796f; q = q * t;
    const float e = __builtin_amdgcn_exp2f((v * v) * (-0.72134752044f));
    const float m = v * (q * e);
    return v < 0.f ? m : v - m;
}
__device__ __forceinline__ f32x4 unpack4(u32x2 u) { return (f32x4){bf_lo(u.x), bf_hi(u.x), bf_lo(u.y), bf_hi(u.y)}; }
__device__ __forceinline__ u32x2 pack4(f32x4 v) { u32x2 r; r.x = cvt_pk_bf16(v[0], v[1]); r.y = cvt_pk_bf16(v[2], v[3]); return r; }
__device__ __forceinline__ float wave_sum(float v) {
#pragma unroll
    for (int o = 1; o < 64; o <<= 1) v += __shfl_xor(v, o);
    return v;
}
__device__ __forceinline__ bf16x8 ld_frag(const bf16_t* p) { return *(const bf16x8*)p; }
__device__ __forceinline__ bf16x8 pack_frag(f32x4 a, f32x4 b) {
    u32x4 u; u.x = cvt_pk_bf16(a[0], a[1]); u.y = cvt_pk_bf16(a[2], a[3]); u.z = cvt_pk_bf16(b[0], b[1]); u.w = cvt_pk_bf16(b[2], b[3]);
    return __builtin_bit_cast(bf16x8, u);
}
__device__ __forceinline__ bf16x8 join_frag(u32x2 a, u32x2 b) { u32x4 u; u.x = a.x; u.y = a.y; u.z = b.x; u.w = b.y; return __builtin_bit_cast(bf16x8, u); }
__device__ __forceinline__ int tid_l() { int t = threadIdx.x; asm volatile("" : "+v"(t)); return t; }
__device__ __forceinline__ unsigned char* ptr_l(unsigned char* q) { asm volatile("" : "+s"(q)); return q; }
#define MFMA(a, b, c) __builtin_amdgcn_mfma_f32_16x16x32_bf16((a), (b), (c), 0, 0, 0)

namespace pg8 {
constexpr int BM = 256, BK = 64, HALF = 128, HTB = HALF * BK * 2, STAGE_BYTES = 8 * HTB, NXCD = 8, WGM = 8;
__host__ __device__ __forceinline__ int lds_byte(int r, int c) { const int st = (r >> 4) * 2 + (c >> 5), rr = r & 15, cc = c & 31, ob = rr * 64 + cc * 2; return st * 1024 + (ob ^ (((ob >> 9) & 1) << 5)); }
__host__ __device__ __forceinline__ void stage_rc(int b, int& R, int& C) { const int st = b / 1024, sb = b % 1024, swz = sb ^ (((sb >> 9) & 1) << 5); R = (st >> 1) * 16 + swz / 64; C = (st & 1) * 32 + (swz % 64) / 2; }
__host__ __device__ __forceinline__ int perm32(int rho) { const int n = rho >> 4, i = rho & 15; return 8 * (i >> 2) + 4 * n + (i & 3); }

struct Unit { int pm, pn, ak, tag; };
struct Gemm { const bf16_t* A; const bf16_t* Bt; int lda, ldb, K; };

__device__ __forceinline__ void tile_of(int wgid, int nM, int nN, int& pm, int& pn) {
    const int nwg = nM * nN;
    { const int q = nwg / NXCD, r = nwg % NXCD, xcd = wgid % NXCD, off = wgid / NXCD; wgid = (xcd < r ? xcd * (q + 1) : r * (q + 1) + (xcd - r) * q) + off; }
    const int nig = WGM * nN, gid = wgid / nig, fm = gid * WGM, gsz = (nM - fm) < WGM ? (nM - fm) : WGM;
    pm = fm + ((wgid % nig) % gsz); pn = (wgid % nig) / gsz;
}
struct PlainOrder {
    int nM, nN, nwg, G, c;
    __device__ void init(int nM_, int nN_, int G_, int c_) { nM = nM_; nN = nN_; nwg = nM * nN; G = G_; c = c_; }
    __device__ bool next(int i, Unit& u) const { const long L = (long)i * G + c; if (L >= nwg) return false; tile_of((int)L, nM, nN, u.pm, u.pn); u.ak = 0; u.tag = 0; return true; }
};
struct MergeOrder {
    int nM, nN, nwg, G, c;
    __device__ void init(int nM_, int nN_, int G_, int c_) { nM = nM_; nN = nN_; nwg = nM * nN; G = G_; c = c_; }
    __device__ bool next(int i, Unit& u) const { const int ti = i / 3, n = i - 3 * ti; const long L = (long)ti * G + c; if (L >= nwg) return false;
        int pm, pc; tile_of((int)L, nM, nN, pm, pc); u.pm = pm; u.pn = n * nN + pc; u.ak = n * 512; u.tag = n; return true; }
};

struct GateOrder {
    int nM, nN, nwg, G, c;
    __device__ void init(int nM_, int nN_, int G_, int c_) { nM = nM_; nN = nN_; nwg = nM * nN; G = G_; c = c_; }
    __device__ bool next(int i, Unit& u) const { const int ti = i / 3, n = i - 3 * ti; const long L = (long)ti * G + c; if (L >= nwg) return false;
        int pm, pc; tile_of((int)L, nM, nN, pm, pc); u.pm = pm; u.pn = n * nN + pc; u.ak = 0; u.tag = n; return true; }
};
template <class Epi, class Sched>
__device__ __forceinline__ void gemm_phase(LAS unsigned char* lds, const Gemm g, const Sched& S, const Epi& E) {
    const int tid = tid_l(), wid = __builtin_amdgcn_readfirstlane(tid >> 6), lane = tid & 63, wr = wid >> 2, wc = wid & 3, fr = lane & 15, fq = lane >> 4;
    const int K = g.K, nt = K / BK;
    unsigned voffA[2], voffB[2];
#pragma unroll
    for (int i = 0; i < 2; ++i) { int R, C; stage_rc(tid * 16 + i * 8192, R, C); const int Rb = (R & ~31) + perm32(R & 31);
        voffA[i] = (unsigned)(R * g.lda + C) * 2u; voffB[i] = (unsigned)(Rb * g.ldb + C) * 2u; }
    const size_t kstep = (size_t)(BK * 2);
    const size_t hstepA = (size_t)HALF * g.lda * 2, hstepB = (size_t)HALF * g.ldb * 2;
    const size_t tstepA = 2 * hstepA, tstepB = 2 * hstepB;
    const unsigned ldsw = (unsigned)wid * 1024u;
    const int aoff = lds_byte(wr * 64 + fr, fq * 8), boff = lds_byte(wc * 32 + fr, fq * 8);
#define PG8_SA(b, h) (((b) * 2 + (h)) * HTB)
#define PG8_SB(b, h) ((4 + (b) * 2 + (h)) * HTB)
#define PG8_STAGE(bufoff, gbase, voff) do { _Pragma("unroll") for (int _i = 0; _i < 2; ++_i) \
        __builtin_amdgcn_global_load_lds((const unsigned*)((const char*)(gbase) + (voff)[_i]), (LAS unsigned*)(lds + (bufoff) + ldsw + _i * 8192), 16, 0, 0); } while (0)
#define PG8_LDA(dst, b, h) do { _Pragma("unroll") for (int m = 0; m < 4; ++m) _Pragma("unroll") for (int k = 0; k < 2; ++k) dst[m][k] = *(const LAS bf16x8*)(lds + PG8_SA(b, h) + aoff + m * 2048 + k * 1024); } while (0)
#define PG8_LDB(dst, b, h) do { _Pragma("unroll") for (int n = 0; n < 2; ++n) _Pragma("unroll") for (int k = 0; k < 2; ++k) dst[n][k] = *(const LAS bf16x8*)(lds + PG8_SB(b, h) + boff + n * 2048 + k * 1024); } while (0)
#define PG8_MMA(ai, bj, At, Bt) do { __builtin_amdgcn_s_setprio(1); _Pragma("unroll") for (int m = 0; m < 4; ++m) _Pragma("unroll") for (int n = 0; n < 2; ++n) _Pragma("unroll") for (int k = 0; k < 2; ++k) \
        acc[ai][bj][m][n] = __builtin_amdgcn_mfma_f32_16x16x32_bf16(Bt[n][k], At[m][k], acc[ai][bj][m][n], 0, 0, 0); __builtin_amdgcn_s_setprio(0); } while (0)
#define PG8_WAIT_V(n) asm volatile("s_waitcnt vmcnt(" #n ")" ::: "memory")
#define PG8_WAIT_L(n) asm volatile("s_waitcnt lgkmcnt(" #n ")" ::: "memory")
#define PG8_BAR __builtin_amdgcn_s_barrier()
#define PG8_SCHED __builtin_amdgcn_sched_barrier(0)
    Unit cur, nxt; int ui = 0;
    if (!S.next(0, cur)) return;
    f32x4 acc[2][2][4][2];
#pragma unroll
    for (int a = 0; a < 2; ++a)
#pragma unroll
        for (int b = 0; b < 2; ++b)
#pragma unroll
            for (int m = 0; m < 4; ++m)
#pragma unroll
                for (int n = 0; n < 2; ++n) acc[a][b][m][n] = (f32x4){0.f, 0.f, 0.f, 0.f};
    bf16x8 At[4][2], B0[2][2], B1[2][2];
    const char* cA = (const char*)g.A + (size_t)cur.pm * tstepA + (size_t)cur.ak * 2; const char* cB = (const char*)g.Bt + (size_t)cur.pn * tstepB;
    PG8_STAGE(PG8_SB(0, 0), cB, voffB); PG8_STAGE(PG8_SB(0, 1), cB + hstepB, voffB); PG8_STAGE(PG8_SA(0, 0), cA, voffA); PG8_STAGE(PG8_SA(0, 1), cA + hstepA, voffA);
    if (wr == 1) PG8_BAR;
    PG8_WAIT_V(2); PG8_BAR;
    PG8_STAGE(PG8_SB(1, 0), cB + kstep, voffB); PG8_STAGE(PG8_SA(1, 0), cA + kstep, voffA); PG8_STAGE(PG8_SB(1, 1), cB + hstepB + kstep, voffB);
    PG8_WAIT_V(6); PG8_BAR;
    for (;;) {
        const bool has_next = S.next(ui + 1, nxt);
        const char* nA = has_next ? (const char*)g.A + (size_t)nxt.pm * tstepA + (size_t)nxt.ak * 2 : cA; const char* nB = has_next ? (const char*)g.Bt + (size_t)nxt.pn * tstepB : cB;
        for (int t = 0; t < nt; t += 2) {
            const bool last = (t == nt - 2);
            const char* a1 = cA + (size_t)(t + 1) * kstep;
            const char* a2 = last ? nA : cA + (size_t)(t + 2) * kstep; const char* b2 = last ? nB : cB + (size_t)(t + 2) * kstep;
            const char* a3 = a2 + kstep; const char* b3 = b2 + kstep;
            PG8_LDB(B0, 0, 0); PG8_LDB(B1, 0, 1); PG8_SCHED; PG8_LDA(At, 0, 0); PG8_STAGE(PG8_SA(1, 1), a1 + hstepA, voffA);
            PG8_WAIT_V(8); PG8_WAIT_L(0); PG8_BAR; PG8_MMA(0, 0, At, B0); PG8_MMA(0, 1, At, B1); PG8_BAR; PG8_SCHED;
            PG8_LDA(At, 0, 1); PG8_STAGE(PG8_SB(0, 0), b2, voffB); PG8_STAGE(PG8_SB(0, 1), b2 + hstepB, voffB); PG8_STAGE(PG8_SA(0, 0), a2, voffA);
            PG8_WAIT_V(8); PG8_WAIT_L(0); PG8_BAR; PG8_MMA(1, 0, At, B0); PG8_MMA(1, 1, At, B1); PG8_BAR; PG8_SCHED;
            PG8_LDB(B0, 1, 0); PG8_LDB(B1, 1, 1); PG8_SCHED; PG8_LDA(At, 1, 0); PG8_STAGE(PG8_SA(0, 1), a2 + hstepA, voffA);
            PG8_WAIT_V(8); PG8_WAIT_L(0); PG8_BAR; PG8_MMA(0, 0, At, B0); PG8_MMA(0, 1, At, B1); PG8_BAR; PG8_SCHED;
            PG8_LDA(At, 1, 1); PG8_STAGE(PG8_SB(1, 0), b3, voffB); PG8_STAGE(PG8_SB(1, 1), b3 + hstepB, voffB); PG8_STAGE(PG8_SA(1, 0), a3, voffA);
            PG8_WAIT_V(8); PG8_WAIT_L(0); PG8_BAR; PG8_MMA(1, 0, At, B0); PG8_MMA(1, 1, At, B1); PG8_BAR; PG8_SCHED;
        }
        if (wr == 0) PG8_BAR;
        E(acc, cur, wr, wc, fr, fq);
        if (!has_next) break;
#pragma unroll
        for (int a = 0; a < 2; ++a)
#pragma unroll
            for (int b = 0; b < 2; ++b)
#pragma unroll
                for (int m = 0; m < 4; ++m)
#pragma unroll
                    for (int n = 0; n < 2; ++n) acc[a][b][m][n] = (f32x4){0.f, 0.f, 0.f, 0.f};
        cur = nxt; cA = nA; cB = nB; ++ui;
        if (wr == 1) PG8_BAR;
    }
    PG8_WAIT_V(0);
    PG8_BAR;
#undef PG8_SA
#undef PG8_SB
#undef PG8_STAGE
#undef PG8_LDA
#undef PG8_LDB
#undef PG8_MMA
#undef PG8_WAIT_V
#undef PG8_WAIT_L
#undef PG8_BAR
#undef PG8_SCHED
}

struct EpiIn {
    bf16_t* P1; bf16_t* Z;
    __device__ __forceinline__ void operator()(const f32x4 (&acc)[2][2][4][2], const Unit& u, int wr, int wc, int fr, int fq) const {
        bf16_t* base; int ld, colt;
        if (u.pn < 13) { base = P1; ld = NP1; colt = u.pn * BM; } else { base = Z; ld = NZ; colt = (u.pn - 13) * BM; }
        const int row0 = u.pm * BM + wr * 64 + fr, col0 = colt + wc * 32 + 8 * fq;
#pragma unroll
        for (int ai = 0; ai < 2; ++ai)
#pragma unroll
            for (int m = 0; m < 4; ++m) { bf16_t* rowp = base + (size_t)(row0 + ai * HALF + m * 16) * ld + col0;
#pragma unroll
                for (int bj = 0; bj < 2; ++bj) { const f32x4 v0 = acc[ai][bj][m][0], v1 = acc[ai][bj][m][1];
                    u32x4 w; w.x = cvt_pk_bf16(v0[0], v0[1]); w.y = cvt_pk_bf16(v0[2], v0[3]); w.z = cvt_pk_bf16(v1[0], v1[1]); w.w = cvt_pk_bf16(v1[2], v1[3]);
                    *(u32x4*)(rowp + bj * HALF) = w; } }
    }
};
template <int ACT> struct EpiPlain {
    bf16_t* O; int ld;
    __device__ __forceinline__ void operator()(const f32x4 (&acc)[2][2][4][2], const Unit& u, int wr, int wc, int fr, int fq) const {
        const int row0 = u.pm * BM + wr * 64 + fr, col0 = u.pn * BM + wc * 32 + 8 * fq;
#pragma unroll
        for (int ai = 0; ai < 2; ++ai)
#pragma unroll
            for (int m = 0; m < 4; ++m) { bf16_t* rowp = O + (size_t)(row0 + ai * HALF + m * 16) * ld + col0;
#pragma unroll
                for (int bj = 0; bj < 2; ++bj) { f32x4 v0 = acc[ai][bj][m][0], v1 = acc[ai][bj][m][1];
                    if (ACT == 1) {
#pragma unroll
                        for (int e = 0; e < 4; ++e) { v0[e] = sigmoidf_(v0[e]); v1[e] = sigmoidf_(v1[e]); } }
                    u32x4 w; w.x = cvt_pk_bf16(v0[0], v0[1]); w.y = cvt_pk_bf16(v0[2], v0[3]); w.z = cvt_pk_bf16(v1[0], v1[1]); w.w = cvt_pk_bf16(v1[2], v1[3]);
                    *(u32x4*)(rowp + bj * HALF) = w; } }
    }
};
struct EpiMerge {
    bf16_t* Mg; const bf16_t* G;
    __device__ __forceinline__ void operator()(const f32x4 (&acc)[2][2][4][2], const Unit& u, int wr, int wc, int fr, int fq) const {
        const int n = u.tag, pc = u.pn - 4 * n;
        const int row0 = u.pm * BM + wr * 64 + fr, col0 = pc * BM + wc * 32 + 8 * fq;
#pragma unroll
        for (int ai = 0; ai < 2; ++ai)
#pragma unroll
            for (int m = 0; m < 4; ++m) { const size_t row = (size_t)(row0 + ai * HALF + m * 16);
#pragma unroll
                for (int bj = 0; bj < 2; ++bj) { const f32x4 v0 = acc[ai][bj][m][0], v1 = acc[ai][bj][m][1];
                    const u32x4 gt = *(const u32x4*)(G + row * NG + n * 1024 + col0 + bj * HALF);
                    bf16_t* mp = Mg + row * DM + col0 + bj * HALF;
                    float o[8];
                    o[0] = bf_lo(gt.x) * v0[0]; o[1] = bf_hi(gt.x) * v0[1]; o[2] = bf_lo(gt.y) * v0[2]; o[3] = bf_hi(gt.y) * v0[3];
                    o[4] = bf_lo(gt.z) * v1[0]; o[5] = bf_hi(gt.z) * v1[1]; o[6] = bf_lo(gt.w) * v1[2]; o[7] = bf_hi(gt.w) * v1[3];
                    if (n > 0) { const u32x4 pv = *(const u32x4*)mp;
                        o[0] += bf_lo(pv.x); o[1] += bf_hi(pv.x); o[2] += bf_lo(pv.y); o[3] += bf_hi(pv.y); o[4] += bf_lo(pv.z); o[5] += bf_hi(pv.z); o[6] += bf_lo(pv.w); o[7] += bf_hi(pv.w); }
                    u32x4 w; w.x = cvt_pk_bf16(o[0], o[1]); w.y = cvt_pk_bf16(o[2], o[3]); w.z = cvt_pk_bf16(o[4], o[5]); w.w = cvt_pk_bf16(o[6], o[7]);
                    *(u32x4*)mp = w; } }
    }
};
}

__device__ __forceinline__ void tr_item(const float* W, int lds_, int k0, int n0s, bf16_t* WT, int ldd, int n0d, int kd0, const float* ksc, float* scr, int lane) {
#pragma unroll
    for (int i = 0; i < 8; ++i) { const int kk = 8 * i + (lane >> 3), n4 = (lane & 7) * 4;
        f32x4 v = (f32x4){0.f, 0.f, 0.f, 0.f}; if (n0s >= 0) { v = *(const f32x4*)(W + (size_t)(k0 + kk) * lds_ + n0s + n4); if (ksc) v = v * ksc[k0 + kk]; }
        float* d = scr + kk * 33 + n4; d[0] = v[0]; d[1] = v[1]; d[2] = v[2]; d[3] = v[3]; }
    asm volatile("s_waitcnt lgkmcnt(0)" ::: "memory");
    const int c = lane & 7;
#pragma unroll
    for (int j = 0; j < 4; ++j) { const int n = (lane >> 3) + 8 * j; const float* s = scr + (8 * c) * 33 + n;
        u32x4 o; o.x = cvt_pk_bf16(s[0 * 33], s[1 * 33]); o.y = cvt_pk_bf16(s[2 * 33], s[3 * 33]); o.z = cvt_pk_bf16(s[4 * 33], s[5 * 33]); o.w = cvt_pk_bf16(s[6 * 33], s[7 * 33]);
        *(u32x4*)(WT + (size_t)(n0d + n) * ldd + kd0 + 8 * c) = o; }
    asm volatile("s_waitcnt lgkmcnt(0)" ::: "memory");
}

__device__ __forceinline__ void phase0a(const Params& p, unsigned char* lds) {
    const int tid = tid_l(), lane = tid & 63, wave = tid >> 6, G = gridDim.x;
    const int gw = blockIdx.x * NWAVES + wave, NGW = G * NWAVES;
    unsigned char* ws = p.ws;
    float* scr = (float*)(lds + wave * 16384);
    constexpr int I_WIN = 152 * 16, I_WG = 96 * 16, I_WBR = 3 * 32 * 8, I_WOUT = 32 * 16, I_WUQ = 24 * 4, I_WUKV = 32 * 2, I_W2 = 16, I_A2 = 16, I_V1 = 8;
    constexpr int I_L = I_WIN + I_WG + I_WBR + I_WOUT + I_WUQ + I_WUKV + I_W2 + I_A2 + I_V1;
    for (int it = gw; it < NL * I_L; it += NGW) {
        const int l = it / I_L; int r = it - l * I_L;
        if (r < I_WIN) { const int nb = r >> 4, kb = r & 15; const int nd = nb * 32;
            int ns; if (nd < 416) ns = nd; else if (nd < 512) ns = -1; else if (nd < 3200) ns = nd - 96; else if (nd < 3328) ns = -1; else ns = nd - 224;
            tr_item(p.w_in + (size_t)l * DM * D_IN_SRC, D_IN_SRC, kb * 64, ns, (bf16_t*)(ws + OFF_WIN + l * SZ_WIN), DM, nd, kb * 64, nullptr, scr, lane); continue; }
        r -= I_WIN;
        if (r < I_WG) { const int nb = r >> 4, kb = r & 15;
            tr_item(p.w_in + (size_t)l * DM * D_IN_SRC, D_IN_SRC, kb * 64, 4640 + nb * 32, (bf16_t*)(ws + OFF_WG + l * SZ_WG), DM, nb * 32, kb * 64, nullptr, scr, lane); continue; }
        r -= I_WG;
        if (r < I_WBR) { const int n = r / 256, r2 = r - n * 256, nb = r2 >> 3, kb = r2 & 7;
            tr_item(p.w_br + ((size_t)(l * 3 + n) * 512) * DM, DM, kb * 64, nb * 32, (bf16_t*)(ws + OFF_WBR + l * SZ_WBR), 512, n * 1024 + nb * 32, kb * 64, nullptr, scr, lane); continue; }
        r -= I_WBR;
        if (r < I_WOUT) { const int nb = r >> 4, kb = r & 15;
            tr_item(p.w_out + (size_t)l * DM * DM, DM, kb * 64, nb * 32, (bf16_t*)(ws + OFF_WOUT + l * SZ_WOUT), DM, nb * 32, kb * 64, nullptr, scr, lane); continue; }
        r -= I_WOUT;
        if (r < I_WUQ) { const int nb = r >> 2, kb = r & 3;
            tr_item(p.w_uq + (size_t)l * 256 * 768, 768, kb * 64, nb * 32, (bf16_t*)(ws + OFF_WUQ + l * SZ_WUQ), 256, nb * 32, kb * 64, p.q_norm + l * 256, scr, lane); continue; }
        r -= I_WUQ;
        if (r < I_WUKV) { const int nb = r >> 1, kb = r & 1;
            tr_item(p.w_ukv + (size_t)l * 128 * 1024, 1024, kb * 64, nb * 32, (bf16_t*)(ws + OFF_WUKV + l * SZ_WUKV), 128, nb * 32, kb * 64, p.kv_norm + l * 128, scr, lane); continue; }
        r -= I_WUKV;
        if (r < I_W2) { tr_item(p.w2 + (size_t)l * 64 * 512, 512, 0, r * 32, (bf16_t*)(ws + OFF_W2T) + (size_t)l * 512 * 64, 64, r * 32, 0, nullptr, scr, lane); continue; }
        r -= I_W2;
        if (r < I_A2) { tr_item(p.a2 + (size_t)l * 64 * 512, 512, 0, r * 32, (bf16_t*)(ws + OFF_A2T) + (size_t)l * 512 * 64, 64, r * 32, 0, nullptr, scr, lane); continue; }
        r -= I_A2;
        if (l >= 1) tr_item(p.v1 + (size_t)(l - 1) * 512 * 32, 32, r * 64, 0, (bf16_t*)(ws + OFF_V1T) + (size_t)(l - 1) * 32 * 512, 512, 0, r * 64, nullptr, scr, lane);
    }
    for (int it = gw; it < NL * 12 * 8; it += NGW) {
        const int l = it / 96, r = it - l * 96, nb = r >> 3, ks = r & 7, n = nb * 256 + lane * 4;
        f32x4 a0 = (f32x4){0.f, 0.f, 0.f, 0.f}, a1 = a0, a2 = a0, a3 = a0;
        const float* w = p.w_ada + (size_t)l * DM * 3072 + n;
#pragma unroll 8
        for (int k = ks * 128; k < ks * 128 + 128; ++k) { const f32x4 wv = *(const f32x4*)(w + (size_t)k * 3072);
            a0 += wv * siluf_(p.c[k]); a1 += wv * siluf_(p.c[DM + k]); a2 += wv * siluf_(p.c[2 * DM + k]); a3 += wv * siluf_(p.c[3 * DM + k]); }
        float* mp = (float*)(ws + OFF_MODP) + ((size_t)(l * 8 + ks) * 4) * 3072 + n;
        *(f32x4*)mp = a0; *(f32x4*)(mp + 3072) = a1; *(f32x4*)(mp + 2 * 3072) = a2; *(f32x4*)(mp + 3 * 3072) = a3;
    }
    const size_t gt = (size_t)blockIdx.x * NTHREADS + tid, GT = (size_t)G * NTHREADS;
    for (size_t i = gt; i < (size_t)3 * 512 * 32; i += GT) { const int l1 = (int)(i / (512 * 32)), r = (int)(i % (512 * 32)), c = r >> 5, k = r & 31;
        ((bf16_t*)(ws + OFF_V2T))[i] = f2bf(p.v2[(size_t)l1 * 32 * 512 + k * 512 + c]); }
    for (size_t i = gt; i < (size_t)NL * 4 * 128 * 128; i += GT) { const int s = (int)(i & 127), t = (int)((i >> 7) & 127);
        ((bf16_t*)(ws + OFF_WS))[i] = f2bf(((s >> 6) <= (t >> 6)) ? p.w_s[i] : 0.f); }
    for (size_t i = gt; i < (size_t)M_TOK * 16; i += GT) { const int t = (int)(i >> 4), k = (int)(i & 15);
        const float inv = powf(10000.f, -(float)(2 * k) / 32.f); const float ang = (float)p.pos[t] * inv;
        ((float*)(ws + OFF_ROPE))[i] = cosf(ang); ((float*)(ws + OFF_ROPE))[(size_t)M_TOK * 16 + i] = sinf(ang); }
    for (size_t i = gt; i < (size_t)M_TOK * DM / 4; i += 8 * GT) { f32x4 v[8];
#pragma unroll
        for (int u = 0; u < 8; ++u) if (i + u * GT < (size_t)M_TOK * DM / 4) v[u] = ((const f32x4*)p.x)[i + u * GT];
#pragma unroll
        for (int u = 0; u < 8; ++u) if (i + u * GT < (size_t)M_TOK * DM / 4) ((f32x4*)p.out)[i + u * GT] = v[u]; }
}

__device__ __forceinline__ f32x4 mod4(const Params& p, int l, int b, int kind, int col) {
    const float* mp = (const float*)(p.ws + OFF_MODP) + ((size_t)(l * 8) * 4 + b) * 3072 + kind * DM + col;
    f32x4 s = *(const f32x4*)(p.b_ada + (size_t)l * 3072 + kind * DM + col);
#pragma unroll
    for (int ks = 0; ks < 8; ++ks) s += *(const f32x4*)(mp + (size_t)ks * 4 * 3072);
    return s;
}
__device__ __forceinline__ void phase_modt(const Params& p) {
    float* T = (float*)(p.ws + OFF_MODT);
    for (int i = blockIdx.x * NTHREADS + tid_l(); i < NL * 4 * 256; i += gridDim.x * NTHREADS) { const int l = i / 1024, r = i - l * 1024, b = r >> 8, col = (r & 255) * 4;
        const f32x4 sh = mod4(p, l, b, 0, col), sc = mod4(p, l, b, 1, col), gt = mod4(p, l, b, 2, col);
        const f32x4 g = *(const f32x4*)(p.pre_g + (size_t)l * DM + col), pg = *(const f32x4*)(p.post_g + (size_t)l * DM + col);
        const size_t o = ((size_t)(l * 4 + b)) * 1024 + col;
        *(f32x4*)(T + o) = g * (sc + 1.f); *(f32x4*)(T + (size_t)NL * 4096 + o) = sh; *(f32x4*)(T + (size_t)2 * NL * 4096 + o) = gt * pg; }
}
__device__ __forceinline__ void normmod_row(const Params& p, int l, int row, const f32x4 (&v)[4], int lane) {
    float ss = 0.f;
#pragma unroll
    for (int j = 0; j < 4; ++j) ss += v[j][0] * v[j][0] + v[j][1] * v[j][1] + v[j][2] * v[j][2] + v[j][3] * v[j][3];
    const float rstd = rsqrtf(wave_sum(ss) * (1.f / DM) + 1e-6f);
    const int b = row / SEQ;
    const float* T = (const float*)(p.ws + OFF_MODT) + ((size_t)(l * 4 + b)) * 1024;
    bf16_t* hrow = (bf16_t*)(p.ws + OFF_H) + (size_t)row * DM;
#pragma unroll
    for (int j = 0; j < 4; ++j) { const int col = 4 * lane + 256 * j;
        const f32x4 a = *(const f32x4*)(T + col), sh = *(const f32x4*)(T + (size_t)NL * 4096 + col);
        f32x4 o = v[j] * rstd * a + sh;
        *(u32x2*)(hrow + col) = pack4(o); }
}
__device__ __forceinline__ void phase0b(const Params& p) {
    const int tidq = tid_l(); const int lane = tidq & 63, gw = blockIdx.x * NWAVES + (tidq >> 6), NGW = gridDim.x * NWAVES;
    for (int row = gw; row < M_TOK; row += NGW) { f32x4 v[4];
#pragma unroll
        for (int j = 0; j < 4; ++j) v[j] = *(const f32x4*)(p.out + (size_t)row * DM + 4 * lane + 256 * j);
        normmod_row(p, 0, row, v, lane); }
}
__device__ __forceinline__ void phase_final(const Params& p, int l) {
    const int tidq = tid_l(); const int lane = tidq & 63, gw = blockIdx.x * NWAVES + (tidq >> 6), NGW = gridDim.x * NWAVES;
    const bf16_t* Y = (const bf16_t*)(p.ws + OFF_R3 + R3_Y);
    for (int row = gw; row < M_TOK; row += NGW) {
        f32x4 y[4]; float ss = 0.f;
#pragma unroll
        for (int j = 0; j < 4; ++j) { y[j] = unpack4(*(const u32x2*)(Y + (size_t)row * DM + 4 * lane + 256 * j)); ss += y[j][0] * y[j][0] + y[j][1] * y[j][1] + y[j][2] * y[j][2] + y[j][3] * y[j][3]; }
        const float rstd = rsqrtf(wave_sum(ss) * (1.f / DM) + 1e-6f);
        const int b = row / SEQ; f32x4 v[4];
        const float* GG = (const float*)(p.ws + OFF_MODT) + (size_t)2 * NL * 4096 + ((size_t)(l * 4 + b)) * 1024;
#pragma unroll
        for (int j = 0; j < 4; ++j) { const int col = 4 * lane + 256 * j;
            const f32x4 xg = *(const f32x4*)(p.out + (size_t)row * DM + col), gg = *(const f32x4*)(GG + col);
            v[j] = xg + gg * (y[j] * rstd);
            *(f32x4*)(p.out + (size_t)row * DM + col) = v[j]; }
        if (l + 1 < NL) normmod_row(p, l + 1, row, v, lane);
    }
}

__device__ __forceinline__ void mla_prep_item(const Params& p, int l, int item, unsigned char* lds) {
    const int tid = tid_l(), lane = tid & 63, wave = tid >> 6, fr = lane & 15, fq = lane >> 4;
    const int t0 = item * 64;
    const bf16_t* P1 = (const bf16_t*)(p.ws + OFF_R1);
    bf16_t* Q = (bf16_t*)(p.ws + OFF_R3 + R3_Q); bf16_t* Kf = (bf16_t*)(p.ws + OFF_R3 + R3_KF); bf16_t* Vt = (bf16_t*)(p.ws + OFF_R3 + R3_VT);
    const bf16_t* Wuq = (const bf16_t*)(p.ws + OFF_WUQ + l * SZ_WUQ); const bf16_t* Wukv = (const bf16_t*)(p.ws + OFF_WUKV + l * SZ_WUKV);
    const float* COS = (const float*)(p.ws + OFF_ROPE); const float* SIN = COS + (size_t)M_TOK * 16;
    float* rq = (float*)lds; float* rkv = rq + 64;
    __syncthreads();
    { const int row = tid >> 3, part = tid & 7; const bf16_t* pr = P1 + (size_t)(t0 + row) * NP1;
        float sq = 0.f, sk = 0.f;
#pragma unroll
        for (int i = 0; i < 4; ++i) { const u32x4 u = *(const u32x4*)(pr + C_QLAT + part * 32 + i * 8);
            sq += bf_lo(u.x) * bf_lo(u.x) + bf_hi(u.x) * bf_hi(u.x) + bf_lo(u.y) * bf_lo(u.y) + bf_hi(u.y) * bf_hi(u.y) + bf_lo(u.z) * bf_lo(u.z) + bf_hi(u.z) * bf_hi(u.z) + bf_lo(u.w) * bf_lo(u.w) + bf_hi(u.w) * bf_hi(u.w); }
#pragma unroll
        for (int i = 0; i < 2; ++i) { const u32x4 u = *(const u32x4*)(pr + C_KVLAT + part * 16 + i * 8);
            sk += bf_lo(u.x) * bf_lo(u.x) + bf_hi(u.x) * bf_hi(u.x) + bf_lo(u.y) * bf_lo(u.y) + bf_hi(u.y) * bf_hi(u.y) + bf_lo(u.z) * bf_lo(u.z) + bf_hi(u.z) * bf_hi(u.z) + bf_lo(u.w) * bf_lo(u.w) + bf_hi(u.w) * bf_hi(u.w); }
        sq += __shfl_xor(sq, 1); sq += __shfl_xor(sq, 2); sq += __shfl_xor(sq, 4);
        sk += __shfl_xor(sk, 1); sk += __shfl_xor(sk, 2); sk += __shfl_xor(sk, 4);
        if (part == 0) { rq[row] = rsqrtf(sq * (1.f / 256.f) + 1e-6f); rkv[row] = rsqrtf(sk * (1.f / 128.f) + 1e-6f); }
        const int i2 = part * 2; const int t = t0 + row;
        const unsigned u1 = *(const unsigned*)(pr + C_KROPE + i2), u2 = *(const unsigned*)(pr + C_KROPE + 16 + i2);
        const float c0 = COS[(size_t)t * 16 + i2], c1 = COS[(size_t)t * 16 + i2 + 1], s0 = SIN[(size_t)t * 16 + i2], s1 = SIN[(size_t)t * 16 + i2 + 1];
        const float x10 = bf_lo(u1), x11 = bf_hi(u1), x20 = bf_lo(u2), x21 = bf_hi(u2);
        const unsigned o1 = cvt_pk_bf16(x10 * c0 - x20 * s0, x11 * c1 - x21 * s1), o2 = cvt_pk_bf16(x20 * c0 + x10 * s0, x21 * c1 + x11 * s1);
#pragma unroll
        for (int h = 0; h < 8; ++h) { *(unsigned*)(Kf + (size_t)t * 768 + h * 96 + 64 + i2) = o1; *(unsigned*)(Kf + (size_t)t * 768 + h * 96 + 80 + i2) = o2; }
    }
    __syncthreads();
    { const int head = wave;
        f32x4 acc[4][6];
#pragma unroll
        for (int rt = 0; rt < 4; ++rt)
#pragma unroll
            for (int ct = 0; ct < 6; ++ct) acc[rt][ct] = (f32x4){0.f, 0.f, 0.f, 0.f};
        const bf16_t* wp = Wuq + (size_t)(head * 96 + fr) * 256 + fq * 8;
#pragma unroll 1
        for (int hf = 0; hf < 2; ++hf) { bf16x8 wf[6][4];
#pragma unroll
            for (int k4 = 0; k4 < 4; ++k4)
#pragma unroll
                for (int ct = 0; ct < 6; ++ct) wf[ct][k4] = ld_frag(wp + (size_t)ct * 16 * 256 + (hf * 4 + k4) * 32);
#pragma unroll
            for (int rt = 0; rt < 4; ++rt) { const bf16_t* ap = P1 + (size_t)(t0 + rt * 16 + fr) * NP1 + C_QLAT + fq * 8 + hf * 128; bf16x8 af[4];
#pragma unroll
                for (int k4 = 0; k4 < 4; ++k4) af[k4] = ld_frag(ap + k4 * 32);
#pragma unroll
                for (int k4 = 0; k4 < 4; ++k4)
#pragma unroll
                    for (int ct = 0; ct < 6; ++ct) acc[rt][ct] = MFMA(wf[ct][k4], af[k4], acc[rt][ct]); } }
#pragma unroll
        for (int rt = 0; rt < 4; ++rt) {
            const int t = t0 + rt * 16 + fr; const float rs = rq[rt * 16 + fr] * QSCALE;
            bf16_t* qp = Q + (size_t)t * 768 + head * 96 + fq * 4;
#pragma unroll
            for (int ct = 0; ct < 4; ++ct) *(u32x2*)(qp + ct * 16) = pack4(acc[rt][ct] * rs);
            const f32x4 cs = *(const f32x4*)(COS + (size_t)t * 16 + fq * 4), sn = *(const f32x4*)(SIN + (size_t)t * 16 + fq * 4);
            const f32x4 x1 = acc[rt][4] * rs, x2 = acc[rt][5] * rs;
            *(u32x2*)(qp + 64) = pack4(x1 * cs - x2 * sn); *(u32x2*)(qp + 80) = pack4(x2 * cs + x1 * sn); }
    }
    { const int head = wave; const int b = t0 / SEQ;
        const bf16_t* wp = Wukv + (size_t)(head * 128 + fr) * 128 + fq * 8;
#pragma unroll 1
        for (int part = 0; part < 2; ++part) {
            bf16x8 wf[4][4]; f32x4 ac[4][4];
#pragma unroll
            for (int ks = 0; ks < 4; ++ks)
#pragma unroll
                for (int ct = 0; ct < 4; ++ct) wf[ct][ks] = ld_frag(wp + (size_t)(part * 64 + ct * 16) * 128 + ks * 32);
#pragma unroll
            for (int rt = 0; rt < 4; ++rt) { const bf16_t* ap = P1 + (size_t)(t0 + rt * 16 + fr) * NP1 + C_KVLAT + fq * 8; bf16x8 af[4];
#pragma unroll
                for (int ks = 0; ks < 4; ++ks) af[ks] = ld_frag(ap + ks * 32);
#pragma unroll
                for (int ct = 0; ct < 4; ++ct) { ac[rt][ct] = (f32x4){0.f, 0.f, 0.f, 0.f};
#pragma unroll
                    for (int ks = 0; ks < 4; ++ks) ac[rt][ct] = part ? MFMA(af[ks], wf[ct][ks], ac[rt][ct]) : MFMA(wf[ct][ks], af[ks], ac[rt][ct]); } }
#pragma unroll
            for (int rt = 0; rt < 4; ++rt) {
                if (part == 0) { const int t = t0 + rt * 16 + fr; const float rs = rkv[rt * 16 + fr];
#pragma unroll
                    for (int ct = 0; ct < 4; ++ct) *(u32x2*)(Kf + (size_t)t * 768 + head * 96 + ct * 16 + fq * 4) = pack4(ac[rt][ct] * rs); }
                else { const f32x4 rv = *(const f32x4*)(rkv + rt * 16 + fq * 4); const int s0 = (t0 % SEQ) + rt * 16 + fq * 4;
#pragma unroll
                    for (int ct = 0; ct < 4; ++ct) *(u32x2*)(Vt + ((size_t)(b * 8 + head) * 64 + ct * 16 + fr) * SEQ + s0) = pack4(ac[rt][ct] * rv); } }
        }
    }
}

__device__ __forceinline__ void gmlp_item(const Params& p, int l, int item, unsigned char* lds, bool do_store = true) {
    const int tid = tid_l(), lane = tid & 63, wave = tid >> 6, fr = lane & 15, fq = lane >> 4;
    const int t0 = item * 128;
    const bf16_t* P1 = (const bf16_t*)(p.ws + OFF_R1); bf16_t* Z = (bf16_t*)(p.ws + OFF_Z);
    const bf16_t* Ws = (const bf16_t*)(p.ws + OFF_WS) + (size_t)l * 4 * 128 * 128;
    bf16_t* vb = (bf16_t*)lds;
    constexpr int VS = 520;
    __syncthreads();
    { const int tok = tid >> 2, qd = tid & 3; const bf16_t* pr = P1 + (size_t)(t0 + tok) * NP1 + C_GMV + qd * 128;
        float s = 0.f, s2 = 0.f;
#pragma unroll 4
        for (int i = 0; i < 16; ++i) { const u32x4 u = *(const u32x4*)(pr + i * 8); const unsigned uu[4] = {u.x, u.y, u.z, u.w};
#pragma unroll
            for (int e = 0; e < 4; ++e) { const float a = geluf_(bf_lo(uu[e])), b = geluf_(bf_hi(uu[e])); s += a + b; s2 += a * a + b * b; } }
        s += __shfl_xor(s, 1); s += __shfl_xor(s, 2); s2 += __shfl_xor(s2, 1); s2 += __shfl_xor(s2, 2);
        const float mean = s * (1.f / 512.f), var = fmaxf(s2 * (1.f / 512.f) - mean * mean, 0.f), rstd = rsqrtf(var + 1e-5f);
        const float* lg = p.ln_g + (size_t)l * 512 + qd * 128; const float* lb = p.ln_b + (size_t)l * 512 + qd * 128;
#pragma unroll 4
        for (int i = 0; i < 16; ++i) { const u32x4 u = *(const u32x4*)(pr + i * 8); const unsigned uu[4] = {u.x, u.y, u.z, u.w}; unsigned oo[4];
#pragma unroll
            for (int e = 0; e < 4; ++e) { const float a = (geluf_(bf_lo(uu[e])) - mean) * rstd * lg[i * 8 + 2 * e] + lb[i * 8 + 2 * e], b = (geluf_(bf_hi(uu[e])) - mean) * rstd * lg[i * 8 + 2 * e + 1] + lb[i * 8 + 2 * e + 1];
                oo[e] = cvt_pk_bf16(a, b); }
            *(u32x4*)(vb + (size_t)tok * VS + qd * 128 + i * 8) = (u32x4){oo[0], oo[1], oo[2], oo[3]}; }
    }
    __syncthreads();
#pragma unroll 1
    for (int g = 0; g < 4; ++g) {
        const int cbase = g * 128 + wave * 16;
        bf16x8 vfr[4];
#pragma unroll
        for (int ks = 0; ks < 4; ++ks) { bf16x8 f;
#pragma unroll
            for (int j = 0; j < 8; ++j) f[j] = (short)vb[(size_t)(ks * 32 + fq * 8 + j) * VS + cbase + fr];
            vfr[ks] = f; }
        const bf16_t* wg = Ws + (size_t)g * 128 * 128;
#pragma unroll 1
        for (int tt = 0; tt < 8; ++tt) {
            f32x4 acc = (f32x4){0.f, 0.f, 0.f, 0.f};
            const bf16_t* wp = wg + (size_t)(tt * 16 + fr) * 128 + fq * 8;
#pragma unroll
            for (int ks = 0; ks < 4; ++ks) acc = MFMA(vfr[ks], ld_frag(wp + ks * 32), acc);
            const int tl = tt * 16 + fr, t = t0 + tl, c = cbase + fq * 4;
            const float bs = p.b_s[(size_t)(l * 4 + g) * 128 + tl];
            const f32x4 u = unpack4(*(const u32x2*)(P1 + (size_t)t * NP1 + C_GMU + c));
            bf16_t* zp = Z + (size_t)t * NZ + 512 + c; const f32x4 z = unpack4(*(const u32x2*)zp);
            f32x4 o;
#pragma unroll
            for (int e = 0; e < 4; ++e) o[e] = geluf_(u[e]) * (acc[e] + bs) * siluf_(z[e]);
            if (do_store) *(u32x2*)zp = pack4(o);
        }
    }
}

__device__ __forceinline__ f32x4 mix4(const bf16_t* pr, const bf16_t* pp, bool has_prev, const float* mu) {
    const f32x4 a = unpack4(*(const u32x2*)pr); f32x4 b = (f32x4){0.f, 0.f, 0.f, 0.f}; if (has_prev) b = unpack4(*(const u32x2*)pp);
    const f32x4 m = *(const f32x4*)mu; return a + (b - a) * m;
}
__device__ __forceinline__ void rwkv_prep_item(const Params& p, int l, int item, unsigned char* lds) {
    const int tid = tid_l(), lane = tid & 63, wave = __builtin_amdgcn_readfirstlane(tid >> 6), fr = lane & 15, fq = lane >> 4;
    const int t0 = item * 64;
    const bf16_t* P1 = (const bf16_t*)(p.ws + OFF_R1);
    const float* mu = p.mu + (size_t)l * 1664 - C_RW;
    const bf16_t* W2T = (const bf16_t*)(p.ws + OFF_W2T) + (size_t)l * 512 * 64; const bf16_t* A2T = (const bf16_t*)(p.ws + OFF_A2T) + (size_t)l * 512 * 64;
    unsigned char* r2 = p.ws + OFF_R2;
    bf16_t* VF = (bf16_t*)(p.ws + OFF_VF);
    constexpr int LS = 136, TS = 40, PS = 36;
    bf16_t* LAT = (bf16_t*)lds; bf16_t* T1 = (bf16_t*)(lds + 64 * LS * 2); float* T1P = (float*)(lds + 64 * LS * 2 + 64 * TS * 2);
    __syncthreads();
    { const int tt = tid >> 3, part = tid & 7; const int t = t0 + tt; const bool hp = (t % SEQ) != 0;
        const bf16_t* pr = P1 + (size_t)t * NP1; const bf16_t* pp = pr - NP1; const int c0 = C_WLAT + part * 16;
        f32x4 x[4];
#pragma unroll
        for (int e = 0; e < 4; ++e) { x[e] = mix4(pr + c0 + e * 4, pp + c0 + e * 4, hp, mu + c0 + e * 4);
            if (part < 4) {
#pragma unroll
                for (int k = 0; k < 4; ++k) x[e][k] = tanhf_(x[e][k]); } }
        u32x4 w0, w1; w0.x = cvt_pk_bf16(x[0][0], x[0][1]); w0.y = cvt_pk_bf16(x[0][2], x[0][3]); w0.z = cvt_pk_bf16(x[1][0], x[1][1]); w0.w = cvt_pk_bf16(x[1][2], x[1][3]);
        w1.x = cvt_pk_bf16(x[2][0], x[2][1]); w1.y = cvt_pk_bf16(x[2][2], x[2][3]); w1.z = cvt_pk_bf16(x[3][0], x[3][1]); w1.w = cvt_pk_bf16(x[3][2], x[3][3]);
        *(u32x4*)(LAT + tt * LS + part * 16) = w0; *(u32x4*)(LAT + tt * LS + part * 16 + 8) = w1; }
    if (l >= 1) { const int rt = wave & 3, kh = wave >> 2; const int t = t0 + rt * 16 + fr; const bool hp = (t % SEQ) != 0;
        const bf16_t* pr = P1 + (size_t)t * NP1; const bf16_t* pp = pr - NP1;
        const bf16_t* V1T = (const bf16_t*)(p.ws + OFF_V1T) + (size_t)(l - 1) * 32 * 512;
        f32x4 c0 = (f32x4){0.f, 0.f, 0.f, 0.f}, c1 = c0;
#pragma unroll 4
        for (int k8 = 0; k8 < 8; ++k8) { const int ks = kh * 8 + k8; const int cv = C_RWV + ks * 32 + fq * 8;
            const bf16x8 af = pack_frag(mix4(pr + cv, pp + cv, hp, mu + cv), mix4(pr + cv + 4, pp + cv + 4, hp, mu + cv + 4));
            c0 = MFMA(ld_frag(V1T + (size_t)fr * 512 + ks * 32 + fq * 8), af, c0); c1 = MFMA(ld_frag(V1T + (size_t)(16 + fr) * 512 + ks * 32 + fq * 8), af, c1); }
        if (kh == 1) { *(f32x4*)(T1P + (rt * 16 + fr) * PS + fq * 4) = c0; *(f32x4*)(T1P + (rt * 16 + fr) * PS + 16 + fq * 4) = c1; }
        __syncthreads();
        if (kh == 0) { c0 += *(const f32x4*)(T1P + (rt * 16 + fr) * PS + fq * 4); c1 += *(const f32x4*)(T1P + (rt * 16 + fr) * PS + 16 + fq * 4);
            *(u32x2*)(T1 + (rt * 16 + fr) * TS + fq * 4) = pack4(c0); *(u32x2*)(T1 + (rt * 16 + fr) * TS + 16 + fq * 4) = pack4(c1); }
    }
    __syncthreads();
    { const int h = wave;
        bf16x8 wa[4][2], ww[4][2], wv2[4];
#pragma unroll
        for (int ct = 0; ct < 4; ++ct) { const int crow = h * 64 + ct * 16 + fr;
#pragma unroll
            for (int ks = 0; ks < 2; ++ks) { wa[ct][ks] = ld_frag(A2T + (size_t)crow * 64 + ks * 32 + fq * 8); ww[ct][ks] = ld_frag(W2T + (size_t)crow * 64 + ks * 32 + fq * 8); }
            wv2[ct] = (bf16x8){0, 0, 0, 0, 0, 0, 0, 0};
            if (l >= 1) wv2[ct] = ld_frag((const bf16_t*)(p.ws + OFF_V2T) + (size_t)(l - 1) * 512 * 32 + (size_t)crow * 32 + fq * 8); }
#pragma unroll 1
        for (int rt = 0; rt < 4; ++rt) { const int tl = rt * 16 + fr, t = t0 + tl; const bool hp = (t % SEQ) != 0;
            const bf16_t* pr = P1 + (size_t)t * NP1; const bf16_t* pp = pr - NP1;
            const bf16x8 fw0 = ld_frag(LAT + tl * LS + fq * 8), fw1 = ld_frag(LAT + tl * LS + 32 + fq * 8), fa0 = ld_frag(LAT + tl * LS + 64 + fq * 8), fa1 = ld_frag(LAT + tl * LS + 96 + fq * 8);
            bf16x8 t1f = (bf16x8){0, 0, 0, 0, 0, 0, 0, 0}; if (l >= 1) t1f = ld_frag(T1 + tl * TS + fq * 8);
            f32x4 ksv[4]; float ss = 0.f;
#pragma unroll
            for (int ct = 0; ct < 4; ++ct) { const int c = h * 64 + ct * 16 + fq * 4;
                ksv[ct] = mix4(pr + C_RWK + c, pp + C_RWK + c, hp, mu + C_RWK + c);
                const f32x4 kr = ksv[ct] * *(const f32x4*)(p.k_k + (size_t)l * 512 + c);
                ss += kr[0] * kr[0] + kr[1] * kr[1] + kr[2] * kr[2] + kr[3] * kr[3]; }
            ss += __shfl_xor(ss, 16); ss += __shfl_xor(ss, 32);
            const float inv = 1.f / fmaxf(sqrtf(ss), 1e-12f);
            float dsum = 0.f;
#pragma unroll
            for (int ct = 0; ct < 4; ++ct) {
                f32x4 aa = (f32x4){0.f, 0.f, 0.f, 0.f}, aw = aa, avm = aa;
                aa = MFMA(wa[ct][0], fa0, aa); aa = MFMA(wa[ct][1], fa1, aa); aw = MFMA(ww[ct][0], fw0, aw); aw = MFMA(ww[ct][1], fw1, aw);
                if (l >= 1) avm = MFMA(wv2[ct], t1f, avm);
                const int c = h * 64 + ct * 16 + fq * 4; const size_t o = (size_t)t * 512 + c;
                const f32x4 rs = mix4(pr + C_RWR + c, pp + C_RWR + c, hp, mu + C_RWR + c);
                f32x4 vs = mix4(pr + C_RWV + c, pp + C_RWV + c, hp, mu + C_RWV + c);
                const f32x4 a0 = *(const f32x4*)(p.a0 + (size_t)l * 512 + c), w0 = *(const f32x4*)(p.w0 + (size_t)l * 512 + c), kkw = *(const f32x4*)(p.k_k + (size_t)l * 512 + c);
                const f32x4 ka = *(const f32x4*)(p.k_a + (size_t)l * 512 + c);
                f32x4 lw, asg;
#pragma unroll
                for (int e = 0; e < 4; ++e) { asg[e] = sigmoidf_(a0[e] + aa[e]); lw[e] = -0.6065306597126334f * sigmoidf_(w0[e] + aw[e]); }
                *(f32x4*)((float*)(r2 + R2_LW) + o) = lw;
                if (l == 0) { *(u32x2*)(VF + o) = pack4(vs); }
                else { const f32x4 vf = unpack4(*(const u32x2*)(VF + o)), v0 = *(const f32x4*)(p.v0 + (size_t)(l - 1) * 512 + c);
#pragma unroll
                    for (int e = 0; e < 4; ++e) vs[e] = vs[e] + (vf[e] - vs[e]) * sigmoidf_(v0[e] + avm[e]); }
                const f32x4 kk = ksv[ct] * kkw * inv, km = ksv[ct] * ((asg - 1.f) * ka + 1.f), bb = kk * asg;
                { const f32x4 rk = *(const f32x4*)(p.r_k + (size_t)l * 512 + c); const f32x4 pr3 = rs * km * rk; dsum += pr3[0] + pr3[1] + pr3[2] + pr3[3]; }
                *(u32x2*)((bf16_t*)(r2 + R2_R) + o) = pack4(rs); *(u32x2*)((bf16_t*)(r2 + R2_K) + o) = pack4(km); *(u32x2*)((bf16_t*)(r2 + R2_V) + o) = pack4(vs);
                *(u32x2*)((bf16_t*)(r2 + R2_KK) + o) = pack4(kk); *(u32x2*)((bf16_t*)(r2 + R2_B) + o) = pack4(bb); }
            dsum += __shfl_xor(dsum, 16); dsum += __shfl_xor(dsum, 32);
            if (fq == 0) ((float*)(p.ws + OFF_DOT))[(size_t)t * 8 + h] = dsum;
        }
    }
}

__device__ __forceinline__ void attn_item(const Params& p, int b, int h, int qb, unsigned char* lds, bool do_store = true) {
    const int tid = tid_l(), lane = tid & 63, wave = tid >> 6, fr = lane & 15, fq = lane >> 4;
    const bf16_t* Q = (const bf16_t*)(p.ws + OFF_R3 + R3_Q); const bf16_t* Kf = (const bf16_t*)(p.ws + OFF_R3 + R3_KF); const bf16_t* Vt = (const bf16_t*)(p.ws + OFF_R3 + R3_VT);
    bf16_t* Z = (bf16_t*)(p.ws + OFF_Z);
    constexpr int KS = 104, VS = 72, KB = 64 * KS * 2, VB = 64 * VS * 2, BUF = KB + VB;
    const int nkt = 4 * qb + 4, mykt = 4 * qb + (wave >> 1) + 1;
    const int trow0 = b * SEQ + qb * 256 + wave * 32 + fr;
    bf16x8 qf[2][3];
#pragma unroll
    for (int r = 0; r < 2; ++r)
#pragma unroll
        for (int ks = 0; ks < 3; ++ks) qf[r][ks] = ld_frag(Q + (size_t)(trow0 + r * 16) * 768 + h * 96 + ks * 32 + fq * 8);
    const bf16_t* kg = Kf + (size_t)(b * SEQ) * 768 + h * 96; const bf16_t* vg = Vt + (size_t)(b * 8 + h) * 64 * SEQ;
    const int kr0 = tid / 12, kc0 = tid % 12, kr1 = (tid + 512) / 12, kc1 = (tid + 512) % 12, vd = tid >> 3, vc = tid & 7;
    u32x4 pk0, pk1 = (u32x4){0, 0, 0, 0}, pv;
    __syncthreads();
    pk0 = *(const u32x4*)(kg + (size_t)kr0 * 768 + kc0 * 8); if (tid < 256) pk1 = *(const u32x4*)(kg + (size_t)kr1 * 768 + kc1 * 8);
    pv = *(const u32x4*)(vg + (size_t)vd * SEQ + vc * 8);
    { bf16_t* ks_ = (bf16_t*)lds; bf16_t* vs_ = (bf16_t*)(lds + KB);
        *(u32x4*)(ks_ + kr0 * KS + kc0 * 8) = pk0; if (tid < 256) *(u32x4*)(ks_ + kr1 * KS + kc1 * 8) = pk1; *(u32x4*)(vs_ + vd * VS + vc * 8) = pv; }
    __syncthreads();
    f32x4 O[2][4]; float m[2] = {-1e30f, -1e30f}, lsum[2] = {0.f, 0.f};
#pragma unroll
    for (int r = 0; r < 2; ++r)
#pragma unroll
        for (int d = 0; d < 4; ++d) O[r][d] = (f32x4){0.f, 0.f, 0.f, 0.f};
#pragma unroll 1
    for (int kt = 0; kt < nkt; ++kt) {
        const bool pre = (kt + 1 < nkt);
        if (pre) { const size_t ko = (size_t)(kt + 1) * 64;
            pk0 = *(const u32x4*)(kg + (ko + kr0) * 768 + kc0 * 8); if (tid < 256) pk1 = *(const u32x4*)(kg + (ko + kr1) * 768 + kc1 * 8);
            pv = *(const u32x4*)(vg + (size_t)vd * SEQ + ko + vc * 8); }
        if (kt < mykt) {
            const bf16_t* ks_ = (const bf16_t*)(lds + (kt & 1) * BUF); const bf16_t* vs_ = (const bf16_t*)(lds + (kt & 1) * BUF + KB);
            f32x4 s[2][4];
#pragma unroll
            for (int c4 = 0; c4 < 4; ++c4) { s[0][c4] = (f32x4){0.f, 0.f, 0.f, 0.f}; s[1][c4] = s[0][c4];
#pragma unroll
                for (int ks = 0; ks < 3; ++ks) { const bf16x8 kf = ld_frag(ks_ + (c4 * 16 + fr) * KS + ks * 32 + fq * 8);
                    s[0][c4] = MFMA(kf, qf[0][ks], s[0][c4]); s[1][c4] = MFMA(kf, qf[1][ks], s[1][c4]); } }
            bf16x8 pf[2][2];
#pragma unroll
            for (int r = 0; r < 2; ++r) {
                float mx = -1e30f;
#pragma unroll
                for (int c4 = 0; c4 < 4; ++c4) mx = fmaxf(fmaxf(fmaxf(s[r][c4][0], s[r][c4][1]), fmaxf(s[r][c4][2], s[r][c4][3])), mx);
                mx = fmaxf(mx, __shfl_xor(mx, 16)); mx = fmaxf(mx, __shfl_xor(mx, 32));
                const float mn = fmaxf(m[r], mx), alpha = __builtin_amdgcn_exp2f(m[r] - mn); m[r] = mn;
                float ps = 0.f;
#pragma unroll
                for (int c4 = 0; c4 < 4; ++c4)
#pragma unroll
                    for (int e = 0; e < 4; ++e) { s[r][c4][e] = __builtin_amdgcn_exp2f(s[r][c4][e] - mn); ps += s[r][c4][e]; }
                lsum[r] = lsum[r] * alpha + ps;
#pragma unroll
                for (int d = 0; d < 4; ++d) O[r][d] = O[r][d] * alpha;
                pf[r][0] = pack_frag(s[r][0], s[r][1]); pf[r][1] = pack_frag(s[r][2], s[r][3]); }
#pragma unroll
            for (int d = 0; d < 4; ++d) { const bf16_t* vp = vs_ + (d * 16 + fr) * VS + fq * 4;
                const bf16x8 v0 = join_frag(*(const u32x2*)(vp), *(const u32x2*)(vp + 16)), v1 = join_frag(*(const u32x2*)(vp + 32), *(const u32x2*)(vp + 48));
#pragma unroll
                for (int r = 0; r < 2; ++r) { O[r][d] = MFMA(v0, pf[r][0], O[r][d]); O[r][d] = MFMA(v1, pf[r][1], O[r][d]); } }
        }
        if (pre) { bf16_t* ks_ = (bf16_t*)(lds + ((kt + 1) & 1) * BUF); bf16_t* vs_ = (bf16_t*)(lds + ((kt + 1) & 1) * BUF + KB);
            *(u32x4*)(ks_ + kr0 * KS + kc0 * 8) = pk0; if (tid < 256) *(u32x4*)(ks_ + kr1 * KS + kc1 * 8) = pk1; *(u32x4*)(vs_ + vd * VS + vc * 8) = pv; }
        __syncthreads();
    }
    if (do_store)
#pragma unroll
    for (int r = 0; r < 2; ++r) { float ls = lsum[r]; ls += __shfl_xor(ls, 16); ls += __shfl_xor(ls, 32); const float il = 1.f / ls;
#pragma unroll
        for (int d = 0; d < 4; ++d) { bf16_t* zp = Z + (size_t)(trow0 + r * 16) * NZ + h * 64 + d * 16 + fq * 4; const f32x4 z = unpack4(*(const u32x2*)zp);
            f32x4 o;
#pragma unroll
            for (int e = 0; e < 4; ++e) o[e] = O[r][d][e] * il * siluf_(z[e]);
            *(u32x2*)zp = pack4(o); } }
}

__device__ __forceinline__ void scan_item(const Params& p, int l, int bh, unsigned char* lds) {
    const int tid = tid_l(), b = bh >> 3, h = bh & 7;
    const unsigned char* r2 = p.ws + OFF_R2; bf16_t* Z = (bf16_t*)(p.ws + OFF_Z);
    float* Lw = (float*)lds; float* La = Lw + 4096; float* Lb = La + 4096; float* Lk = Lb + 4096; float* Lr = Lk + 4096; float* Lv = Lr + 4096; float* Ly = Lv + 4096;
    const int i = tid >> 3, jp = tid & 7;
    float st[8];
#pragma unroll
    for (int e = 0; e < 8; ++e) st[e] = 0.f;
    const int et = tid >> 3, ep = tid & 7;
#pragma unroll 1
    for (int ck = 0; ck < SEQ / 64; ++ck) {
        const size_t tg = (size_t)b * SEQ + ck * 64 + et; const size_t o = tg * 512 + h * 64 + ep * 8;
        __syncthreads();
        { const u32x4 ur = *(const u32x4*)((const bf16_t*)(r2 + R2_R) + o), uk = *(const u32x4*)((const bf16_t*)(r2 + R2_K) + o), uv = *(const u32x4*)((const bf16_t*)(r2 + R2_V) + o),
                      ukk = *(const u32x4*)((const bf16_t*)(r2 + R2_KK) + o), ub = *(const u32x4*)((const bf16_t*)(r2 + R2_B) + o);
            const f32x4 l0 = *(const f32x4*)((const float*)(r2 + R2_LW) + o), l1 = *(const f32x4*)((const float*)(r2 + R2_LW) + o + 4);
            const int lo = et * 64 + ep * 8;
            *(f32x4*)(Lw + lo) = (f32x4){__expf(l0[0]), __expf(l0[1]), __expf(l0[2]), __expf(l0[3])}; *(f32x4*)(Lw + lo + 4) = (f32x4){__expf(l1[0]), __expf(l1[1]), __expf(l1[2]), __expf(l1[3])};
            *(f32x4*)(La + lo) = (f32x4){-bf_lo(ukk.x), -bf_hi(ukk.x), -bf_lo(ukk.y), -bf_hi(ukk.y)}; *(f32x4*)(La + lo + 4) = (f32x4){-bf_lo(ukk.z), -bf_hi(ukk.z), -bf_lo(ukk.w), -bf_hi(ukk.w)};
            *(f32x4*)(Lb + lo) = (f32x4){bf_lo(ub.x), bf_hi(ub.x), bf_lo(ub.y), bf_hi(ub.y)}; *(f32x4*)(Lb + lo + 4) = (f32x4){bf_lo(ub.z), bf_hi(ub.z), bf_lo(ub.w), bf_hi(ub.w)};
            *(f32x4*)(Lk + lo) = (f32x4){bf_lo(uk.x), bf_hi(uk.x), bf_lo(uk.y), bf_hi(uk.y)}; *(f32x4*)(Lk + lo + 4) = (f32x4){bf_lo(uk.z), bf_hi(uk.z), bf_lo(uk.w), bf_hi(uk.w)};
            *(f32x4*)(Lr + lo) = (f32x4){bf_lo(ur.x), bf_hi(ur.x), bf_lo(ur.y), bf_hi(ur.y)}; *(f32x4*)(Lr + lo + 4) = (f32x4){bf_lo(ur.z), bf_hi(ur.z), bf_lo(ur.w), bf_hi(ur.w)};
            *(f32x4*)(Lv + lo) = (f32x4){bf_lo(uv.x), bf_hi(uv.x), bf_lo(uv.y), bf_hi(uv.y)}; *(f32x4*)(Lv + lo + 4) = (f32x4){bf_lo(uv.z), bf_hi(uv.z), bf_lo(uv.w), bf_hi(uv.w)};
        }
        __syncthreads();
#pragma unroll 1
        for (int t = 0; t < 64; ++t) { const int lo = t * 64 + jp * 8;
            const f32x4 w0 = *(const f32x4*)(Lw + lo), w1 = *(const f32x4*)(Lw + lo + 4), a0 = *(const f32x4*)(La + lo), a1 = *(const f32x4*)(La + lo + 4), b0 = *(const f32x4*)(Lb + lo), b1 = *(const f32x4*)(Lb + lo + 4),
                        k0 = *(const f32x4*)(Lk + lo), k1 = *(const f32x4*)(Lk + lo + 4), r0 = *(const f32x4*)(Lr + lo), r1 = *(const f32x4*)(Lr + lo + 4);
            const float vi = Lv[t * 64 + i];
            float sa = st[0] * a0[0] + st[1] * a0[1] + st[2] * a0[2] + st[3] * a0[3] + st[4] * a1[0] + st[5] * a1[1] + st[6] * a1[2] + st[7] * a1[3];
            sa += __shfl_xor(sa, 1); sa += __shfl_xor(sa, 2); sa += __shfl_xor(sa, 4);
            st[0] = st[0] * w0[0] + sa * b0[0] + vi * k0[0]; st[1] = st[1] * w0[1] + sa * b0[1] + vi * k0[1]; st[2] = st[2] * w0[2] + sa * b0[2] + vi * k0[2]; st[3] = st[3] * w0[3] + sa * b0[3] + vi * k0[3];
            st[4] = st[4] * w1[0] + sa * b1[0] + vi * k1[0]; st[5] = st[5] * w1[1] + sa * b1[1] + vi * k1[1]; st[6] = st[6] * w1[2] + sa * b1[2] + vi * k1[2]; st[7] = st[7] * w1[3] + sa * b1[3] + vi * k1[3];
            float y = st[0] * r0[0] + st[1] * r0[1] + st[2] * r0[2] + st[3] * r0[3] + st[4] * r1[0] + st[5] * r1[1] + st[6] * r1[2] + st[7] * r1[3];
            y += __shfl_xor(y, 1); y += __shfl_xor(y, 2); y += __shfl_xor(y, 4);
            if (jp == 0) Ly[t * 64 + i] = y;
        }
        __syncthreads();
        { const int lo = et * 64 + ep * 8;
            const f32x4 y0 = *(const f32x4*)(Ly + lo), y1 = *(const f32x4*)(Ly + lo + 4), r0 = *(const f32x4*)(Lr + lo), r1 = *(const f32x4*)(Lr + lo + 4), k0 = *(const f32x4*)(Lk + lo), k1 = *(const f32x4*)(Lk + lo + 4),
                        v0 = *(const f32x4*)(Lv + lo), v1 = *(const f32x4*)(Lv + lo + 4);
            const f32x4 rk0 = *(const f32x4*)(p.r_k + (size_t)l * 512 + h * 64 + ep * 8), rk1 = *(const f32x4*)(p.r_k + (size_t)l * 512 + h * 64 + ep * 8 + 4);
            float s = y0[0] + y0[1] + y0[2] + y0[3] + y1[0] + y1[1] + y1[2] + y1[3];
            float dot = r0[0] * k0[0] * rk0[0] + r0[1] * k0[1] * rk0[1] + r0[2] * k0[2] * rk0[2] + r0[3] * k0[3] * rk0[3] + r1[0] * k1[0] * rk1[0] + r1[1] * k1[1] * rk1[1] + r1[2] * k1[2] * rk1[2] + r1[3] * k1[3] * rk1[3];
            s += __shfl_xor(s, 1); s += __shfl_xor(s, 2); s += __shfl_xor(s, 4);
            dot += __shfl_xor(dot, 1); dot += __shfl_xor(dot, 2); dot += __shfl_xor(dot, 4);
            const float mean = s * (1.f / 64.f);
            const f32x4 d0 = y0 - mean, d1 = y1 - mean;
            float q = d0[0] * d0[0] + d0[1] * d0[1] + d0[2] * d0[2] + d0[3] * d0[3] + d1[0] * d1[0] + d1[1] * d1[1] + d1[2] * d1[2] + d1[3] * d1[3];
            q += __shfl_xor(q, 1); q += __shfl_xor(q, 2); q += __shfl_xor(q, 4);
            const float rstd = rsqrtf(q * (1.f / 64.f) + 64e-5f);
            const f32x4 g0 = *(const f32x4*)(p.lnx_g + (size_t)l * 512 + h * 64 + ep * 8), g1 = *(const f32x4*)(p.lnx_g + (size_t)l * 512 + h * 64 + ep * 8 + 4),
                        e0 = *(const f32x4*)(p.lnx_b + (size_t)l * 512 + h * 64 + ep * 8), e1 = *(const f32x4*)(p.lnx_b + (size_t)l * 512 + h * 64 + ep * 8 + 4);
            bf16_t* zp = Z + tg * NZ + 1024 + h * 64 + ep * 8; const u32x4 zu = *(const u32x4*)zp;
            const f32x4 o0 = d0 * rstd * g0 + e0 + v0 * dot, o1 = d1 * rstd * g1 + e1 + v1 * dot;
            u32x4 w; w.x = cvt_pk_bf16(o0[0] * siluf_(bf_lo(zu.x)), o0[1] * siluf_(bf_hi(zu.x))); w.y = cvt_pk_bf16(o0[2] * siluf_(bf_lo(zu.y)), o0[3] * siluf_(bf_hi(zu.y)));
            w.z = cvt_pk_bf16(o1[0] * siluf_(bf_lo(zu.z)), o1[1] * siluf_(bf_hi(zu.z))); w.w = cvt_pk_bf16(o1[2] * siluf_(bf_lo(zu.w)), o1[3] * siluf_(bf_hi(zu.w)));
            *(u32x4*)zp = w; }
    }
}


constexpr int MS = 72;
__device__ __forceinline__ f32x4 nt_tile(const bf16_t* Am, int arow, const bf16_t* Bm, int brow, f32x4 acc, int fq) {
    acc = MFMA(ld_frag(Am + arow * MS + fq * 8), ld_frag(Bm + brow * MS + fq * 8), acc);
    acc = MFMA(ld_frag(Am + arow * MS + 32 + fq * 8), ld_frag(Bm + brow * MS + 32 + fq * 8), acc);
    return acc;
}
#if PROBE_SCAN
#define CHKF_OLD(ptr, n, bit) do { unsigned _c = 0u; for (int _i = tid; _i < (n); _i += NTHREADS) { const float _a = (ptr)[_i]; if (!(fabsf(_a) < 1e30f)) _c = (bit); } if (_c) atomicOr((unsigned*)(p.ws + WS_END + 5 * MiB), _c); } while (0)
#define CHKB_OLD(ptr, bit) do { unsigned _c = 0u; for (int _i = tid; _i < 4096; _i += NTHREADS) { const float _a = bf2f((ptr)[(_i >> 6) * MS + (_i & 63)]); if (!(fabsf(_a) < 1e30f)) _c = (bit); } if (_c) atomicOr((unsigned*)(p.ws + WS_END + 5 * MiB), _c); } while (0)
#endif
#define CHKF(ptr, n, bit)
#define CHKB(ptr, bit)
struct ChunkIn { u32x4 ur, uk, uv, ukk, ub; f32x4 lwa, lwb; };
__device__ __forceinline__ void chunk_load(const Params& p, int item, ChunkIn& in, int tid) {
    const int bh = item >> 6, ck = item & 63, b = bh >> 3, h = bh & 7;
    const size_t tok0 = (size_t)b * SEQ + ck * 64;
    const unsigned char* r2 = p.ws + OFF_R2; const float* LWg = (const float*)(r2 + R2_LW);
    const int t = tid & 63, j0 = (tid >> 6) * 8; const size_t o = (tok0 + t) * 512 + h * 64 + j0;
    in.ur = *(const u32x4*)((const bf16_t*)(r2 + R2_R) + o); in.uk = *(const u32x4*)((const bf16_t*)(r2 + R2_K) + o); in.uv = *(const u32x4*)((const bf16_t*)(r2 + R2_V) + o);
    in.ukk = *(const u32x4*)((const bf16_t*)(r2 + R2_KK) + o); in.ub = *(const u32x4*)((const bf16_t*)(r2 + R2_B) + o);
    in.lwa = *(const f32x4*)(LWg + o); in.lwb = *(const f32x4*)(LWg + o + 4);
}
__device__ __forceinline__ void chunk_item(const Params& p, int item, int next_item, ChunkIn& in, unsigned char* lds) {
    const int tid = tid_l(), lane = tid & 63, wave = __builtin_amdgcn_readfirstlane(tid >> 6), fr = lane & 15, fq = lane >> 4;
    const int bh = item >> 6, ck = item & 63, b = bh >> 3, h = bh & 7;
    const size_t tok0 = (size_t)b * SEQ + ck * 64;
    const unsigned char* r2 = p.ws + OFF_R2; unsigned char* r1 = p.ws + OFF_R1;
    float* CUM = (float*)lds; float* TF = CUM + 4096; float* XB = TF + 4096; float* TOT = XB + 1024;
    bf16_t* MB = (bf16_t*)(lds + 38912);
    bf16_t *AT_ = MB, *BT_ = MB + 1 * 64 * MS, *KT_ = MB + 2 * 64 * MS, *RT_ = MB + 3 * 64 * MS, *ATT = MB + 4 * 64 * MS, *VT = MB + 5 * 64 * MS, *KHT = MB + 6 * 64 * MS, *BHT = MB + 7 * 64 * MS,
           *MAK = MB + 8 * 64 * MS, *MRB = MB + 9 * 64 * MS, *MRK = MB + 10 * 64 * MS, *TB = MB + 11 * 64 * MS;
    bf16_t *MVT = AT_, *TAT = BT_, *W1T = KT_;
    const float* LWg = (const float*)(r2 + R2_LW);
    __syncthreads();
    { const int t = tid & 63, j0 = (tid >> 6) * 8;
        const u32x4 ur = in.ur, uk = in.uk, uv = in.uv, ukk = in.ukk, ub = in.ub; const float lwl[8] = {in.lwa[0], in.lwa[1], in.lwa[2], in.lwa[3], in.lwb[0], in.lwb[1], in.lwb[2], in.lwb[3]};
        float cml[8], cCl[8];
#pragma unroll
        for (int e = 0; e < 8; ++e) cml[e] = lwl[e];
#pragma unroll
        for (int d = 1; d < 64; d <<= 1)
#pragma unroll
            for (int e = 0; e < 8; ++e) { const float o2 = __shfl_up(cml[e], d); cml[e] += (t >= d) ? o2 : 0.f; }
#pragma unroll
        for (int e = 0; e < 8; ++e) cCl[e] = __shfl(cml[e], 63);
        const unsigned rr[4] = {ur.x, ur.y, ur.z, ur.w}, kr[4] = {uk.x, uk.y, uk.z, uk.w}, vr[4] = {uv.x, uv.y, uv.z, uv.w}, qr[4] = {ukk.x, ukk.y, ukk.z, ukk.w}, br[4] = {ub.x, ub.y, ub.z, ub.w};
        unsigned oa[4], ob[4], ok[4], orr[4];
#pragma unroll
        for (int e2 = 0; e2 < 4; ++e2) { float va[2], vb[2], vk[2], vrr[2];
#pragma unroll
            for (int hh = 0; hh < 2; ++hh) { const int e = 2 * e2 + hh;
                const float cm = cml[e], lwv = lwl[e], cC = cCl[e];
                const float rv = hh ? bf_hi(rr[e2]) : bf_lo(rr[e2]), kv = hh ? bf_hi(kr[e2]) : bf_lo(kr[e2]), vv = hh ? bf_hi(vr[e2]) : bf_lo(vr[e2]), qv = hh ? bf_hi(qr[e2]) : bf_lo(qr[e2]), bv = hh ? bf_hi(br[e2]) : bf_lo(br[e2]);
                const float en = __expf(-cm), eh = __expf(cC - cm);
                va[hh] = -qv * __expf(cm - lwv); vb[hh] = bv * en; vk[hh] = kv * en; vrr[hh] = rv * __expf(cm);
                ATT[(j0 + e) * MS + t] = f2bf(va[hh]); VT[(j0 + e) * MS + t] = f2bf(vv); KHT[(j0 + e) * MS + t] = f2bf(kv * eh); BHT[(j0 + e) * MS + t] = f2bf(bv * eh);
                if (t == 63) ((float*)(r1 + R1_PC))[(size_t)item * 64 + j0 + e] = __expf(cC); }
            oa[e2] = cvt_pk_bf16(va[0], va[1]); ob[e2] = cvt_pk_bf16(vb[0], vb[1]); ok[e2] = cvt_pk_bf16(vk[0], vk[1]); orr[e2] = cvt_pk_bf16(vrr[0], vrr[1]); }
        *(u32x4*)(AT_ + t * MS + j0) = (u32x4){oa[0], oa[1], oa[2], oa[3]}; *(u32x4*)(BT_ + t * MS + j0) = (u32x4){ob[0], ob[1], ob[2], ob[3]};
        *(u32x4*)(KT_ + t * MS + j0) = (u32x4){ok[0], ok[1], ok[2], ok[3]}; *(u32x4*)(RT_ + t * MS + j0) = (u32x4){orr[0], orr[1], orr[2], orr[3]};
    }
    if (next_item >= 0) chunk_load(p, next_item, in, tid);
    __syncthreads();
#pragma unroll 1
    for (int x = 0; x < 8; ++x) { const int q = wave * 8 + x, mat = q >> 4, tm = (q >> 2) & 3, tn = q & 3;
        const bf16_t* Am = (mat & 1) ? KT_ : BT_; const bf16_t* Bm = (mat & 2) ? RT_ : AT_;
        f32x4 acc = nt_tile(Am, tm * 16 + fr, Bm, tn * 16 + fr, (f32x4){0.f, 0.f, 0.f, 0.f}, fq);
        const int t = tn * 16 + fr, s0 = tm * 16 + fq * 4;
#pragma unroll
        for (int e = 0; e < 4; ++e) { const bool keep = (mat & 2) ? (s0 + e <= t) : (s0 + e < t); acc[e] = keep ? acc[e] : 0.f; }
        if (mat == 0) *(f32x4*)(CUM + t * 64 + s0) = acc;
        else { bf16_t* Om = (mat == 1) ? MAK : (mat == 2) ? MRB : MRK; *(u32x2*)(Om + t * MS + s0) = pack4(acc); }
    }
    __syncthreads();

    if (wave == 0) { const int base = (lane >> 5) * 32, c = lane & 31; float xv[32]; int roff = base * 65; float prev = 0.f;
#pragma unroll
        for (int t = 0; t < 32; ++t) { float a = (t == c) ? 1.f : 0.f;
            asm volatile("" : "+v"(roff), "+v"(prev));
            const float* Lr = CUM + roff + t * 64;
#pragma unroll
            for (int s2 = 0; s2 < t; ++s2) a += Lr[s2] * xv[s2];
            xv[t] = a; prev = a; }
#pragma unroll
        for (int t = 0; t < 32; ++t) { TF[(base + t) * 64 + base + c] = xv[t]; if (base == 0) TF[t * 64 + 32 + c] = 0.f; }
    } else {
#pragma unroll 1
        for (int q = wave - 1; q < 16; q += 7) { const int tm = q >> 2, tn = q & 3;
            const f32x4 acc = nt_tile(MAK, tm * 16 + fr, VT, tn * 16 + fr, (f32x4){0.f, 0.f, 0.f, 0.f}, fq);
            *(u32x2*)(MVT + (tn * 16 + fr) * MS + tm * 16 + fq * 4) = pack4(acc); }
    }
    __syncthreads();
    { const int r = tid >> 4, c0 = (tid & 15) * 2; float x0 = 0.f, x1 = 0.f;
#pragma unroll 8
        for (int k = 0; k < 32; ++k) { const float lv = CUM[(32 + r) * 64 + k]; x0 += lv * TF[k * 64 + c0]; x1 += lv * TF[k * 64 + c0 + 1]; }
        XB[r * 32 + c0] = x0; XB[r * 32 + c0 + 1] = x1;
        __syncthreads();
        float y0 = 0.f, y1 = 0.f;
#pragma unroll 8
        for (int k = 0; k < 32; ++k) { const float tv = TF[(32 + r) * 64 + 32 + k]; y0 += tv * XB[k * 32 + c0]; y1 += tv * XB[k * 32 + c0 + 1]; }
        TF[(32 + r) * 64 + c0] = y0; TF[(32 + r) * 64 + c0 + 1] = y1;
    }
    __syncthreads();
    { const int t = tid >> 3, s0 = (tid & 7) * 8; const f32x4 a = *(const f32x4*)(TF + t * 64 + s0), b2 = *(const f32x4*)(TF + t * 64 + s0 + 4);
        u32x4 w; w.x = cvt_pk_bf16(a[0], a[1]); w.y = cvt_pk_bf16(a[2], a[3]); w.z = cvt_pk_bf16(b2[0], b2[1]); w.w = cvt_pk_bf16(b2[2], b2[3]);
        *(u32x4*)(TB + t * MS + s0) = w; }
    __syncthreads();
#pragma unroll 1
    for (int x = 0; x < 2; ++x) { const int q = wave * 2 + x, tm = q >> 2, tn = q & 3;
        const f32x4 acc = nt_tile(TB, tm * 16 + fr, ATT, tn * 16 + fr, (f32x4){0.f, 0.f, 0.f, 0.f}, fq);
        *(u32x2*)(TAT + (tn * 16 + fr) * MS + tm * 16 + fq * 4) = pack4(acc); }
    __syncthreads();
#pragma unroll 1
    for (int x = 0; x < 2; ++x) { const int q = wave * 2 + x, tm = q >> 2, tn = q & 3;
        const f32x4 acc = nt_tile(TB, tm * 16 + fr, MVT, tn * 16 + fr, (f32x4){0.f, 0.f, 0.f, 0.f}, fq);
        *(u32x2*)(W1T + (tn * 16 + fr) * MS + tm * 16 + fq * 4) = pack4(acc); }
    __syncthreads();
#pragma unroll 1
    for (int x = 0; x < 8; ++x) { const int q = wave * 8 + x, o = q >> 4, tm = (q >> 2) & 3, tn = q & 3;
        const int ar = tm * 16 + fr, br_ = tn * 16 + fr; f32x4 acc = (f32x4){0.f, 0.f, 0.f, 0.f};
        if (o == 0) acc = nt_tile(TAT, ar, BHT, br_, acc, fq);
        else if (o == 1) { acc = unpack4(*(const u32x2*)(RT_ + br_ * MS + tm * 16 + fq * 4)); acc = nt_tile(TAT, ar, MRB, br_, acc, fq); }
        else if (o == 2) { acc = nt_tile(KHT, ar, VT, br_, acc, fq); acc = nt_tile(BHT, ar, W1T, br_, acc, fq); }
        else { acc = nt_tile(VT, ar, MRK, br_, acc, fq);
#if EXP_CONSTY
            acc = (f32x4){1.f, 2.f, 3.f, 4.f};
#endif
#if !EXP_NOW1
            acc = nt_tile(W1T, ar, MRB, br_, acc, fq);
#endif
        }
        bf16_t* og = (bf16_t*)(r1 + (size_t)o * 16 * MiB) + (size_t)item * 4096 + br_ * 64 + tm * 16 + fq * 4;
        *(u32x2*)og = pack4(acc); }
}

__device__ __forceinline__ void seq_compute(const unsigned char* bufp, bf16_t* SB, float* yb, f32x4 (&Sacc)[4], int wave, int fr, int fq) {
    const bf16_t* GP = (const bf16_t*)bufp; const bf16_t* RA = GP + 64 * MS; const bf16_t* HT = RA + 64 * MS; const bf16_t* YQ = HT + 64 * MS; const float* PC = (const float*)(bufp + 4 * 64 * MS * 2);
    const bf16x8 sf0 = ld_frag(SB + fr * MS + fq * 8), sf1 = ld_frag(SB + fr * MS + 32 + fq * 8);
#pragma unroll
    for (int tt = 0; tt < 4; ++tt) { f32x4 y = unpack4(*(const u32x2*)(YQ + (tt * 16 + fr) * MS + wave * 16 + fq * 4));
        y = MFMA(sf0, ld_frag(RA + (tt * 16 + fr) * MS + fq * 8), y); y = MFMA(sf1, ld_frag(RA + (tt * 16 + fr) * MS + 32 + fq * 8), y);
        *(f32x4*)(yb + (tt * 16 + fr) * 64 + wave * 16 + fq * 4) = y; }
#pragma unroll
    for (int jt = 0; jt < 4; ++jt) { const f32x4 pc = *(const f32x4*)(PC + jt * 16 + fq * 4);
        f32x4 a = unpack4(*(const u32x2*)(HT + (wave * 16 + fr) * MS + jt * 16 + fq * 4)) + Sacc[jt] * pc;
        a = MFMA(ld_frag(GP + (jt * 16 + fr) * MS + fq * 8), sf0, a); a = MFMA(ld_frag(GP + (jt * 16 + fr) * MS + 32 + fq * 8), sf1, a);
        Sacc[jt] = a; }
#pragma unroll
    for (int jt = 0; jt < 4; ++jt) *(u32x2*)(SB + fr * MS + jt * 16 + fq * 4) = pack4(Sacc[jt]);
}
__device__ __forceinline__ void seq_epilogue(const Params& p, int l, const float* yb, float dot, u32x4 vu, u32x4 zu, bf16_t* zp, int ch) {
    const f32x4 y0 = *(const f32x4*)yb, y1 = *(const f32x4*)(yb + 4);
    float s1 = y0[0] + y0[1] + y0[2] + y0[3] + y1[0] + y1[1] + y1[2] + y1[3];
    s1 += __shfl_xor(s1, 1); s1 += __shfl_xor(s1, 2); s1 += __shfl_xor(s1, 4);
    const float mean = s1 * (1.f / 64.f); const f32x4 d0 = y0 - mean, d1 = y1 - mean;
    float s2 = d0[0] * d0[0] + d0[1] * d0[1] + d0[2] * d0[2] + d0[3] * d0[3] + d1[0] * d1[0] + d1[1] * d1[1] + d1[2] * d1[2] + d1[3] * d1[3];
    s2 += __shfl_xor(s2, 1); s2 += __shfl_xor(s2, 2); s2 += __shfl_xor(s2, 4);
    const float rstd = rsqrtf(s2 * (1.f / 64.f) + 64e-5f);
    const f32x4 g0 = *(const f32x4*)(p.lnx_g + (size_t)l * 512 + ch), g1 = *(const f32x4*)(p.lnx_g + (size_t)l * 512 + ch + 4), e0 = *(const f32x4*)(p.lnx_b + (size_t)l * 512 + ch), e1 = *(const f32x4*)(p.lnx_b + (size_t)l * 512 + ch + 4);
    const f32x4 v0 = (f32x4){bf_lo(vu.x), bf_hi(vu.x), bf_lo(vu.y), bf_hi(vu.y)}, v1 = (f32x4){bf_lo(vu.z), bf_hi(vu.z), bf_lo(vu.w), bf_hi(vu.w)};
    const f32x4 o0 = d0 * rstd * g0 + e0 + v0 * dot, o1 = d1 * rstd * g1 + e1 + v1 * dot;
    u32x4 w; w.x = cvt_pk_bf16(o0[0] * siluf_(bf_lo(zu.x)), o0[1] * siluf_(bf_hi(zu.x))); w.y = cvt_pk_bf16(o0[2] * siluf_(bf_lo(zu.y)), o0[3] * siluf_(bf_hi(zu.y)));
    w.z = cvt_pk_bf16(o1[0] * siluf_(bf_lo(zu.z)), o1[1] * siluf_(bf_hi(zu.z))); w.w = cvt_pk_bf16(o1[2] * siluf_(bf_lo(zu.w)), o1[3] * siluf_(bf_hi(zu.w)));
    *(u32x4*)zp = w;
}
__device__ __forceinline__ void seq_item(const Params& p, int l, int bh, unsigned char* lds, bf16_t* dstp, int dst_ld, size_t dst_tok0) {
    const int tid = tid_l(), lane = tid & 63, wave = __builtin_amdgcn_readfirstlane(tid >> 6), fr = lane & 15, fq = lane >> 4;
    const int b = bh >> 3, h = bh & 7;
    const unsigned char* r1 = p.ws + OFF_R1;
    constexpr int BUFB = 4 * 64 * MS * 2 + 256;
    bf16_t* SB = (bf16_t*)(lds + 2 * BUFB) + wave * 16 * MS;
    float* YB = (float*)(lds + 2 * BUFB + 4 * 16 * MS * 2);
    const int srow = tid >> 3, sc8 = tid & 7;
    u32x4 preA[4], preB[4]; float pcA = 0.f, pcB = 0.f;
#define SEQ_LOAD(PRE, PC, CI) do { const size_t _ci = (CI); _Pragma("unroll") for (int m = 0; m < 4; ++m) PRE[m] = *(const u32x4*)((const bf16_t*)(r1 + (size_t)m * 16 * MiB) + _ci * 4096 + srow * 64 + sc8 * 8); \
        if (tid < 64) PC = ((const float*)(r1 + R1_PC))[_ci * 64 + tid]; } while (0)
#define SEQ_STORE(PRE, PC, BUFP) do { unsigned char* _b = (BUFP); _Pragma("unroll") for (int m = 0; m < 4; ++m) *(u32x4*)((bf16_t*)_b + m * 64 * MS + srow * MS + sc8 * 8) = PRE[m]; \
        if (tid < 64) ((float*)(_b + 4 * 64 * MS * 2))[tid] = PC; } while (0)
    __syncthreads();
    SEQ_LOAD(preA, pcA, (size_t)bh * 64);
    SEQ_LOAD(preB, pcB, (size_t)bh * 64 + 1);
    SEQ_STORE(preA, pcA, lds);
    if (wave < 4) { for (int e = lane; e < 16 * MS / 2; e += 64) ((unsigned*)SB)[e] = 0u; }
    __syncthreads();
    f32x4 Sacc[4];
#pragma unroll
    for (int jt = 0; jt < 4; ++jt) Sacc[jt] = (f32x4){0.f, 0.f, 0.f, 0.f};
#define SEQ_ITER(C, PRE_NEXT, PC_NEXT, PRE_LOAD, PC_LOAD) do { const int c = (C); \
        if (c + 2 < 64) SEQ_LOAD(PRE_LOAD, PC_LOAD, (size_t)bh * 64 + c + 2); \
        const int et = tid >> 3, eq = tid & 7; const size_t tg = (size_t)b * SEQ + c * 64 + et; const int ch = h * 64 + eq * 8; \
        const float dot = ((const float*)(p.ws + OFF_DOT))[tg * 8 + h]; \
        const u32x4 vu = *(const u32x4*)((const bf16_t*)(p.ws + OFF_R2 + R2_V) + tg * 512 + ch); \
        const u32x4 zu = *(const u32x4*)((const bf16_t*)(p.ws + OFF_Z) + tg * NZ + 1024 + ch); \
        if (wave < 4) seq_compute(lds + (c & 1) * BUFB, SB, YB + (c & 1) * 4096, Sacc, wave, fr, fq); \
        if (c + 1 < 64) SEQ_STORE(PRE_NEXT, PC_NEXT, lds + ((c + 1) & 1) * BUFB); \
        __syncthreads(); \
        seq_epilogue(p, l, YB + (c & 1) * 4096 + et * 64 + eq * 8, dot, vu, zu, dstp + (tg - dst_tok0) * dst_ld + ch, ch); } while (0)
#pragma unroll 1
    for (int c2 = 0; c2 < 64; c2 += 2) { SEQ_ITER(c2, preB, pcB, preA, pcA); SEQ_ITER(c2 + 1, preA, pcA, preB, pcB); }
#undef SEQ_ITER
#undef SEQ_LOAD
#undef SEQ_STORE
}

#define XB_TMO      128
#define XB_XCNT(j)  (256  + 64 * (j))
#define XB_XSUB(j)  (1280 + 64 * (j))
#define XB_XGEN(j)  (2304 + 64 * (j))
#define XB_TOP      3328
#define XB_TOPGEN   3392
#define XCD_BAR_WORDS 3456
#define XB_SPIN_CAP (1u << 18)

__device__ __forceinline__ unsigned xb_ld(unsigned* p)              { return __hip_atomic_load(p, __ATOMIC_RELAXED, __HIP_MEMORY_SCOPE_AGENT); }
__device__ __forceinline__ unsigned xb_add(unsigned* p, unsigned v) { return __hip_atomic_fetch_add(p, v, __ATOMIC_RELAXED, __HIP_MEMORY_SCOPE_AGENT); }
__device__ __forceinline__ unsigned xb_xcc_id() { return (unsigned)__builtin_amdgcn_s_getreg((3 << 11) | 20) & 0xFu; }
#define XB_SPIN(cond, bar) do { unsigned _sp = 0; while (cond) { __builtin_amdgcn_s_sleep(1); \
    if ((++_sp & 255u) == 0u) { if (xb_ld(&(bar)[XB_TMO])) break; if (_sp > XB_SPIN_CAP) { atomicAdd(&(bar)[XB_TMO], 1u); break; } } } } while (0)

struct XcdBarrier {
    unsigned* bar; unsigned x;
    volatile LAS unsigned* st;
};

__device__ __forceinline__ XcdBarrier xcd_barrier_post(unsigned* bar, volatile LAS unsigned* st) {
    XcdBarrier b; b.bar = bar; b.x = xb_xcc_id(); b.st = st;
    if (threadIdx.x == 0) (void)xb_add(&bar[XB_XCNT(b.x)], 1u);
    return b;
}
__device__ __forceinline__ void xcd_barrier_complete(unsigned* bar, unsigned x, unsigned& nloc, unsigned& nx) {
    const unsigned G = gridDim.x * gridDim.y * gridDim.z;
    unsigned sum, cnt, mine, sp = 0u;
    for (;;) {
        sum = 0u; cnt = 0u; mine = 0u;
#pragma unroll
        for (unsigned j = 0; j < 16; ++j) { const unsigned c = xb_ld(&bar[XB_XCNT(j)]); sum += c; cnt += (c > 0u) ? 1u : 0u; mine = (j == x) ? c : mine; }
        if (sum == G) break;
        __builtin_amdgcn_s_sleep(1);
        if ((++sp & 255u) == 0u) { if (xb_ld(&bar[XB_TMO])) break; if (sp > XB_SPIN_CAP) { atomicAdd(&bar[XB_TMO], 1u); break; } }
    }
    nloc = mine > 0u ? mine : 1u; nx = cnt > 0u ? cnt : 1u;
}

__device__ __forceinline__ void xcd_barrier(const XcdBarrier& b) {
    asm volatile("s_waitcnt vmcnt(0)" ::: "memory");
    __syncthreads();
    if (threadIdx.x == 0) {
        unsigned* bar = b.bar;
        __builtin_amdgcn_s_waitcnt(0);
        unsigned nloc = b.st[0], nx = b.st[1];
        if (nloc == 0u) { xcd_barrier_complete(bar, b.x, nloc, nx); b.st[0] = nloc; b.st[1] = nx; }
        const unsigned old = xb_add(&bar[XB_XSUB(b.x)], 1u);
        const unsigned gen = old / nloc;
        if (old + 1u == (gen + 1u) * nloc) {
            __builtin_amdgcn_fence(__ATOMIC_RELEASE, "agent");
            asm volatile("s_waitcnt vmcnt(0)" ::: "memory");
            const unsigned og = xb_add(&bar[XB_TOP], 1u);
            const unsigned tg = og / nx;
            if (og + 1u == (tg + 1u) * nx) xb_add(&bar[XB_TOPGEN], 1u);
            else XB_SPIN(xb_ld(&bar[XB_TOPGEN]) == tg, bar);
            __builtin_amdgcn_fence(__ATOMIC_ACQUIRE, "agent");
            xb_add(&bar[XB_XGEN(b.x)], 1u);
            asm volatile("s_waitcnt vmcnt(0)" ::: "memory");
        } else {
            XB_SPIN(xb_ld(&bar[XB_XGEN(b.x)]) == gen, bar);
            __builtin_amdgcn_fence(__ATOMIC_ACQUIRE, "agent");
            asm volatile("s_waitcnt vmcnt(0)" ::: "memory");
        }
    }
    __syncthreads();
}


constexpr int PH_PER_LAYER = 7, PH_PRE = 3, N_PHASES = PH_PRE + NL * PH_PER_LAYER;
__global__ void __launch_bounds__(NTHREADS, 2) trunk_fwd(Params p0) {
    extern __shared__ __attribute__((aligned(16))) unsigned char lds[];
    const int G = gridDim.x, bx = blockIdx.x;
    Params p = p0;
    volatile LAS unsigned* xb_st = (volatile LAS unsigned*)((LAS unsigned char*)lds + (LDS_BYTES - 16));
    if (threadIdx.x == 0) { xb_st[0] = 0u; xb_st[1] = 0u; }
    XcdBarrier xbar; xbar.bar = nullptr; xbar.x = 0; xbar.st = xb_st;
    __syncthreads();
#if EXP_ZERO
    for (int i = threadIdx.x; i < LDS_BYTES / 4; i += NTHREADS) ((unsigned*)lds)[i] = 0u;
    __syncthreads();
    if (p0.ph_lo == 0) { u32x4* z = (u32x4*)(p0.ws + OFF_DOT); const size_t n = (WS_END - OFF_DOT) / 16;
        for (size_t i = (size_t)bx * NTHREADS + threadIdx.x; i < n; i += (size_t)G * NTHREADS) z[i] = (u32x4){0u, 0u, 0u, 0u}; }
#endif
    for (int ph = p0.ph_lo; ph < p0.ph_hi; ++ph) {
        unsigned char* ws = ptr_l(p0.ws); p.ws = ws;
#if TS_K >= 0
        if (bx == 0 && threadIdx.x == 0) ((unsigned long long*)(ws + WS_END + 32768))[ph] = __builtin_amdgcn_s_memrealtime();
#endif
        if (ph == 0) { if (PHEN & 1) for (int rep = 0; rep < REP_P0; ++rep) phase0a(p, lds); }
        else if (ph == 1) { phase_modt(p); }
        else if (ph == 2) { if (PHEN & 2) phase0b(p); }
        else {
            const int l = (ph - PH_PRE) / PH_PER_LAYER, k = (ph - PH_PRE) % PH_PER_LAYER;
            if (k == 0 && (PHEN & 4)) for (int rep = 0; rep < REP_IN; ++rep) {
                pg8::Gemm g{(const bf16_t*)(ws + OFF_H), (const bf16_t*)(ws + OFF_WIN + l * SZ_WIN), DM, DM, DM};
                pg8::PlainOrder S; S.init(M_TOK / 256, NIN / 256, G, bx);
                pg8::EpiIn E{(bf16_t*)(ws + OFF_R1), (bf16_t*)(ws + OFF_Z)};
                pg8::gemm_phase(( LAS unsigned char*)lds, g, S, E);
            } else if (k == 1 && (PHEN & 8)) {
                for (int it = bx; it < 640; it += G) {
                    if (it < 128) { if (PHEN & 512) { for (int rep = 1; rep < REP_GM; ++rep) gmlp_item(p, l, it, lds, false); gmlp_item(p, l, it, lds); } }
                    else if (it < 384) { if (PHEN & 1024) for (int rep = 0; rep < REP_MLA; ++rep) mla_prep_item(p, l, it - 128, lds); }
                    else { if (PHEN & 2048) for (int rep = 0; rep < REP_RW; ++rep) rwkv_prep_item(p, l, it - 384, lds); }
                }
            } else if (k == 2 && (PHEN & 16)) {
                for (int rep = 0; rep < REP_CHUNK; ++rep) { ChunkIn cin; chunk_load(p, bx & 2047, cin, tid_l());
                    for (int it = bx; it < 2048; it += G) chunk_item(p, it, (it + G < 2048) ? it + G : -1, cin, lds); }
            } else if (k == 3 && (PHEN & 16)) {
#if !USE_CHUNK
                for (int it = bx; it < 32; it += G) scan_item(p, l, it, lds);
#elif PROBE_SCAN
                for (int it = bx; it < 32; it += G) { if (l == 0 && it < 8) seq_item(p, l, it, lds, (bf16_t*)(ws + WS_END), 512, 0); scan_item(p, l, it, lds); }
#else
                for (int it = bx; it < 32; it += G) { if (PHEN & 8192) seq_item(p, l, it, lds, (bf16_t*)(ws + OFF_Z) + 1024, NZ, 0); }
#endif
                {
                    unsigned* ctr = (unsigned*)(ptr_l(p0.ws) + WS_END + 16384) + l * 16;
                    volatile LAS unsigned* slot = (volatile LAS unsigned*)((LAS unsigned char*)lds + (LDS_BYTES - 8));
                    for (;;) {
                        __syncthreads();
                        if (tid_l() == 0) *slot = __hip_atomic_fetch_add(ctr, 1u, __ATOMIC_RELAXED, __HIP_MEMORY_SCOPE_AGENT);
                        __syncthreads();
                        const unsigned i = *slot;
                        if (i >= 512u) break;
                        const int qb = 15 - (int)(i >> 5), bh = (int)(i & 31);
                        attn_item(p, bh >> 3, bh & 7, qb, lds);
                    }
                }
            } else if (k == 4 && (PHEN & 32)) {
                { pg8::Gemm g{(const bf16_t*)(ws + OFF_H), (const bf16_t*)(ws + OFF_WG + l * SZ_WG), DM, DM, DM};
                    pg8::GateOrder S; S.init(M_TOK / 256, DM / 256, G, bx);
                    pg8::EpiPlain<1> E{(bf16_t*)(ws + OFF_R2), NG};
                    pg8::gemm_phase((LAS unsigned char*)lds, g, S, E); }
                { pg8::Gemm g{(const bf16_t*)(ws + OFF_Z), (const bf16_t*)(ws + OFF_WBR + l * SZ_WBR), NZ, 512, 512};
                    pg8::MergeOrder S; S.init(M_TOK / 256, DM / 256, G, bx);
                    pg8::EpiMerge E{(bf16_t*)(ws + OFF_R3 + R3_MERGED), (const bf16_t*)(ws + OFF_R2)};
                    pg8::gemm_phase((LAS unsigned char*)lds, g, S, E); }
            } else if (k == 5 && (PHEN & 128)) {
                pg8::Gemm g{(const bf16_t*)(ws + OFF_R3 + R3_MERGED), (const bf16_t*)(ws + OFF_WOUT + l * SZ_WOUT), DM, DM, DM};
                pg8::PlainOrder S; S.init(M_TOK / 256, DM / 256, G, bx);
                pg8::EpiPlain<0> E{(bf16_t*)(ws + OFF_R3 + R3_Y), DM};
                pg8::gemm_phase((LAS unsigned char*)lds, g, S, E);
            } else if (k == 6 && (PHEN & 256)) {
                phase_final(p, l);
            }
        }
#if PROBE_SCAN
        if (ph == N_PHASES - 1 && bx == 0 && threadIdx.x == 0) { const unsigned cd = *(volatile unsigned*)(ws + WS_END + 5 * MiB); p.out[5] = 1000.f * (float)cd; }
        if (ph == 0 && bx == 0 && threadIdx.x == 0) *(unsigned*)(ws + WS_END + 5 * MiB) = 0u;
#endif
#if TS_K >= 0
        if (ph == N_PHASES - 1 && bx == 0 && threadIdx.x == 0) { unsigned long long* ts = (unsigned long long*)(ws + WS_END + 32768); const unsigned long long tend = __builtin_amdgcn_s_memrealtime(); unsigned long long sum = 0;
            if (TS_K < 8) { for (int l2 = 0; l2 < NL; ++l2) { const int a = PH_PRE + l2 * PH_PER_LAYER + TS_K; sum += ((a + 1 < N_PHASES) ? ts[a + 1] : tend) - ts[a]; } }
            else sum = ts[PH_PRE] - ts[0];
            p.out[5] = 10.f * (float)sum; }
#endif
        if (ph + 1 < p0.ph_hi) {
            if (ph == p0.ph_lo) {
                if (bx == 0) { const int tz = tid_l(); if (tz < 64) __hip_atomic_store((unsigned*)(ptr_l(p0.ws) + WS_END + 16384) + tz, 0u, __ATOMIC_RELAXED, __HIP_MEMORY_SCOPE_AGENT); }
                if (bx == 0) { unsigned* zb = (unsigned*)ptr_l(p0.ws + WS_END); for (int i = tid_l(); i < XCD_BAR_WORDS; i += NTHREADS) __hip_atomic_store(zb + i, 0u, __ATOMIC_RELAXED, __HIP_MEMORY_SCOPE_AGENT); }
                cg::this_grid().sync();
                xbar = xcd_barrier_post((unsigned*)ptr_l(p0.ws + WS_END), xb_st);
            } else { XcdBarrier b2; b2.bar = (unsigned*)ptr_l(p0.ws + WS_END); b2.x = xbar.x; b2.st = xb_st; xcd_barrier(b2); }
        }
    }
}

extern "C" void kernel_launch(void* const* d_in, const int* in_sizes, int n_in, void* d_out, int out_size, void* d_ws, size_t ws_size, hipStream_t stream) {
    static int grid = 0;
    if (grid == 0) {
        if (n_in != 31 || out_size != M_TOK * DM || ws_size < WS_END + 65536) { fprintf(stderr, "kernel_launch: unexpected shapes (n_in %d out %d ws %zu)\n", n_in, out_size, ws_size); grid = -1; return; }
        int dev = 0, cus = 0, per_cu = 0;
        hipGetDevice(&dev); hipDeviceGetAttribute(&cus, hipDeviceAttributeMultiprocessorCount, dev);
        hipFuncSetAttribute((const void*)trunk_fwd, hipFuncAttributeMaxDynamicSharedMemorySize, LDS_BYTES);
        hipOccupancyMaxActiveBlocksPerMultiprocessor(&per_cu, (const void*)trunk_fwd, NTHREADS, LDS_BYTES);
        if (per_cu < 1) { fprintf(stderr, "kernel_launch: occupancy query says %d blocks per CU\n", per_cu); grid = -1; return; }
        grid = cus * 1;
    }
    if (grid < 0) return;
    Params p{};
    p.x = (const float*)d_in[0]; p.c = (const float*)d_in[1]; p.pos = (const int*)d_in[2]; p.pre_g = (const float*)d_in[3]; p.post_g = (const float*)d_in[4];
    p.w_ada = (const float*)d_in[5]; p.b_ada = (const float*)d_in[6]; p.w_in = (const float*)d_in[7]; p.q_norm = (const float*)d_in[8]; p.w_uq = (const float*)d_in[9];
    p.kv_norm = (const float*)d_in[10]; p.w_ukv = (const float*)d_in[11]; p.ln_g = (const float*)d_in[12]; p.ln_b = (const float*)d_in[13]; p.w_s = (const float*)d_in[14]; p.b_s = (const float*)d_in[15];
    p.mu = (const float*)d_in[16]; p.w0 = (const float*)d_in[17]; p.w2 = (const float*)d_in[18]; p.a0 = (const float*)d_in[19]; p.a2 = (const float*)d_in[20]; p.k_k = (const float*)d_in[21];
    p.k_a = (const float*)d_in[22]; p.r_k = (const float*)d_in[23]; p.lnx_g = (const float*)d_in[24]; p.lnx_b = (const float*)d_in[25]; p.v0 = (const float*)d_in[26]; p.v1 = (const float*)d_in[27];
    p.v2 = (const float*)d_in[28]; p.w_br = (const float*)d_in[29]; p.w_out = (const float*)d_in[30];
    p.out = (float*)d_out; p.ws = (unsigned char*)d_ws;
#if ONE_LAUNCH
    p.ph_lo = 0; p.ph_hi = N_PHASES;
    void* args[] = {&p};
    hipError_t e = hipLaunchCooperativeKernel((const void*)trunk_fwd, dim3(grid), dim3(NTHREADS), args, LDS_BYTES, stream);
    if (e != hipSuccess) fprintf(stderr, "cooperative launch failed: %s (grid %d)\n", hipGetErrorString(e), grid);
#else
    for (int ph = 0; ph < N_PHASES; ++ph) { p.ph_lo = ph; p.ph_hi = ph + 1;
        hipLaunchKernelGGL(trunk_fwd, dim3(grid), dim3(NTHREADS), LDS_BYTES, stream, p); }
#endif
}
```
